# Optimizing an MI355X kernel written in HIP

```python
import jax
import jax.numpy as jnp
from jax import lax
import numpy as np

D_MODEL = 2048
BATCH = 1
SEQ = 16384
DEPTH = 2

NSA_HEADS = 8
NSA_GROUPS = 2
NSA_HPG = NSA_HEADS // NSA_GROUPS
NSA_DH = 64
CMP_LEN = 32
CMP_STRIDE = 16
CMP_HIDDEN = 128
SEL_LEN = 64
SEL_TOPN = 16
WINDOW = 512
FORCE_SCORE = 1.0e4
POOL_GROUPS = 4
POOL_WINDOWS = (2, 4, 8, 16)
POOL_WIDTH = 512
POOL_GW = POOL_WIDTH // POOL_GROUPS
MLA_HEADS = 8
MLA_Q_RANK = 512
MLA_KV_RANK = 256
MLA_NOPE = 64
MLA_ROPE = 32
MLA_DV = 64
ROPE_BASE = 10000.0
CONV_CH = 512
CONV_K = 31
N_BRANCH = 4
X_HEADS = 4
X_DH = 128
MEM_LEN = 256
MOE_GROUPS = 4
MOE_EPG = 8
N_EXPERTS = MOE_GROUPS * MOE_EPG
MOE_TOPK = 2
EXPERT_FF = 512
MOE_BLOCK = 256
Q_BLK = 128
LN_EPS = 1e-5
RMS_EPS = 1e-6
DN_ALPHA = (2 * DEPTH) ** 0.25
DN_BETA = (8 * DEPTH) ** -0.25
IN_SIZES = (NSA_HEADS * NSA_DH, 6 * NSA_GROUPS * NSA_DH, 3 * NSA_HEADS, POOL_WIDTH,
            MLA_Q_RANK, MLA_KV_RANK, MLA_ROPE, 2 * CONV_CH, N_BRANCH * D_MODEL)
IN_WIDTH = sum(IN_SIZES)

kernel_name = 'hybrid_nsa_pool_mla_conv_hmoe_block'


def _split(u, sizes):
    out, o = [], 0
    for s in sizes:
        out.append(u[..., o:o + s])
        o += s
    return out


def _layer_norm(x, g, b):
    xf = x.astype(jnp.float32)
    mu = jnp.mean(xf, -1, keepdims=True)
    var = jnp.mean(jnp.square(xf - mu), -1, keepdims=True)
    return ((xf - mu) * lax.rsqrt(var + LN_EPS) * g + b).astype(x.dtype)


def _rms_norm(x, g):
    xf = x.astype(jnp.float32)
    return (xf * lax.rsqrt(jnp.mean(xf * xf, -1, keepdims=True) + RMS_EPS) * g).astype(x.dtype)


def _rope(x, positions):
    half = x.shape[-1] // 2
    inv = ROPE_BASE ** (-jnp.arange(half, dtype=jnp.float32) / half)
    ang = positions.astype(jnp.float32)[..., None] * inv
    ang = ang.reshape(ang.shape[:2] + (1,) * (x.ndim - 3) + (half,))
    cos, sin = jnp.cos(ang), jnp.sin(ang)
    xf = x.astype(jnp.float32)
    x1, x2 = xf[..., :half], xf[..., half:]
    return jnp.concatenate([x1 * cos - x2 * sin, x2 * cos + x1 * sin], -1).astype(x.dtype)


def _masked_softmax(s, mask):
    s = jnp.where(mask, s.astype(jnp.float32), -jnp.inf)
    m = jnp.max(s, -1, keepdims=True)
    m = jnp.where(jnp.isfinite(m), m, 0.0)
    p = jnp.exp(s - m)
    return p / jnp.maximum(jnp.sum(p, -1, keepdims=True), 1e-30)


def _nsa(q, kv, gates, cmp_pos, cmp_w1, cmp_w2):
    B, S = q.shape[0], q.shape[1]
    f32 = jnp.float32
    n_cmp = (S - CMP_LEN) // CMP_STRIDE + 1
    n_sel = S // SEL_LEN
    top_n = min(SEL_TOPN, n_sel)
    span = CMP_LEN // CMP_STRIDE
    ratio = SEL_LEN // CMP_STRIDE
    k_cmp, v_cmp, k_sel, v_sel, k_win, v_win = [kv[:, :, j] for j in range(6)]
    tok = CMP_STRIDE * np.arange(n_cmp)[:, None] + np.arange(CMP_LEN)[None, :]

    def compress(t, j):
        blocks = t[:, tok] + cmp_pos[j][:, None, :]
        w1 = cmp_w1[j].reshape(CMP_LEN, NSA_DH, CMP_HIDDEN)
        hid = jax.nn.gelu(jnp.einsum('bnlgd,ldh->bngh', blocks, w1))
        return jnp.einsum('bngh,hd->bngd', hid, cmp_w2[j])

    kc = compress(k_cmp, 0)
    vc = compress(v_cmp, 1)
    cmp_last = CMP_STRIDE * jnp.arange(n_cmp) + CMP_LEN - 1
    ks_blk = k_sel.reshape(B, n_sel, SEL_LEN, NSA_GROUPS, NSA_DH).transpose(0, 3, 1, 2, 4)
    vs_blk = v_sel.reshape(B, n_sel, SEL_LEN, NSA_GROUPS, NSA_DH).transpose(0, 3, 1, 2, 4)
    pad = ((0, 0), (WINDOW, 0), (0, 0), (0, 0))
    kw_pad = jnp.pad(k_win, pad)
    vw_pad = jnp.pad(v_win, pad)
    b_ix = jnp.arange(B)[:, None, None, None]
    g_ix = jnp.arange(NSA_GROUPS)[None, None, :, None]
    blk_id = jnp.arange(n_sel)
    q_blocks = (q.astype(f32) * NSA_DH ** -0.5).reshape(
        B, S // Q_BLK, Q_BLK, NSA_GROUPS, NSA_HPG, NSA_DH)

    def one_block(i):
        t0 = i * Q_BLK
        tq = t0 + jnp.arange(Q_BLK)
        qi = q_blocks[:, i]
        s = jnp.einsum('btghd,bngd->btghn', qi, kc)
        p_cmp = _masked_softmax(s, (cmp_last[None, :] <= tq[:, None])[None, :, None, None, :])
        o_cmp = jnp.einsum('btghn,bngd->btghd', p_cmp, vc)
        imp = jnp.sum(p_cmp, 3)
        imp = jnp.pad(imp, ((0, 0), (0, 0), (0, 0), (span - 1, max(ratio * n_sel - n_cmp, 0))))
        score = imp[..., 0:ratio * n_sel:ratio]
        for o in range(1, ratio + span - 1):
            score = score + imp[..., o:o + ratio * n_sel:ratio]
        cur = tq // SEL_LEN
        valid = blk_id[None, :] <= cur[:, None]
        forced = (blk_id[None, :] == 0) | (blk_id[None, :] == cur[:, None]) | (blk_id[None, :] == cur[:, None] - 1)
        score = jnp.where(forced[None, :, None, :], FORCE_SCORE, score)
        score = jnp.where(valid[None, :, None, :], score, -1.0)
        _, idx = lax.top_k(score, top_n)
        ks = ks_blk[b_ix, g_ix, idx]
        vs = vs_blk[b_ix, g_ix, idx]
        kpos = idx[..., None] * SEL_LEN + jnp.arange(SEL_LEN)
        s = jnp.einsum('btghd,btgnld->btghnl', qi, ks).reshape(B, Q_BLK, NSA_GROUPS, NSA_HPG, top_n * SEL_LEN)
        smask = (kpos <= tq[None, :, None, None, None]).reshape(B, Q_BLK, NSA_GROUPS, 1, top_n * SEL_LEN)
        p = _masked_softmax(s, smask)
        o_sel = jnp.einsum('btghm,btgmd->btghd', p, vs.reshape(B, Q_BLK, NSA_GROUPS, top_n * SEL_LEN, NSA_DH))
        kw = lax.dynamic_slice_in_dim(kw_pad, t0, WINDOW + Q_BLK, 1)
        vw = lax.dynamic_slice_in_dim(vw_pad, t0, WINDOW + Q_BLK, 1)
        kwpos = t0 - WINDOW + jnp.arange(WINDOW + Q_BLK)
        wmask = (kwpos[None, :] <= tq[:, None]) & (kwpos[None, :] > tq[:, None] - WINDOW) & (kwpos[None, :] >= 0)
        s = jnp.einsum('btghd,bsgd->btghs', qi, kw)
        p = _masked_softmax(s, wmask[None, :, None, None, :])
        o_win = jnp.einsum('btghs,bsgd->btghd', p, vw)
        return o_cmp, o_sel, o_win

    o_cmp, o_sel, o_win = lax.map(one_block, jnp.arange(S // Q_BLK))

    def unblock(o):
        return jnp.moveaxis(o, 0, 1).reshape(B, S, NSA_HEADS, NSA_DH)

    g = jax.nn.sigmoid(gates.astype(f32))
    o = g[..., 0:1] * unblock(o_cmp) + g[..., 1:2] * unblock(o_sel) + g[..., 2:3] * unblock(o_win)
    return o.reshape(B, S, NSA_HEADS * NSA_DH)


def _multiscale_pool(u, w_pool, pool_scale):
    B, S, _ = u.shape
    ug = u.astype(jnp.float32).reshape(B, S, POOL_GROUPS, POOL_GW)
    cs = jnp.cumsum(ug, axis=1)
    t = jnp.arange(S)
    outs = []
    for gi, w in enumerate(POOL_WINDOWS):
        c = cs[:, :, gi]
        prev = jnp.pad(c, ((0, 0), (w, 0), (0, 0)))[:, :S]
        mean = (c - prev) / jnp.minimum(t + 1, w).astype(jnp.float32)[None, :, None]
        outs.append(mean - ug[:, :, gi])
    pooled = jnp.stack(outs, axis=2)
    mixed = jnp.einsum('bsgc,gcd->bsgd', pooled, w_pool)
    return (mixed.reshape(B, S, POOL_WIDTH) * pool_scale).astype(u.dtype)


def _causal_attention(q, k, v):
    B, S, H, Dk = q.shape
    Dv = v.shape[-1]
    n_blk = S // Q_BLK
    f32 = jnp.float32
    qb = (q.astype(f32) * Dk ** -0.5).reshape(B, n_blk, Q_BLK, H, Dk)
    kb = k.reshape(B, n_blk, Q_BLK, H, Dk)
    vb = v.reshape(B, n_blk, Q_BLK, H, Dv)
    ar = jnp.arange(Q_BLK)

    def q_block(i):
        qi = qb[:, i]

        def kv_step(j, carry):
            m, l, acc = carry
            kj = kb[:, j].astype(f32)
            vj = vb[:, j].astype(f32)
            s = jnp.einsum('bqhd,bkhd->bhqk', qi, kj)
            causal = (j * Q_BLK + ar)[None, :] <= (i * Q_BLK + ar)[:, None]
            s = jnp.where(causal, s, -jnp.inf)
            m_new = jnp.maximum(m, jnp.max(s, -1))
            p = jnp.exp(s - m_new[..., None])
            corr = jnp.exp(m - m_new)
            return (m_new, l * corr + jnp.sum(p, -1),
                    acc * corr[..., None] + jnp.einsum('bhqk,bkhd->bhqd', p, vj))

        init = (jnp.full((B, H, Q_BLK), -jnp.inf, f32), jnp.zeros((B, H, Q_BLK), f32),
                jnp.zeros((B, H, Q_BLK, Dv), f32))
        m, l, acc = lax.fori_loop(0, i + 1, kv_step, init)
        return jnp.transpose(acc / l[..., None], (0, 2, 1, 3))

    out = lax.map(q_block, jnp.arange(n_blk))
    return jnp.moveaxis(out, 0, 1).reshape(B, S, H, Dv)


def _mla(u_cq, u_ckv, u_kr, positions, q_norm, w_uq, kv_norm, w_ukv):
    B, S, _ = u_cq.shape
    qh = (_rms_norm(u_cq, q_norm) @ w_uq).reshape(B, S, MLA_HEADS, MLA_NOPE + MLA_ROPE)
    kvh = (_rms_norm(u_ckv, kv_norm) @ w_ukv).reshape(B, S, MLA_HEADS, MLA_NOPE + MLA_DV)
    k_rope = _rope(u_kr, positions)
    q_full = jnp.concatenate([qh[..., :MLA_NOPE], _rope(qh[..., MLA_NOPE:], positions)], -1)
    k_full = jnp.concatenate([kvh[..., :MLA_NOPE],
                              jnp.broadcast_to(k_rope[:, :, None, :], (B, S, MLA_HEADS, MLA_ROPE)).astype(kvh.dtype)], -1)
    o = _causal_attention(q_full, k_full, kvh[..., MLA_NOPE:])
    return o.reshape(B, S, MLA_HEADS * MLA_DV)


def _conv_module(u, conv_w, conv_b, ln_g, ln_b):
    a, b = jnp.split(u, 2, axis=-1)
    h = a * jax.nn.sigmoid(b)
    h = lax.conv_general_dilated(h, conv_w[:, None, :].astype(h.dtype), (1,), [(CONV_K - 1, 0)],
                                 dimension_numbers=('NWC', 'WIO', 'NWC'),
                                 feature_group_count=CONV_CH) + conv_b
    return jax.nn.silu(_layer_norm(h, ln_g, ln_b))


def _hybrid_mixer(x, positions, w_in, b_in, nsa_cmp_pos, nsa_cmp_w1, nsa_cmp_w2, w_nsa_o,
                  w_pool, pool_scale, w_pool_o, mla_q_norm, w_mla_uq, mla_kv_norm, w_mla_ukv,
                  w_mla_o, conv_w, conv_b, conv_ln_g, conv_ln_b, w_conv_o, w_out):
    B, S, _ = x.shape
    u = x @ w_in + b_in
    u_q, u_kv, u_g, u_pool, u_cq, u_ckv, u_kr, u_conv, u_merge = _split(u, IN_SIZES)
    q = u_q.reshape(B, S, NSA_GROUPS, NSA_HPG, NSA_DH)
    kv = u_kv.reshape(B, S, 6, NSA_GROUPS, NSA_DH)
    br_nsa = _nsa(q, kv, u_g.reshape(B, S, NSA_HEADS, 3), nsa_cmp_pos, nsa_cmp_w1, nsa_cmp_w2) @ w_nsa_o
    br_pool = _multiscale_pool(u_pool, w_pool, pool_scale) @ w_pool_o
    br_mla = _mla(u_cq, u_ckv, u_kr, positions, mla_q_norm, w_mla_uq, mla_kv_norm, w_mla_ukv) @ w_mla_o
    br_conv = _conv_module(u_conv, conv_w, conv_b, conv_ln_g, conv_ln_b) @ w_conv_o
    g = jax.nn.sigmoid(u_merge.astype(jnp.float32)).reshape(B, S, N_BRANCH, D_MODEL)
    merged = g[:, :, 0] * br_nsa + g[:, :, 1] * br_pool + g[:, :, 2] * br_mla + g[:, :, 3] * br_conv
    return merged.astype(x.dtype) @ w_out


def _cross_attention(x, mem, w_q, w_k, w_v, w_o):
    B, S, _ = x.shape
    M = mem.shape[1]
    q = (x @ w_q).reshape(B, S, X_HEADS, X_DH)
    k = (mem @ w_k).reshape(B, M, X_HEADS, X_DH)
    v = (mem @ w_v).reshape(B, M, X_HEADS, X_DH)
    s = jnp.einsum('bshd,bmhd->bhsm', q, k).astype(jnp.float32) * X_DH ** -0.5
    p = jax.nn.softmax(s, axis=-1)
    o = jnp.einsum('bhsm,bmhd->bshd', p, v.astype(jnp.float32)).reshape(B, S, X_HEADS * X_DH)
    return o.astype(x.dtype) @ w_o


def _hier_moe(x, w_group, b_group, w_router, b_router, w_e_in, w_e_out):
    B, S, D = x.shape
    T = B * S
    f32 = jnp.float32
    h = x.reshape(T, D)
    g_logits = (h @ w_group).astype(f32) + b_group
    g_sel = jnp.argmax(g_logits, -1)
    g_w = jnp.take_along_axis(jax.nn.softmax(g_logits, -1), g_sel[:, None], 1)
    e_logits = ((h @ w_router).astype(f32) + b_router).reshape(T, MOE_GROUPS, MOE_EPG)
    e_logits = jnp.take_along_axis(e_logits, g_sel[:, None, None], 1)[:, 0]
    top_p, top_i = lax.top_k(jax.nn.softmax(e_logits, -1), MOE_TOPK)
    gate = g_w * top_p / jnp.sum(top_p, -1, keepdims=True)
    expert = g_sel[:, None] * MOE_EPG + top_i
    A = T * MOE_TOPK
    e_flat = expert.reshape(A)
    w_flat = gate.reshape(A)
    tok_flat = jnp.repeat(jnp.arange(T, dtype=jnp.int32), MOE_TOPK)
    order = jnp.argsort(e_flat)
    e_sorted = e_flat[order]
    counts = jnp.bincount(e_flat, length=N_EXPERTS)
    padded = (counts + MOE_BLOCK - 1) // MOE_BLOCK * MOE_BLOCK
    start = jnp.cumsum(counts) - counts
    pend = jnp.cumsum(padded)
    pstart = pend - padded
    dest = pstart[e_sorted] + jnp.arange(A) - start[e_sorted]
    n_blocks = -(-A // MOE_BLOCK) + N_EXPERTS
    rows = n_blocks * MOE_BLOCK
    row_tok = jnp.full((rows,), T, jnp.int32).at[dest].set(tok_flat[order])
    row_w = jnp.zeros((rows,), f32).at[dest].set(w_flat[order])
    block_expert = jnp.minimum(jnp.searchsorted(pend, jnp.arange(n_blocks) * MOE_BLOCK, side='right'), N_EXPERTS - 1)
    h_pad = jnp.concatenate([h, jnp.zeros((1, D), h.dtype)], 0)

    def expert_block(args):
        toks, wts, e = args
        xe = h_pad[toks]
        a, b = jnp.split(xe @ w_e_in[e], 2, axis=-1)
        return ((jax.nn.silu(a) * b) @ w_e_out[e]).astype(f32) * wts[:, None]

    yb = lax.map(expert_block, (row_tok.reshape(n_blocks, MOE_BLOCK), row_w.reshape(n_blocks, MOE_BLOCK), block_expert))
    y = jnp.zeros((T + 1, D), f32).at[row_tok].add(yb.reshape(rows, D))
    return y[:T].astype(x.dtype).reshape(B, S, D)


def setup_inputs(seed: int = 0) -> dict:
    key = jax.random.key(seed)
    ks = iter(jax.random.split(key, 48))
    f32 = jnp.float32
    L = DEPTH

    def w(shape, fan_in, gain=1.0):
        return jax.random.normal(next(ks), shape, f32) * (gain * fan_in ** -0.5)

    def gain(shape):
        return 1.0 + 0.02 * jax.random.normal(next(ks), shape, f32)

    def bias(shape, s=0.01):
        return s * jax.random.normal(next(ks), shape, f32)

    return {
        'x': jax.random.normal(next(ks), (BATCH, SEQ, D_MODEL), f32),
        'mem': jax.random.normal(next(ks), (BATCH, MEM_LEN, D_MODEL), f32),
        'positions': jnp.broadcast_to(jnp.arange(SEQ, dtype=jnp.int32), (BATCH, SEQ)),
        'w_in': w((L, D_MODEL, IN_WIDTH), D_MODEL),
        'b_in': bias((L, IN_WIDTH)),
        'nsa_cmp_pos': bias((L, 2, CMP_LEN, NSA_DH), 0.1),
        'nsa_cmp_w1': w((L, 2, CMP_LEN * NSA_DH, CMP_HIDDEN), CMP_LEN * NSA_DH),
        'nsa_cmp_w2': w((L, 2, CMP_HIDDEN, NSA_DH), CMP_HIDDEN),
        'w_nsa_o': w((L, NSA_HEADS * NSA_DH, D_MODEL), NSA_HEADS * NSA_DH),
        'w_pool': w((L, POOL_GROUPS, POOL_GW, POOL_GW), POOL_GW),
        'pool_scale': gain((L, POOL_WIDTH)),
        'w_pool_o': w((L, POOL_WIDTH, D_MODEL), POOL_WIDTH),
        'mla_q_norm': gain((L, MLA_Q_RANK)),
        'w_mla_uq': w((L, MLA_Q_RANK, MLA_HEADS * (MLA_NOPE + MLA_ROPE)), MLA_Q_RANK),
        'mla_kv_norm': gain((L, MLA_KV_RANK)),
        'w_mla_ukv': w((L, MLA_KV_RANK, MLA_HEADS * (MLA_NOPE + MLA_DV)), MLA_KV_RANK),
        'w_mla_o': w((L, MLA_HEADS * MLA_DV, D_MODEL), MLA_HEADS * MLA_DV),
        'conv_w': w((L, CONV_K, CONV_CH), CONV_K),
        'conv_b': bias((L, CONV_CH)),
        'conv_ln_g': gain((L, CONV_CH)),
        'conv_ln_b': bias((L, CONV_CH)),
        'w_conv_o': w((L, CONV_CH, D_MODEL), CONV_CH),
        'w_out': w((L, D_MODEL, D_MODEL), D_MODEL, DN_BETA),
        'ln_mix_g': gain((L, D_MODEL)),
        'ln_mix_b': bias((L, D_MODEL)),
        'w_xq': w((L, D_MODEL, X_HEADS * X_DH), D_MODEL),
        'w_xk': w((L, D_MODEL, X_HEADS * X_DH), D_MODEL),
        'w_xv': w((L, D_MODEL, X_HEADS * X_DH), D_MODEL, DN_BETA),
        'w_xo': w((L, X_HEADS * X_DH, D_MODEL), X_HEADS * X_DH, DN_BETA),
        'ln_x_g': gain((L, D_MODEL)),
        'ln_x_b': bias((L, D_MODEL)),
        'w_group': w((L, D_MODEL, MOE_GROUPS), D_MODEL),
        'b_group': bias((L, MOE_GROUPS)),
        'w_router': w((L, D_MODEL, N_EXPERTS), D_MODEL),
        'b_router': bias((L, N_EXPERTS)),
        'w_expert_in': w((L, N_EXPERTS, D_MODEL, 2 * EXPERT_FF), D_MODEL),
        'w_expert_out': w((L, N_EXPERTS, EXPERT_FF, D_MODEL), EXPERT_FF, DN_BETA),
        'ln_ffn_g': gain((L, D_MODEL)),
        'ln_ffn_b': bias((L, D_MODEL)),
    }


def reference(x, mem, positions, w_in, b_in, nsa_cmp_pos, nsa_cmp_w1, nsa_cmp_w2, w_nsa_o,
              w_pool, pool_scale, w_pool_o, mla_q_norm, w_mla_uq, mla_kv_norm, w_mla_ukv, w_mla_o,
              conv_w, conv_b, conv_ln_g, conv_ln_b, w_conv_o, w_out, ln_mix_g, ln_mix_b,
              w_xq, w_xk, w_xv, w_xo, ln_x_g, ln_x_b, w_group, b_group, w_router, b_router,
              w_expert_in, w_expert_out, ln_ffn_g, ln_ffn_b):
    for l in range(DEPTH):
        h = _hybrid_mixer(x, positions, w_in[l], b_in[l], nsa_cmp_pos[l], nsa_cmp_w1[l], nsa_cmp_w2[l],
                          w_nsa_o[l], w_pool[l], pool_scale[l], w_pool_o[l], mla_q_norm[l], w_mla_uq[l],
                          mla_kv_norm[l], w_mla_ukv[l], w_mla_o[l], conv_w[l], conv_b[l], conv_ln_g[l],
                          conv_ln_b[l], w_conv_o[l], w_out[l])
        x = _layer_norm(DN_ALPHA * x + h, ln_mix_g[l], ln_mix_b[l])
        h = _cross_attention(x, mem, w_xq[l], w_xk[l], w_xv[l], w_xo[l])
        x = _layer_norm(DN_ALPHA * x + h, ln_x_g[l], ln_x_b[l])
        h = _hier_moe(x, w_group[l], b_group[l], w_router[l], b_router[l], w_expert_in[l], w_expert_out[l])
        x = _layer_norm(DN_ALPHA * x + h, ln_ffn_g[l], ln_ffn_b[l])
    return x
```

```cpp
#include <hip/hip_runtime.h>
#include <cstdio>
#include <cstdint>

#define LAS __attribute__((address_space(3)))
#define GAS __attribute__((address_space(1)))
typedef unsigned short bf16;
typedef short bf16x8 __attribute__((ext_vector_type(8)));
typedef short s16x4 __attribute__((ext_vector_type(4)));
typedef float f32x2 __attribute__((ext_vector_type(2)));
typedef float f32x4 __attribute__((ext_vector_type(4)));
typedef float f32x16 __attribute__((ext_vector_type(16)));
typedef unsigned u32x2 __attribute__((ext_vector_type(2)));
typedef unsigned u32x4 __attribute__((ext_vector_type(4)));

constexpr int S = 16384, D = 2048, DEPTH = 2;
constexpr int IN_W = 11832;
constexpr int NIN = 12032;
constexpr int U2W = 3840;
constexpr int U2_Q = 0, U2_KV = 512, U2_POOL = 1280, U2_CQ = 1792, U2_CKV = 2304, U2_CONV = 2560, U2_G = 3584, U2_KR = 3616;
constexpr int NCMP = 1023;
constexpr int RMAX = 40960;
constexpr float DN_ALPHA = 1.4142135623730951f;
constexpr float LOG2E = 1.4426950408889634f;

typedef __bf16 bf16x2_t __attribute__((ext_vector_type(2)));
__device__ __forceinline__ unsigned cvt_pk_bf16(float lo, float hi) { const f32x2 v = {lo, hi}; const bf16x2_t b = __builtin_convertvector(v, bf16x2_t); return __builtin_bit_cast(unsigned, b); }
__device__ __forceinline__ float bf2f(unsigned short b) { return __uint_as_float(((unsigned)b) << 16); }
__device__ __forceinline__ float bflo(unsigned w) { return __uint_as_float(w << 16); }
__device__ __forceinline__ float bfhi(unsigned w) { return __uint_as_float(w & 0xffff0000u); }
__device__ __forceinline__ unsigned short f2bf(float f) { return (unsigned short)(cvt_pk_bf16(f, 0.f) & 0xffffu); }
__device__ __forceinline__ float wave_sum(float v) {
#pragma unroll
    for (int o = 1; o < 64; o <<= 1) v += __shfl_xor(v, o);
    return v;
}
__device__ __forceinline__ float sigmoidf_(float x) { return 1.0f / (1.0f + __expf(-x)); }
#define LDS_WAIT() asm volatile("s_waitcnt lgkmcnt(0)" ::: "memory")
#define VM_WAIT() asm volatile("s_waitcnt vmcnt(0)" ::: "memory")

namespace pg8 {
constexpr int BM = 256, BK = 64, HALF = 128, HTB = HALF * BK * 2, STAGE_BYTES = 8 * HTB, NXCD = 8, WGM = 8;
__host__ __device__ __forceinline__ int lds_byte(int r, int c) { const int st = (r >> 4) * 2 + (c >> 5), rr = r & 15, cc = c & 31, ob = rr * 64 + cc * 2; return st * 1024 + (ob ^ (((ob >> 9) & 1) << 5)); }
__host__ __device__ __forceinline__ void stage_rc(int b, int& R, int& C) { const int st = b / 1024, sb = b % 1024, swz = sb ^ (((sb >> 9) & 1) << 5); R = (st >> 1) * 16 + swz / 64; C = (st & 1) * 32 + (swz % 64) / 2; }
__host__ __device__ __forceinline__ int perm32(int rho) { const int n = rho >> 4, i = rho & 15; return 8 * (i >> 2) + 4 * n + (i & 3); }

struct Unit { int pm, pn; };
struct Gemm { const bf16* A; const bf16* Bt; int lda, ldb, K; };

struct StaticOrder {
    int nM, nN, nwg, G, c;
    __device__ void init(int M, int N, int G_, int c_) { nM = M / BM; nN = N / BM; nwg = nM * nN; G = G_; c = c_; }
    __device__ bool next(int i, Unit& u) const {
        const long L = (long)i * G + c; if (L >= nwg) return false;
        int wgid = (int)L; { const int q = nwg / NXCD, r = nwg % NXCD, xcd = wgid % NXCD, off = wgid / NXCD; wgid = (xcd < r ? xcd * (q + 1) : r * (q + 1) + (xcd - r) * q) + off; }
        const int nig = WGM * nN, gid = wgid / nig, fm = gid * WGM, gsz = (nM - fm) < WGM ? (nM - fm) : WGM;
        u.pm = fm + ((wgid % nig) % gsz); u.pn = (wgid % nig) / gsz; return true;
    }
};
struct GroupedOrder {
    const int* tile_expert; int ntiles, npn, G, c;
    __device__ bool next(int i, Unit& u) const {
        const long L = (long)i * G + c; if (L >= (long)ntiles * npn) return false;
        const int rt = (int)(L / npn), pn = (int)(L % npn);
        u.pm = rt; u.pn = __builtin_amdgcn_readfirstlane(tile_expert[rt]) * npn + pn; return true;
    }
};

template <class Epi, class Sched>
__device__ __forceinline__ void gemm_phase(LAS unsigned char* lds, const Gemm g, const Sched& S, const Epi& E) {
    int tid = threadIdx.x; asm volatile("" : "+v"(tid));
    const int wid = __builtin_amdgcn_readfirstlane(tid >> 6), lane = tid & 63, wr = wid >> 2, wc = wid & 3, fr = lane & 15, fq = lane >> 4;
    const int K = g.K, nt = K / BK;
    unsigned voffA[2], voffB[2];
#pragma unroll
    for (int i = 0; i < 2; ++i) { int R, C; stage_rc(tid * 16 + i * 8192, R, C); const int Rb = Epi::PERM ? ((R & ~31) + perm32(R & 31)) : R;
        voffA[i] = (unsigned)(R * g.lda + C) * 2u; voffB[i] = (unsigned)(Rb * g.ldb + C) * 2u; }
    const size_t kstep = (size_t)(BK * 2);
    const size_t hstepA = (size_t)HALF * g.lda * 2, hstepB = (size_t)HALF * g.ldb * 2;
    const size_t tstepA = 2 * hstepA, tstepB = 2 * hstepB;
    const unsigned ldsw = (unsigned)wid * 1024u;
    const int aoff = lds_byte(wr * 64 + fr, fq * 8), boff = lds_byte(wc * 32 + fr, fq * 8);
#define PG8_SA(b, h) (((b) * 2 + (h)) * HTB)
#define PG8_SB(b, h) ((4 + (b) * 2 + (h)) * HTB)
#define PG8_STAGE(bufoff, gbase, voff) do { _Pragma("unroll") for (int _i = 0; _i < 2; ++_i) \
        __builtin_amdgcn_global_load_lds((const unsigned*)((const char*)(gbase) + (voff)[_i]), (LAS unsigned*)(lds + (bufoff) + ldsw + _i * 8192), 16, 0, 0); } while (0)
#define PG8_LDA(dst, b, h) do { _Pragma("unroll") for (int m = 0; m < 4; ++m) _Pragma("unroll") for (int k = 0; k < 2; ++k) dst[m][k] = *(const LAS bf16x8*)(lds + PG8_SA(b, h) + aoff + m * 2048 + k * 1024); } while (0)
#define PG8_LDB(dst, b, h) do { _Pragma("unroll") for (int n = 0; n < 2; ++n) _Pragma("unroll") for (int k = 0; k < 2; ++k) dst[n][k] = *(const LAS bf16x8*)(lds + PG8_SB(b, h) + boff + n * 2048 + k * 1024); } while (0)
#define PG8_MMA(ai, bj, At, Bt) do { __builtin_amdgcn_s_setprio(1); _Pragma("unroll") for (int m = 0; m < 4; ++m) _Pragma("unroll") for (int n = 0; n < 2; ++n) _Pragma("unroll") for (int k = 0; k < 2; ++k) \
        acc[ai][bj][m][n] = __builtin_amdgcn_mfma_f32_16x16x32_bf16(Bt[n][k], At[m][k], acc[ai][bj][m][n], 0, 0, 0); __builtin_amdgcn_s_setprio(0); } while (0)
#define PG8_WAIT_V(n) asm volatile("s_waitcnt vmcnt(" #n ")" ::: "memory")
#define PG8_WAIT_L(n) asm volatile("s_waitcnt lgkmcnt(" #n ")" ::: "memory")
#define PG8_BAR __builtin_amdgcn_s_barrier()
#define PG8_SCHED __builtin_amdgcn_sched_barrier(0)
    Unit cur, nxt; int ui = 0;
    if (!S.next(0, cur)) return;
    f32x4 acc[2][2][4][2];
#pragma unroll
    for (int a = 0; a < 2; ++a)
#pragma unroll
        for (int b = 0; b < 2; ++b)
#pragma unroll
            for (int m = 0; m < 4; ++m)
#pragma unroll
                for (int n = 0; n < 2; ++n) acc[a][b][m][n] = (f32x4){0.f, 0.f, 0.f, 0.f};
    bf16x8 At[4][2], B0[2][2], B1[2][2];
    const char* cA = (const char*)g.A + (size_t)cur.pm * tstepA; const char* cB = (const char*)g.Bt + (size_t)cur.pn * tstepB;
    PG8_STAGE(PG8_SB(0, 0), cB, voffB); PG8_STAGE(PG8_SB(0, 1), cB + hstepB, voffB); PG8_STAGE(PG8_SA(0, 0), cA, voffA); PG8_STAGE(PG8_SA(0, 1), cA + hstepA, voffA);
    if (wr == 1) PG8_BAR;
    PG8_WAIT_V(2); PG8_BAR;
    PG8_STAGE(PG8_SB(1, 0), cB + kstep, voffB); PG8_STAGE(PG8_SA(1, 0), cA + kstep, voffA); PG8_STAGE(PG8_SB(1, 1), cB + hstepB + kstep, voffB);
    PG8_WAIT_V(6); PG8_BAR;
    for (;;) {
        const bool has_next = S.next(ui + 1, nxt);
        const char* nA = has_next ? (const char*)g.A + (size_t)nxt.pm * tstepA : cA; const char* nB = has_next ? (const char*)g.Bt + (size_t)nxt.pn * tstepB : cB;
        for (int t = 0; t < nt; t += 2) {
            const bool last = (t == nt - 2);
            const char* a1 = cA + (size_t)(t + 1) * kstep;
            const char* a2 = last ? nA : cA + (size_t)(t + 2) * kstep; const char* b2 = last ? nB : cB + (size_t)(t + 2) * kstep;
            const char* a3 = a2 + kstep; const char* b3 = b2 + kstep;
            if constexpr (Epi::MIDK > 0) { if (t > 0 && (t % Epi::MIDK) == 0) { PG8_SCHED; E.mid(acc, cur, t / Epi::MIDK, wr, wc, fr, fq); PG8_SCHED; } }
            PG8_LDB(B0, 0, 0); PG8_LDB(B1, 0, 1); PG8_SCHED; PG8_LDA(At, 0, 0); PG8_STAGE(PG8_SA(1, 1), a1 + hstepA, voffA);
            PG8_WAIT_V(8); PG8_WAIT_L(0); PG8_BAR; PG8_MMA(0, 0, At, B0); PG8_MMA(0, 1, At, B1); PG8_BAR; PG8_SCHED;
            PG8_LDA(At, 0, 1); PG8_STAGE(PG8_SB(0, 0), b2, voffB); PG8_STAGE(PG8_SB(0, 1), b2 + hstepB, voffB); PG8_STAGE(PG8_SA(0, 0), a2, voffA);
            PG8_WAIT_V(8); PG8_WAIT_L(0); PG8_BAR; PG8_MMA(1, 0, At, B0); PG8_MMA(1, 1, At, B1); PG8_BAR; PG8_SCHED;
            PG8_LDB(B0, 1, 0); PG8_LDB(B1, 1, 1); PG8_SCHED; PG8_LDA(At, 1, 0); PG8_STAGE(PG8_SA(0, 1), a2 + hstepA, voffA);
            PG8_WAIT_V(8); PG8_WAIT_L(0); PG8_BAR; PG8_MMA(0, 0, At, B0); PG8_MMA(0, 1, At, B1); PG8_BAR; PG8_SCHED;
            PG8_LDA(At, 1, 1); PG8_STAGE(PG8_SB(1, 0), b3, voffB); PG8_STAGE(PG8_SB(1, 1), b3 + hstepB, voffB); PG8_STAGE(PG8_SA(1, 0), a3, voffA);
            PG8_WAIT_V(8); PG8_WAIT_L(0); PG8_BAR; PG8_MMA(1, 0, At, B0); PG8_MMA(1, 1, At, B1); PG8_BAR; PG8_SCHED;
        }
        if (wr == 0) PG8_BAR;
        E(acc, cur, wr, wc, fr, fq);
        if (!has_next) break;
#pragma unroll
        for (int a = 0; a < 2; ++a)
#pragma unroll
            for (int b = 0; b < 2; ++b)
#pragma unroll
                for (int m = 0; m < 4; ++m)
#pragma unroll
                    for (int n = 0; n < 2; ++n) acc[a][b][m][n] = (f32x4){0.f, 0.f, 0.f, 0.f};
        cur = nxt; cA = nA; cB = nB; ++ui;
        if (wr == 1) PG8_BAR;
    }
    PG8_WAIT_V(0);
    PG8_BAR;
#undef PG8_SA
#undef PG8_SB
#undef PG8_STAGE
#undef PG8_LDA
#undef PG8_LDB
#undef PG8_MMA
#undef PG8_WAIT_V
#undef PG8_WAIT_L
#undef PG8_BAR
#undef PG8_SCHED
}
}

__device__ __forceinline__ float fast_sigmoid(float x) { return __builtin_amdgcn_rcpf(1.0f + __builtin_amdgcn_exp2f(-x * LOG2E)); }
__device__ __forceinline__ u32x4 pack8(const f32x4 v0, const f32x4 v1) { u32x4 w; w.x = cvt_pk_bf16(v0[0], v0[1]); w.y = cvt_pk_bf16(v0[2], v0[3]); w.z = cvt_pk_bf16(v1[0], v1[1]); w.w = cvt_pk_bf16(v1[2], v1[3]); return w; }

struct EpiIn {
    static constexpr bool PERM = true; static constexpr int MIDK = 0;
    bf16* gate; bf16* u2; const float* bias;
    __device__ __forceinline__ void operator()(const f32x4 (&acc)[2][2][4][2], const pg8::Unit& u, int wr, int wc, int fr, int fq) const {
        const int row0 = u.pm * 256 + wr * 64 + fr; const bool isg = u.pn < 32;
        bf16* base = isg ? gate : u2; const int ldc = isg ? 8192 : U2W; const int colt = isg ? u.pn * 256 : (u.pn - 32) * 256;
        const int col0 = colt + wc * 32 + 8 * fq, bcol0 = u.pn * 256 + wc * 32 + 8 * fq;
        f32x4 bv[2][2];
#pragma unroll
        for (int bj = 0; bj < 2; ++bj)
#pragma unroll
            for (int n = 0; n < 2; ++n) bv[bj][n] = *(const f32x4*)(bias + bcol0 + bj * 128 + 4 * n);
#pragma unroll
        for (int ai = 0; ai < 2; ++ai)
#pragma unroll
            for (int m = 0; m < 4; ++m) { bf16* rowp = base + (size_t)(row0 + ai * 128 + m * 16) * ldc + col0;
#pragma unroll
                for (int bj = 0; bj < 2; ++bj) { f32x4 v0 = acc[ai][bj][m][0] + bv[bj][0], v1 = acc[ai][bj][m][1] + bv[bj][1];
                    if (isg) {
#pragma unroll
                        for (int j = 0; j < 4; ++j) { v0[j] = fast_sigmoid(v0[j]); v1[j] = fast_sigmoid(v1[j]); } }
                    *(u32x4*)(rowp + bj * 128) = pack8(v0, v1); } }
    }
};
struct EpiScale {
    static constexpr bool PERM = true; static constexpr int MIDK = 0;
    bf16* O; int ldc; const float* rowscale; float cs; int npn_mod;
    __device__ __forceinline__ void operator()(const f32x4 (&acc)[2][2][4][2], const pg8::Unit& u, int wr, int wc, int fr, int fq) const {
        const int row0 = u.pm * 256 + wr * 64 + fr; const int pnl = npn_mod ? (u.pn % npn_mod) : u.pn;
        const int col0 = pnl * 256 + wc * 32 + 8 * fq;
#pragma unroll
        for (int ai = 0; ai < 2; ++ai)
#pragma unroll
            for (int m = 0; m < 4; ++m) { const int row = row0 + ai * 128 + m * 16; const float sc = (rowscale ? rowscale[row] : 1.0f) * cs;
                bf16* rowp = O + (size_t)row * ldc + col0;
#pragma unroll
                for (int bj = 0; bj < 2; ++bj) *(u32x4*)(rowp + bj * 128) = pack8(acc[ai][bj][m][0] * sc, acc[ai][bj][m][1] * sc); }
    }
};
struct EpiGlu {
    static constexpr bool PERM = true; static constexpr int MIDK = 0;
    bf16* H;
    __device__ __forceinline__ void operator()(const f32x4 (&acc)[2][2][4][2], const pg8::Unit& u, int wr, int wc, int fr, int fq) const {
        const int row0 = u.pm * 256 + wr * 64 + fr; const int col0 = (u.pn & 3) * 128 + wc * 32 + 8 * fq;
#pragma unroll
        for (int ai = 0; ai < 2; ++ai)
#pragma unroll
            for (int m = 0; m < 4; ++m) { f32x4 o[2];
#pragma unroll
                for (int n = 0; n < 2; ++n)
#pragma unroll
                    for (int j = 0; j < 4; ++j) { const float a = acc[ai][0][m][n][j], b = acc[ai][1][m][n][j]; o[n][j] = a * fast_sigmoid(a) * b; }
                *(u32x4*)(H + (size_t)(row0 + ai * 128 + m * 16) * 512 + col0) = pack8(o[0], o[1]); }
    }
};
struct EpiResid {
    static constexpr bool PERM = false; static constexpr int MIDK = 0;
    float* X;
    __device__ __forceinline__ void operator()(const f32x4 (&acc)[2][2][4][2], const pg8::Unit& u, int wr, int wc, int fr, int fq) const {
        const int row0 = u.pm * 256 + wr * 64 + fr, col0 = u.pn * 256 + wc * 32 + 4 * fq;
#pragma unroll
        for (int ai = 0; ai < 2; ++ai)
#pragma unroll
            for (int m = 0; m < 4; ++m) { float* rowp = X + (size_t)(row0 + ai * 128 + m * 16) * D + col0;
#pragma unroll
                for (int bj = 0; bj < 2; ++bj)
#pragma unroll
                    for (int n = 0; n < 2; ++n) { f32x4* p = (f32x4*)(rowp + bj * 128 + n * 16); *p = *p * DN_ALPHA + acc[ai][bj][m][n]; } }
    }
};
struct EpiMerge {
    static constexpr bool PERM = true; static constexpr int MIDK = 8;
    const bf16* gate; bf16* O;
    __device__ __forceinline__ void mid(f32x4 (&acc)[2][2][4][2], const pg8::Unit& u, int seg, int wr, int wc, int fr, int fq) const {
        int row0 = u.pm * 256 + wr * 64 + fr; const int col0 = u.pn * 256 + wc * 32 + 8 * fq; asm volatile("" : "+v"(row0));
#pragma unroll
        for (int ai = 0; ai < 2; ++ai)
#pragma unroll
            for (int m = 0; m < 4; ++m) { const bf16* gp = gate + (size_t)(row0 + ai * 128 + m * 16) * 8192 + (size_t)(seg - 1) * 2048 + col0;
#pragma unroll
                for (int bj = 0; bj < 2; ++bj) { const u32x4 a = *(const u32x4*)(gp + bj * 128), b = *(const u32x4*)(gp + 2048 + bj * 128);
#pragma unroll
                    for (int q = 0; q < 4; ++q) { const float r0 = fmaxf(bflo(a[q]), 1e-30f) * __builtin_amdgcn_rcpf(fmaxf(bflo(b[q]), 1e-30f)), r1 = fmaxf(bfhi(a[q]), 1e-30f) * __builtin_amdgcn_rcpf(fmaxf(bfhi(b[q]), 1e-30f));
                        acc[ai][bj][m][q >> 1][(q & 1) * 2] *= r0; acc[ai][bj][m][q >> 1][(q & 1) * 2 + 1] *= r1; } }
                asm volatile("" ::: "memory"); }
    }
    __device__ __forceinline__ void operator()(const f32x4 (&acc)[2][2][4][2], const pg8::Unit& u, int wr, int wc, int fr, int fq) const {
        const int row0 = u.pm * 256 + wr * 64 + fr, col0 = u.pn * 256 + wc * 32 + 8 * fq;
#pragma unroll
        for (int ai = 0; ai < 2; ++ai)
#pragma unroll
            for (int m = 0; m < 4; ++m) { const int row = row0 + ai * 128 + m * 16; const bf16* gp = gate + (size_t)row * 8192 + 3 * 2048 + col0;
#pragma unroll
                for (int bj = 0; bj < 2; ++bj) { const u32x4 a = *(const u32x4*)(gp + bj * 128); f32x4 v0, v1;
                    v0[0] = acc[ai][bj][m][0][0] * fmaxf(bflo(a[0]), 1e-30f); v0[1] = acc[ai][bj][m][0][1] * fmaxf(bfhi(a[0]), 1e-30f);
                    v0[2] = acc[ai][bj][m][0][2] * fmaxf(bflo(a[1]), 1e-30f); v0[3] = acc[ai][bj][m][0][3] * fmaxf(bfhi(a[1]), 1e-30f);
                    v1[0] = acc[ai][bj][m][1][0] * fmaxf(bflo(a[2]), 1e-30f); v1[1] = acc[ai][bj][m][1][1] * fmaxf(bfhi(a[2]), 1e-30f);
                    v1[2] = acc[ai][bj][m][1][2] * fmaxf(bflo(a[3]), 1e-30f); v1[3] = acc[ai][bj][m][1][3] * fmaxf(bfhi(a[3]), 1e-30f);
                    *(u32x4*)(O + (size_t)row * D + col0 + bj * 128) = pack8(v0, v1); } }
    }
};

#define XB_TMO      128
#define XB_XCNT(j)  (256  + 64 * (j))
#define XB_XSUB(j)  (1280 + 64 * (j))
#define XB_XGEN(j)  (2304 + 64 * (j))
#define XB_TOP      3328
#define XB_TOPGEN   3392
#define XCD_BAR_WORDS 3456
#define XB_SPIN_CAP (1u << 25)
__device__ __forceinline__ unsigned xb_ld(unsigned* p)              { return __hip_atomic_load(p, __ATOMIC_RELAXED, __HIP_MEMORY_SCOPE_AGENT); }
__device__ __forceinline__ unsigned xb_add(unsigned* p, unsigned v) { return __hip_atomic_fetch_add(p, v, __ATOMIC_RELAXED, __HIP_MEMORY_SCOPE_AGENT); }
__device__ __forceinline__ unsigned xb_xcc_id() { return (unsigned)__builtin_amdgcn_s_getreg((3 << 11) | 20) & 0xFu; }
#define XB_SPIN(cond, bar) do { unsigned _sp = 0; while (cond) { __builtin_amdgcn_s_sleep(1); \
    if ((++_sp & 255u) == 0u) { if (xb_ld(&(bar)[XB_TMO])) break; if (_sp > XB_SPIN_CAP) { atomicAdd(&(bar)[XB_TMO], 1u); break; } } } } while (0)
struct XcdBarrier { unsigned* bar; unsigned x; volatile LAS unsigned* st; };
__device__ __forceinline__ XcdBarrier xcd_barrier_post(unsigned* bar, volatile LAS unsigned* st) {
    XcdBarrier b; b.bar = bar; b.x = xb_xcc_id(); b.st = st;
    if (threadIdx.x == 0) (void)xb_add(&bar[XB_XCNT(b.x)], 1u);
    return b;
}
__device__ __forceinline__ void xcd_barrier_complete(unsigned* bar, unsigned x, unsigned& nloc, unsigned& nx) {
    const unsigned G = gridDim.x * gridDim.y * gridDim.z;
    unsigned sum, cnt, mine, sp = 0u;
    for (;;) {
        sum = 0u; cnt = 0u; mine = 0u;
#pragma unroll
        for (unsigned j = 0; j < 16; ++j) { const unsigned c = xb_ld(&bar[XB_XCNT(j)]); sum += c; cnt += (c > 0u) ? 1u : 0u; mine = (j == x) ? c : mine; }
        if (sum == G) break;
        __builtin_amdgcn_s_sleep(1);
        if ((++sp & 255u) == 0u) { if (xb_ld(&bar[XB_TMO])) break; if (sp > XB_SPIN_CAP) { atomicAdd(&bar[XB_TMO], 1u); break; } }
    }
    nloc = mine > 0u ? mine : 1u; nx = cnt > 0u ? cnt : 1u;
}
__device__ __forceinline__ void xcd_barrier(const XcdBarrier& b) {
    asm volatile("s_waitcnt vmcnt(0)" ::: "memory");
    __syncthreads();
    if (threadIdx.x == 0) {
        unsigned* bar = b.bar;
        __builtin_amdgcn_s_waitcnt(0);
        unsigned nloc = b.st[0], nx = b.st[1];
        if (nloc == 0u) { xcd_barrier_complete(bar, b.x, nloc, nx); b.st[0] = nloc; b.st[1] = nx; }
        const unsigned old = xb_add(&bar[XB_XSUB(b.x)], 1u);
        const unsigned gen = old / nloc;
        if (old + 1u == (gen + 1u) * nloc) {
            __builtin_amdgcn_fence(__ATOMIC_RELEASE, "agent");
            asm volatile("s_waitcnt vmcnt(0)" ::: "memory");
            const unsigned og = xb_add(&bar[XB_TOP], 1u);
            const unsigned tg = og / nx;
            if (og + 1u == (tg + 1u) * nx) xb_add(&bar[XB_TOPGEN], 1u);
            else XB_SPIN(xb_ld(&bar[XB_TOPGEN]) == tg, bar);
            __builtin_amdgcn_fence(__ATOMIC_ACQUIRE, "agent");
            xb_add(&bar[XB_XGEN(b.x)], 1u);
            asm volatile("s_waitcnt vmcnt(0)" ::: "memory");
        } else {
            XB_SPIN(xb_ld(&bar[XB_XGEN(b.x)]) == gen, bar);
            __builtin_amdgcn_fence(__ATOMIC_ACQUIRE, "agent");
            asm volatile("s_waitcnt vmcnt(0)" ::: "memory");
        }
    }
    __syncthreads();
}

constexpr size_t MiB = 1u << 20;
constexpr size_t WS_CTL = 0, CTL_ZERO_BYTES = 1 * MiB;
constexpr size_t WS_WL0 = 2 * MiB, WS_WLSTRIDE = 272 * MiB;
constexpr size_t WO_WIN = 0, WO_WBR = 48 * MiB, WO_WOUT = 56 * MiB, WO_WXQ = 64 * MiB, WO_WXK = 66 * MiB, WO_WXV = 68 * MiB, WO_WXO = 70 * MiB, WO_WUQ = 72 * MiB, WO_WUKV = 73 * MiB,
                 WO_W1C = 74 * MiB, WO_W2C = 75 * MiB, WO_BIASP = 76 * MiB, WO_B1C = 77 * MiB, WO_WEIN = 80 * MiB, WO_WEOUT = 208 * MiB;
constexpr size_t WS_X = 546 * MiB, WS_XB = 674 * MiB, WS_GATE = 738 * MiB, WS_U2 = 994 * MiB, WS_ABR = 1114 * MiB, WS_MERGED = 1178 * MiB, WS_QH = 1242 * MiB, WS_KVH = 1266 * MiB,
                 WS_QM = 1298 * MiB, WS_KM = 1322 * MiB, WS_VTM = 1346 * MiB, WS_VTSEL = 1362 * MiB, WS_VTWIN = 1366 * MiB, WS_KC = 1370 * MiB, WS_VCT = 1371 * MiB, WS_HID = 1372 * MiB,
                 WS_OCMP = 1373 * MiB, WS_OWIN = 1389 * MiB, WS_SCORES = 1405 * MiB, WS_IDX = 1437 * MiB, WS_NV = 1439 * MiB, WS_RSTD = 1440 * MiB, WS_ROPE = 1441 * MiB, WS_QX = 1443 * MiB,
                 WS_OX = 1459 * MiB, WS_KX = 1475 * MiB, WS_VXT = 1476 * MiB, WS_MEMB = 1477 * MiB, WS_CSTAT = 1478 * MiB, WS_MOE = 1479 * MiB, WS_END = 1481 * MiB;
constexpr size_t WS_XS = WS_GATE, WS_Y2 = WS_GATE + 160 * MiB, WS_HS = WS_GATE + 320 * MiB;
static_assert(WS_HS + 40 * MiB <= WS_ABR, "MoE overlay");
constexpr int CW_CNT = 1024;
constexpr int CW_BAR = 4096;
constexpr size_t MO_TOKE = 0, MO_TOKW = 128 * 1024, MO_TOKP = 256 * 1024, MO_ROWW = 384 * 1024, MO_TILEE = 640 * 1024, MO_NT = 644 * 1024;

constexpr int RING_BYTES = 131072;
constexpr int LDS_BYTES = 147456;
constexpr int MISC_OFF = LDS_BYTES - 512;

constexpr int NWAVES = 8;
struct Args { const void* in[39]; float* out; unsigned char* ws; int ph_lo, ph_hi, li, pad; };
static_assert(sizeof(Args) == 39 * 8 + 8 + 8 + 16, "Args has no padding");

struct Frame {
    LAS unsigned char* lds;
    int tid, lane, wave, G, gw, NGW;
    unsigned char* ws;
};

__device__ __forceinline__ int in_col(int n) {
    if (n < 8192) return 3640 + n;
    if (n < 8704) return n - 8192;
    if (n < 9472) return 512 + (n - 8704);
    if (n < 9984) return 1304 + (n - 9472);
    if (n < 10496) return 1816 + (n - 9984);
    if (n < 10752) return 2328 + (n - 10496);
    if (n < 11776) return 2616 + (n - 10752);
    const int c = n - 11776; if (c < 24) return 1280 + c; if (c >= 32 && c < 64) return 2584 + (c - 32); return -1;
}
struct Job { const float* W; const float* ks; bf16* WT; int ldw, ldt, kdst0, mode, nkb, nnb, nbatch; size_t sstride, dstride; };
__device__ __forceinline__ void transpose_item(const Job& J, int item, LAS float* scr, int lane) {
    const int per = J.nkb * J.nnb, e = item / per, r = item % per, kb = r / J.nnb, nb = r % J.nnb, k0 = kb * 64, n0 = nb * 64;
    const float* W = J.W + (size_t)e * J.sstride; bf16* WT = J.WT + (size_t)e * J.dstride;
    const int nq = 4 * (lane & 15), nd = n0 + nq;
    int sc;
    if (J.mode == 1) sc = in_col(nd);
    else if (J.mode == 2) { const int T = nd >> 8, w = nd & 255; sc = (w < 128) ? (T * 128 + w) : (512 + T * 128 + (w - 128)); }
    else sc = nd;
#pragma unroll 4
    for (int i = 0; i < 16; ++i) { const int kk = (lane >> 4) + 4 * i;
        f32x4 v = (f32x4){0.f, 0.f, 0.f, 0.f};
        if (sc >= 0) v = *(const f32x4*)(W + (size_t)(k0 + kk) * J.ldw + sc);
        if (J.ks) v = v * J.ks[k0 + kk];
        LAS float* d = scr + kk * 65 + nq; d[0] = v[0]; d[1] = v[1]; d[2] = v[2]; d[3] = v[3]; }
    LDS_WAIT(); asm volatile("" ::: "memory");
    const int c = lane & 7;
#pragma unroll
    for (int j = 0; j < 8; ++j) { const int n = (lane >> 3) + 8 * j; const LAS float* s = scr + (8 * c) * 65 + n;
        u32x4 o; o.x = cvt_pk_bf16(s[0 * 65], s[1 * 65]); o.y = cvt_pk_bf16(s[2 * 65], s[3 * 65]); o.z = cvt_pk_bf16(s[4 * 65], s[5 * 65]); o.w = cvt_pk_bf16(s[6 * 65], s[7 * 65]);
        *(u32x4*)(WT + (size_t)(n0 + n) * J.ldt + J.kdst0 + k0 + 8 * c) = o; }
    LDS_WAIT(); asm volatile("" ::: "memory");
}
constexpr int NJOBS = 15;
__device__ __forceinline__ Job get_job(const Args& a, int l, int j) {
    unsigned char* wl = a.ws + WS_WL0 + (size_t)l * WS_WLSTRIDE;
    Job J; J.ks = nullptr; J.kdst0 = 0; J.mode = 0; J.nbatch = 1; J.sstride = 0; J.dstride = 0;
#define SRC(i, per) ((const float*)a.in[i] + (size_t)l * (per))
    switch (j) {
    case 0:  J.W = SRC(3, (size_t)D * IN_W); J.ldw = IN_W; J.WT = (bf16*)(wl + WO_WIN); J.ldt = D; J.mode = 1; J.nkb = 32; J.nnb = NIN / 64; break;
    case 1:  J.W = SRC(8, 512 * D);  J.ldw = D; J.WT = (bf16*)(wl + WO_WBR); J.ldt = D; J.kdst0 = 0;    J.nkb = 8; J.nnb = 32; break;
    case 2:  J.W = SRC(16, 512 * D); J.ldw = D; J.WT = (bf16*)(wl + WO_WBR); J.ldt = D; J.kdst0 = 1024; J.nkb = 8; J.nnb = 32; break;
    case 3:  J.W = SRC(21, 512 * D); J.ldw = D; J.WT = (bf16*)(wl + WO_WBR); J.ldt = D; J.kdst0 = 1536; J.nkb = 8; J.nnb = 32; break;
    case 4:  J.W = SRC(22, (size_t)D * D); J.ldw = D; J.WT = (bf16*)(wl + WO_WOUT); J.ldt = D; J.nkb = 32; J.nnb = 32; break;
    case 5:  J.W = SRC(13, 512 * 768); J.ldw = 768; J.ks = SRC(12, 512); J.WT = (bf16*)(wl + WO_WUQ); J.ldt = 512; J.nkb = 8; J.nnb = 12; break;
    case 6:  J.W = SRC(15, 256 * 1024); J.ldw = 1024; J.ks = SRC(14, 256); J.WT = (bf16*)(wl + WO_WUKV); J.ldt = 256; J.nkb = 4; J.nnb = 16; break;
    case 7:  J.W = SRC(25, D * 512); J.ldw = 512; J.WT = (bf16*)(wl + WO_WXQ); J.ldt = D; J.nkb = 32; J.nnb = 8; break;
    case 8:  J.W = SRC(26, D * 512); J.ldw = 512; J.WT = (bf16*)(wl + WO_WXK); J.ldt = D; J.nkb = 32; J.nnb = 8; break;
    case 9:  J.W = SRC(27, D * 512); J.ldw = 512; J.WT = (bf16*)(wl + WO_WXV); J.ldt = D; J.nkb = 32; J.nnb = 8; break;
    case 10: J.W = SRC(28, 512 * D); J.ldw = D; J.WT = (bf16*)(wl + WO_WXO); J.ldt = 512; J.nkb = 8; J.nnb = 32; break;
    case 11: J.W = SRC(35, (size_t)32 * D * 1024); J.ldw = 1024; J.WT = (bf16*)(wl + WO_WEIN); J.ldt = D; J.mode = 2; J.nkb = 32; J.nnb = 16; J.nbatch = 32; J.sstride = (size_t)D * 1024; J.dstride = (size_t)1024 * D; break;
    case 12: J.W = SRC(36, (size_t)32 * 512 * D); J.ldw = D; J.WT = (bf16*)(wl + WO_WEOUT); J.ldt = 512; J.nkb = 8; J.nnb = 32; J.nbatch = 32; J.sstride = (size_t)512 * D; J.dstride = (size_t)D * 512; break;
    case 13: J.W = SRC(6, 2 * 2048 * 128); J.ldw = 128; J.WT = (bf16*)(wl + WO_W1C); J.ldt = 2048; J.nkb = 32; J.nnb = 2; J.nbatch = 2; J.sstride = 2048 * 128; J.dstride = 128 * 2048; break;
    default: J.W = SRC(7, 2 * 128 * 64); J.ldw = 64; J.WT = (bf16*)(wl + WO_W2C); J.ldt = 128; J.nkb = 2; J.nnb = 1; J.nbatch = 2; J.sstride = 128 * 64; J.dstride = 64 * 128; break;
    }
#undef SRC
    return J;
}

struct Row { f32x4 v[8]; };
__device__ __forceinline__ void row_load(Row& r, const float* p, int lane) {
    asm volatile("" : "+v"(lane));
#pragma unroll
    for (int j = 0; j < 8; ++j) r.v[j] = *(const f32x4*)(p + 4 * lane + 256 * j);
}
__device__ __forceinline__ void row_store_f32(const Row& r, float* p, int lane) {
    asm volatile("" : "+v"(lane));
#pragma unroll
    for (int j = 0; j < 8; ++j) *(f32x4*)(p + 4 * lane + 256 * j) = r.v[j];
}
__device__ __forceinline__ void row_store_bf16(const Row& r, bf16* p, int lane) {
    asm volatile("" : "+v"(lane));
#pragma unroll
    for (int j = 0; j < 8; ++j) { u32x2 w; w.x = cvt_pk_bf16(r.v[j][0], r.v[j][1]); w.y = cvt_pk_bf16(r.v[j][2], r.v[j][3]); *(u32x2*)(p + 4 * lane + 256 * j) = w; }
}
__device__ __forceinline__ void row_add_bf16(Row& r, const bf16* p, int lane) {
    asm volatile("" : "+v"(lane));
#pragma unroll
    for (int j = 0; j < 8; ++j) { const u32x2 w = *(const u32x2*)(p + 4 * lane + 256 * j); r.v[j][0] += bflo(w.x); r.v[j][1] += bfhi(w.x); r.v[j][2] += bflo(w.y); r.v[j][3] += bfhi(w.y); }
}
__device__ __forceinline__ void row_layernorm(Row& r, const float* g, const float* b, int lane) {
    asm volatile("" : "+v"(lane));
    float s = 0.f;
#pragma unroll
    for (int j = 0; j < 8; ++j) s += (r.v[j][0] + r.v[j][1]) + (r.v[j][2] + r.v[j][3]);
    const float mean = wave_sum(s) * (1.0f / D); float q = 0.f;
#pragma unroll
    for (int j = 0; j < 8; ++j) { r.v[j] = r.v[j] - mean; q += (r.v[j][0] * r.v[j][0] + r.v[j][1] * r.v[j][1]) + (r.v[j][2] * r.v[j][2] + r.v[j][3] * r.v[j][3]); }
    const float rstd = 1.0f / sqrtf(wave_sum(q) * (1.0f / D) + 1e-5f);
#pragma unroll
    for (int j = 0; j < 8; ++j) { const f32x4 gg = *(const f32x4*)(g + 4 * lane + 256 * j), bb = *(const f32x4*)(b + 4 * lane + 256 * j); r.v[j] = r.v[j] * rstd * gg + bb; }
}

template <class AP, class BP>
__device__ __forceinline__ f32x4 sgemm16(const AP& ap, const BP& bp, int K, int lane) {
    const int r = lane & 15, G = lane >> 4; f32x4 acc = (f32x4){0.f, 0.f, 0.f, 0.f};
#pragma unroll 4
    for (int k0 = 0; k0 < K; k0 += 32) { const bf16x8 a = *(const bf16x8*)ap(r, k0 + 8 * G), b = *(const bf16x8*)bp(r, k0 + 8 * G);
        acc = __builtin_amdgcn_mfma_f32_16x16x32_bf16(a, b, acc, 0, 0, 0); }
    return acc;
}
__device__ __forceinline__ void transpose_tile64(const bf16* src, size_t sp, bf16* dst, size_t dp, LAS bf16* scr, int lane) {
#pragma unroll
    for (int c = 0; c < 8; ++c) { const u32x4 v = *(const u32x4*)(src + (size_t)lane * sp + 8 * c); LAS unsigned* d = (LAS unsigned*)(scr + lane * 66 + 8 * c); d[0] = v.x; d[1] = v.y; d[2] = v.z; d[3] = v.w; }
    LDS_WAIT(); asm volatile("" ::: "memory");
#pragma unroll
    for (int c = 0; c < 8; ++c) { unsigned w[4];
#pragma unroll
        for (int q = 0; q < 4; ++q) { const unsigned lo = scr[(8 * c + 2 * q) * 66 + lane], hi = scr[(8 * c + 2 * q + 1) * 66 + lane]; w[q] = lo | (hi << 16); }
        *(u32x4*)(dst + (size_t)lane * dp + 8 * c) = (u32x4){w[0], w[1], w[2], w[3]}; }
    LDS_WAIT(); asm volatile("" ::: "memory");
}
__device__ __forceinline__ float gelu_tanh(float x) { const float u = 0.7978845608028654f * (x + 0.044715f * x * x * x); return 0.5f * x * (1.0f + tanhf(u)); }

__device__ __forceinline__ void phase_prologue(const Args& a, Frame& F) {
    LAS float* scr = (LAS float*)(F.lds + F.wave * 16640);
    const int gw = F.gw, NGW = F.NGW, lane = F.lane;
    { int off = 0;
      for (int l = 0; l < DEPTH; ++l)
        for (int j = 0; j < NJOBS; ++j) { const Job J = get_job(a, l, j); const int n = J.nbatch * J.nkb * J.nnb;
            int st = (gw - off) % NGW; if (st < 0) st += NGW;
            for (int it = st; it < n; it += NGW) transpose_item(J, it, scr, lane);
            off = (off + n) % NGW; } }
#pragma unroll 1
    for (int i = gw * 64 + lane; i < DEPTH * NIN; i += NGW * 64) { const int l = i / NIN, n = i % NIN; const int sc = in_col(n);
        ((float*)(a.ws + WS_WL0 + (size_t)l * WS_WLSTRIDE + WO_BIASP))[n] = sc >= 0 ? ((const float*)a.in[4])[(size_t)l * IN_W + sc] : 0.f; }
#pragma unroll 1
    for (int it = gw; it < DEPTH * 4 * 16 * 32; it += NGW) { const int nb = it & 31, cb = (it >> 5) & 15, g = (it >> 9) & 3, l = it >> 11; const int n = nb * 64 + lane;
        const float* wp = (const float*)a.in[9] + ((size_t)(l * 4 + g) * 128 + 8 * cb) * 128; const float* ps = (const float*)a.in[10] + l * 512 + 128 * g;
        const float* wo = (const float*)a.in[11] + ((size_t)l * 512 + 128 * g) * D + n;
        float acc[8];
#pragma unroll
        for (int i = 0; i < 8; ++i) acc[i] = 0.f;
        for (int d = 0; d < 128; ++d) { const float b = wo[(size_t)d * D] * ps[d];
#pragma unroll
            for (int i = 0; i < 8; ++i) acc[i] += wp[i * 128 + d] * b; }
        bf16* dst = (bf16*)(a.ws + WS_WL0 + (size_t)l * WS_WLSTRIDE + WO_WBR) + (size_t)n * D + 512 + 128 * g + 8 * cb;
        *(u32x4*)dst = (u32x4){cvt_pk_bf16(acc[0], acc[1]), cvt_pk_bf16(acc[2], acc[3]), cvt_pk_bf16(acc[4], acc[5]), cvt_pk_bf16(acc[6], acc[7])}; }
#pragma unroll 1
    for (int it = gw; it < DEPTH * 2; it += NGW) { const float* pos = (const float*)a.in[5] + (size_t)it * 2048; const float* w1 = (const float*)a.in[6] + (size_t)it * 2048 * 128;
        float a0 = 0.f, a1 = 0.f;
        for (int k = 0; k < 2048; ++k) { const float p = pos[k]; a0 += p * w1[(size_t)k * 128 + lane]; a1 += p * w1[(size_t)k * 128 + 64 + lane]; }
        float* dst = (float*)(a.ws + WS_WL0 + (size_t)(it >> 1) * WS_WLSTRIDE + WO_B1C) + (it & 1) * 128; dst[lane] = a0; dst[64 + lane] = a1; }
#pragma unroll 1
    for (int i = gw * 64 + lane; i < S * 16; i += NGW * 64) { const int t = i >> 4, k = i & 15; const float inv = powf(10000.0f, -(float)k / 16.0f); const float ang = (float)((const int*)a.in[2])[t] * inv;
        float sn, cs; sincosf(ang, &sn, &cs); ((f32x2*)(a.ws + WS_ROPE))[i] = (f32x2){cs, sn}; }
#pragma unroll 1
    for (int r = gw; r < S + 256; r += NGW) { Row rw;
        if (r < S) { row_load(rw, (const float*)a.in[0] + (size_t)r * D, lane); row_store_f32(rw, (float*)(a.ws + WS_X) + (size_t)r * D, lane); row_store_bf16(rw, (bf16*)(a.ws + WS_XB) + (size_t)r * D, lane); }
        else { row_load(rw, (const float*)a.in[1] + (size_t)(r - S) * D, lane); row_store_bf16(rw, (bf16*)(a.ws + WS_MEMB) + (size_t)(r - S) * D, lane); } }
}

__device__ __forceinline__ int crow(int r, int hi) { return (r & 3) + 8 * (r >> 2) + 4 * hi; }
template <int DK, int DV, class V>
__device__ __forceinline__ void attn32(const V& v, int lane, float& m_fin, float& l_fin) {
    const int col = lane & 31, hi = lane >> 5;
    constexpr int NKS = DK / 16, NVB = DV / 32;
    bf16x8 qf[NKS];
    { const bf16* qp = v.qptr(col);
#pragma unroll
      for (int s = 0; s < NKS; ++s) qf[s] = *(const bf16x8*)(qp + 16 * s + 8 * hi); }
    f32x16 o[NVB];
#pragma unroll
    for (int b = 0; b < NVB; ++b)
#pragma unroll
        for (int r = 0; r < 16; ++r) o[b][r] = 0.f;
    float m_run = -INFINITY, l_run = 0.f;
    for (int T = v.tb; T < v.te; ++T) {
        const int key0 = 32 * T;
        const bf16* kp = v.kptr(key0 + col);
        f32x16 sacc;
#pragma unroll
        for (int r = 0; r < 16; ++r) sacc[r] = 0.f;
#pragma unroll
        for (int s = 0; s < NKS; ++s) { const bf16x8 kf = *(const bf16x8*)(kp + 16 * s + 8 * hi); sacc = __builtin_amdgcn_mfma_f32_32x32x16_bf16(kf, qf[s], sacc, 0, 0, 0); }
        float x[16]; float mt = -INFINITY;
#pragma unroll
        for (int r = 0; r < 16; ++r) { const int key = key0 + crow(r, hi); x[r] = v.valid(key, col) ? sacc[r] * v.scale2 : -INFINITY; mt = fmaxf(mt, x[r]); }
        mt = fmaxf(mt, __shfl_xor(mt, 32));
        const float m_new = fmaxf(m_run, mt);
        const float mref = (m_new == -INFINITY) ? 0.f : m_new;
        const float corr = __builtin_amdgcn_exp2f(m_run - mref);
        float ps = 0.f;
#pragma unroll
        for (int r = 0; r < 16; ++r) { x[r] = __builtin_amdgcn_exp2f(x[r] - mref); ps += x[r]; }
        l_run = l_run * corr + ps; m_run = m_new;
#pragma unroll
        for (int b = 0; b < NVB; ++b)
#pragma unroll
            for (int r = 0; r < 16; ++r) o[b][r] *= corr;
        bf16x8 pf[2];
#pragma unroll
        for (int s2 = 0; s2 < 2; ++s2) { const u32x4 w = (u32x4){cvt_pk_bf16(x[8 * s2 + 0], x[8 * s2 + 1]), cvt_pk_bf16(x[8 * s2 + 2], x[8 * s2 + 3]), cvt_pk_bf16(x[8 * s2 + 4], x[8 * s2 + 5]), cvt_pk_bf16(x[8 * s2 + 6], x[8 * s2 + 7])};
            pf[s2] = __builtin_bit_cast(bf16x8, w); }
#pragma unroll
        for (int b = 0; b < NVB; ++b) { const bf16* vp = v.vtptr(32 * b + col) + key0 + 4 * hi;
#pragma unroll
            for (int s2 = 0; s2 < 2; ++s2) { const u32x2 lo = *(const u32x2*)(vp + 16 * s2), hh = *(const u32x2*)(vp + 16 * s2 + 8);
                const bf16x8 vf = __builtin_bit_cast(bf16x8, (u32x4){lo.x, lo.y, hh.x, hh.y});
                o[b] = __builtin_amdgcn_mfma_f32_32x32x16_bf16(vf, pf[s2], o[b], 0, 0, 0); } }
    }
    const float l = l_run + __shfl_xor(l_run, 32);
    const float inv = l > 0.f ? 1.0f / l : 0.f;
#pragma unroll
    for (int b = 0; b < NVB; ++b)
#pragma unroll
        for (int i = 0; i < 4; ++i) v.store(col, 32 * b + 8 * i + 4 * hi, (f32x4){o[b][4 * i] * inv, o[b][4 * i + 1] * inv, o[b][4 * i + 2] * inv, o[b][4 * i + 3] * inv});
    m_fin = m_run; l_fin = l;
}
__device__ __forceinline__ void store4_bf16(bf16* p, const f32x4 v) { *(u32x2*)p = (u32x2){cvt_pk_bf16(v[0], v[1]), cvt_pk_bf16(v[2], v[3])}; }

struct VarMLA {
    const bf16* Q; const bf16* K; const bf16* Vt; bf16* O; int t0, hd, tb, te; float scale2;
    __device__ __forceinline__ const bf16* qptr(int col) const { return Q + (size_t)(t0 + col) * 768 + hd * 96; }
    __device__ __forceinline__ const bf16* kptr(int key) const { return K + (size_t)key * 768 + hd * 96; }
    __device__ __forceinline__ const bf16* vtptr(int dv) const { return Vt + (size_t)(hd * 64 + dv) * S; }
    __device__ __forceinline__ bool valid(int key, int col) const { return key <= t0 + col; }
    __device__ __forceinline__ void store(int col, int dv, const f32x4 x) const { store4_bf16(O + (size_t)(t0 + col) * D + 1024 + hd * 64 + dv, x); }
};
struct VarWin {
    const bf16* U2; const bf16* Vt; bf16* O; int t0, g, tb, te; float scale2;
    __device__ __forceinline__ const bf16* qptr(int col) const { return U2 + (size_t)(t0 + (col >> 2)) * U2W + U2_Q + (4 * g + (col & 3)) * 64; }
    __device__ __forceinline__ const bf16* kptr(int key) const { return U2 + (size_t)key * U2W + U2_KV + (4 * 2 + g) * 64; }
    __device__ __forceinline__ const bf16* vtptr(int dv) const { return Vt + (size_t)(g * 64 + dv) * S; }
    __device__ __forceinline__ bool valid(int key, int col) const { const int tok = t0 + (col >> 2); return key <= tok && key > tok - 512; }
    __device__ __forceinline__ void store(int col, int dv, const f32x4 x) const { store4_bf16(O + (size_t)(t0 + (col >> 2)) * 512 + (4 * g + (col & 3)) * 64 + dv, x); }
};
struct VarCmp {
    const bf16* U2; const bf16* KC; const bf16* Vt; bf16* O; int t0, g, tb, te; float scale2;
    __device__ __forceinline__ const bf16* qptr(int col) const { return U2 + (size_t)(t0 + (col >> 2)) * U2W + U2_Q + (4 * g + (col & 3)) * 64; }
    __device__ __forceinline__ const bf16* kptr(int c) const { return KC + (size_t)(g * 1024 + c) * 64; }
    __device__ __forceinline__ const bf16* vtptr(int dv) const { return Vt + (size_t)(g * 64 + dv) * 1024; }
    __device__ __forceinline__ bool valid(int c, int col) const { return 16 * c + 31 <= t0 + (col >> 2); }
    __device__ __forceinline__ void store(int col, int dv, const f32x4 x) const { store4_bf16(O + (size_t)(t0 + (col >> 2)) * 512 + (4 * g + (col & 3)) * 64 + dv, x); }
};
struct VarX {
    const bf16* Q; const bf16* K; const bf16* Vt; bf16* O; int t0, hd, tb, te; float scale2;
    __device__ __forceinline__ const bf16* qptr(int col) const { return Q + (size_t)(t0 + col) * 512 + hd * 128; }
    __device__ __forceinline__ const bf16* kptr(int key) const { return K + (size_t)key * 512 + hd * 128; }
    __device__ __forceinline__ const bf16* vtptr(int dv) const { return Vt + (size_t)(hd * 128 + dv) * 256; }
    __device__ __forceinline__ bool valid(int, int) const { return true; }
    __device__ __forceinline__ void store(int col, int dv, const f32x4 x) const { store4_bf16(O + (size_t)(t0 + col) * 512 + hd * 128 + dv, x); }
};
__device__ __forceinline__ void cmp_scores(const VarCmp& v, int lane, float m_fin, float l_fin, float* sc) {
    const int col = lane & 31, hi = lane >> 5;
    bf16x8 qf[4];
    { const bf16* qp = v.qptr(col);
#pragma unroll
      for (int s = 0; s < 4; ++s) qf[s] = *(const bf16x8*)(qp + 16 * s + 8 * hi); }
    const float mref = (m_fin == -INFINITY) ? 0.f : m_fin; const float inv = l_fin > 0.f ? 1.0f / l_fin : 0.f;
    float* dst = sc + (size_t)((v.t0 + (col >> 2)) * 2 + v.g) * 256;
    float carry = 0.f;
    for (int T = 0; T < 32; ++T) {
        float sv[4];
        if (T < v.te) {
            const int key0 = 32 * T; const bf16* kp = v.kptr(key0 + col);
            f32x16 sacc;
#pragma unroll
            for (int r = 0; r < 16; ++r) sacc[r] = 0.f;
#pragma unroll
            for (int s = 0; s < 4; ++s) { const bf16x8 kf = *(const bf16x8*)(kp + 16 * s + 8 * hi); sacc = __builtin_amdgcn_mfma_f32_32x32x16_bf16(kf, qf[s], sacc, 0, 0, 0); }
            float Gs[4], Es[4];
#pragma unroll
            for (int i = 0; i < 4; ++i) { float p[4];
#pragma unroll
                for (int q = 0; q < 4; ++q) { const int r = 4 * i + q; const int key = key0 + crow(r, hi); p[q] = v.valid(key, col) ? __builtin_amdgcn_exp2f(sacc[r] * v.scale2 - mref) * inv : 0.f; }
                Gs[i] = (p[0] + p[1]) + (p[2] + p[3]); Es[i] = p[3]; }
#pragma unroll
            for (int i = 0; i < 4; ++i) { Gs[i] += __shfl_xor(Gs[i], 1); Gs[i] += __shfl_xor(Gs[i], 2); Es[i] += __shfl_xor(Es[i], 1); Es[i] += __shfl_xor(Es[i], 2); }
            float eo[4];
#pragma unroll
            for (int i = 0; i < 4; ++i) eo[i] = __shfl_xor(Es[i], 32);
            if (hi) { sv[0] = Gs[0] + eo[0]; sv[1] = Gs[1] + eo[1]; sv[2] = Gs[2] + eo[2]; sv[3] = Gs[3] + eo[3]; }
            else { sv[0] = Gs[0] + carry; sv[1] = Gs[1] + eo[0]; sv[2] = Gs[2] + eo[1]; sv[3] = Gs[3] + eo[2]; }
            carry = eo[3];
        } else { sv[0] = hi ? 0.f : carry; sv[1] = 0.f; sv[2] = 0.f; sv[3] = 0.f; carry = 0.f; }
        if ((col & 3) == 0) {
#pragma unroll
            for (int i = 0; i < 4; ++i) dst[8 * T + 2 * i + hi] = sv[i]; }
    }
}

__device__ __forceinline__ void sel_attn_unit(const bf16* U2, const bf16* VTS, const bf16* OCMP, const bf16* OWIN, const int* idx, int nv, bf16* ABR, int t, int g, int lane) {
    const int c16 = lane & 15, G = lane >> 4;
    const float scale2 = 0.125f * LOG2E;
    bf16x8 qf[2];
    { const bf16* qp = U2 + (size_t)t * U2W + U2_Q + (4 * g + (c16 & 3)) * 64;
#pragma unroll
      for (int ks = 0; ks < 2; ++ks) { qf[ks] = *(const bf16x8*)(qp + 32 * ks + 8 * G); if (c16 >= 4) qf[ks] = (bf16x8){0, 0, 0, 0, 0, 0, 0, 0}; } }
    f32x4 o[4];
#pragma unroll
    for (int d = 0; d < 4; ++d) o[d] = (f32x4){0.f, 0.f, 0.f, 0.f};
    float m_run = -INFINITY, l_run = 0.f;
    for (int b = 0; b < nv; ++b) {
        const int blk = __builtin_amdgcn_readfirstlane(idx[b]); const int key0 = 64 * blk;
        f32x4 acc[4];
#pragma unroll
        for (int kt = 0; kt < 4; ++kt) { const bf16* kp = U2 + (size_t)(key0 + 16 * kt + c16) * U2W + U2_KV + (2 * 2 + g) * 64 + 8 * G;
            const bf16x8 k0 = *(const bf16x8*)kp, k1 = *(const bf16x8*)(kp + 32);
            acc[kt] = __builtin_amdgcn_mfma_f32_16x16x32_bf16(k0, qf[0], (f32x4){0.f, 0.f, 0.f, 0.f}, 0, 0, 0);
            acc[kt] = __builtin_amdgcn_mfma_f32_16x16x32_bf16(k1, qf[1], acc[kt], 0, 0, 0); }
        float mt = -INFINITY;
#pragma unroll
        for (int kt = 0; kt < 4; ++kt)
#pragma unroll
            for (int i = 0; i < 4; ++i) { const int key = key0 + 16 * kt + 4 * G + i; acc[kt][i] = (key <= t) ? acc[kt][i] * scale2 : -INFINITY; mt = fmaxf(mt, acc[kt][i]); }
        mt = fmaxf(mt, __shfl_xor(mt, 16)); mt = fmaxf(mt, __shfl_xor(mt, 32));
        const float m_new = fmaxf(m_run, mt); const float mref = (m_new == -INFINITY) ? 0.f : m_new;
        const float corr = __builtin_amdgcn_exp2f(m_run - mref); float ps = 0.f;
#pragma unroll
        for (int kt = 0; kt < 4; ++kt)
#pragma unroll
            for (int i = 0; i < 4; ++i) { acc[kt][i] = __builtin_amdgcn_exp2f(acc[kt][i] - mref); ps += acc[kt][i]; }
        l_run = l_run * corr + ps; m_run = m_new;
#pragma unroll
        for (int d = 0; d < 4; ++d) o[d] = o[d] * corr;
        bf16x8 pf[2];
#pragma unroll
        for (int u = 0; u < 2; ++u) pf[u] = __builtin_bit_cast(bf16x8, (u32x4){cvt_pk_bf16(acc[2 * u][0], acc[2 * u][1]), cvt_pk_bf16(acc[2 * u][2], acc[2 * u][3]), cvt_pk_bf16(acc[2 * u + 1][0], acc[2 * u + 1][1]), cvt_pk_bf16(acc[2 * u + 1][2], acc[2 * u + 1][3])});
#pragma unroll
        for (int d = 0; d < 4; ++d) { const bf16* vp = VTS + (size_t)(g * 64 + 16 * d + c16) * S + key0 + 4 * G;
#pragma unroll
            for (int u = 0; u < 2; ++u) { const u32x2 lo = *(const u32x2*)(vp + 32 * u), hh = *(const u32x2*)(vp + 32 * u + 16);
                o[d] = __builtin_amdgcn_mfma_f32_16x16x32_bf16(__builtin_bit_cast(bf16x8, (u32x4){lo.x, lo.y, hh.x, hh.y}), pf[u], o[d], 0, 0, 0); } }
    }
    float l = l_run; l += __shfl_xor(l, 16); l += __shfl_xor(l, 32);
    const float inv = l > 0.f ? 1.0f / l : 0.f;
    if (c16 < 4) { const int head = 4 * g + c16; const bf16* gp = U2 + (size_t)t * U2W + U2_G + head * 3;
        const float s0 = sigmoidf_(bf2f(gp[0])), s1 = sigmoidf_(bf2f(gp[1])) * inv, s2 = sigmoidf_(bf2f(gp[2]));
#pragma unroll
        for (int d = 0; d < 4; ++d) { const size_t off = (size_t)t * 512 + head * 64 + 16 * d + 4 * G; const u32x2 oc = *(const u32x2*)(OCMP + off), ow = *(const u32x2*)(OWIN + off);
            f32x4 r; r[0] = s0 * bflo(oc.x) + s1 * o[d][0] + s2 * bflo(ow.x); r[1] = s0 * bfhi(oc.x) + s1 * o[d][1] + s2 * bfhi(ow.x);
            r[2] = s0 * bflo(oc.y) + s1 * o[d][2] + s2 * bflo(ow.y); r[3] = s0 * bfhi(oc.y) + s1 * o[d][3] + s2 * bfhi(ow.y);
            store4_bf16(ABR + (size_t)t * D + head * 64 + 16 * d + 4 * G, r); } }
}
__device__ __forceinline__ void topk_unit(const float* sc, int t, int* idx_out, int* nv_out, int lane) {
    const int cur = t >> 6;
    if (cur + 1 <= 16) { if (lane < 16) idx_out[lane] = lane <= cur ? lane : cur; if (lane == 0) *nv_out = cur + 1; return; }
    f32x4 v = *(const f32x4*)(sc + 4 * lane);
#pragma unroll
    for (int q = 0; q < 4; ++q) { const int j = 4 * lane + q; if (j == 0 || j >= cur - 1) v[q] = -INFINITY; }
    if (lane == 0) { idx_out[0] = 0; idx_out[1] = cur - 1; idx_out[2] = cur; *nv_out = 16; }
    for (int n = 0; n < 13; ++n) {
        float bv = v[0]; int bi = 4 * lane;
#pragma unroll
        for (int q = 1; q < 4; ++q) if (v[q] > bv) { bv = v[q]; bi = 4 * lane + q; }
#pragma unroll
        for (int o = 1; o < 64; o <<= 1) { const float ov = __shfl_xor(bv, o); const int oi = __shfl_xor(bi, o); if (ov > bv || (ov == bv && oi < bi)) { bv = ov; bi = oi; } }
        if (lane == 0) idx_out[3 + n] = bi;
        if ((bi >> 2) == lane) {
#pragma unroll
            for (int q = 0; q < 4; ++q) if ((bi & 3) == q) v[q] = -INFINITY; }
    }
}

struct LP {
    unsigned char* ws; unsigned char* wl; int l;
    __device__ __forceinline__ bf16* w(size_t off) const { return (bf16*)(wl + off); }
    __device__ __forceinline__ bf16* b(size_t off) const { return (bf16*)(ws + off); }
    __device__ __forceinline__ float* f(size_t off) const { return (float*)(ws + off); }
    __device__ __forceinline__ int* i(size_t off) const { return (int*)(ws + off); }
};
#define INF32(a, idx, per) ((const float*)(a).in[idx] + (size_t)l * (per))

#ifndef BPARTS
#define BPARTS 31
#endif
__device__ __forceinline__ void phase_prep(const Args& a, Frame& F, const LP& P) {
    const int l = P.l, lane = F.lane, tid = F.tid;
    const bf16* U2 = P.b(WS_U2); bf16* ABR = P.b(WS_ABR);
    if (BPARTS & 1) { const float* cw = INF32(a, 17, 31 * 512); const float* cb = INF32(a, 18, 512); const float* lg = INF32(a, 19, 512); const float* lb = INF32(a, 20, 512);
      LAS float* cs = (LAS float*)F.lds;
      const int c = tid;
      float w[31];
#pragma unroll
      for (int k = 0; k < 31; ++k) w[k] = cw[k * 512 + c];
      const float bias = cb[c];
#pragma unroll 1
      for (int tile = blockIdx.x; tile < S / 32; tile += F.G) { const int t0 = tile * 32;
          float hreg[62];
#pragma unroll
          for (int r = 0; r < 62; ++r) { int tok = t0 - 30 + r; const bool ok = tok >= 0; tok = ok ? tok : 0;
              const bf16* up = U2 + (size_t)tok * U2W + U2_CONV + c; const float hv = bf2f(up[0]) * sigmoidf_(bf2f(up[512])); hreg[r] = ok ? hv : 0.f; }
#pragma unroll
          for (int i = 0; i < 32; ++i) { float acc = bias;
#pragma unroll
              for (int k = 0; k < 31; ++k) acc += w[k] * hreg[i + k];
              cs[i * 512 + c] = acc; }
          __syncthreads();
#pragma unroll
          for (int q = 0; q < 4; ++q) { const int tt = 4 * F.wave + q; float v[8]; float s = 0.f;
#pragma unroll
              for (int j = 0; j < 8; ++j) { v[j] = cs[tt * 512 + lane + 64 * j]; s += v[j]; }
              const float mean = wave_sum(s) * (1.0f / 512.0f); float qq = 0.f;
#pragma unroll
              for (int j = 0; j < 8; ++j) { v[j] -= mean; qq += v[j] * v[j]; }
              const float rstd = 1.0f / sqrtf(wave_sum(qq) * (1.0f / 512.0f) + 1e-5f);
#pragma unroll
              for (int j = 0; j < 8; ++j) { const int ch = lane + 64 * j; const float y = v[j] * rstd * lg[ch] + lb[ch]; ABR[(size_t)(t0 + tt) * D + 1536 + ch] = f2bf(y * sigmoidf_(y)); } }
          __syncthreads(); } }
    if (BPARTS & 2) { float* rq = P.f(WS_RSTD); float* rkv = rq + S;
#pragma unroll 1
      for (int t = F.gw; t < S; t += F.NGW) { const bf16* row = U2 + (size_t)t * U2W;
          { const u32x4 v = *(const u32x4*)(row + U2_CQ + 8 * lane); float s = 0.f;
#pragma unroll
            for (int q = 0; q < 4; ++q) { const float x0 = bflo(v[q]), x1 = bfhi(v[q]); s += x0 * x0 + x1 * x1; }
            s = wave_sum(s); if (lane == 0) rq[t] = 1.0f / sqrtf(s * (1.0f / 512.0f) + 1e-6f); }
          { const u32x2 v = *(const u32x2*)(row + U2_CKV + 4 * lane); float s = bflo(v.x) * bflo(v.x) + bfhi(v.x) * bfhi(v.x) + bflo(v.y) * bflo(v.y) + bfhi(v.y) * bfhi(v.y);
            s = wave_sum(s); if (lane == 0) rkv[t] = 1.0f / sqrtf(s * (1.0f / 256.0f) + 1e-6f); }
          { const int w = 2 << (lane >> 4); const int cnt = (t + 1 < w) ? (t + 1) : w; float sum[8];
#pragma unroll
            for (int q = 0; q < 8; ++q) sum[q] = 0.f;
            u32x4 self = (u32x4){0u, 0u, 0u, 0u};
            for (int i = 0; i < cnt; ++i) { const u32x4 v = *(const u32x4*)(U2 + (size_t)(t - i) * U2W + U2_POOL + 8 * lane); if (i == 0) self = v;
#pragma unroll
                for (int q = 0; q < 4; ++q) { sum[2 * q] += bflo(v[q]); sum[2 * q + 1] += bfhi(v[q]); } }
            const float ic = 1.0f / (float)cnt; u32x4 o;
#pragma unroll
            for (int q = 0; q < 4; ++q) o[q] = cvt_pk_bf16(sum[2 * q] * ic - bflo(self[q]), sum[2 * q + 1] * ic - bfhi(self[q]));
            *(u32x4*)(ABR + (size_t)t * D + 512 + 8 * lane) = o; } } }
    if (BPARTS & 4) { LAS bf16* scr = (LAS bf16*)(F.lds + 65536 + F.wave * 8448);
#pragma unroll 1
      for (int it = F.gw; it < 2 * 2 * (S / 64); it += F.NGW) { const int tt = it % (S / 64), g = (it / (S / 64)) & 1, which = it / (2 * (S / 64));
          const bf16* src = U2 + (size_t)(tt * 64) * U2W + U2_KV + ((which ? 5 : 3) * 2 + g) * 64;
          bf16* dst = P.b(which ? WS_VTWIN : WS_VTSEL) + (size_t)(g * 64) * S + tt * 64;
          transpose_tile64(src, U2W, dst, S, scr, lane); } }
    if (BPARTS & 8) { bf16* HID = P.b(WS_HID); const float* b1c = (const float*)(P.wl + WO_B1C);
#pragma unroll 1
      for (int it = F.gw; it < 4 * 64 * 8; it += F.NGW) { const int nt = it & 7, mt = (it >> 3) & 63, jg = it >> 9, j = jg >> 1, g = jg & 1;
          const bf16* Ab = U2 + U2_KV + (j * 2 + g) * 64; const bf16* Bb = P.w(WO_W1C) + (size_t)j * 128 * 2048;
          auto ap = [&](int r, int k) { int n = 16 * mt + r; n = n > 1022 ? 1022 : n; return Ab + (size_t)(16 * n + (k >> 6)) * U2W + (k & 63); };
          auto bp = [&](int r, int k) { return Bb + (size_t)(16 * nt + r) * 2048 + k; };
          const f32x4 acc = sgemm16(ap, bp, 2048, lane);
          const int h = 16 * nt + (lane & 15); const float bb = b1c[j * 128 + h];
#pragma unroll
          for (int i = 0; i < 4; ++i) { const int n = 16 * mt + 4 * (lane >> 4) + i; HID[((size_t)jg * 1024 + n) * 128 + h] = f2bf(gelu_tanh(acc[i] + bb)); } } }
    if (BPARTS & 16) { const bf16* MEMB = P.b(WS_MEMB); bf16* KX = P.b(WS_KX) + (size_t)l * 256 * 512; bf16* VXT = P.b(WS_VXT) + (size_t)l * 512 * 256;
#pragma unroll 1
      for (int it = F.gw; it < 1024; it += F.NGW) {
          if (it < 512) { const int mt = it >> 5, nt = it & 31;
              auto ap = [&](int r, int k) { return MEMB + (size_t)(16 * mt + r) * D + k; };
              auto bp = [&](int r, int k) { return P.w(WO_WXK) + (size_t)(16 * nt + r) * D + k; };
              const f32x4 acc = sgemm16(ap, bp, D, lane);
#pragma unroll
              for (int i = 0; i < 4; ++i) KX[(size_t)(16 * mt + 4 * (lane >> 4) + i) * 512 + 16 * nt + (lane & 15)] = f2bf(acc[i]);
          } else { const int q = it - 512, mt = q >> 4, nt = q & 15;
              auto ap = [&](int r, int k) { return P.w(WO_WXV) + (size_t)(16 * mt + r) * D + k; };
              auto bp = [&](int r, int k) { return MEMB + (size_t)(16 * nt + r) * D + k; };
              const f32x4 acc = sgemm16(ap, bp, D, lane);
#pragma unroll
              for (int i = 0; i < 4; ++i) VXT[(size_t)(16 * mt + 4 * (lane >> 4) + i) * 256 + 16 * nt + (lane & 15)] = f2bf(acc[i]); } } }
}

__device__ __forceinline__ void phase_compress2(Frame& F, const LP& P) {
    const int lane = F.lane; const bf16* HID = P.b(WS_HID); const bf16* W2 = P.w(WO_W2C);
#pragma unroll 1
    for (int it = F.gw; it < 1024; it += F.NGW) {
        if (it < 512) { const int nt = it & 3, mt = (it >> 2) & 63, g = it >> 8;
            auto ap = [&](int r, int k) { return HID + ((size_t)(0 * 2 + g) * 1024 + 16 * mt + r) * 128 + k; };
            auto bp = [&](int r, int k) { return W2 + (size_t)(16 * nt + r) * 128 + k; };
            const f32x4 acc = sgemm16(ap, bp, 128, lane);
#pragma unroll
            for (int i = 0; i < 4; ++i) P.b(WS_KC)[((size_t)g * 1024 + 16 * mt + 4 * (lane >> 4) + i) * 64 + 16 * nt + (lane & 15)] = f2bf(acc[i]);
        } else { const int q = it - 512, nt = q & 63, mt = (q >> 6) & 3, g = q >> 8;
            auto ap = [&](int r, int k) { return W2 + (size_t)64 * 128 + (size_t)(16 * mt + r) * 128 + k; };
            auto bp = [&](int r, int k) { return HID + ((size_t)(1 * 2 + g) * 1024 + 16 * nt + r) * 128 + k; };
            const f32x4 acc = sgemm16(ap, bp, 128, lane);
#pragma unroll
            for (int i = 0; i < 4; ++i) P.b(WS_VCT)[((size_t)g * 64 + 16 * mt + 4 * (lane >> 4) + i) * 1024 + 16 * nt + (lane & 15)] = f2bf(acc[i]); } }
}

__device__ __forceinline__ void phase_d(Frame& F, const LP& P) {
    const int lane = F.lane;
    { const bf16* QH = P.b(WS_QH); const bf16* KVH = P.b(WS_KVH); const bf16* U2 = P.b(WS_U2); bf16* QM = P.b(WS_QM); bf16* KM = P.b(WS_KM); const f32x2* rope = (const f32x2*)(P.ws + WS_ROPE);
      const float qs = 0.10206207261596577f * LOG2E;
#pragma unroll 1
      for (int i = F.gw * 64 + lane; i < S * 8; i += F.NGW * 64) { const int t = i >> 3, hd = i & 7;
          const bf16* qp = QH + (size_t)t * 768 + hd * 96; bf16* qo = QM + (size_t)t * 768 + hd * 96; bf16* ko = KM + (size_t)t * 768 + hd * 96;
#pragma unroll
          for (int c = 0; c < 8; ++c) { const u32x4 v = *(const u32x4*)(qp + 8 * c); u32x4 o;
#pragma unroll
              for (int q = 0; q < 4; ++q) o[q] = cvt_pk_bf16(bflo(v[q]) * qs, bfhi(v[q]) * qs);
              *(u32x4*)(qo + 8 * c) = o; }
#pragma unroll
          for (int c = 0; c < 8; ++c) *(u32x4*)(ko + 8 * c) = *(const u32x4*)(KVH + (size_t)t * 1024 + hd * 128 + 8 * c);
          const bf16* kr = U2 + (size_t)t * U2W + U2_KR;
#pragma unroll
          for (int k = 0; k < 16; k += 2) { const f32x2 cs0 = rope[t * 16 + k], cs1 = rope[t * 16 + k + 1];
              { const unsigned a = *(const unsigned*)(qp + 64 + k), b = *(const unsigned*)(qp + 80 + k);
                const float x10 = bflo(a), x11 = bfhi(a), x20 = bflo(b), x21 = bfhi(b);
                *(unsigned*)(qo + 64 + k) = cvt_pk_bf16((x10 * cs0.x - x20 * cs0.y) * qs, (x11 * cs1.x - x21 * cs1.y) * qs);
                *(unsigned*)(qo + 80 + k) = cvt_pk_bf16((x20 * cs0.x + x10 * cs0.y) * qs, (x21 * cs1.x + x11 * cs1.y) * qs); }
              { const unsigned a = *(const unsigned*)(kr + k), b = *(const unsigned*)(kr + 16 + k);
                const float x10 = bflo(a), x11 = bfhi(a), x20 = bflo(b), x21 = bfhi(b);
                *(unsigned*)(ko + 64 + k) = cvt_pk_bf16(x10 * cs0.x - x20 * cs0.y, x11 * cs1.x - x21 * cs1.y);
                *(unsigned*)(ko + 80 + k) = cvt_pk_bf16(x20 * cs0.x + x10 * cs0.y, x21 * cs1.x + x11 * cs1.y); } } }
      LAS bf16* scr = (LAS bf16*)(F.lds + F.wave * 8448);
#pragma unroll 1
      for (int it = F.gw; it < 8 * (S / 64); it += F.NGW) { const int tt = it % (S / 64), hd = it / (S / 64);
          transpose_tile64(KVH + (size_t)(tt * 64) * 1024 + hd * 128 + 64, 1024, P.b(WS_VTM) + (size_t)(hd * 64) * S + tt * 64, S, scr, lane); } }
#pragma unroll 1
    for (int u = F.gw; u < (S / 8) * 2; u += F.NGW) { const int g = u & 1, t0 = (u >> 1) * 8;
        VarCmp v; v.U2 = P.b(WS_U2); v.KC = P.b(WS_KC); v.Vt = P.b(WS_VCT); v.O = P.b(WS_OCMP); v.t0 = t0; v.g = g; v.scale2 = 0.125f * LOG2E; v.tb = 0;
        const int cmax = (t0 + 7 >= 31) ? ((t0 + 7 - 31) >> 4) : -1; v.te = cmax < 0 ? 0 : (cmax >> 5) + 1;
        float m, lsum; attn32<64, 64>(v, lane, m, lsum);
        cmp_scores(v, lane, m, lsum, P.f(WS_SCORES)); }
}

__device__ __forceinline__ void phase_e(Frame& F, const LP& P) {
    const int lane = F.lane;
    if (F.G == 256) {
        const int hd = blockIdx.x & 7, a0 = 8 * (blockIdx.x >> 3) + F.wave;
#pragma unroll 1
        for (int rep = 0; rep < 2; ++rep) { const int qt = rep ? 511 - a0 : a0;
            VarMLA v; v.Q = P.b(WS_QM); v.K = P.b(WS_KM); v.Vt = P.b(WS_VTM); v.O = P.b(WS_ABR); v.t0 = qt * 32; v.hd = hd; v.tb = 0; v.te = qt + 1; v.scale2 = 1.0f;
            float m, lsum; attn32<96, 64>(v, lane, m, lsum); }
    } else {
#pragma unroll 1
        for (int u = F.gw; u < 512 * 8; u += F.NGW) { const int hd = u & 7, qt = u >> 3;
            VarMLA v; v.Q = P.b(WS_QM); v.K = P.b(WS_KM); v.Vt = P.b(WS_VTM); v.O = P.b(WS_ABR); v.t0 = qt * 32; v.hd = hd; v.tb = 0; v.te = qt + 1; v.scale2 = 1.0f;
            float m, lsum; attn32<96, 64>(v, lane, m, lsum); }
    }
#pragma unroll 1
    for (int u = F.gw; u < (S / 8) * 2; u += F.NGW) { const int g = u & 1, t0 = (u >> 1) * 8;
        VarWin v; v.U2 = P.b(WS_U2); v.Vt = P.b(WS_VTWIN); v.O = P.b(WS_OWIN); v.t0 = t0; v.g = g; v.scale2 = 0.125f * LOG2E;
        const int lo = t0 - 511 > 0 ? t0 - 511 : 0; v.tb = lo >> 5; v.te = ((t0 + 7) >> 5) + 1;
        float m, lsum; attn32<64, 64>(v, lane, m, lsum); }
#pragma unroll 1
    for (int u = F.gw; u < S * 2; u += F.NGW) { const int t = u >> 1;
        topk_unit(P.f(WS_SCORES) + (size_t)u * 256, t, P.i(WS_IDX) + (size_t)u * 16, P.i(WS_NV) + u, lane); }
}
__device__ __forceinline__ void phase_f(Frame& F, const LP& P) {
#pragma unroll 1
    for (int u = F.gw; u < S * 2; u += F.NGW) { const int t = u >> 1, g = u & 1;
        const int nv = __builtin_amdgcn_readfirstlane(P.i(WS_NV)[u]);
        sel_attn_unit(P.b(WS_U2), P.b(WS_VTSEL), P.b(WS_OCMP), P.b(WS_OWIN), P.i(WS_IDX) + (size_t)u * 16, nv, P.b(WS_ABR), t, g, F.lane); }
}
__device__ __forceinline__ void phase_xattn(Frame& F, const LP& P) {
#pragma unroll 1
    for (int u = F.gw; u < (S / 32) * 4; u += F.NGW) { const int hd = u & 3, qt = u >> 2;
        VarX v; v.Q = P.b(WS_QX); v.K = P.b(WS_KX) + (size_t)P.l * 256 * 512; v.Vt = P.b(WS_VXT) + (size_t)P.l * 512 * 256; v.O = P.b(WS_OX); v.t0 = qt * 32; v.hd = hd; v.tb = 0; v.te = 8; v.scale2 = 1.0f;
        float m, lsum; attn32<128, 128>(v, F.lane, m, lsum); }
}

__device__ __forceinline__ void phase_ln(const Args& a, Frame& F, const LP& P, int gi, int bi) {
    const int l = P.l; const float* g = INF32(a, gi, D); const float* b = INF32(a, bi, D);
#pragma unroll 1
    for (int r = F.gw; r < S; r += F.NGW) { Row rw; float* xp = P.f(WS_X) + (size_t)r * D; row_load(rw, xp, F.lane); row_layernorm(rw, g, b, F.lane);
        row_store_f32(rw, xp, F.lane); row_store_bf16(rw, P.b(WS_XB) + (size_t)r * D, F.lane); }
}
__device__ __forceinline__ void route_token(const float (&lg)[36], int t, const float* bg, const float* br, int* toke, float* tokw, unsigned* cnt, int lane) {
    float gl[4]; int gs = 0;
#pragma unroll
    for (int e = 0; e < 4; ++e) gl[e] = lg[e] + bg[e];
    float gmax = gl[0];
#pragma unroll
    for (int e = 1; e < 4; ++e) { if (gl[e] > gmax) { gmax = gl[e]; gs = e; } }
    float gsum = 0.f;
#pragma unroll
    for (int e = 0; e < 4; ++e) gsum += __expf(gl[e] - gmax);
    const float gw = 1.0f / gsum;
    float el[8];
    const float s0 = gs == 0 ? 1.f : 0.f, s1 = gs == 1 ? 1.f : 0.f, s2 = gs == 2 ? 1.f : 0.f, s3 = gs == 3 ? 1.f : 0.f;
#pragma unroll
    for (int e = 0; e < 8; ++e) el[e] = (lg[4 + e] * s0 + lg[12 + e] * s1) + (lg[20 + e] * s2 + lg[28 + e] * s3) + br[gs * 8 + e];
    int i1 = 0; float e1 = el[0];
#pragma unroll
    for (int e = 1; e < 8; ++e) if (el[e] > e1) { e1 = el[e]; i1 = e; }
    int i2 = -1; float e2 = -INFINITY;
#pragma unroll
    for (int e = 0; e < 8; ++e) if (e != i1 && el[e] > e2) { e2 = el[e]; i2 = e; }
    const float r2 = __expf(e2 - e1); const float p1 = 1.0f / (1.0f + r2), p2 = r2 * p1;
    if (lane == 0) { const int x1 = gs * 8 + i1, x2 = gs * 8 + i2;
        toke[2 * t] = x1; toke[2 * t + 1] = x2; tokw[2 * t] = gw * p1; tokw[2 * t + 1] = gw * p2;
        atomicAdd(cnt + x1, 1u); atomicAdd(cnt + x2, 1u); }
}
__device__ __forceinline__ void phase_ln_router(const Args& a, Frame& F, const LP& P) {
    const int l = P.l, lane = F.lane; const float* g = INF32(a, 29, D); const float* b = INF32(a, 30, D);
    const float* wg = INF32(a, 31, D * 4); const float* bg = INF32(a, 32, 4); const float* wr = INF32(a, 33, D * 32); const float* br = INF32(a, 34, 32);
    int* toke = (int*)(P.ws + WS_MOE + MO_TOKE); float* tokw = (float*)(P.ws + WS_MOE + MO_TOKW); unsigned* cnt = (unsigned*)(P.ws + WS_CTL) + CW_CNT + 128 * l;
#pragma unroll 1
    for (int r0 = F.gw; r0 < S; r0 += F.NGW) {
        Row ra; float* xa = P.f(WS_X) + (size_t)r0 * D;
        row_load(ra, xa, lane); row_layernorm(ra, g, b, lane); row_store_f32(ra, xa, lane); row_store_bf16(ra, P.b(WS_XB) + (size_t)r0 * D, lane);
        float la[36];
#pragma unroll
        for (int e = 0; e < 36; ++e) la[e] = 0.f;
#pragma unroll
        for (int j = 0; j < 8; ++j) { int lv = lane; asm volatile("" : "+v"(lv));
#pragma unroll
            for (int i = 0; i < 4; ++i) { const int k = 4 * lv + 256 * j + i; const float va = ra.v[j][i];
                const f32x4 w0 = *(const f32x4*)(wg + (size_t)k * 4);
#pragma unroll
                for (int e = 0; e < 4; ++e) la[e] += va * w0[e];
#pragma unroll
                for (int q = 0; q < 4; ++q) { const f32x4 w1 = *(const f32x4*)(wr + (size_t)k * 32 + 4 * q);
#pragma unroll
                    for (int e = 0; e < 4; ++e) la[4 + 4 * q + e] += va * w1[e]; }
                asm volatile("" ::: "memory"); } }
#pragma unroll
        for (int e = 0; e < 20; ++e) { la[e] = wave_sum(la[e]); asm volatile("" : "+v"(la[e])); }
#pragma unroll
        for (int j = 0; j < 8; ++j) { int lv = lane; asm volatile("" : "+v"(lv));
#pragma unroll
            for (int i = 0; i < 4; ++i) { const int k = 4 * lv + 256 * j + i; const float va = ra.v[j][i];
#pragma unroll
                for (int q = 4; q < 8; ++q) { const f32x4 w1 = *(const f32x4*)(wr + (size_t)k * 32 + 4 * q);
#pragma unroll
                    for (int e = 0; e < 4; ++e) la[4 + 4 * q + e] += va * w1[e]; }
                asm volatile("" ::: "memory"); } }
#pragma unroll
        for (int e = 20; e < 36; ++e) la[e] = wave_sum(la[e]);
        route_token(la, r0, bg, br, toke, tokw, cnt, lane); }
}
__device__ __forceinline__ void phase_moe_assign(Frame& F, const LP& P) {
    const int lane = F.lane;
    unsigned* cnt = (unsigned*)(P.ws + WS_CTL) + CW_CNT + 128 * P.l; unsigned* fill = cnt + 64;
    const unsigned c = lane < 32 ? __hip_atomic_load(cnt + lane, __ATOMIC_RELAXED, __HIP_MEMORY_SCOPE_AGENT) : 0u;
    const unsigned padded = (c + 255u) & ~255u;
    unsigned incl = padded;
#pragma unroll
    for (int o = 1; o < 32; o <<= 1) { const unsigned v = __shfl_up(incl, o); if ((lane & 31) >= o) incl += v; }
    const unsigned pstart = incl - padded;
    if (F.gw == 0) {
        int* tile_e = (int*)(P.ws + WS_MOE + MO_TILEE); int* ntp = (int*)(P.ws + WS_MOE + MO_NT);
        if (lane < 32) for (unsigned r = pstart; r < incl; r += 256) tile_e[r >> 8] = lane;
        const unsigned total = __shfl(incl, 31); if (lane == 0) *ntp = (int)(total >> 8);
    }
    const int* toke = (const int*)(P.ws + WS_MOE + MO_TOKE); const float* tokw = (const float*)(P.ws + WS_MOE + MO_TOKW);
    int* tokp = (int*)(P.ws + WS_MOE + MO_TOKP); float* roww = (float*)(P.ws + WS_MOE + MO_ROWW);
#pragma unroll 1
    for (int t = F.gw; t < S; t += F.NGW) {
#pragma unroll
        for (int k = 0; k < 2; ++k) { const int e = toke[2 * t + k];
            unsigned pos = 0; if (lane == 0) pos = atomicAdd(fill + e, 1u);
            pos = __shfl(pos, 0) + __shfl(pstart, e);
            if (lane == 0) { tokp[2 * t + k] = (int)pos; roww[pos] = tokw[2 * t + k]; }
            const u32x4* src = (const u32x4*)(P.b(WS_XB) + (size_t)t * D); u32x4* dst = (u32x4*)(P.b(WS_XS) + (size_t)pos * D);
#pragma unroll
            for (int j = 0; j < 4; ++j) dst[lane + 64 * j] = src[lane + 64 * j]; } }
}
__device__ __forceinline__ void phase_moe_combine(const Args& a, Frame& F, const LP& P, bool last) {
    const int l = P.l; const float* g = INF32(a, 37, D); const float* b = INF32(a, 38, D); const int* tokp = (const int*)(P.ws + WS_MOE + MO_TOKP);
#pragma unroll 1
    for (int r = F.gw; r < S; r += F.NGW) { Row rw; float* xp = P.f(WS_X) + (size_t)r * D; row_load(rw, xp, F.lane);
#pragma unroll
        for (int j = 0; j < 8; ++j) rw.v[j] = rw.v[j] * DN_ALPHA;
        row_add_bf16(rw, P.b(WS_Y2) + (size_t)tokp[2 * r] * D, F.lane); row_add_bf16(rw, P.b(WS_Y2) + (size_t)tokp[2 * r + 1] * D, F.lane);
        row_layernorm(rw, g, b, F.lane);
        if (last) row_store_f32(rw, a.out + (size_t)r * D, F.lane);
        else { row_store_f32(rw, xp, F.lane); row_store_bf16(rw, P.b(WS_XB) + (size_t)r * D, F.lane); } }
}

constexpr int NPH_LAYER = 17, NPHASES = 1 + DEPTH * NPH_LAYER;
__global__ void __launch_bounds__(NWAVES * 64, 2) mk_fwd(Args a) {
    extern __shared__ __attribute__((aligned(16))) unsigned char lds_raw[];
    Frame F;
    F.lds = (LAS unsigned char*)lds_raw;
    F.tid = threadIdx.x; F.lane = F.tid & 63; F.wave = __builtin_amdgcn_readfirstlane(F.tid >> 6);
    F.G = gridDim.x; F.gw = blockIdx.x * NWAVES + F.wave; F.NGW = F.G * NWAVES; F.ws = a.ws;
    volatile LAS unsigned* MISC = (volatile LAS unsigned*)(F.lds + MISC_OFF);
    if (F.tid < 32) MISC[F.tid] = 0u;
    __syncthreads();
    unsigned* ctl = (unsigned*)(a.ws + WS_CTL);
    XcdBarrier bar = xcd_barrier_post(ctl + CW_BAR + a.li * XCD_BAR_WORDS, MISC + 8);
    const int lo = a.ph_lo, hi = a.ph_hi;
#if defined(PHMASK)
#define IN(k) (((PHMASK >> (((k) == 0) ? 0 : (((k) - 1) % NPH_LAYER) + 1)) & 1) && lo <= (k) && (k) < hi)
#elif defined(PHSEL)
#define IN(k) ((((k) == 0) ? 0 : (((k) - 1) % NPH_LAYER) + 1) == PHSEL && lo <= (k) && (k) < hi)
#else
#define IN(k) (lo <= (k) && (k) < hi)
#endif
#define SEAM(k) do { if (IN((k) + 1)) xcd_barrier(bar); } while (0)
#define FRESH() do { int t_ = threadIdx.x; asm volatile("" : "+v"(t_)); F.tid = t_; F.lane = t_ & 63; F.wave = __builtin_amdgcn_readfirstlane(t_ >> 6); F.gw = blockIdx.x * NWAVES + F.wave; } while (0)
    const int G = F.G, bx = blockIdx.x;

    if (IN(0)) { FRESH(); phase_prologue(a, F); SEAM(0); }

    for (int l = 0; l < DEPTH; ++l) {
        LP P; P.ws = a.ws; P.wl = a.ws + WS_WL0 + (size_t)l * WS_WLSTRIDE; P.l = l;
        const int pb = 1 + NPH_LAYER * l;
        if (IN(pb + 0)) { FRESH(); pg8::Gemm g{P.b(WS_XB), P.w(WO_WIN), D, D, D}; pg8::StaticOrder so; so.init(S, NIN, G, bx);
            EpiIn E{P.b(WS_GATE), P.b(WS_U2), (const float*)(P.wl + WO_BIASP)}; pg8::gemm_phase(F.lds, g, so, E); SEAM(pb + 0); }
        if (IN(pb + 1)) { FRESH(); phase_prep(a, F, P); SEAM(pb + 1); }
        if (IN(pb + 2)) { FRESH();
            { pg8::Gemm g{P.b(WS_U2) + U2_CQ, P.w(WO_WUQ), U2W, 512, 512}; pg8::StaticOrder so; so.init(S, 768, G, bx);
              EpiScale E{P.b(WS_QH), 768, P.f(WS_RSTD), 1.0f, 0}; pg8::gemm_phase(F.lds, g, so, E); }
            { pg8::Gemm g{P.b(WS_U2) + U2_CKV, P.w(WO_WUKV), U2W, 256, 256}; pg8::StaticOrder so; so.init(S, 1024, G, bx);
              EpiScale E{P.b(WS_KVH), 1024, P.f(WS_RSTD) + S, 1.0f, 0}; pg8::gemm_phase(F.lds, g, so, E); }
            phase_compress2(F, P); SEAM(pb + 2); }
        if (IN(pb + 3)) { FRESH(); phase_d(F, P); SEAM(pb + 3); }
        if (IN(pb + 4)) { FRESH(); phase_e(F, P); SEAM(pb + 4); }
        if (IN(pb + 5)) { FRESH(); phase_f(F, P); SEAM(pb + 5); }
        if (IN(pb + 6)) { FRESH(); pg8::Gemm g{P.b(WS_ABR), P.w(WO_WBR), D, D, D}; pg8::StaticOrder so; so.init(S, D, G, bx);
            EpiMerge E{P.b(WS_GATE), P.b(WS_MERGED)}; pg8::gemm_phase(F.lds, g, so, E); SEAM(pb + 6); }
        if (IN(pb + 7)) { FRESH(); pg8::Gemm g{P.b(WS_MERGED), P.w(WO_WOUT), D, D, D}; pg8::StaticOrder so; so.init(S, D, G, bx);
            EpiResid E{P.f(WS_X)}; pg8::gemm_phase(F.lds, g, so, E); SEAM(pb + 7); }
        if (IN(pb + 8)) { FRESH(); phase_ln(a, F, P, 23, 24); SEAM(pb + 8); }
        if (IN(pb + 9)) { FRESH(); pg8::Gemm g{P.b(WS_XB), P.w(WO_WXQ), D, D, D}; pg8::StaticOrder so; so.init(S, 512, G, bx);
            EpiScale E{P.b(WS_QX), 512, nullptr, 0.08838834764831845f * LOG2E, 0}; pg8::gemm_phase(F.lds, g, so, E); SEAM(pb + 9); }
        if (IN(pb + 10)) { FRESH(); phase_xattn(F, P); SEAM(pb + 10); }
        if (IN(pb + 11)) { FRESH(); pg8::Gemm g{P.b(WS_OX), P.w(WO_WXO), 512, 512, 512}; pg8::StaticOrder so; so.init(S, D, G, bx);
            EpiResid E{P.f(WS_X)}; pg8::gemm_phase(F.lds, g, so, E); SEAM(pb + 11); }
        if (IN(pb + 12)) { FRESH(); phase_ln_router(a, F, P); SEAM(pb + 12); }
        if (IN(pb + 13)) { FRESH(); phase_moe_assign(F, P); SEAM(pb + 13); }
        if (IN(pb + 14)) { FRESH(); const int* te = (const int*)(P.ws + WS_MOE + MO_TILEE); const int ntl = *(const int*)(P.ws + WS_MOE + MO_NT);
            pg8::Gemm g{P.b(WS_XS), P.w(WO_WEIN), D, D, D}; pg8::GroupedOrder so{te, ntl, 4, G, bx};
            EpiGlu E{P.b(WS_HS)}; pg8::gemm_phase(F.lds, g, so, E); SEAM(pb + 14); }
        if (IN(pb + 15)) { FRESH(); const int* te = (const int*)(P.ws + WS_MOE + MO_TILEE); const int ntl = *(const int*)(P.ws + WS_MOE + MO_NT);
            pg8::Gemm g{P.b(WS_HS), P.w(WO_WEOUT), 512, 512, 512}; pg8::GroupedOrder so{te, ntl, 8, G, bx};
            EpiScale E{P.b(WS_Y2), D, (const float*)(P.ws + WS_MOE + MO_ROWW), 1.0f, 8}; pg8::gemm_phase(F.lds, g, so, E); SEAM(pb + 15); }
        if (IN(pb + 16)) { FRESH(); phase_moe_combine(a, F, P, l == DEPTH - 1); SEAM(pb + 16); }
    }
#undef IN
#undef SEAM
}

#ifndef MK_PER_PHASE
#define MK_PER_PHASE 1
#endif
extern "C" void kernel_launch(void* const* d_in, const int* in_sizes, int n_in, void* d_out, int out_size, void* d_ws, size_t ws_size, hipStream_t stream) {
    static int grid = 0;
    if (grid == 0) {
        if (n_in != 39 || out_size != S * D || ws_size < WS_END) { fprintf(stderr, "kernel_launch: unexpected problem (n_in %d, out %d, ws %zu)\n", n_in, out_size, ws_size); grid = -1; return; }
        int dev = 0, cus = 0;
        if (hipGetDevice(&dev) != hipSuccess || hipDeviceGetAttribute(&cus, hipDeviceAttributeMultiprocessorCount, dev) != hipSuccess) { grid = -1; return; }
        if (hipFuncSetAttribute((const void*)mk_fwd, hipFuncAttributeMaxDynamicSharedMemorySize, LDS_BYTES) != hipSuccess) { fprintf(stderr, "kernel_launch: hipFuncSetAttribute failed\n"); grid = -1; return; }
        int per_cu = 0;
        if (hipOccupancyMaxActiveBlocksPerMultiprocessor(&per_cu, (const void*)mk_fwd, NWAVES * 64, LDS_BYTES) != hipSuccess || per_cu < 1) fprintf(stderr, "kernel_launch: occupancy query reports %d\n", per_cu);
        (void)hipGetLastError();
        grid = cus;
    }
    if (grid < 0) return;
    if (hipMemsetAsync((char*)d_ws + WS_CTL, 0, CTL_ZERO_BYTES, stream) != hipSuccess) return;
    Args a{};
    for (int i = 0; i < 39; ++i) a.in[i] = d_in[i];
    a.out = (float*)d_out; a.ws = (unsigned char*)d_ws; a.pad = 0;
#if MK_PER_PHASE
#ifndef MK_LAST
#define MK_LAST NPHASES
#endif
    for (int p = 0; p < MK_LAST; ++p) { a.ph_lo = p; a.ph_hi = p + 1; a.li = p; hipLaunchKernelGGL(mk_fwd, dim3(grid), dim3(NWAVES * 64), LDS_BYTES, stream, a); }
#else
    a.ph_lo = 0; a.ph_hi = NPHASES; a.li = 0;
    hipLaunchKernelGGL(mk_fwd, dim3(grid), dim3(NWAVES * 64), LDS_BYTES, stream, a);
#endif
}
```

```cpp
#include <hip/hip_runtime.h>
#include <cstdio>
#include <cstdint>

#define LAS __attribute__((address_space(3)))
#define GAS __attribute__((address_space(1)))
typedef unsigned short bf16;
typedef short bf16x8 __attribute__((ext_vector_type(8)));
typedef short s16x4 __attribute__((ext_vector_type(4)));
typedef float f32x2 __attribute__((ext_vector_type(2)));
typedef float f32x4 __attribute__((ext_vector_type(4)));
typedef float f32x16 __attribute__((ext_vector_type(16)));
typedef unsigned u32x2 __attribute__((ext_vector_type(2)));
typedef unsigned u32x4 __attribute__((ext_vector_type(4)));

constexpr int S = 16384, D = 2048, DEPTH = 2;
constexpr int IN_W = 11832;
constexpr int NIN = 12032;
constexpr int U2W = 3840;
constexpr int U2_Q = 0, U2_KV = 512, U2_POOL = 1280, U2_CQ = 1792, U2_CKV = 2304, U2_CONV = 2560, U2_G = 3584, U2_KR = 3616;
constexpr int NCMP = 1023;
constexpr int RMAX = 40960;
constexpr float DN_ALPHA = 1.4142135623730951f;
constexpr float LOG2E = 1.4426950408889634f;

typedef __bf16 bf16x2_t __attribute__((ext_vector_type(2)));
__device__ __forceinline__ unsigned cvt_pk_bf16(float lo, float hi) { const f32x2 v = {lo, hi}; const bf16x2_t b = __builtin_convertvector(v, bf16x2_t); return __builtin_bit_cast(unsigned, b); }
__device__ __forceinline__ float bf2f(unsigned short b) { return __uint_as_float(((unsigned)b) << 16); }
__device__ __forceinline__ float bflo(unsigned w) { return __uint_as_float(w << 16); }
__device__ __forceinline__ float bfhi(unsigned w) { return __uint_as_float(w & 0xffff0000u); }
__device__ __forceinline__ unsigned short f2bf(float f) { return (unsigned short)(cvt_pk_bf16(f, 0.f) & 0xffffu); }
__device__ __forceinline__ float wave_sum(float v) {
#pragma unroll
    for (int o = 1; o < 64; o <<= 1) v += __shfl_xor(v, o);
    return v;
}
__device__ __forceinline__ float sigmoidf_(float x) { return 1.0f / (1.0f + __expf(-x)); }
#define LDS_WAIT() asm volatile("s_waitcnt lgkmcnt(0)" ::: "memory")
#define VM_WAIT() asm volatile("s_waitcnt vmcnt(0)" ::: "memory")

namespace pg8 {
constexpr int BM = 256, BK = 64, HALF = 128, HTB = HALF * BK * 2, STAGE_BYTES = 8 * HTB, NXCD = 8, WGM = 8;
__host__ __device__ __forceinline__ int lds_byte(int r, int c) { const int st = (r >> 4) * 2 + (c >> 5), rr = r & 15, cc = c & 31, ob = rr * 64 + cc * 2; return st * 1024 + (ob ^ (((ob >> 9) & 1) << 5)); }
__host__ __device__ __forceinline__ void stage_rc(int b, int& R, int& C) { const int st = b / 1024, sb = b % 1024, swz = sb ^ (((sb >> 9) & 1) << 5); R = (st >> 1) * 16 + swz / 64; C = (st & 1) * 32 + (swz % 64) / 2; }
__host__ __device__ __forceinline__ int perm32(int rho) { const int n = rho >> 4, i = rho & 15; return 8 * (i >> 2) + 4 * n + (i & 3); }

struct Unit { int pm, pn; };
struct Gemm { const bf16* A; const bf16* Bt; int lda, ldb, K; };

struct StaticOrder {
    int nM, nN, nwg, G, c;
    __device__ void init(int M, int N, int G_, int c_) { nM = M / BM; nN = N / BM; nwg = nM * nN; G = G_; c = c_; }
    __device__ bool next(int i, Unit& u) const {
        const long L = (long)i * G + c; if (L >= nwg) return false;
        int wgid = (int)L; { const int q = nwg / NXCD, r = nwg % NXCD, xcd = wgid % NXCD, off = wgid / NXCD; wgid = (xcd < r ? xcd * (q + 1) : r * (q + 1) + (xcd - r) * q) + off; }
        const int nig = WGM * nN, gid = wgid / nig, fm = gid * WGM, gsz = (nM - fm) < WGM ? (nM - fm) : WGM;
        u.pm = fm + ((wgid % nig) % gsz); u.pn = (wgid % nig) / gsz; return true;
    }
};
struct GroupedOrder {
    const int* tile_expert; int ntiles, npn, G, c;
    __device__ bool next(int i, Unit& u) const {
        const long L = (long)i * G + c; if (L >= (long)ntiles * npn) return false;
        const int rt = (int)(L / npn), pn = (int)(L % npn);
        u.pm = rt; u.pn = __builtin_amdgcn_readfirstlane(tile_expert[rt]) * npn + pn; return true;
    }
};

template <class Epi, class Sched>
__device__ __forceinline__ void gemm_phase(LAS unsigned char* lds, const Gemm g, const Sched& S, const Epi& E) {
    int tid = threadIdx.x; asm volatile("" : "+v"(tid));
    const int wid = __builtin_amdgcn_readfirstlane(tid >> 6), lane = tid & 63, wr = wid >> 2, wc = wid & 3, fr = lane & 15, fq = lane >> 4;
    const int K = g.K, nt = K / BK;
    unsigned voffA[2], voffB[2];
#pragma unroll
    for (int i = 0; i < 2; ++i) { int R, C; stage_rc(tid * 16 + i * 8192, R, C); const int Rb = Epi::PERM ? ((R & ~31) + perm32(R & 31)) : R;
        voffA[i] = (unsigned)(R * g.lda + C) * 2u; voffB[i] = (unsigned)(Rb * g.ldb + C) * 2u; }
    const size_t kstep = (size_t)(BK * 2);
    const size_t hstepA = (size_t)HALF * g.lda * 2, hstepB = (size_t)HALF * g.ldb * 2;
    const size_t tstepA = 2 * hstepA, tstepB = 2 * hstepB;
    const unsigned ldsw = (unsigned)wid * 1024u;
    const int aoff = lds_byte(wr * 64 + fr, fq * 8), boff = lds_byte(wc * 32 + fr, fq * 8);
#define PG8_SA(b, h) (((b) * 2 + (h)) * HTB)
#define PG8_SB(b, h) ((4 + (b) * 2 + (h)) * HTB)
#define PG8_STAGE(bufoff, gbase, voff) do { _Pragma("unroll") for (int _i = 0; _i < 2; ++_i) \
        __builtin_amdgcn_global_load_lds((const unsigned*)((const char*)(gbase) + (voff)[_i]), (LAS unsigned*)(lds + (bufoff) + ldsw + _i * 8192), 16, 0, 0); } while (0)
#define PG8_LDA(dst, b, h) do { _Pragma("unroll") for (int m = 0; m < 4; ++m) _Pragma("unroll") for (int k = 0; k < 2; ++k) dst[m][k] = *(const LAS bf16x8*)(lds + PG8_SA(b, h) + aoff + m * 2048 + k * 1024); } while (0)
#define PG8_LDB(dst, b, h) do { _Pragma("unroll") for (int n = 0; n < 2; ++n) _Pragma("unroll") for (int k = 0; k < 2; ++k) dst[n][k] = *(const LAS bf16x8*)(lds + PG8_SB(b, h) + boff + n * 2048 + k * 1024); } while (0)
#define PG8_MMA(ai, bj, At, Bt) do { __builtin_amdgcn_s_setprio(1); _Pragma("unroll") for (int m = 0; m < 4; ++m) _Pragma("unroll") for (int n = 0; n < 2; ++n) _Pragma("unroll") for (int k = 0; k < 2; ++k) \
        acc[ai][bj][m][n] = __builtin_amdgcn_mfma_f32_16x16x32_bf16(Bt[n][k], At[m][k], acc[ai][bj][m][n], 0, 0, 0); __builtin_amdgcn_s_setprio(0); } while (0)
#define PG8_WAIT_V(n) asm volatile("s_waitcnt vmcnt(" #n ")" ::: "memory")
#define PG8_WAIT_L(n) asm volatile("s_waitcnt lgkmcnt(" #n ")" ::: "memory")
#define PG8_BAR __builtin_amdgcn_s_barrier()
#define PG8_SCHED __builtin_amdgcn_sched_barrier(0)
    Unit cur, nxt; int ui = 0;
    if (!S.next(0, cur)) return;
    f32x4 acc[2][2][4][2];
#pragma unroll
    for (int a = 0; a < 2; ++a)
#pragma unroll
        for (int b = 0; b < 2; ++b)
#pragma unroll
            for (int m = 0; m < 4; ++m)
#pragma unroll
                for (int n = 0; n < 2; ++n) acc[a][b][m][n] = (f32x4){0.f, 0.f, 0.f, 0.f};
    bf16x8 At[4][2], B0[2][2], B1[2][2];
    const char* cA = (const char*)g.A + (size_t)cur.pm * tstepA; const char* cB = (const char*)g.Bt + (size_t)cur.pn * tstepB;
    PG8_STAGE(PG8_SB(0, 0), cB, voffB); PG8_STAGE(PG8_SB(0, 1), cB + hstepB, voffB); PG8_STAGE(PG8_SA(0, 0), cA, voffA); PG8_STAGE(PG8_SA(0, 1), cA + hstepA, voffA);
    if (wr == 1) PG8_BAR;
    PG8_WAIT_V(2); PG8_BAR;
    PG8_STAGE(PG8_SB(1, 0), cB + kstep, voffB); PG8_STAGE(PG8_SA(1, 0), cA + kstep, voffA); PG8_STAGE(PG8_SB(1, 1), cB + hstepB + kstep, voffB);
    PG8_WAIT_V(6); PG8_BAR;
    for (;;) {
        const bool has_next = S.next(ui + 1, nxt);
        const char* nA = has_next ? (const char*)g.A + (size_t)nxt.pm * tstepA : cA; const char* nB = has_next ? (const char*)g.Bt + (size_t)nxt.pn * tstepB : cB;
        for (int t = 0; t < nt; t += 2) {
            const bool last = (t == nt - 2);
            const char* a1 = cA + (size_t)(t + 1) * kstep;
            const char* a2 = last ? nA : cA + (size_t)(t + 2) * kstep; const char* b2 = last ? nB : cB + (size_t)(t + 2) * kstep;
            const char* a3 = a2 + kstep; const char* b3 = b2 + kstep;
            if constexpr (Epi::MIDK > 0) { if (t > 0 && (t % Epi::MIDK) == 0) { PG8_SCHED; E.mid(acc, cur, t / Epi::MIDK, wr, wc, fr, fq); PG8_SCHED; } }
            PG8_LDB(B0, 0, 0); PG8_LDB(B1, 0, 1); PG8_SCHED; PG8_LDA(At, 0, 0); PG8_STAGE(PG8_SA(1, 1), a1 + hstepA, voffA);
            PG8_WAIT_V(8); PG8_WAIT_L(0); PG8_BAR; PG8_MMA(0, 0, At, B0); PG8_MMA(0, 1, At, B1); PG8_BAR; PG8_SCHED;
            PG8_LDA(At, 0, 1); PG8_STAGE(PG8_SB(0, 0), b2, voffB); PG8_STAGE(PG8_SB(0, 1), b2 + hstepB, voffB); PG8_STAGE(PG8_SA(0, 0), a2, voffA);
            PG8_WAIT_V(8); PG8_WAIT_L(0); PG8_BAR; PG8_MMA(1, 0, At, B0); PG8_MMA(1, 1, At, B1); PG8_BAR; PG8_SCHED;
            PG8_LDB(B0, 1, 0); PG8_LDB(B1, 1, 1); PG8_SCHED; PG8_LDA(At, 1, 0); PG8_STAGE(PG8_SA(0, 1), a2 + hstepA, voffA);
            PG8_WAIT_V(8); PG8_WAIT_L(0); PG8_BAR; PG8_MMA(0, 0, At, B0); PG8_MMA(0, 1, At, B1); PG8_BAR; PG8_SCHED;
            PG8_LDA(At, 1, 1); PG8_STAGE(PG8_SB(1, 0), b3, voffB); PG8_STAGE(PG8_SB(1, 1), b3 + hstepB, voffB); PG8_STAGE(PG8_SA(1, 0), a3, voffA);
            PG8_WAIT_V(8); PG8_WAIT_L(0); PG8_BAR; PG8_MMA(1, 0, At, B0); PG8_MMA(1, 1, At, B1); PG8_BAR; PG8_SCHED;
        }
        if (wr == 0) PG8_BAR;
        E(acc, cur, wr, wc, fr, fq);
        if (!has_next) break;
#pragma unroll
        for (int a = 0; a < 2; ++a)
#pragma unroll
            for (int b = 0; b < 2; ++b)
#pragma unroll
                for (int m = 0; m < 4; ++m)
#pragma unroll
                    for (int n = 0; n < 2; ++n) acc[a][b][m][n] = (f32x4){0.f, 0.f, 0.f, 0.f};
        cur = nxt; cA = nA; cB = nB; ++ui;
        if (wr == 1) PG8_BAR;
    }
    PG8_WAIT_V(0);
    PG8_BAR;
#undef PG8_SA
#undef PG8_SB
#undef PG8_STAGE
#undef PG8_LDA
#undef PG8_LDB
#undef PG8_MMA
#undef PG8_WAIT_V
#undef PG8_WAIT_L
#undef PG8_BAR
#undef PG8_SCHED
}
}

__device__ __forceinline__ float fast_sigmoid(float x) { return __builtin_amdgcn_rcpf(1.0f + __builtin_amdgcn_exp2f(-x * LOG2E)); }
__device__ __forceinline__ u32x4 pack8(const f32x4 v0, const f32x4 v1) { u32x4 w; w.x = cvt_pk_bf16(v0[0], v0[1]); w.y = cvt_pk_bf16(v0[2], v0[3]); w.z = cvt_pk_bf16(v1[0], v1[1]); w.w = cvt_pk_bf16(v1[2], v1[3]); return w; }

struct EpiIn {
    static constexpr bool PERM = true; static constexpr int MIDK = 0;
    bf16* gate; bf16* u2; const float* bias;
    __device__ __forceinline__ void operator()(const f32x4 (&acc)[2][2][4][2], const pg8::Unit& u, int wr, int wc, int fr, int fq) const {
        const int row0 = u.pm * 256 + wr * 64 + fr; const bool isg = u.pn < 32;
        bf16* base = isg ? gate : u2; const int ldc = isg ? 8192 : U2W; const int colt = isg ? u.pn * 256 : (u.pn - 32) * 256;
        const int col0 = colt + wc * 32 + 8 * fq, bcol0 = u.pn * 256 + wc * 32 + 8 * fq;
        f32x4 bv[2][2];
#pragma unroll
        for (int bj = 0; bj < 2; ++bj)
#pragma unroll
            for (int n = 0; n < 2; ++n) bv[bj][n] = *(const f32x4*)(bias + bcol0 + bj * 128 + 4 * n);
#pragma unroll
        for (int ai = 0; ai < 2; ++ai)
#pragma unroll
            for (int m = 0; m < 4; ++m) { bf16* rowp = base + (size_t)(row0 + ai * 128 + m * 16) * ldc + col0;
#pragma unroll
                for (int bj = 0; bj < 2; ++bj) { f32x4 v0 = acc[ai][bj][m][0] + bv[bj][0], v1 = acc[ai][bj][m][1] + bv[bj][1];
                    if (isg) {
#pragma unroll
                        for (int j = 0; j < 4; ++j) { v0[j] = fast_sigmoid(v0[j]); v1[j] = fast_sigmoid(v1[j]); } }
                    *(u32x4*)(rowp + bj * 128) = pack8(v0, v1); } }
    }
};
struct EpiScale {
    static constexpr bool PERM = true; static constexpr int MIDK = 0;
    bf16* O; int ldc; const float* rowscale; float cs; int npn_mod;
    __device__ __forceinline__ void operator()(const f32x4 (&acc)[2][2][4][2], const pg8::Unit& u, int wr, int wc, int fr, int fq) const {
        const int row0 = u.pm * 256 + wr * 64 + fr; const int pnl = npn_mod ? (u.pn % npn_mod) : u.pn;
        const int col0 = pnl * 256 + wc * 32 + 8 * fq;
#pragma unroll
        for (int ai = 0; ai < 2; ++ai)
#pragma unroll
            for (int m = 0; m < 4; ++m) { const int row = row0 + ai * 128 + m * 16; const float sc = (rowscale ? rowscale[row] : 1.0f) * cs;
                bf16* rowp = O + (size_t)row * ldc + col0;
#pragma unroll
                for (int bj = 0; bj < 2; ++bj) *(u32x4*)(rowp + bj * 128) = pack8(acc[ai][bj][m][0] * sc, acc[ai][bj][m][1] * sc); }
    }
};
struct EpiGlu {
    static constexpr bool PERM = true; static constexpr int MIDK = 0;
    bf16* H;
    __device__ __forceinline__ void operator()(const f32x4 (&acc)[2][2][4][2], const pg8::Unit& u, int wr, int wc, int fr, int fq) const {
        const int row0 = u.pm * 256 + wr * 64 + fr; const int col0 = (u.pn & 3) * 128 + wc * 32 + 8 * fq;
#pragma unroll
        for (int ai = 0; ai < 2; ++ai)
#pragma unroll
            for (int m = 0; m < 4; ++m) { f32x4 o[2];
#pragma unroll
                for (int n = 0; n < 2; ++n)
#pragma unroll
                    for (int j = 0; j < 4; ++j) { const float a = acc[ai][0][m][n][j], b = acc[ai][1][m][n][j]; o[n][j] = a * fast_sigmoid(a) * b; }
                *(u32x4*)(H + (size_t)(row0 + ai * 128 + m * 16) * 512 + col0) = pack8(o[0], o[1]); }
    }
};
struct EpiResid {
    static constexpr bool PERM = false; static constexpr int MIDK = 0;
    float* X;
    __device__ __forceinline__ void operator()(const f32x4 (&acc)[2][2][4][2], const pg8::Unit& u, int wr, int wc, int fr, int fq) const {
        const int row0 = u.pm * 256 + wr * 64 + fr, col0 = u.pn * 256 + wc * 32 + 4 * fq;
#pragma unroll
        for (int ai = 0; ai < 2; ++ai)
#pragma unroll
            for (int m = 0; m < 4; ++m) { float* rowp = X + (size_t)(row0 + ai * 128 + m * 16) * D + col0;
#pragma unroll
                for (int bj = 0; bj < 2; ++bj)
#pragma unroll
                    for (int n = 0; n < 2; ++n) { f32x4* p = (f32x4*)(rowp + bj * 128 + n * 16); *p = *p * DN_ALPHA + acc[ai][bj][m][n]; } }
    }
};
struct EpiMerge {
    static constexpr bool PERM = true; static constexpr int MIDK = 8;
    const bf16* gate; bf16* O;
    __device__ __forceinline__ void mid(f32x4 (&acc)[2][2][4][2], const pg8::Unit& u, int seg, int wr, int wc, int fr, int fq) const {
        int row0 = u.pm * 256 + wr * 64 + fr; const int col0 = u.pn * 256 + wc * 32 + 8 * fq; asm volatile("" : "+v"(row0));
#pragma unroll
        for (int ai = 0; ai < 2; ++ai)
#pragma unroll
            for (int m = 0; m < 4; ++m) { const bf16* gp = gate + (size_t)(row0 + ai * 128 + m * 16) * 8192 + (size_t)(seg - 1) * 2048 + col0;
#pragma unroll
                for (int bj = 0; bj < 2; ++bj) { const u32x4 a = *(const u32x4*)(gp + bj * 128), b = *(const u32x4*)(gp + 2048 + bj * 128);
#pragma unroll
                    for (int q = 0; q < 4; ++q) { const float r0 = fmaxf(bflo(a[q]), 1e-30f) * __builtin_amdgcn_rcpf(fmaxf(bflo(b[q]), 1e-30f)), r1 = fmaxf(bfhi(a[q]), 1e-30f) * __builtin_amdgcn_rcpf(fmaxf(bfhi(b[q]), 1e-30f));
                        acc[ai][bj][m][q >> 1][(q & 1) * 2] *= r0; acc[ai][bj][m][q >> 1][(q & 1) * 2 + 1] *= r1; } }
                asm volatile("" ::: "memory"); }
    }
    __device__ __forceinline__ void operator()(const f32x4 (&acc)[2][2][4][2], const pg8::Unit& u, int wr, int wc, int fr, int fq) const {
        const int row0 = u.pm * 256 + wr * 64 + fr, col0 = u.pn * 256 + wc * 32 + 8 * fq;
#pragma unroll
        for (int ai = 0; ai < 2; ++ai)
#pragma unroll
            for (int m = 0; m < 4; ++m) { const int row = row0 + ai * 128 + m * 16; const bf16* gp = gate + (size_t)row * 8192 + 3 * 2048 + col0;
#pragma unroll
                for (int bj = 0; bj < 2; ++bj) { const u32x4 a = *(const u32x4*)(gp + bj * 128); f32x4 v0, v1;
                    v0[0] = acc[ai][bj][m][0][0] * fmaxf(bflo(a[0]), 1e-30f); v0[1] = acc[ai][bj][m][0][1] * fmaxf(bfhi(a[0]), 1e-30f);
                    v0[2] = acc[ai][bj][m][0][2] * fmaxf(bflo(a[1]), 1e-30f); v0[3] = acc[ai][bj][m][0][3] * fmaxf(bfhi(a[1]), 1e-30f);
                    v1[0] = acc[ai][bj][m][1][0] * fmaxf(bflo(a[2]), 1e-30f); v1[1] = acc[ai][bj][m][1][1] * fmaxf(bfhi(a[2]), 1e-30f);
                    v1[2] = acc[ai][bj][m][1][2] * fmaxf(bflo(a[3]), 1e-30f); v1[3] = acc[ai][bj][m][1][3] * fmaxf(bfhi(a[3]), 1e-30f);
                    *(u32x4*)(O + (size_t)row * D + col0 + bj * 128) = pack8(v0, v1); } }
    }
};

#define XB_TMO      128
#define XB_XCNT(j)  (256  + 64 * (j))
#define XB_XSUB(j)  (1280 + 64 * (j))
#define XB_XGEN(j)  (2304 + 64 * (j))
#define XB_TOP      3328
#define XB_TOPGEN   3392
#define XCD_BAR_WORDS 3456
#define XB_SPIN_CAP (1u << 25)
__device__ __forceinline__ unsigned xb_ld(unsigned* p)              { return __hip_atomic_load(p, __ATOMIC_RELAXED, __HIP_MEMORY_SCOPE_AGENT); }
__device__ __forceinline__ unsigned xb_add(unsigned* p, unsigned v) { return __hip_atomic_fetch_add(p, v, __ATOMIC_RELAXED, __HIP_MEMORY_SCOPE_AGENT); }
__device__ __forceinline__ unsigned xb_xcc_id() { return (unsigned)__builtin_amdgcn_s_getreg((3 << 11) | 20) & 0xFu; }
#define XB_SPIN(cond, bar) do { unsigned _sp = 0; while (cond) { __builtin_amdgcn_s_sleep(1); \
    if ((++_sp & 255u) == 0u) { if (xb_ld(&(bar)[XB_TMO])) break; if (_sp > XB_SPIN_CAP) { atomicAdd(&(bar)[XB_TMO], 1u); break; } } } } while (0)
struct XcdBarrier { unsigned* bar; unsigned x; volatile LAS unsigned* st; };
__device__ __forceinline__ XcdBarrier xcd_barrier_post(unsigned* bar, volatile LAS unsigned* st) {
    XcdBarrier b; b.bar = bar; b.x = xb_xcc_id(); b.st = st;
    if (threadIdx.x == 0) (void)xb_add(&bar[XB_XCNT(b.x)], 1u);
    return b;
}
__device__ __forceinline__ void xcd_barrier_complete(unsigned* bar, unsigned x, unsigned& nloc, unsigned& nx) {
    const unsigned G = gridDim.x * gridDim.y * gridDim.z;
    unsigned sum, cnt, mine, sp = 0u;
    for (;;) {
        sum = 0u; cnt = 0u; mine = 0u;
#pragma unroll
        for (unsigned j = 0; j < 16; ++j) { const unsigned c = xb_ld(&bar[XB_XCNT(j)]); sum += c; cnt += (c > 0u) ? 1u : 0u; mine = (j == x) ? c : mine; }
        if (sum == G) break;
        __builtin_amdgcn_s_sleep(1);
        if ((++sp & 255u) == 0u) { if (xb_ld(&bar[XB_TMO])) break; if (sp > XB_SPIN_CAP) { atomicAdd(&bar[XB_TMO], 1u); break; } }
    }
    nloc = mine > 0u ? mine : 1u; nx = cnt > 0u ? cnt : 1u;
}
__device__ __forceinline__ void xcd_barrier(const XcdBarrier& b) {
    asm volatile("s_waitcnt vmcnt(0)" ::: "memory");
    __syncthreads();
    if (threadIdx.x == 0) {
        unsigned* bar = b.bar;
        __builtin_amdgcn_s_waitcnt(0);
        unsigned nloc = b.st[0], nx = b.st[1];
        if (nloc == 0u) { xcd_barrier_complete(bar, b.x, nloc, nx); b.st[0] = nloc; b.st[1] = nx; }
        const unsigned old = xb_add(&bar[XB_XSUB(b.x)], 1u);
        const unsigned gen = old / nloc;
        if (old + 1u == (gen + 1u) * nloc) {
            __builtin_amdgcn_fence(__ATOMIC_RELEASE, "agent");
            asm volatile("s_waitcnt vmcnt(0)" ::: "memory");
            const unsigned og = xb_add(&bar[XB_TOP], 1u);
            const unsigned tg = og / nx;
            if (og + 1u == (tg + 1u) * nx) xb_add(&bar[XB_TOPGEN], 1u);
            else XB_SPIN(xb_ld(&bar[XB_TOPGEN]) == tg, bar);
            __builtin_amdgcn_fence(__ATOMIC_ACQUIRE, "agent");
            xb_add(&bar[XB_XGEN(b.x)], 1u);
            asm volatile("s_waitcnt vmcnt(0)" ::: "memory");
        } else {
            XB_SPIN(xb_ld(&bar[XB_XGEN(b.x)]) == gen, bar);
            __builtin_amdgcn_fence(__ATOMIC_ACQUIRE, "agent");
            asm volatile("s_waitcnt vmcnt(0)" ::: "memory");
        }
    }
    __syncthreads();
}

constexpr size_t MiB = 1u << 20;
constexpr size_t WS_CTL = 0, CTL_ZERO_BYTES = 1 * MiB;
constexpr size_t WS_WL0 = 2 * MiB, WS_WLSTRIDE = 272 * MiB;
constexpr size_t WO_WIN = 0, WO_WBR = 48 * MiB, WO_WOUT = 56 * MiB, WO_WXQ = 64 * MiB, WO_WXK = 66 * MiB, WO_WXV = 68 * MiB, WO_WXO = 70 * MiB, WO_WUQ = 72 * MiB, WO_WUKV = 73 * MiB,
                 WO_W1C = 74 * MiB, WO_W2C = 75 * MiB, WO_BIASP = 76 * MiB, WO_B1C = 77 * MiB, WO_WEIN = 80 * MiB, WO_WEOUT = 208 * MiB;
constexpr size_t WS_X = 546 * MiB, WS_XB = 674 * MiB, WS_GATE = 738 * MiB, WS_U2 = 994 * MiB, WS_ABR = 1114 * MiB, WS_MERGED = 1178 * MiB, WS_QH = 1242 * MiB, WS_KVH = 1266 * MiB,
                 WS_QM = 1298 * MiB, WS_KM = 1322 * MiB, WS_VTM = 1346 * MiB, WS_VTSEL = 1362 * MiB, WS_VTWIN = 1366 * MiB, WS_KC = 1370 * MiB, WS_VCT = 1371 * MiB, WS_HID = 1372 * MiB,
                 WS_OCMP = 1373 * MiB, WS_OWIN = 1389 * MiB, WS_SCORES = 1405 * MiB, WS_IDX = 1437 * MiB, WS_NV = 1439 * MiB, WS_RSTD = 1440 * MiB, WS_ROPE = 1441 * MiB, WS_QX = 1443 * MiB,
                 WS_OX = 1459 * MiB, WS_KX = 1475 * MiB, WS_VXT = 1476 * MiB, WS_MEMB = 1477 * MiB, WS_CSTAT = 1478 * MiB, WS_MOE = 1479 * MiB, WS_END = 1481 * MiB;
constexpr size_t WS_XS = WS_GATE, WS_Y2 = WS_GATE + 160 * MiB, WS_HS = WS_GATE + 320 * MiB;
static_assert(WS_HS + 40 * MiB <= WS_ABR, "MoE overlay");
constexpr int CW_CNT = 1024;
constexpr int CW_BAR = 4096;
constexpr size_t MO_TOKE = 0, MO_TOKW = 128 * 1024, MO_TOKP = 256 * 1024, MO_ROWW = 384 * 1024, MO_TILEE = 640 * 1024, MO_NT = 644 * 1024;

constexpr int RING_BYTES = 131072;
constexpr int LDS_BYTES = 147456;
constexpr int MISC_OFF = LDS_BYTES - 512;

constexpr int NWAVES = 8;
struct Args { const void* in[39]; float* out; unsigned char* ws; int ph_lo, ph_hi, li, pad; };
static_assert(sizeof(Args) == 39 * 8 + 8 + 8 + 16, "Args has no padding");

struct Frame {
    LAS unsigned char* lds;
    int tid, lane, wave, G, gw, NGW;
    unsigned char* ws;
};

__device__ __forceinline__ int in_col(int n) {
    if (n < 8192) return 3640 + n;
    if (n < 8704) return n - 8192;
    if (n < 9472) return 512 + (n - 8704);
    if (n < 9984) return 1304 + (n - 9472);
    if (n < 10496) return 1816 + (n - 9984);
    if (n < 10752) return 2328 + (n - 10496);
    if (n < 11776) return 2616 + (n - 10752);
    const int c = n - 11776; if (c < 24) return 1280 + c; if (c >= 32 && c < 64) return 2584 + (c - 32); return -1;
}
struct Job { const float* W; const float* ks; bf16* WT; int ldw, ldt, kdst0, mode, nkb, nnb, nbatch; size_t sstride, dstride; };
__device__ __forceinline__ void transpose_item(const Job& J, int item, LAS float* scr, int lane) {
    const int per = J.nkb * J.nnb, e = item / per, r = item % per, kb = r / J.nnb, nb = r % J.nnb, k0 = kb * 64, n0 = nb * 64;
    const float* W = J.W + (size_t)e * J.sstride; bf16* WT = J.WT + (size_t)e * J.dstride;
    const int nq = 4 * (lane & 15), nd = n0 + nq;
    int sc;
    if (J.mode == 1) sc = in_col(nd);
    else if (J.mode == 2) { const int T = nd >> 8, w = nd & 255; sc = (w < 128) ? (T * 128 + w) : (512 + T * 128 + (w - 128)); }
    else sc = nd;
#pragma unroll 4
    for (int i = 0; i < 16; ++i) { const int kk = (lane >> 4) + 4 * i;
        f32x4 v = (f32x4){0.f, 0.f, 0.f, 0.f};
        if (sc >= 0) v = *(const f32x4*)(W + (size_t)(k0 + kk) * J.ldw + sc);
        if (J.ks) v = v * J.ks[k0 + kk];
        LAS float* d = scr + kk * 65 + nq; d[0] = v[0]; d[1] = v[1]; d[2] = v[2]; d[3] = v[3]; }
    LDS_WAIT(); asm volatile("" ::: "memory");
    const int c = lane & 7;
#pragma unroll
    for (int j = 0; j < 8; ++j) { const int n = (lane >> 3) + 8 * j; const LAS float* s = scr + (8 * c) * 65 + n;
        u32x4 o; o.x = cvt_pk_bf16(s[0 * 65], s[1 * 65]); o.y = cvt_pk_bf16(s[2 * 65], s[3 * 65]); o.z = cvt_pk_bf16(s[4 * 65], s[5 * 65]); o.w = cvt_pk_bf16(s[6 * 65], s[7 * 65]);
        *(u32x4*)(WT + (size_t)(n0 + n) * J.ldt + J.kdst0 + k0 + 8 * c) = o; }
    LDS_WAIT(); asm volatile("" ::: "memory");
}
constexpr int NJOBS = 15;
__device__ __forceinline__ Job get_job(const Args& a, int l, int j) {
    unsigned char* wl = a.ws + WS_WL0 + (size_t)l * WS_WLSTRIDE;
    Job J; J.ks = nullptr; J.kdst0 = 0; J.mode = 0; J.nbatch = 1; J.sstride = 0; J.dstride = 0;
#define SRC(i, per) ((const float*)a.in[i] + (size_t)l * (per))
    switch (j) {
    case 0:  J.W = SRC(3, (size_t)D * IN_W); J.ldw = IN_W; J.WT = (bf16*)(wl + WO_WIN); J.ldt = D; J.mode = 1; J.nkb = 32; J.nnb = NIN / 64; break;
    case 1:  J.W = SRC(8, 512 * D);  J.ldw = D; J.WT = (bf16*)(wl + WO_WBR); J.ldt = D; J.kdst0 = 0;    J.nkb = 8; J.nnb = 32; break;
    case 2:  J.W = SRC(16, 512 * D); J.ldw = D; J.WT = (bf16*)(wl + WO_WBR); J.ldt = D; J.kdst0 = 1024; J.nkb = 8; J.nnb = 32; break;
    case 3:  J.W = SRC(21, 512 * D); J.ldw = D; J.WT = (bf16*)(wl + WO_WBR); J.ldt = D; J.kdst0 = 1536; J.nkb = 8; J.nnb = 32; break;
    case 4:  J.W = SRC(22, (size_t)D * D); J.ldw = D; J.WT = (bf16*)(wl + WO_WOUT); J.ldt = D; J.nkb = 32; J.nnb = 32; break;
    case 5:  J.W = SRC(13, 512 * 768); J.ldw = 768; J.ks = SRC(12, 512); J.WT = (bf16*)(wl + WO_WUQ); J.ldt = 512; J.nkb = 8; J.nnb = 12; break;
    case 6:  J.W = SRC(15, 256 * 1024); J.ldw = 1024; J.ks = SRC(14, 256); J.WT = (bf16*)(wl + WO_WUKV); J.ldt = 256; J.nkb = 4; J.nnb = 16; break;
    case 7:  J.W = SRC(25, D * 512); J.ldw = 512; J.WT = (bf16*)(wl + WO_WXQ); J.ldt = D; J.nkb = 32; J.nnb = 8; break;
    case 8:  J.W = SRC(26, D * 512); J.ldw = 512; J.WT = (bf16*)(wl + WO_WXK); J.ldt = D; J.nkb = 32; J.nnb = 8; break;
    case 9:  J.W = SRC(27, D * 512); J.ldw = 512; J.WT = (bf16*)(wl + WO_WXV); J.ldt = D; J.nkb = 32; J.nnb = 8; break;
    case 10: J.W = SRC(28, 512 * D); J.ldw = D; J.WT = (bf16*)(wl + WO_WXO); J.ldt = 512; J.nkb = 8; J.nnb = 32; break;
    case 11: J.W = SRC(35, (size_t)32 * D * 1024); J.ldw = 1024; J.WT = (bf16*)(wl + WO_WEIN); J.ldt = D; J.mode = 2; J.nkb = 32; J.nnb = 16; J.nbatch = 32; J.sstride = (size_t)D * 1024; J.dstride = (size_t)1024 * D; break;
    case 12: J.W = SRC(36, (size_t)32 * 512 * D); J.ldw = D; J.WT = (bf16*)(wl + WO_WEOUT); J.ldt = 512; J.nkb = 8; J.nnb = 32; J.nbatch = 32; J.sstride = (size_t)512 * D; J.dstride = (size_t)D * 512; break;
    case 13: J.W = SRC(6, 2 * 2048 * 128); J.ldw = 128; J.WT = (bf16*)(wl + WO_W1C); J.ldt = 2048; J.nkb = 32; J.nnb = 2; J.nbatch = 2; J.sstride = 2048 * 128; J.dstride = 128 * 2048; break;
    default: J.W = SRC(7, 2 * 128 * 64); J.ldw = 64; J.WT = (bf16*)(wl + WO_W2C); J.ldt = 128; J.nkb = 2; J.nnb = 1; J.nbatch = 2; J.sstride = 128 * 64; J.dstride = 64 * 128; break;
    }
#undef SRC
    return J;
}

struct Row { f32x4 v[8]; };
__device__ __forceinline__ void row_load(Row& r, const float* p, int lane) {
    asm volatile("" : "+v"(lane));
#pragma unroll
    for (int j = 0; j < 8; ++j) r.v[j] = *(const f32x4*)(p + 4 * lane + 256 * j);
}
__device__ __forceinline__ void row_store_f32(const Row& r, float* p, int lane) {
    asm volatile("" : "+v"(lane));
#pragma unroll
    for (int j = 0; j < 8; ++j) *(f32x4*)(p + 4 * lane + 256 * j) = r.v[j];
}
__device__ __forceinline__ void row_store_bf16(const Row& r, bf16* p, int lane) {
    asm volatile("" : "+v"(lane));
#pragma unroll
    for (int j = 0; j < 8; ++j) { u32x2 w; w.x = cvt_pk_bf16(r.v[j][0], r.v[j][1]); w.y = cvt_pk_bf16(r.v[j][2], r.v[j][3]); *(u32x2*)(p + 4 * lane + 256 * j) = w; }
}
__device__ __forceinline__ void row_add_bf16(Row& r, const bf16* p, int lane) {
    asm volatile("" : "+v"(lane));
#pragma unroll
    for (int j = 0; j < 8; ++j) { const u32x2 w = *(const u32x2*)(p + 4 * lane + 256 * j); r.v[j][0] += bflo(w.x); r.v[j][1] += bfhi(w.x); r.v[j][2] += bflo(w.y); r.v[j][3] += bfhi(w.y); }
}
__device__ __forceinline__ void row_layernorm(Row& r, const float* g, const float* b, int lane) {
    asm volatile("" : "+v"(lane));
    float s = 0.f;
#pragma unroll
    for (int j = 0; j < 8; ++j) s += (r.v[j][0] + r.v[j][1]) + (r.v[j][2] + r.v[j][3]);
    const float mean = wave_sum(s) * (1.0f / D); float q = 0.f;
#pragma unroll
    for (int j = 0; j < 8; ++j) { r.v[j] = r.v[j] - mean; q += (r.v[j][0] * r.v[j][0] + r.v[j][1] * r.v[j][1]) + (r.v[j][2] * r.v[j][2] + r.v[j][3] * r.v[j][3]); }
    const float rstd = 1.0f / sqrtf(wave_sum(q) * (1.0f / D) + 1e-5f);
#pragma unroll
    for (int j = 0; j < 8; ++j) { const f32x4 gg = *(const f32x4*)(g + 4 * lane + 256 * j), bb = *(const f32x4*)(b + 4 * lane + 256 * j); r.v[j] = r.v[j] * rstd * gg + bb; }
}

template <class AP, class BP>
__device__ __forceinline__ f32x4 sgemm16(const AP& ap, const BP& bp, int K, int lane) {
    const int r = lane & 15, G = lane >> 4; f32x4 acc = (f32x4){0.f, 0.f, 0.f, 0.f};
#pragma unroll 4
    for (int k0 = 0; k0 < K; k0 += 32) { const bf16x8 a = *(const bf16x8*)ap(r, k0 + 8 * G), b = *(const bf16x8*)bp(r, k0 + 8 * G);
        acc = __builtin_amdgcn_mfma_f32_16x16x32_bf16(a, b, acc, 0, 0, 0); }
    return acc;
}
__device__ __forceinline__ void transpose_tile64(const bf16* src, size_t sp, bf16* dst, size_t dp, LAS bf16* scr, int lane) {
#pragma unroll
    for (int c = 0; c < 8; ++c) { const u32x4 v = *(const u32x4*)(src + (size_t)lane * sp + 8 * c); LAS unsigned* d = (LAS unsigned*)(scr + lane * 66 + 8 * c); d[0] = v.x; d[1] = v.y; d[2] = v.z; d[3] = v.w; }
    LDS_WAIT(); asm volatile("" ::: "memory");
#pragma unroll
    for (int c = 0; c < 8; ++c) { unsigned w[4];
#pragma unroll
        for (int q = 0; q < 4; ++q) { const unsigned lo = scr[(8 * c + 2 * q) * 66 + lane], hi = scr[(8 * c + 2 * q + 1) * 66 + lane]; w[q] = lo | (hi << 16); }
        *(u32x4*)(dst + (size_t)lane * dp + 8 * c) = (u32x4){w[0], w[1], w[2], w[3]}; }
    LDS_WAIT(); asm volatile("" ::: "memory");
}
__device__ __forceinline__ float gelu_tanh(float x) { const float u = 0.7978845608028654f * (x + 0.044715f * x * x * x); return 0.5f * x * (1.0f + tanhf(u)); }

__device__ __forceinline__ void phase_prologue(const Args& a, Frame& F) {
    LAS float* scr = (LAS float*)(F.lds + F.wave * 16640);
    const int gw = F.gw, NGW = F.NGW, lane = F.lane;
    { int off = 0;
      for (int l = 0; l < DEPTH; ++l)
        for (int j = 0; j < NJOBS; ++j) { const Job J = get_job(a, l, j); const int n = J.nbatch * J.nkb * J.nnb;
            int st = (gw - off) % NGW; if (st < 0) st += NGW;
            for (int it = st; it < n; it += NGW) transpose_item(J, it, scr, lane);
            off = (off + n) % NGW; } }
#pragma unroll 1
    for (int i = gw * 64 + lane; i < DEPTH * NIN; i += NGW * 64) { const int l = i / NIN, n = i % NIN; const int sc = in_col(n);
        ((float*)(a.ws + WS_WL0 + (size_t)l * WS_WLSTRIDE + WO_BIASP))[n] = sc >= 0 ? ((const float*)a.in[4])[(size_t)l * IN_W + sc] : 0.f; }
#pragma unroll 1
    for (int it = gw; it < DEPTH * 4 * 16 * 32; it += NGW) { const int nb = it & 31, cb = (it >> 5) & 15, g = (it >> 9) & 3, l = it >> 11; const int n = nb * 64 + lane;
        const float* wp = (const float*)a.in[9] + ((size_t)(l * 4 + g) * 128 + 8 * cb) * 128; const float* ps = (const float*)a.in[10] + l * 512 + 128 * g;
        const float* wo = (const float*)a.in[11] + ((size_t)l * 512 + 128 * g) * D + n;
        float acc[8];
#pragma unroll
        for (int i = 0; i < 8; ++i) acc[i] = 0.f;
        for (int d = 0; d < 128; ++d) { const float b = wo[(size_t)d * D] * ps[d];
#pragma unroll
            for (int i = 0; i < 8; ++i) acc[i] += wp[i * 128 + d] * b; }
        bf16* dst = (bf16*)(a.ws + WS_WL0 + (size_t)l * WS_WLSTRIDE + WO_WBR) + (size_t)n * D + 512 + 128 * g + 8 * cb;
        *(u32x4*)dst = (u32x4){cvt_pk_bf16(acc[0], acc[1]), cvt_pk_bf16(acc[2], acc[3]), cvt_pk_bf16(acc[4], acc[5]), cvt_pk_bf16(acc[6], acc[7])}; }
#pragma unroll 1
    for (int it = gw; it < DEPTH * 2; it += NGW) { const float* pos = (const float*)a.in[5] + (size_t)it * 2048; const float* w1 = (const float*)a.in[6] + (size_t)it * 2048 * 128;
        float a0 = 0.f, a1 = 0.f;
        for (int k = 0; k < 2048; ++k) { const float p = pos[k]; a0 += p * w1[(size_t)k * 128 + lane]; a1 += p * w1[(size_t)k * 128 + 64 + lane]; }
        float* dst = (float*)(a.ws + WS_WL0 + (size_t)(it >> 1) * WS_WLSTRIDE + WO_B1C) + (it & 1) * 128; dst[lane] = a0; dst[64 + lane] = a1; }
#pragma unroll 1
    for (int i = gw * 64 + lane; i < S * 16; i += NGW * 64) { const int t = i >> 4, k = i & 15; const float inv = powf(10000.0f, -(float)k / 16.0f); const float ang = (float)((const int*)a.in[2])[t] * inv;
        float sn, cs; sincosf(ang, &sn, &cs); ((f32x2*)(a.ws + WS_ROPE))[i] = (f32x2){cs, sn}; }
#pragma unroll 1
    for (int r = gw; r < S + 256; r += NGW) { Row rw;
        if (r < S) { row_load(rw, (const float*)a.in[0] + (size_t)r * D, lane); row_store_f32(rw, (float*)(a.ws + WS_X) + (size_t)r * D, lane); row_store_bf16(rw, (bf16*)(a.ws + WS_XB) + (size_t)r * D, lane); }
        else { row_load(rw, (const float*)a.in[1] + (size_t)(r - S) * D, lane); row_store_bf16(rw, (bf16*)(a.ws + WS_MEMB) + (size_t)(r - S) * D, lane); } }
}

__device__ __forceinline__ int crow(int r, int hi) { return (r & 3) + 8 * (r >> 2) + 4 * hi; }
template <int DK, int DV, class V>
__device__ __forceinline__ void attn32(const V& v, int lane, float& m_fin, float& l_fin) {
    const int col = lane & 31, hi = lane >> 5;
    constexpr int NKS = DK / 16, NVB = DV / 32;
    bf16x8 qf[NKS];
    { const bf16* qp = v.qptr(col);
#pragma unroll
      for (int s = 0; s < NKS; ++s) qf[s] = *(const bf16x8*)(qp + 16 * s + 8 * hi); }
    f32x16 o[NVB];
#pragma unroll
    for (int b = 0; b < NVB; ++b)
#pragma unroll
        for (int r = 0; r < 16; ++r) o[b][r] = 0.f;
    float m_run = -INFINITY, l_run = 0.f;
    for (int T = v.tb; T < v.te; ++T) {
        const int key0 = 32 * T;
        const bf16* kp = v.kptr(key0 + col);
        f32x16 sacc;
#pragma unroll
        for (int r = 0; r < 16; ++r) sacc[r] = 0.f;
#pragma unroll
        for (int s = 0; s < NKS; ++s) { const bf16x8 kf = *(const bf16x8*)(kp + 16 * s + 8 * hi); sacc = __builtin_amdgcn_mfma_f32_32x32x16_bf16(kf, qf[s], sacc, 0, 0, 0); }
        float x[16]; float mt = -INFINITY;
#pragma unroll
        for (int r = 0; r < 16; ++r) { const int key = key0 + crow(r, hi); x[r] = v.valid(key, col) ? sacc[r] * v.scale2 : -INFINITY; mt = fmaxf(mt, x[r]); }
        mt = fmaxf(mt, __shfl_xor(mt, 32));
        const float m_new = fmaxf(m_run, mt);
        const float mref = (m_new == -INFINITY) ? 0.f : m_new;
        const float corr = __builtin_amdgcn_exp2f(m_run - mref);
        float ps = 0.f;
#pragma unroll
        for (int r = 0; r < 16; ++r) { x[r] = __builtin_amdgcn_exp2f(x[r] - mref); ps += x[r]; }
        l_run = l_run * corr + ps; m_run = m_new;
#pragma unroll
        for (int b = 0; b < NVB; ++b)
#pragma unroll
            for (int r = 0; r < 16; ++r) o[b][r] *= corr;
        bf16x8 pf[2];
#pragma unroll
        for (int s2 = 0; s2 < 2; ++s2) { const u32x4 w = (u32x4){cvt_pk_bf16(x[8 * s2 + 0], x[8 * s2 + 1]), cvt_pk_bf16(x[8 * s2 + 2], x[8 * s2 + 3]), cvt_pk_bf16(x[8 * s2 + 4], x[8 * s2 + 5]), cvt_pk_bf16(x[8 * s2 + 6], x[8 * s2 + 7])};
            pf[s2] = __builtin_bit_cast(bf16x8, w); }
#pragma unroll
        for (int b = 0; b < NVB; ++b) { const bf16* vp = v.vtptr(32 * b + col) + key0 + 4 * hi;
#pragma unroll
            for (int s2 = 0; s2 < 2; ++s2) { const u32x2 lo = *(const u32x2*)(vp + 16 * s2), hh = *(const u32x2*)(vp + 16 * s2 + 8);
                const bf16x8 vf = __builtin_bit_cast(bf16x8, (u32x4){lo.x, lo.y, hh.x, hh.y});
                o[b] = __builtin_amdgcn_mfma_f32_32x32x16_bf16(vf, pf[s2], o[b], 0, 0, 0); } }
    }
    const float l = l_run + __shfl_xor(l_run, 32);
    const float inv = l > 0.f ? 1.0f / l : 0.f;
#pragma unroll
    for (int b = 0; b < NVB; ++b)
#pragma unroll
        for (int i = 0; i < 4; ++i) v.store(col, 32 * b + 8 * i + 4 * hi, (f32x4){o[b][4 * i] * inv, o[b][4 * i + 1] * inv, o[b][4 * i + 2] * inv, o[b][4 * i + 3] * inv});
    m_fin = m_run; l_fin = l;
}
__device__ __forceinline__ void store4_bf16(bf16* p, const f32x4 v) { *(u32x2*)p = (u32x2){cvt_pk_bf16(v[0], v[1]), cvt_pk_bf16(v[2], v[3])}; }

struct VarMLA {
    const bf16* Q; const bf16* K; const bf16* Vt; bf16* O; int t0, hd, tb, te; float scale2;
    __device__ __forceinline__ const bf16* qptr(int col) const { return Q + (size_t)(t0 + col) * 768 + hd * 96; }
    __device__ __forceinline__ const bf16* kptr(int key) const { return K + (size_t)key * 768 + hd * 96; }
    __device__ __forceinline__ const bf16* vtptr(int dv) const { return Vt + (size_t)(hd * 64 + dv) * S; }
    __device__ __forceinline__ bool valid(int key, int col) const { return key <= t0 + col; }
    __device__ __forceinline__ void store(int col, int dv, const f32x4 x) const { store4_bf16(O + (size_t)(t0 + col) * D + 1024 + hd * 64 + dv, x); }
};
struct VarWin {
    const bf16* U2; const bf16* Vt; bf16* O; int t0, g, tb, te; float scale2;
    __device__ __forceinline__ const bf16* qptr(int col) const { return U2 + (size_t)(t0 + (col >> 2)) * U2W + U2_Q + (4 * g + (col & 3)) * 64; }
    __device__ __forceinline__ const bf16* kptr(int key) const { return U2 + (size_t)key * U2W + U2_KV + (4 * 2 + g) * 64; }
    __device__ __forceinline__ const bf16* vtptr(int dv) const { return Vt + (size_t)(g * 64 + dv) * S; }
    __device__ __forceinline__ bool valid(int key, int col) const { const int tok = t0 + (col >> 2); return key <= tok && key > tok - 512; }
    __device__ __forceinline__ void store(int col, int dv, const f32x4 x) const { store4_bf16(O + (size_t)(t0 + (col >> 2)) * 512 + (4 * g + (col & 3)) * 64 + dv, x); }
};
struct VarCmp {
    const bf16* U2; const bf16* KC; const bf16* Vt; bf16* O; int t0, g, tb, te; float scale2;
    __device__ __forceinline__ const bf16* qptr(int col) const { return U2 + (size_t)(t0 + (col >> 2)) * U2W + U2_Q + (4 * g + (col & 3)) * 64; }
    __device__ __forceinline__ const bf16* kptr(int c) const { return KC + (size_t)(g * 1024 + c) * 64; }
    __device__ __forceinline__ const bf16* vtptr(int dv) const { return Vt + (size_t)(g * 64 + dv) * 1024; }
    __device__ __forceinline__ bool valid(int c, int col) const { return 16 * c + 31 <= t0 + (col >> 2); }
    __device__ __forceinline__ void store(int col, int dv, const f32x4 x) const { store4_bf16(O + (size_t)(t0 + (col >> 2)) * 512 + (4 * g + (col & 3)) * 64 + dv, x); }
};
struct VarX {
    const bf16* Q; const bf16* K; const bf16* Vt; bf16* O; int t0, hd, tb, te; float scale2;
    __device__ __forceinline__ const bf16* qptr(int col) const { return Q + (size_t)(t0 + col) * 512 + hd * 128; }
    __device__ __forceinline__ const bf16* kptr(int key) const { return K + (size_t)key * 512 + hd * 128; }
    __device__ __forceinline__ const bf16* vtptr(int dv) const { return Vt + (size_t)(hd * 128 + dv) * 256; }
    __device__ __forceinline__ bool valid(int, int) const { return true; }
    __device__ __forceinline__ void store(int col, int dv, const f32x4 x) const { store4_bf16(O + (size_t)(t0 + col) * 512 + hd * 128 + dv, x); }
};
__device__ __forceinline__ void cmp_scores(const VarCmp& v, int lane, float m_fin, float l_fin, float* sc) {
    const int col = lane & 31, hi = lane >> 5;
    bf16x8 qf[4];
    { const bf16* qp = v.qptr(col);
#pragma unroll
      for (int s = 0; s < 4; ++s) qf[s] = *(const bf16x8*)(qp + 16 * s + 8 * hi); }
    const float mref = (m_fin == -INFINITY) ? 0.f : m_fin; const float inv = l_fin > 0.f ? 1.0f / l_fin : 0.f;
    float* dst = sc + (size_t)((v.t0 + (col >> 2)) * 2 + v.g) * 256;
    float carry = 0.f;
    for (int T = 0; T < 32; ++T) {
        float sv[4];
        if (T < v.te) {
            const int key0 = 32 * T; const bf16* kp = v.kptr(key0 + col);
            f32x16 sacc;
#pragma unroll
            for (int r = 0; r < 16; ++r) sacc[r] = 0.f;
#pragma unroll
            for (int s = 0; s < 4; ++s) { const bf16x8 kf = *(const bf16x8*)(kp + 16 * s + 8 * hi); sacc = __builtin_amdgcn_mfma_f32_32x32x16_bf16(kf, qf[s], sacc, 0, 0, 0); }
            float Gs[4], Es[4];
#pragma unroll
            for (int i = 0; i < 4; ++i) { float p[4];
#pragma unroll
                for (int q = 0; q < 4; ++q) { const int r = 4 * i + q; const int key = key0 + crow(r, hi); p[q] = v.valid(key, col) ? __builtin_amdgcn_exp2f(sacc[r] * v.scale2 - mref) * inv : 0.f; }
                Gs[i] = (p[0] + p[1]) + (p[2] + p[3]); Es[i] = p[3]; }
#pragma unroll
            for (int i = 0; i < 4; ++i) { Gs[i] += __shfl_xor(Gs[i], 1); Gs[i] += __shfl_xor(Gs[i], 2); Es[i] += __shfl_xor(Es[i], 1); Es[i] += __shfl_xor(Es[i], 2); }
            float eo[4];
#pragma unroll
            for (int i = 0; i < 4; ++i) eo[i] = __shfl_xor(Es[i], 32);
            if (hi) { sv[0] = Gs[0] + eo[0]; sv[1] = Gs[1] + eo[1]; sv[2] = Gs[2] + eo[2]; sv[3] = Gs[3] + eo[3]; }
            else { sv[0] = Gs[0] + carry; sv[1] = Gs[1] + eo[0]; sv[2] = Gs[2] + eo[1]; sv[3] = Gs[3] + eo[2]; }
            carry = eo[3];
        } else { sv[0] = hi ? 0.f : carry; sv[1] = 0.f; sv[2] = 0.f; sv[3] = 0.f; carry = 0.f; }
        if ((col & 3) == 0) {
#pragma unroll
            for (int i = 0; i < 4; ++i) dst[8 * T + 2 * i + hi] = sv[i]; }
    }
}

__device__ __forceinline__ void sel_attn_unit(const bf16* U2, const bf16* VTS, const bf16* OCMP, const bf16* OWIN, const int* idx, int nv, bf16* ABR, int t, int g, int lane) {
    const int c16 = lane & 15, G = lane >> 4;
    const float scale2 = 0.125f * LOG2E;
    bf16x8 qf[2];
    { const bf16* qp = U2 + (size_t)t * U2W + U2_Q + (4 * g + (c16 & 3)) * 64;
#pragma unroll
      for (int ks = 0; ks < 2; ++ks) { qf[ks] = *(const bf16x8*)(qp + 32 * ks + 8 * G); if (c16 >= 4) qf[ks] = (bf16x8){0, 0, 0, 0, 0, 0, 0, 0}; } }
    f32x4 o[4];
#pragma unroll
    for (int d = 0; d < 4; ++d) o[d] = (f32x4){0.f, 0.f, 0.f, 0.f};
    float m_run = -INFINITY, l_run = 0.f;
    for (int b = 0; b < nv; ++b) {
        const int blk = __builtin_amdgcn_readfirstlane(idx[b]); const int key0 = 64 * blk;
        f32x4 acc[4];
#pragma unroll
        for (int kt = 0; kt < 4; ++kt) { const bf16* kp = U2 + (size_t)(key0 + 16 * kt + c16) * U2W + U2_KV + (2 * 2 + g) * 64 + 8 * G;
            const bf16x8 k0 = *(const bf16x8*)kp, k1 = *(const bf16x8*)(kp + 32);
            acc[kt] = __builtin_amdgcn_mfma_f32_16x16x32_bf16(k0, qf[0], (f32x4){0.f, 0.f, 0.f, 0.f}, 0, 0, 0);
            acc[kt] = __builtin_amdgcn_mfma_f32_16x16x32_bf16(k1, qf[1], acc[kt], 0, 0, 0); }
        float mt = -INFINITY;
#pragma unroll
        for (int kt = 0; kt < 4; ++kt)
#pragma unroll
            for (int i = 0; i < 4; ++i) { const int key = key0 + 16 * kt + 4 * G + i; acc[kt][i] = (key <= t) ? acc[kt][i] * scale2 : -INFINITY; mt = fmaxf(mt, acc[kt][i]); }
        mt = fmaxf(mt, __shfl_xor(mt, 16)); mt = fmaxf(mt, __shfl_xor(mt, 32));
        const float m_new = fmaxf(m_run, mt); const float mref = (m_new == -INFINITY) ? 0.f : m_new;
        const float corr = __builtin_amdgcn_exp2f(m_run - mref); float ps = 0.f;
#pragma unroll
        for (int kt = 0; kt < 4; ++kt)
#pragma unroll
            for (int i = 0; i < 4; ++i) { acc[kt][i] = __builtin_amdgcn_exp2f(acc[kt][i] - mref); ps += acc[kt][i]; }
        l_run = l_run * corr + ps; m_run = m_new;
#pragma unroll
        for (int d = 0; d < 4; ++d) o[d] = o[d] * corr;
        bf16x8 pf[2];
#pragma unroll
        for (int u = 0; u < 2; ++u) pf[u] = __builtin_bit_cast(bf16x8, (u32x4){cvt_pk_bf16(acc[2 * u][0], acc[2 * u][1]), cvt_pk_bf16(acc[2 * u][2], acc[2 * u][3]), cvt_pk_bf16(acc[2 * u + 1][0], acc[2 * u + 1][1]), cvt_pk_bf16(acc[2 * u + 1][2], acc[2 * u + 1][3])});
#pragma unroll
        for (int d = 0; d < 4; ++d) { const bf16* vp = VTS + (size_t)(g * 64 + 16 * d + c16) * S + key0 + 4 * G;
#pragma unroll
            for (int u = 0; u < 2; ++u) { const u32x2 lo = *(const u32x2*)(vp + 32 * u), hh = *(const u32x2*)(vp + 32 * u + 16);
                o[d] = __builtin_amdgcn_mfma_f32_16x16x32_bf16(__builtin_bit_cast(bf16x8, (u32x4){lo.x, lo.y, hh.x, hh.y}), pf[u], o[d], 0, 0, 0); } }
    }
    float l = l_run; l += __shfl_xor(l, 16); l += __shfl_xor(l, 32);
    const float inv = l > 0.f ? 1.0f / l : 0.f;
    if (c16 < 4) { const int head = 4 * g + c16; const bf16* gp = U2 + (size_t)t * U2W + U2_G + head * 3;
        const float s0 = sigmoidf_(bf2f(gp[0])), s1 = sigmoidf_(bf2f(gp[1])) * inv, s2 = sigmoidf_(bf2f(gp[2]));
#pragma unroll
        for (int d = 0; d < 4; ++d) { const size_t off = (size_t)t * 512 + head * 64 + 16 * d + 4 * G; const u32x2 oc = *(const u32x2*)(OCMP + off), ow = *(const u32x2*)(OWIN + off);
            f32x4 r; r[0] = s0 * bflo(oc.x) + s1 * o[d][0] + s2 * bflo(ow.x); r[1] = s0 * bfhi(oc.x) + s1 * o[d][1] + s2 * bfhi(ow.x);
            r[2] = s0 * bflo(oc.y) + s1 * o[d][2] + s2 * bflo(ow.y); r[3] = s0 * bfhi(oc.y) + s1 * o[d][3] + s2 * bfhi(ow.y);
            store4_bf16(ABR + (size_t)t * D + head * 64 + 16 * d + 4 * G, r); } }
}
__device__ __forceinline__ void topk_unit(const float* sc, int t, int* idx_out, int* nv_out, int lane) {
    const int cur = t >> 6;
    if (cur + 1 <= 16) { if (lane < 16) idx_out[lane] = lane <= cur ? lane : cur; if (lane == 0) *nv_out = cur + 1; return; }
    f32x4 v = *(const f32x4*)(sc + 4 * lane);
#pragma unroll
    for (int q = 0; q < 4; ++q) { const int j = 4 * lane + q; if (j == 0 || j >= cur - 1) v[q] = -INFINITY; }
    if (lane == 0) { idx_out[0] = 0; idx_out[1] = cur - 1; idx_out[2] = cur; *nv_out = 16; }
    for (int n = 0; n < 13; ++n) {
        float bv = v[0]; int bi = 4 * lane;
#pragma unroll
        for (int q = 1; q < 4; ++q) if (v[q] > bv) { bv = v[q]; bi = 4 * lane + q; }
#pragma unroll
        for (int o = 1; o < 64; o <<= 1) { const float ov = __shfl_xor(bv, o); const int oi = __shfl_xor(bi, o); if (ov > bv || (ov == bv && oi < bi)) { bv = ov; bi = oi; } }
        if (lane == 0) idx_out[3 + n] = bi;
        if ((bi >> 2) == lane) {
#pragma unroll
            for (int q = 0; q < 4; ++q) if ((bi & 3) == q) v[q] = -INFINITY; }
    }
}

struct LP {
    unsigned char* ws; unsigned char* wl; int l;
    __device__ __forceinline__ bf16* w(size_t off) const { return (bf16*)(wl + off); }
    __device__ __forceinline__ bf16* b(size_t off) const { return (bf16*)(ws + off); }
    __device__ __forceinline__ float* f(size_t off) const { return (float*)(ws + off); }
    __device__ __forceinline__ int* i(size_t off) const { return (int*)(ws + off); }
};
#define INF32(a, idx, per) ((const float*)(a).in[idx] + (size_t)l * (per))

#ifndef BPARTS
#define BPARTS 31
#endif
__device__ __forceinline__ void phase_prep(const Args& a, Frame& F, const LP& P) {
    const int l = P.l, lane = F.lane, tid = F.tid;
    const bf16* U2 = P.b(WS_U2); bf16* ABR = P.b(WS_ABR);
    if (BPARTS & 1) { const float* cw = INF32(a, 17, 31 * 512); const float* cb = INF32(a, 18, 512); const float* lg = INF32(a, 19, 512); const float* lb = INF32(a, 20, 512);
      LAS float* cs = (LAS float*)F.lds;
      const int c = tid;
      float w[31];
#pragma unroll
      for (int k = 0; k < 31; ++k) w[k] = cw[k * 512 + c];
      const float bias = cb[c];
#pragma unroll 1
      for (int tile = blockIdx.x; tile < S / 32; tile += F.G) { const int t0 = tile * 32;
          float hreg[62];
#pragma unroll
          for (int r = 0; r < 62; ++r) { int tok = t0 - 30 + r; const bool ok = tok >= 0; tok = ok ? tok : 0;
              const bf16* up = U2 + (size_t)tok * U2W + U2_CONV + c; const float hv = bf2f(up[0]) * sigmoidf_(bf2f(up[512])); hreg[r] = ok ? hv : 0.f; }
#pragma unroll
          for (int i = 0; i < 32; ++i) { float acc = bias;
#pragma unroll
              for (int k = 0; k < 31; ++k) acc += w[k] * hreg[i + k];
              cs[i * 512 + c] = acc; }
          __syncthreads();
#pragma unroll
          for (int q = 0; q < 4; ++q) { const int tt = 4 * F.wave + q; float v[8]; float s = 0.f;
#pragma unroll
              for (int j = 0; j < 8; ++j) { v[j] = cs[tt * 512 + lane + 64 * j]; s += v[j]; }
              const float mean = wave_sum(s) * (1.0f / 512.0f); float qq = 0.f;
#pragma unroll
              for (int j = 0; j < 8; ++j) { v[j] -= mean; qq += v[j] * v[j]; }
              const float rstd = 1.0f / sqrtf(wave_sum(qq) * (1.0f / 512.0f) + 1e-5f);
#pragma unroll
              for (int j = 0; j < 8; ++j) { const int ch = lane + 64 * j; const float y = v[j] * rstd * lg[ch] + lb[ch]; ABR[(size_t)(t0 + tt) * D + 1536 + ch] = f2bf(y * sigmoidf_(y)); } }
          __syncthreads(); } }
    if (BPARTS & 2) { float* rq = P.f(WS_RSTD); float* rkv = rq + S;
#pragma unroll 1
      for (int t = F.gw; t < S; t += F.NGW) { const bf16* row = U2 + (size_t)t * U2W;
          { const u32x4 v = *(const u32x4*)(row + U2_CQ + 8 * lane); float s = 0.f;
#pragma unroll
            for (int q = 0; q < 4; ++q) { const float x0 = bflo(v[q]), x1 = bfhi(v[q]); s += x0 * x0 + x1 * x1; }
            s = wave_sum(s); if (lane == 0) rq[t] = 1.0f / sqrtf(s * (1.0f / 512.0f) + 1e-6f); }
          { const u32x2 v = *(const u32x2*)(row + U2_CKV + 4 * lane); float s = bflo(v.x) * bflo(v.x) + bfhi(v.x) * bfhi(v.x) + bflo(v.y) * bflo(v.y) + bfhi(v.y) * bfhi(v.y);
            s = wave_sum(s); if (lane == 0) rkv[t] = 1.0f / sqrtf(s * (1.0f / 256.0f) + 1e-6f); }
          { const int w = 2 << (lane >> 4); const int cnt = (t + 1 < w) ? (t + 1) : w; float sum[8];
#pragma unroll
            for (int q = 0; q < 8; ++q) sum[q] = 0.f;
            u32x4 self = (u32x4){0u, 0u, 0u, 0u};
            for (int i = 0; i < cnt; ++i) { const u32x4 v = *(const u32x4*)(U2 + (size_t)(t - i) * U2W + U2_POOL + 8 * lane); if (i == 0) self = v;
#pragma unroll
                for (int q = 0; q < 4; ++q) { sum[2 * q] += bflo(v[q]); sum[2 * q + 1] += bfhi(v[q]); } }
            const float ic = 1.0f / (float)cnt; u32x4 o;
#pragma unroll
            for (int q = 0; q < 4; ++q) o[q] = cvt_pk_bf16(sum[2 * q] * ic - bflo(self[q]), sum[2 * q + 1] * ic - bfhi(self[q]));
            *(u32x4*)(ABR + (size_t)t * D + 512 + 8 * lane) = o; } } }
    if (BPARTS & 4) { LAS bf16* scr = (LAS bf16*)(F.lds + 65536 + F.wave * 8448);
#pragma unroll 1
      for (int it = F.gw; it < 2 * 2 * (S / 64); it += F.NGW) { const int tt = it % (S / 64), g = (it / (S / 64)) & 1, which = it / (2 * (S / 64));
          const bf16* src = U2 + (size_t)(tt * 64) * U2W + U2_KV + ((which ? 5 : 3) * 2 + g) * 64;
          bf16* dst = P.b(which ? WS_VTWIN : WS_VTSEL) + (size_t)(g * 64) * S + tt * 64;
          transpose_tile64(src, U2W, dst, S, scr, lane); } }
    if (BPARTS & 8) { bf16* HID = P.b(WS_HID); const float* b1c = (const float*)(P.wl + WO_B1C);
#pragma unroll 1
      for (int it = F.gw; it < 4 * 64 * 8; it += F.NGW) { const int nt = it & 7, mt = (it >> 3) & 63, jg = it >> 9, j = jg >> 1, g = jg & 1;
          const bf16* Ab = U2 + U2_KV + (j * 2 + g) * 64; const bf16* Bb = P.w(WO_W1C) + (size_t)j * 128 * 2048;
          auto ap = [&](int r, int k) { int n = 16 * mt + r; n = n > 1022 ? 1022 : n; return Ab + (size_t)(16 * n + (k >> 6)) * U2W + (k & 63); };
          auto bp = [&](int r, int k) { return Bb + (size_t)(16 * nt + r) * 2048 + k; };
          const f32x4 acc = sgemm16(ap, bp, 2048, lane);
          const int h = 16 * nt + (lane & 15); const float bb = b1c[j * 128 + h];
#pragma unroll
          for (int i = 0; i < 4; ++i) { const int n = 16 * mt + 4 * (lane >> 4) + i; HID[((size_t)jg * 1024 + n) * 128 + h] = f2bf(gelu_tanh(acc[i] + bb)); } } }
    if (BPARTS & 16) { const bf16* MEMB = P.b(WS_MEMB); bf16* KX = P.b(WS_KX) + (size_t)l * 256 * 512; bf16* VXT = P.b(WS_VXT) + (size_t)l * 512 * 256;
#pragma unroll 1
      for (int it = F.gw; it < 1024; it += F.NGW) {
          if (it < 512) { const int mt = it >> 5, nt = it & 31;
              auto ap = [&](int r, int k) { return MEMB + (size_t)(16 * mt + r) * D + k; };
              auto bp = [&](int r, int k) { return P.w(WO_WXK) + (size_t)(16 * nt + r) * D + k; };
              const f32x4 acc = sgemm16(ap, bp, D, lane);
#pragma unroll
              for (int i = 0; i < 4; ++i) KX[(size_t)(16 * mt + 4 * (lane >> 4) + i) * 512 + 16 * nt + (lane & 15)] = f2bf(acc[i]);
          } else { const int q = it - 512, mt = q >> 4, nt = q & 15;
              auto ap = [&](int r, int k) { return P.w(WO_WXV) + (size_t)(16 * mt + r) * D + k; };
              auto bp = [&](int r, int k) { return MEMB + (size_t)(16 * nt + r) * D + k; };
              const f32x4 acc = sgemm16(ap, bp, D, lane);
#pragma unroll
              for (int i = 0; i < 4; ++i) VXT[(size_t)(16 * mt + 4 * (lane >> 4) + i) * 256 + 16 * nt + (lane & 15)] = f2bf(acc[i]); } } }
}

__device__ __forceinline__ void phase_compress2(Frame& F, const LP& P) {
    const int lane = F.lane; const bf16* HID = P.b(WS_HID); const bf16* W2 = P.w(WO_W2C);
#pragma unroll 1
    for (int it = F.gw; it < 1024; it += F.NGW) {
        if (it < 512) { const int nt = it & 3, mt = (it >> 2) & 63, g = it >> 8;
            auto ap = [&](int r, int k) { return HID + ((size_t)(0 * 2 + g) * 1024 + 16 * mt + r) * 128 + k; };
            auto bp = [&](int r, int k) { return W2 + (size_t)(16 * nt + r) * 128 + k; };
            const f32x4 acc = sgemm16(ap, bp, 128, lane);
#pragma unroll
            for (int i = 0; i < 4; ++i) P.b(WS_KC)[((size_t)g * 1024 + 16 * mt + 4 * (lane >> 4) + i) * 64 + 16 * nt + (lane & 15)] = f2bf(acc[i]);
        } else { const int q = it - 512, nt = q & 63, mt = (q >> 6) & 3, g = q >> 8;
            auto ap = [&](int r, int k) { return W2 + (size_t)64 * 128 + (size_t)(16 * mt + r) * 128 + k; };
            auto bp = [&](int r, int k) { return HID + ((size_t)(1 * 2 + g) * 1024 + 16 * nt + r) * 128 + k; };
            const f32x4 acc = sgemm16(ap, bp, 128, lane);
#pragma unroll
            for (int i = 0; i < 4; ++i) P.b(WS_VCT)[((size_t)g * 64 + 16 * mt + 4 * (lane >> 4) + i) * 1024 + 16 * nt + (lane & 15)] = f2bf(acc[i]); } }
}

__device__ __forceinline__ void phase_d(Frame& F, const LP& P) {
    const int lane = F.lane;
    { const bf16* QH = P.b(WS_QH); const bf16* KVH = P.b(WS_KVH); const bf16* U2 = P.b(WS_U2); bf16* QM = P.b(WS_QM); bf16* KM = P.b(WS_KM); const f32x2* rope = (const f32x2*)(P.ws + WS_ROPE);
      const float qs = 0.10206207261596577f * LOG2E;
#pragma unroll 1
      for (int i = F.gw * 64 + lane; i < S * 8; i += F.NGW * 64) { const int t = i >> 3, hd = i & 7;
          const bf16* qp = QH + (size_t)t * 768 + hd * 96; bf16* qo = QM + (size_t)t * 768 + hd * 96; bf16* ko = KM + (size_t)t * 768 + hd * 96;
#pragma unroll
          for (int c = 0; c < 8; ++c) { const u32x4 v = *(const u32x4*)(qp + 8 * c); u32x4 o;
#pragma unroll
              for (int q = 0; q < 4; ++q) o[q] = cvt_pk_bf16(bflo(v[q]) * qs, bfhi(v[q]) * qs);
              *(u32x4*)(qo + 8 * c) = o; }
#pragma unroll
          for (int c = 0; c < 8; ++c) *(u32x4*)(ko + 8 * c) = *(const u32x4*)(KVH + (size_t)t * 1024 + hd * 128 + 8 * c);
          const bf16* kr = U2 + (size_t)t * U2W + U2_KR;
#pragma unroll
          for (int k = 0; k < 16; k += 2) { const f32x2 cs0 = rope[t * 16 + k], cs1 = rope[t * 16 + k + 1];
              { const unsigned a = *(const unsigned*)(qp + 64 + k), b = *(const unsigned*)(qp + 80 + k);
                const float x10 = bflo(a), x11 = bfhi(a), x20 = bflo(b), x21 = bfhi(b);
                *(unsigned*)(qo + 64 + k) = cvt_pk_bf16((x10 * cs0.x - x20 * cs0.y) * qs, (x11 * cs1.x - x21 * cs1.y) * qs);
                *(unsigned*)(qo + 80 + k) = cvt_pk_bf16((x20 * cs0.x + x10 * cs0.y) * qs, (x21 * cs1.x + x11 * cs1.y) * qs); }
              { const unsigned a = *(const unsigned*)(kr + k), b = *(const unsigned*)(kr + 16 + k);
                const float x10 = bflo(a), x11 = bfhi(a), x20 = bflo(b), x21 = bfhi(b);
                *(unsigned*)(ko + 64 + k) = cvt_pk_bf16(x10 * cs0.x - x20 * cs0.y, x11 * cs1.x - x21 * cs1.y);
                *(unsigned*)(ko + 80 + k) = cvt_pk_bf16(x20 * cs0.x + x10 * cs0.y, x21 * cs1.x + x11 * cs1.y); } } }
      LAS bf16* scr = (LAS bf16*)(F.lds + F.wave * 8448);
#pragma unroll 1
      for (int it = F.gw; it < 8 * (S / 64); it += F.NGW) { const int tt = it % (S / 64), hd = it / (S / 64);
          transpose_tile64(KVH + (size_t)(tt * 64) * 1024 + hd * 128 + 64, 1024, P.b(WS_VTM) + (size_t)(hd * 64) * S + tt * 64, S, scr, lane); } }
#pragma unroll 1
    for (int u = F.gw; u < (S / 8) * 2; u += F.NGW) { const int g = u & 1, t0 = (u >> 1) * 8;
        VarCmp v; v.U2 = P.b(WS_U2); v.KC = P.b(WS_KC); v.Vt = P.b(WS_VCT); v.O = P.b(WS_OCMP); v.t0 = t0; v.g = g; v.scale2 = 0.125f * LOG2E; v.tb = 0;
        const int cmax = (t0 + 7 >= 31) ? ((t0 + 7 - 31) >> 4) : -1; v.te = cmax < 0 ? 0 : (cmax >> 5) + 1;
        float m, lsum; attn32<64, 64>(v, lane, m, lsum);
        cmp_scores(v, lane, m, lsum, P.f(WS_SCORES)); }
}

__device__ __forceinline__ void phase_e(Frame& F, const LP& P) {
    const int lane = F.lane;
    if (F.G == 256) {
        const int hd = blockIdx.x & 7, a0 = 8 * (blockIdx.x >> 3) + F.wave;
#pragma unroll 1
        for (int rep = 0; rep < 2; ++rep) { const int qt = rep ? 511 - a0 : a0;
            VarMLA v; v.Q = P.b(WS_QM); v.K = P.b(WS_KM); v.Vt = P.b(WS_VTM); v.O = P.b(WS_ABR); v.t0 = qt * 32; v.hd = hd; v.tb = 0; v.te = qt + 1; v.scale2 = 1.0f;
            float m, lsum; attn32<96, 64>(v, lane, m, lsum); }
    } else {
#pragma unroll 1
        for (int u = F.gw; u < 512 * 8; u += F.NGW) { const int hd = u & 7, qt = u >> 3;
            VarMLA v; v.Q = P.b(WS_QM); v.K = P.b(WS_KM); v.Vt = P.b(WS_VTM); v.O = P.b(WS_ABR); v.t0 = qt * 32; v.hd = hd; v.tb = 0; v.te = qt + 1; v.scale2 = 1.0f;
            float m, lsum; attn32<96, 64>(v, lane, m, lsum); }
    }
#pragma unroll 1
    for (int u = F.gw; u < (S / 8) * 2; u += F.NGW) { const int g = u & 1, t0 = (u >> 1) * 8;
        VarWin v; v.U2 = P.b(WS_U2); v.Vt = P.b(WS_VTWIN); v.O = P.b(WS_OWIN); v.t0 = t0; v.g = g; v.scale2 = 0.125f * LOG2E;
        const int lo = t0 - 511 > 0 ? t0 - 511 : 0; v.tb = lo >> 5; v.te = ((t0 + 7) >> 5) + 1;
        float m, lsum; attn32<64, 64>(v, lane, m, lsum); }
#pragma unroll 1
    for (int u = F.gw; u < S * 2; u += F.NGW) { const int t = u >> 1;
        topk_unit(P.f(WS_SCORES) + (size_t)u * 256, t, P.i(WS_IDX) + (size_t)u * 16, P.i(WS_NV) + u, lane); }
}
__device__ __forceinline__ void phase_f(Frame& F, const LP& P) {
#pragma unroll 1
    for (int u = F.gw; u < S * 2; u += F.NGW) { const int t = u >> 1, g = u & 1;
        const int nv = __builtin_amdgcn_readfirstlane(P.i(WS_NV)[u]);
        sel_attn_unit(P.b(WS_U2), P.b(WS_VTSEL), P.b(WS_OCMP), P.b(WS_OWIN), P.i(WS_IDX) + (size_t)u * 16, nv, P.b(WS_ABR), t, g, F.lane); }
}
__device__ __forceinline__ void phase_xattn(Frame& F, const LP& P) {
#pragma unroll 1
    for (int u = F.gw; u < (S / 32) * 4; u += F.NGW) { const int hd = u & 3, qt = u >> 2;
        VarX v; v.Q = P.b(WS_QX); v.K = P.b(WS_KX) + (size_t)P.l * 256 * 512; v.Vt = P.b(WS_VXT) + (size_t)P.l * 512 * 256; v.O = P.b(WS_OX); v.t0 = qt * 32; v.hd = hd; v.tb = 0; v.te = 8; v.scale2 = 1.0f;
        float m, lsum; attn32<128, 128>(v, F.lane, m, lsum); }
}

__device__ __forceinline__ void phase_ln(const Args& a, Frame& F, const LP& P, int gi, int bi) {
    const int l = P.l; const float* g = INF32(a, gi, D); const float* b = INF32(a, bi, D);
#pragma unroll 1
    for (int r = F.gw; r < S; r += F.NGW) { Row rw; float* xp = P.f(WS_X) + (size_t)r * D; row_load(rw, xp, F.lane); row_layernorm(rw, g, b, F.lane);
        row_store_f32(rw, xp, F.lane); row_store_bf16(rw, P.b(WS_XB) + (size_t)r * D, F.lane); }
}
__device__ __forceinline__ void route_token(const float (&lg)[36], int t, const float* bg, const float* br, int* toke, float* tokw, unsigned* cnt, int lane) {
    float gl[4]; int gs = 0;
#pragma unroll
    for (int e = 0; e < 4; ++e) gl[e] = lg[e] + bg[e];
    float gmax = gl[0];
#pragma unroll
    for (int e = 1; e < 4; ++e) { if (gl[e] > gmax) { gmax = gl[e]; gs = e; } }
    float gsum = 0.f;
#pragma unroll
    for (int e = 0; e < 4; ++e) gsum += __expf(gl[e] - gmax);
    const float gw = 1.0f / gsum;
    float el[8];
    const float s0 = gs == 0 ? 1.f : 0.f, s1 = gs == 1 ? 1.f : 0.f, s2 = gs == 2 ? 1.f : 0.f, s3 = gs == 3 ? 1.f : 0.f;
#pragma unroll
    for (int e = 0; e < 8; ++e) el[e] = (lg[4 + e] * s0 + lg[12 + e] * s1) + (lg[20 + e] * s2 + lg[28 + e] * s3) + br[gs * 8 + e];
    int i1 = 0; float e1 = el[0];
#pragma unroll
    for (int e = 1; e < 8; ++e) if (el[e] > e1) { e1 = el[e]; i1 = e; }
    int i2 = -1; float e2 = -INFINITY;
#pragma unroll
    for (int e = 0; e < 8; ++e) if (e != i1 && el[e] > e2) { e2 = el[e]; i2 = e; }
    const float r2 = __expf(e2 - e1); const float p1 = 1.0f / (1.0f + r2), p2 = r2 * p1;
    if (lane == 0) { const int x1 = gs * 8 + i1, x2 = gs * 8 + i2;
        toke[2 * t] = x1; toke[2 * t + 1] = x2; tokw[2 * t] = gw * p1; tokw[2 * t + 1] = gw * p2;
        atomicAdd(cnt + x1, 1u); atomicAdd(cnt + x2, 1u); }
}
__device__ __forceinline__ void phase_ln_router(const Args& a, Frame& F, const LP& P) {
    const int l = P.l, lane = F.lane; const float* g = INF32(a, 29, D); const float* b = INF32(a, 30, D);
    const float* wg = INF32(a, 31, D * 4); const float* bg = INF32(a, 32, 4); const float* wr = INF32(a, 33, D * 32); const float* br = INF32(a, 34, 32);
    int* toke = (int*)(P.ws + WS_MOE + MO_TOKE); float* tokw = (float*)(P.ws + WS_MOE + MO_TOKW); unsigned* cnt = (unsigned*)(P.ws + WS_CTL) + CW_CNT + 128 * l;
#pragma unroll 1
    for (int r0 = F.gw; r0 < S; r0 += F.NGW) {
        Row ra; float* xa = P.f(WS_X) + (size_t)r0 * D;
        row_load(ra, xa, lane); row_layernorm(ra, g, b, lane); row_store_f32(ra, xa, lane); row_store_bf16(ra, P.b(WS_XB) + (size_t)r0 * D, lane);
        float la[36];
#pragma unroll
        for (int e = 0; e < 36; ++e) la[e] = 0.f;
#pragma unroll
        for (int j = 0; j < 8; ++j) { int lv = lane; asm volatile("" : "+v"(lv));
#pragma unroll
            for (int i = 0; i < 4; ++i) { const int k = 4 * lv + 256 * j + i; const float va = ra.v[j][i];
                const f32x4 w0 = *(const f32x4*)(wg + (size_t)k * 4);
#pragma unroll
                for (int e = 0; e < 4; ++e) la[e] += va * w0[e];
#pragma unroll
                for (int q = 0; q < 4; ++q) { const f32x4 w1 = *(const f32x4*)(wr + (size_t)k * 32 + 4 * q);
#pragma unroll
                    for (int e = 0; e < 4; ++e) la[4 + 4 * q + e] += va * w1[e]; }
                asm volatile("" ::: "memory"); } }
#pragma unroll
        for (int e = 0; e < 20; ++e) { la[e] = wave_sum(la[e]); asm volatile("" : "+v"(la[e])); }
#pragma unroll
        for (int j = 0; j < 8; ++j) { int lv = lane; asm volatile("" : "+v"(lv));
#pragma unroll
            for (int i = 0; i < 4; ++i) { const int k = 4 * lv + 256 * j + i; const float va = ra.v[j][i];
#pragma unroll
                for (int q = 4; q < 8; ++q) { const f32x4 w1 = *(const f32x4*)(wr + (size_t)k * 32 + 4 * q);
#pragma unroll
                    for (int e = 0; e < 4; ++e) la[4 + 4 * q + e] += va * w1[e]; }
                asm volatile("" ::: "memory"); } }
#pragma unroll
        for (int e = 20; e < 36; ++e) la[e] = wave_sum(la[e]);
        route_token(la, r0, bg, br, toke, tokw, cnt, lane); }
}
__device__ __forceinline__ void phase_moe_assign(Frame& F, const LP& P) {
    const int lane = F.lane;
    unsigned* cnt = (unsigned*)(P.ws + WS_CTL) + CW_CNT + 128 * P.l; unsigned* fill = cnt + 64;
    const unsigned c = lane < 32 ? __hip_atomic_load(cnt + lane, __ATOMIC_RELAXED, __HIP_MEMORY_SCOPE_AGENT) : 0u;
    const unsigned padded = (c + 255u) & ~255u;
    unsigned incl = padded;
#pragma unroll
    for (int o = 1; o < 32; o <<= 1) { const unsigned v = __shfl_up(incl, o); if ((lane & 31) >= o) incl += v; }
    const unsigned pstart = incl - padded;
    if (F.gw == 0) {
        int* tile_e = (int*)(P.ws + WS_MOE + MO_TILEE); int* ntp = (int*)(P.ws + WS_MOE + MO_NT);
        if (lane < 32) for (unsigned r = pstart; r < incl; r += 256) tile_e[r >> 8] = lane;
        const unsigned total = __shfl(incl, 31); if (lane == 0) *ntp = (int)(total >> 8);
    }
    const int* toke = (const int*)(P.ws + WS_MOE + MO_TOKE); const float* tokw = (const float*)(P.ws + WS_MOE + MO_TOKW);
    int* tokp = (int*)(P.ws + WS_MOE + MO_TOKP); float* roww = (float*)(P.ws + WS_MOE + MO_ROWW);
#pragma unroll 1
    for (int t = F.gw; t < S; t += F.NGW) {
#pragma unroll
        for (int k = 0; k < 2; ++k) { const int e = toke[2 * t + k];
            unsigned pos = 0; if (lane == 0) pos = atomicAdd(fill + e, 1u);
            pos = __shfl(pos, 0) + __shfl(pstart, e);
            if (lane == 0) { tokp[2 * t + k] = (int)pos; roww[pos] = tokw[2 * t + k]; }
            const u32x4* src = (const u32x4*)(P.b(WS_XB) + (size_t)t * D); u32x4* dst = (u32x4*)(P.b(WS_XS) + (size_t)pos * D);
#pragma unroll
            for (int j = 0; j < 4; ++j) dst[lane + 64 * j] = src[lane + 64 * j]; } }
}
__device__ __forceinline__ void phase_moe_combine(const Args& a, Frame& F, const LP& P, bool last) {
    const int l = P.l; const float* g = INF32(a, 37, D); const float* b = INF32(a, 38, D); const int* tokp = (const int*)(P.ws + WS_MOE + MO_TOKP);
#pragma unroll 1
    for (int r = F.gw; r < S; r += F.NGW) { Row rw; float* xp = P.f(WS_X) + (size_t)r * D; row_load(rw, xp, F.lane);
#pragma unroll
        for (int j = 0; j < 8; ++j) rw.v[j] = rw.v[j] * DN_ALPHA;
        row_add_bf16(rw, P.b(WS_Y2) + (size_t)tokp[2 * r] * D, F.lane); row_add_bf16(rw, P.b(WS_Y2) + (size_t)tokp[2 * r + 1] * D, F.lane);
        row_layernorm(rw, g, b, F.lane);
        if (last) row_store_f32(rw, a.out + (size_t)r * D, F.lane);
        else { row_store_f32(rw, xp, F.lane); row_store_bf16(rw, P.b(WS_XB) + (size_t)r * D, F.lane); } }
}

constexpr int NPH_LAYER = 17, NPHASES = 1 + DEPTH * NPH_LAYER;
__global__ void __launch_bounds__(NWAVES * 64, 2) mk_fwd(Args a) {
    extern __shared__ __attribute__((aligned(16))) unsigned char lds_raw[];
    Frame F;
    F.lds = (LAS unsigned char*)lds_raw;
    F.tid = threadIdx.x; F.lane = F.tid & 63; F.wave = __builtin_amdgcn_readfirstlane(F.tid >> 6);
    F.G = gridDim.x; F.gw = blockIdx.x * NWAVES + F.wave; F.NGW = F.G * NWAVES; F.ws = a.ws;
    volatile LAS unsigned* MISC = (volatile LAS unsigned*)(F.lds + MISC_OFF);
    if (F.tid < 32) MISC[F.tid] = 0u;
    __syncthreads();
    unsigned* ctl = (unsigned*)(a.ws + WS_CTL);
    XcdBarrier bar = xcd_barrier_post(ctl + CW_BAR + a.li * XCD_BAR_WORDS, MISC + 8);
    const int lo = a.ph_lo, hi = a.ph_hi;
#if defined(PHMASK)
#define IN(k) (((PHMASK >> (((k) == 0) ? 0 : (((k) - 1) % NPH_LAYER) + 1)) & 1) && lo <= (k) && (k) < hi)
#elif defined(PHSEL)
#define IN(k) ((((k) == 0) ? 0 : (((k) - 1) % NPH_LAYER) + 1) == PHSEL && lo <= (k) && (k) < hi)
#else
#define IN(k) (lo <= (k) && (k) < hi)
#endif
#define SEAM(k) do { if (IN((k) + 1)) xcd_barrier(bar); } while (0)
#define FRESH() do { int t_ = threadIdx.x; asm volatile("" : "+v"(t_)); F.tid = t_; F.lane = t_ & 63; F.wave = __builtin_amdgcn_readfirstlane(t_ >> 6); F.gw = blockIdx.x * NWAVES + F.wave; } while (0)
    const int G = F.G, bx = blockIdx.x;

    if (IN(0)) { FRESH(); phase_prologue(a, F); SEAM(0); }

    for (int l = 0; l < DEPTH; ++l) {
        LP P; P.ws = a.ws; P.wl = a.ws + WS_WL0 + (size_t)l * WS_WLSTRIDE; P.l = l;
        const int pb = 1 + NPH_LAYER * l;
        if (IN(pb + 0)) { FRESH(); pg8::Gemm g{P.b(WS_XB), P.w(WO_WIN), D, D, D}; pg8::StaticOrder so; so.init(S, NIN, G, bx);
            EpiIn E{P.b(WS_GATE), P.b(WS_U2), (const float*)(P.wl + WO_BIASP)}; pg8::gemm_phase(F.lds, g, so, E); SEAM(pb + 0); }
        if (IN(pb + 1)) { FRESH(); phase_prep(a, F, P); SEAM(pb + 1); }
        if (IN(pb + 2)) { FRESH();
            { pg8::Gemm g{P.b(WS_U2) + U2_CQ, P.w(WO_WUQ), U2W, 512, 512}; pg8::StaticOrder so; so.init(S, 768, G, bx);
              EpiScale E{P.b(WS_QH), 768, P.f(WS_RSTD), 1.0f, 0}; pg8::gemm_phase(F.lds, g, so, E); }
            { pg8::Gemm g{P.b(WS_U2) + U2_CKV, P.w(WO_WUKV), U2W, 256, 256}; pg8::StaticOrder so; so.init(S, 1024, G, bx);
              EpiScale E{P.b(WS_KVH), 1024, P.f(WS_RSTD) + S, 1.0f, 0}; pg8::gemm_phase(F.lds, g, so, E); }
            phase_compress2(F, P); SEAM(pb + 2); }
        if (IN(pb + 3)) { FRESH(); phase_d(F, P); SEAM(pb + 3); }
        if (IN(pb + 4)) { FRESH(); phase_e(F, P); SEAM(pb + 4); }
        if (IN(pb + 5)) { FRESH(); phase_f(F, P); SEAM(pb + 5); }
        if (IN(pb + 6)) { FRESH(); pg8::Gemm g{P.b(WS_ABR), P.w(WO_WBR), D, D, D}; pg8::StaticOrder so; so.init(S, D, G, bx);
            EpiMerge E{P.b(WS_GATE), P.b(WS_MERGED)}; pg8::gemm_phase(F.lds, g, so, E); SEAM(pb + 6); }
        if (IN(pb + 7)) { FRESH(); pg8::Gemm g{P.b(WS_MERGED), P.w(WO_WOUT), D, D, D}; pg8::StaticOrder so; so.init(S, D, G, bx);
            EpiResid E{P.f(WS_X)}; pg8::gemm_phase(F.lds, g, so, E); SEAM(pb + 7); }
        if (IN(pb + 8)) { FRESH(); phase_ln(a, F, P, 23, 24); SEAM(pb + 8); }
        if (IN(pb + 9)) { FRESH(); pg8::Gemm g{P.b(WS_XB), P.w(WO_WXQ), D, D, D}; pg8::StaticOrder so; so.init(S, 512, G, bx);
            EpiScale E{P.b(WS_QX), 512, nullptr, 0.08838834764831845f * LOG2E, 0}; pg8::gemm_phase(F.lds, g, so, E); SEAM(pb + 9); }
        if (IN(pb + 10)) { FRESH(); phase_xattn(F, P); SEAM(pb + 10); }
        if (IN(pb + 11)) { FRESH(); pg8::Gemm g{P.b(WS_OX), P.w(WO_WXO), 512, 512, 512}; pg8::StaticOrder so; so.init(S, D, G, bx);
            EpiResid E{P.f(WS_X)}; pg8::gemm_phase(F.lds, g, so, E); SEAM(pb + 11); }
        if (IN(pb + 12)) { FRESH(); phase_ln_router(a, F, P); SEAM(pb + 12); }
        if (IN(pb + 13)) { FRESH(); phase_moe_assign(F, P); SEAM(pb + 13); }
        if (IN(pb + 14)) { FRESH(); const int* te = (const int*)(P.ws + WS_MOE + MO_TILEE); const int ntl = *(const int*)(P.ws + WS_MOE + MO_NT);
            pg8::Gemm g{P.b(WS_XS), P.w(WO_WEIN), D, D, D}; pg8::GroupedOrder so{te, ntl, 4, G, bx};
            EpiGlu E{P.b(WS_HS)}; pg8::gemm_phase(F.lds, g, so, E); SEAM(pb + 14); }
        if (IN(pb + 15)) { FRESH(); const int* te = (const int*)(P.ws + WS_MOE + MO_TILEE); const int ntl = *(const int*)(P.ws + WS_MOE + MO_NT);
            pg8::Gemm g{P.b(WS_HS), P.w(WO_WEOUT), 512, 512, 512}; pg8::GroupedOrder so{te, ntl, 8, G, bx};
            EpiScale E{P.b(WS_Y2), D, (const float*)(P.ws + WS_MOE + MO_ROWW), 1.0f, 8}; pg8::gemm_phase(F.lds, g, so, E); SEAM(pb + 15); }
        if (IN(pb + 16)) { FRESH(); phase_moe_combine(a, F, P, l == DEPTH - 1); SEAM(pb + 16); }
    }
#undef IN
#undef SEAM
}

#ifndef MK_PER_PHASE
#define MK_PER_PHASE 0
#endif
extern "C" void kernel_launch(void* const* d_in, const int* in_sizes, int n_in, void* d_out, int out_size, void* d_ws, size_t ws_size, hipStream_t stream) {
    static int grid = 0;
    if (grid == 0) {
        if (n_in != 39 || out_size != S * D || ws_size < WS_END) { fprintf(stderr, "kernel_launch: unexpected problem (n_in %d, out %d, ws %zu)\n", n_in, out_size, ws_size); grid = -1; return; }
        int dev = 0, cus = 0;
        if (hipGetDevice(&dev) != hipSuccess || hipDeviceGetAttribute(&cus, hipDeviceAttributeMultiprocessorCount, dev) != hipSuccess) { grid = -1; return; }
        if (hipFuncSetAttribute((const void*)mk_fwd, hipFuncAttributeMaxDynamicSharedMemorySize, LDS_BYTES) != hipSuccess) { fprintf(stderr, "kernel_launch: hipFuncSetAttribute failed\n"); grid = -1; return; }
        int per_cu = 0;
        if (hipOccupancyMaxActiveBlocksPerMultiprocessor(&per_cu, (const void*)mk_fwd, NWAVES * 64, LDS_BYTES) != hipSuccess || per_cu < 1) fprintf(stderr, "kernel_launch: occupancy query reports %d\n", per_cu);
        (void)hipGetLastError();
        grid = cus;
    }
    if (grid < 0) return;
    if (hipMemsetAsync((char*)d_ws + WS_CTL, 0, CTL_ZERO_BYTES, stream) != hipSuccess) return;
    Args a{};
    for (int i = 0; i < 39; ++i) a.in[i] = d_in[i];
    a.out = (float*)d_out; a.ws = (unsigned char*)d_ws; a.pad = 0;
#if MK_PER_PHASE
#ifndef MK_LAST
#define MK_LAST NPHASES
#endif
    for (int p = 0; p < MK_LAST; ++p) { a.ph_lo = p; a.ph_hi = p + 1; a.li = p; hipLaunchKernelGGL(mk_fwd, dim3(grid), dim3(NWAVES * 64), LDS_BYTES, stream, a); }
#else
    a.ph_lo = 0; a.ph_hi = NPHASES; a.li = 0;
    hipLaunchKernelGGL(mk_fwd, dim3(grid), dim3(NWAVES * 64), LDS_BYTES, stream, a);
#endif
}
```

```cpp
#include <hip/hip_runtime.h>
#include <cstdio>
#include <cstdint>

#define LAS __attribute__((address_space(3)))
#define GAS __attribute__((address_space(1)))
typedef unsigned short bf16;
typedef short bf16x8 __attribute__((ext_vector_type(8)));
typedef short s16x4 __attribute__((ext_vector_type(4)));
typedef float f32x2 __attribute__((ext_vector_type(2)));
typedef float f32x4 __attribute__((ext_vector_type(4)));
typedef float f32x16 __attribute__((ext_vector_type(16)));
typedef unsigned u32x2 __attribute__((ext_vector_type(2)));
typedef unsigned u32x4 __attribute__((ext_vector_type(4)));

constexpr int S = 16384, D = 2048, DEPTH = 2;
constexpr int IN_W = 11832;
constexpr int NIN = 12032;
constexpr int U2W = 3840;
constexpr int U2_Q = 0, U2_KV = 512, U2_POOL = 1280, U2_CQ = 1792, U2_CKV = 2304, U2_CONV = 2560, U2_G = 3584, U2_KR = 3616;
constexpr int NCMP = 1023;
constexpr int RMAX = 40960;
constexpr float DN_ALPHA = 1.4142135623730951f;
constexpr float LOG2E = 1.4426950408889634f;

typedef __bf16 bf16x2_t __attribute__((ext_vector_type(2)));
__device__ __forceinline__ unsigned cvt_pk_bf16(float lo, float hi) { const f32x2 v = {lo, hi}; const bf16x2_t b = __builtin_convertvector(v, bf16x2_t); return __builtin_bit_cast(unsigned, b); }
__device__ __forceinline__ float bf2f(unsigned short b) { return __uint_as_float(((unsigned)b) << 16); }
__device__ __forceinline__ float bflo(unsigned w) { return __uint_as_float(w << 16); }
__device__ __forceinline__ float bfhi(unsigned w) { return __uint_as_float(w & 0xffff0000u); }
__device__ __forceinline__ unsigned short f2bf(float f) { return (unsigned short)(cvt_pk_bf16(f, 0.f) & 0xffffu); }
__device__ __forceinline__ float wave_sum(float v) {
#pragma unroll
    for (int o = 1; o < 64; o <<= 1) v += __shfl_xor(v, o);
    return v;
}
__device__ __forceinline__ float sigmoidf_(float x) { return 1.0f / (1.0f + __expf(-x)); }
#define LDS_WAIT() asm volatile("s_waitcnt lgkmcnt(0)" ::: "memory")
#define VM_WAIT() asm volatile("s_waitcnt vmcnt(0)" ::: "memory")

namespace pg8 {
constexpr int BM = 256, BK = 64, HALF = 128, HTB = HALF * BK * 2, STAGE_BYTES = 8 * HTB, NXCD = 8, WGM = 8;
__host__ __device__ __forceinline__ int lds_byte(int r, int c) { const int st = (r >> 4) * 2 + (c >> 5), rr = r & 15, cc = c & 31, ob = rr * 64 + cc * 2; return st * 1024 + (ob ^ (((ob >> 9) & 1) << 5)); }
__host__ __device__ __forceinline__ void stage_rc(int b, int& R, int& C) { const int st = b / 1024, sb = b % 1024, swz = sb ^ (((sb >> 9) & 1) << 5); R = (st >> 1) * 16 + swz / 64; C = (st & 1) * 32 + (swz % 64) / 2; }
__host__ __device__ __forceinline__ int perm32(int rho) { const int n = rho >> 4, i = rho & 15; return 8 * (i >> 2) + 4 * n + (i & 3); }

struct Unit { int pm, pn; };
struct Gemm { const bf16* A; const bf16* Bt; int lda, ldb, K; const int* rowtok; };

struct StaticOrder {
    static constexpr bool GATHER = false;
    int nM, nN, nwg, G, c;
    __device__ void init(int M, int N, int G_, int c_) { nM = M / BM; nN = N / BM; nwg = nM * nN; G = G_; c = c_; }
    __device__ bool next(int i, Unit& u) const {
        const long L = (long)i * G + c; if (L >= nwg) return false;
        int wgid = (int)L; { const int q = nwg / NXCD, r = nwg % NXCD, xcd = wgid % NXCD, off = wgid / NXCD; wgid = (xcd < r ? xcd * (q + 1) : r * (q + 1) + (xcd - r) * q) + off; }
        const int nig = WGM * nN, gid = wgid / nig, fm = gid * WGM, gsz = (nM - fm) < WGM ? (nM - fm) : WGM;
        u.pm = fm + ((wgid % nig) % gsz); u.pn = (wgid % nig) / gsz; return true;
    }
};
template <bool GATHER_> struct GroupedOrderT {
    static constexpr bool GATHER = GATHER_;
    const int* tile_expert; int ntiles, npn, G, c;
    __device__ bool next(int i, Unit& u) const {
        const long L = (long)i * G + c; if (L >= (long)ntiles * npn) return false;
        const int rt = (int)(L / npn), pn = (int)(L % npn);
        u.pm = rt; u.pn = __builtin_amdgcn_readfirstlane(tile_expert[rt]) * npn + pn; return true;
    }
};
typedef GroupedOrderT<false> GroupedOrder; typedef GroupedOrderT<true> GroupedGather;

template <class Epi, class Sched>
__device__ __forceinline__ void gemm_phase(LAS unsigned char* lds, const Gemm g, const Sched& S, const Epi& E) {
    int tid = threadIdx.x; asm volatile("" : "+v"(tid));
    const int wid = __builtin_amdgcn_readfirstlane(tid >> 6), lane = tid & 63, wr = wid >> 2, wc = wid & 3, fr = lane & 15, fq = lane >> 4;
    const int K = g.K, nt = K / BK;
    constexpr bool GATHER = Sched::GATHER;
    unsigned voffB[2], vAc[2][2], vAn[2][2]; int Rr[2], Cc[2];
#pragma unroll
    for (int i = 0; i < 2; ++i) { int R, C; stage_rc(tid * 16 + i * 8192, R, C); const int Rb = Epi::PERM ? ((R & ~31) + perm32(R & 31)) : R; Rr[i] = R; Cc[i] = C;
        voffB[i] = (unsigned)(Rb * g.ldb + C) * 2u;
#pragma unroll
        for (int h = 0; h < 2; ++h) { vAc[h][i] = (unsigned)((R + h * HALF) * g.lda + C) * 2u; vAn[h][i] = vAc[h][i]; } }
    const size_t kstep = (size_t)(BK * 2);
    const size_t hstepB = (size_t)HALF * g.ldb * 2;
    const size_t tstepA = (size_t)2 * HALF * g.lda * 2, tstepB = 2 * hstepB;
    const unsigned ldsw = (unsigned)wid * 1024u;
    const int aoff = lds_byte(wr * 64 + fr, fq * 8), boff = lds_byte(wc * 32 + fr, fq * 8);
#define PG8_GOFF(v, u) do { _Pragma("unroll") for (int _h = 0; _h < 2; ++_h) _Pragma("unroll") for (int _i = 0; _i < 2; ++_i) { \
        const int _t = g.rowtok[(u).pm * 256 + _h * HALF + Rr[_i]]; (v)[_h][_i] = (unsigned)(_t * g.lda + Cc[_i]) * 2u; } \
        _Pragma("unroll") for (int _h = 0; _h < 2; ++_h) _Pragma("unroll") for (int _i = 0; _i < 2; ++_i) asm volatile("" : "+v"((v)[_h][_i])); } while (0)
#define PG8_SA(b, h) (((b) * 2 + (h)) * HTB)
#define PG8_SB(b, h) ((4 + (b) * 2 + (h)) * HTB)
#define PG8_STAGE(bufoff, gbase, voff) do { _Pragma("unroll") for (int _i = 0; _i < 2; ++_i) \
        __builtin_amdgcn_global_load_lds((const unsigned*)((const char*)(gbase) + (voff)[_i]), (LAS unsigned*)(lds + (bufoff) + ldsw + _i * 8192), 16, 0, 0); } while (0)
#define PG8_LDA(dst, b, h) do { _Pragma("unroll") for (int m = 0; m < 4; ++m) _Pragma("unroll") for (int k = 0; k < 2; ++k) dst[m][k] = *(const LAS bf16x8*)(lds + PG8_SA(b, h) + aoff + m * 2048 + k * 1024); } while (0)
#define PG8_LDB(dst, b, h) do { _Pragma("unroll") for (int n = 0; n < 2; ++n) _Pragma("unroll") for (int k = 0; k < 2; ++k) dst[n][k] = *(const LAS bf16x8*)(lds + PG8_SB(b, h) + boff + n * 2048 + k * 1024); } while (0)
#define PG8_MMA(ai, bj, At, Bt) do { __builtin_amdgcn_s_setprio(1); _Pragma("unroll") for (int m = 0; m < 4; ++m) _Pragma("unroll") for (int n = 0; n < 2; ++n) _Pragma("unroll") for (int k = 0; k < 2; ++k) \
        acc[ai][bj][m][n] = __builtin_amdgcn_mfma_f32_16x16x32_bf16(Bt[n][k], At[m][k], acc[ai][bj][m][n], 0, 0, 0); __builtin_amdgcn_s_setprio(0); } while (0)
#define PG8_WAIT_V(n) asm volatile("s_waitcnt vmcnt(" #n ")" ::: "memory")
#define PG8_WAIT_L(n) asm volatile("s_waitcnt lgkmcnt(" #n ")" ::: "memory")
#define PG8_BAR __builtin_amdgcn_s_barrier()
#define PG8_SCHED __builtin_amdgcn_sched_barrier(0)
    Unit cur, nxt; int ui = 0;
    if (!S.next(0, cur)) return;
    f32x4 acc[2][2][4][2];
#pragma unroll
    for (int a = 0; a < 2; ++a)
#pragma unroll
        for (int b = 0; b < 2; ++b)
#pragma unroll
            for (int m = 0; m < 4; ++m)
#pragma unroll
                for (int n = 0; n < 2; ++n) acc[a][b][m][n] = (f32x4){0.f, 0.f, 0.f, 0.f};
    bf16x8 At[4][2], B0[2][2], B1[2][2];
    if constexpr (GATHER) PG8_GOFF(vAc, cur);
    const char* cA = (const char*)g.A + (GATHER ? (size_t)0 : (size_t)cur.pm * tstepA); const char* cB = (const char*)g.Bt + (size_t)cur.pn * tstepB;
    PG8_STAGE(PG8_SB(0, 0), cB, voffB); PG8_STAGE(PG8_SB(0, 1), cB + hstepB, voffB); PG8_STAGE(PG8_SA(0, 0), cA, vAc[0]); PG8_STAGE(PG8_SA(0, 1), cA, vAc[1]);
    if (wr == 1) PG8_BAR;
    PG8_WAIT_V(2); PG8_BAR;
    PG8_STAGE(PG8_SB(1, 0), cB + kstep, voffB); PG8_STAGE(PG8_SA(1, 0), cA + kstep, vAc[0]); PG8_STAGE(PG8_SB(1, 1), cB + hstepB + kstep, voffB);
    PG8_WAIT_V(6); PG8_BAR;
    for (;;) {
        const bool has_next = S.next(ui + 1, nxt);
        if constexpr (GATHER) { if (has_next) PG8_GOFF(vAn, nxt); }
        const char* nA = GATHER ? cA : (has_next ? (const char*)g.A + (size_t)nxt.pm * tstepA : cA); const char* nB = has_next ? (const char*)g.Bt + (size_t)nxt.pn * tstepB : cB;
        for (int t = 0; t < nt; t += 2) {
            const bool last = (t == nt - 2);
            const char* a1 = cA + (size_t)(t + 1) * kstep;
            const char* a2 = last ? nA : cA + (size_t)(t + 2) * kstep; const char* b2 = last ? nB : cB + (size_t)(t + 2) * kstep;
            const char* a3 = a2 + kstep; const char* b3 = b2 + kstep;
            unsigned v2[2][2];
#pragma unroll
            for (int h = 0; h < 2; ++h)
#pragma unroll
                for (int i = 0; i < 2; ++i) v2[h][i] = (GATHER && last && has_next) ? vAn[h][i] : vAc[h][i];
            if constexpr (Epi::MIDK > 0) { if (t > 0 && (t % Epi::MIDK) == 0) { if (wr == 0) PG8_BAR; PG8_SCHED; E.mid(acc, cur, t / Epi::MIDK, wr, wc, fr, fq); PG8_SCHED; if (wr == 1) PG8_BAR; } }
            PG8_LDB(B0, 0, 0); PG8_LDB(B1, 0, 1); PG8_SCHED; PG8_LDA(At, 0, 0); PG8_STAGE(PG8_SA(1, 1), a1, vAc[1]);
            PG8_WAIT_V(8); PG8_WAIT_L(0); PG8_BAR; PG8_MMA(0, 0, At, B0); PG8_MMA(0, 1, At, B1); PG8_BAR; PG8_SCHED;
            PG8_LDA(At, 0, 1); PG8_STAGE(PG8_SB(0, 0), b2, voffB); PG8_STAGE(PG8_SB(0, 1), b2 + hstepB, voffB); PG8_STAGE(PG8_SA(0, 0), a2, v2[0]);
            PG8_WAIT_V(8); PG8_WAIT_L(0); PG8_BAR; PG8_MMA(1, 0, At, B0); PG8_MMA(1, 1, At, B1); PG8_BAR; PG8_SCHED;
            PG8_LDB(B0, 1, 0); PG8_LDB(B1, 1, 1); PG8_SCHED; PG8_LDA(At, 1, 0); PG8_STAGE(PG8_SA(0, 1), a2, v2[1]);
            PG8_WAIT_V(8); PG8_WAIT_L(0); PG8_BAR; PG8_MMA(0, 0, At, B0); PG8_MMA(0, 1, At, B1); PG8_BAR; PG8_SCHED;
            PG8_LDA(At, 1, 1); PG8_STAGE(PG8_SB(1, 0), b3, voffB); PG8_STAGE(PG8_SB(1, 1), b3 + hstepB, voffB); PG8_STAGE(PG8_SA(1, 0), a3, v2[0]);
            PG8_WAIT_V(8); PG8_WAIT_L(0); PG8_BAR; PG8_MMA(1, 0, At, B0); PG8_MMA(1, 1, At, B1); PG8_BAR; PG8_SCHED;
        }
        if (wr == 0) PG8_BAR;
        E(acc, cur, wr, wc, fr, fq);
        if (!has_next) break;
#pragma unroll
        for (int a = 0; a < 2; ++a)
#pragma unroll
            for (int b = 0; b < 2; ++b)
#pragma unroll
                for (int m = 0; m < 4; ++m)
#pragma unroll
                    for (int n = 0; n < 2; ++n) acc[a][b][m][n] = (f32x4){0.f, 0.f, 0.f, 0.f};
        cur = nxt; cA = nA; cB = nB; ++ui;
        if constexpr (GATHER) {
#pragma unroll
            for (int h = 0; h < 2; ++h)
#pragma unroll
                for (int i = 0; i < 2; ++i) vAc[h][i] = vAn[h][i]; }
        if (wr == 1) PG8_BAR;
    }
    PG8_WAIT_V(0);
    PG8_BAR;
#undef PG8_GOFF
#undef PG8_SA
#undef PG8_SB
#undef PG8_STAGE
#undef PG8_LDA
#undef PG8_LDB
#undef PG8_MMA
#undef PG8_WAIT_V
#undef PG8_WAIT_L
#undef PG8_BAR
#undef PG8_SCHED
}
}

__device__ __forceinline__ float fast_sigmoid(float x) { return __builtin_amdgcn_rcpf(1.0f + __builtin_amdgcn_exp2f(-x * LOG2E)); }
__device__ __forceinline__ u32x4 pack8(const f32x4 v0, const f32x4 v1) { u32x4 w; w.x = cvt_pk_bf16(v0[0], v0[1]); w.y = cvt_pk_bf16(v0[2], v0[3]); w.z = cvt_pk_bf16(v1[0], v1[1]); w.w = cvt_pk_bf16(v1[2], v1[3]); return w; }

struct EpiIn {
    static constexpr bool PERM = true; static constexpr int MIDK = 0;
    bf16* gate; bf16* u2; const float* bias;
    __device__ __forceinline__ void operator()(const f32x4 (&acc)[2][2][4][2], const pg8::Unit& u, int wr, int wc, int fr, int fq) const {
        const int row0 = u.pm * 256 + wr * 64 + fr; const bool isg = u.pn < 32;
        bf16* base = isg ? gate : u2; const int ldc = isg ? 8192 : U2W; const int colt = isg ? u.pn * 256 : (u.pn - 32) * 256;
        const int col0 = colt + wc * 32 + 8 * fq, bcol0 = u.pn * 256 + wc * 32 + 8 * fq;
        f32x4 bv[2][2];
#pragma unroll
        for (int bj = 0; bj < 2; ++bj)
#pragma unroll
            for (int n = 0; n < 2; ++n) bv[bj][n] = *(const f32x4*)(bias + bcol0 + bj * 128 + 4 * n);
#pragma unroll
        for (int ai = 0; ai < 2; ++ai)
#pragma unroll
            for (int m = 0; m < 4; ++m) { bf16* rowp = base + (size_t)(row0 + ai * 128 + m * 16) * ldc + col0;
#pragma unroll
                for (int bj = 0; bj < 2; ++bj) { f32x4 v0 = acc[ai][bj][m][0] + bv[bj][0], v1 = acc[ai][bj][m][1] + bv[bj][1];
                    if (isg) {
#pragma unroll
                        for (int j = 0; j < 4; ++j) { v0[j] = fast_sigmoid(v0[j]); v1[j] = fast_sigmoid(v1[j]); } }
                    *(u32x4*)(rowp + bj * 128) = pack8(v0, v1); } }
    }
};
struct EpiScale {
    static constexpr bool PERM = true; static constexpr int MIDK = 0;
    bf16* O; int ldc; const float* rowscale; float cs; int npn_mod;
    __device__ __forceinline__ void operator()(const f32x4 (&acc)[2][2][4][2], const pg8::Unit& u, int wr, int wc, int fr, int fq) const {
        const int row0 = u.pm * 256 + wr * 64 + fr; const int pnl = npn_mod ? (u.pn % npn_mod) : u.pn;
        const int col0 = pnl * 256 + wc * 32 + 8 * fq;
#pragma unroll
        for (int ai = 0; ai < 2; ++ai)
#pragma unroll
            for (int m = 0; m < 4; ++m) { const int row = row0 + ai * 128 + m * 16; const float sc = (rowscale ? rowscale[row] : 1.0f) * cs;
                bf16* rowp = O + (size_t)row * ldc + col0;
#pragma unroll
                for (int bj = 0; bj < 2; ++bj) *(u32x4*)(rowp + bj * 128) = pack8(acc[ai][bj][m][0] * sc, acc[ai][bj][m][1] * sc); }
    }
};
template <size_t OFF_O, size_t OFF_RS, size_t OFF_ROPE>
struct EpiQM {
    static constexpr bool PERM = true; static constexpr int MIDK = 0;
    unsigned char* ws;
    __device__ __forceinline__ void operator()(const f32x4 (&acc)[2][2][4][2], const pg8::Unit& u, int wr, int wc, int fr, int fq) const {
        const int row0 = u.pm * 256 + wr * 64 + fr; const int col0 = u.pn * 256 + wc * 32 + 8 * fq;
        bf16* O = (bf16*)(ws + OFF_O); const float* rowscale = (const float*)(ws + OFF_RS); const f32x2* rope = (const f32x2*)(ws + OFF_ROPE);
        const float qs = 0.10206207261596577f * LOG2E;
#pragma unroll
        for (int ai = 0; ai < 2; ++ai)
#pragma unroll
            for (int m = 0; m < 4; ++m) { const int row = row0 + ai * 128 + m * 16; const float sc = rowscale[row] * qs;
                asm volatile("" ::: "memory");
                bf16* rowp = O + (size_t)row * 768 + col0;
#pragma unroll
                for (int bj = 0; bj < 2; ++bj) { f32x4 v0 = acc[ai][bj][m][0] * sc, v1 = acc[ai][bj][m][1] * sc;
                    if ((8 * u.pn + 4 * bj + wc) % 3 == 2) {
                        const f32x4* rp = (const f32x4*)(rope + (size_t)row * 16 + 8 * (fq & 1));
                        const float sg = fq < 2 ? -1.0f : 1.0f;
                        { const f32x4 c01 = rp[0], c23 = rp[1]; const float q0 = __shfl_xor(v0[0], 32), q1 = __shfl_xor(v0[1], 32), q2 = __shfl_xor(v0[2], 32), q3 = __shfl_xor(v0[3], 32);
                          v0[0] = v0[0] * c01[0] + sg * q0 * c01[1]; v0[1] = v0[1] * c01[2] + sg * q1 * c01[3]; v0[2] = v0[2] * c23[0] + sg * q2 * c23[1]; v0[3] = v0[3] * c23[2] + sg * q3 * c23[3]; }
                        asm volatile("" ::: "memory");
                        { const f32x4 c45 = rp[2], c67 = rp[3]; const float q0 = __shfl_xor(v1[0], 32), q1 = __shfl_xor(v1[1], 32), q2 = __shfl_xor(v1[2], 32), q3 = __shfl_xor(v1[3], 32);
                          v1[0] = v1[0] * c45[0] + sg * q0 * c45[1]; v1[1] = v1[1] * c45[2] + sg * q1 * c45[3]; v1[2] = v1[2] * c67[0] + sg * q2 * c67[1]; v1[3] = v1[3] * c67[2] + sg * q3 * c67[3]; } }
                    *(u32x4*)(rowp + bj * 128) = pack8(v0, v1); } }
    }
};
struct EpiGlu {
    static constexpr bool PERM = true; static constexpr int MIDK = 0;
    bf16* H;
    __device__ __forceinline__ void operator()(const f32x4 (&acc)[2][2][4][2], const pg8::Unit& u, int wr, int wc, int fr, int fq) const {
        const int row0 = u.pm * 256 + wr * 64 + fr; const int col0 = (u.pn & 3) * 128 + wc * 32 + 8 * fq;
#pragma unroll
        for (int ai = 0; ai < 2; ++ai)
#pragma unroll
            for (int m = 0; m < 4; ++m) { f32x4 o[2];
#pragma unroll
                for (int n = 0; n < 2; ++n)
#pragma unroll
                    for (int j = 0; j < 4; ++j) { const float a = acc[ai][0][m][n][j], b = acc[ai][1][m][n][j]; o[n][j] = a * fast_sigmoid(a) * b; }
                *(u32x4*)(H + (size_t)(row0 + ai * 128 + m * 16) * 512 + col0) = pack8(o[0], o[1]); }
    }
};
struct EpiResid {
    static constexpr bool PERM = true; static constexpr int MIDK = 0;
    const bf16* X; bf16* Y;
    __device__ __forceinline__ void operator()(const f32x4 (&acc)[2][2][4][2], const pg8::Unit& u, int wr, int wc, int fr, int fq) const {
        const int row0 = u.pm * 256 + wr * 64 + fr, col0 = u.pn * 256 + wc * 32 + 8 * fq;
#pragma unroll
        for (int ai = 0; ai < 2; ++ai)
#pragma unroll
            for (int m = 0; m < 4; ++m) { const size_t ro = (size_t)(row0 + ai * 128 + m * 16) * D + col0;
#pragma unroll
                for (int bj = 0; bj < 2; ++bj) { const u32x4 xv = *(const u32x4*)(X + ro + bj * 128); f32x4 v0, v1;
                    v0[0] = bflo(xv.x) * DN_ALPHA + acc[ai][bj][m][0][0]; v0[1] = bfhi(xv.x) * DN_ALPHA + acc[ai][bj][m][0][1]; v0[2] = bflo(xv.y) * DN_ALPHA + acc[ai][bj][m][0][2]; v0[3] = bfhi(xv.y) * DN_ALPHA + acc[ai][bj][m][0][3];
                    v1[0] = bflo(xv.z) * DN_ALPHA + acc[ai][bj][m][1][0]; v1[1] = bfhi(xv.z) * DN_ALPHA + acc[ai][bj][m][1][1]; v1[2] = bflo(xv.w) * DN_ALPHA + acc[ai][bj][m][1][2]; v1[3] = bfhi(xv.w) * DN_ALPHA + acc[ai][bj][m][1][3];
                    *(u32x4*)(Y + ro + bj * 128) = pack8(v0, v1); } }
    }
};
struct EpiMerge {
    static constexpr bool PERM = true; static constexpr int MIDK = 8;
    const bf16* gate; bf16* O;
    __device__ __forceinline__ void mid(f32x4 (&acc)[2][2][4][2], const pg8::Unit& u, int seg, int wr, int wc, int fr, int fq) const {
        int row0 = u.pm * 256 + wr * 64 + fr; const int col0 = u.pn * 256 + wc * 32 + 8 * fq; asm volatile("" : "+v"(row0));
#pragma unroll
        for (int ai = 0; ai < 2; ++ai)
#pragma unroll
            for (int m = 0; m < 4; ++m) { const bf16* gp = gate + (size_t)(row0 + ai * 128 + m * 16) * 8192 + (size_t)(seg - 1) * 2048 + col0;
#pragma unroll
                for (int bj = 0; bj < 2; ++bj) { const u32x4 a = *(const u32x4*)(gp + bj * 128), b = *(const u32x4*)(gp + 2048 + bj * 128);
#pragma unroll
                    for (int q = 0; q < 4; ++q) { const float r0 = fmaxf(bflo(a[q]), 1e-30f) * __builtin_amdgcn_rcpf(fmaxf(bflo(b[q]), 1e-30f)), r1 = fmaxf(bfhi(a[q]), 1e-30f) * __builtin_amdgcn_rcpf(fmaxf(bfhi(b[q]), 1e-30f));
                        acc[ai][bj][m][q >> 1][(q & 1) * 2] *= r0; acc[ai][bj][m][q >> 1][(q & 1) * 2 + 1] *= r1; } }
                asm volatile("" ::: "memory"); }
    }
    __device__ __forceinline__ void operator()(const f32x4 (&acc)[2][2][4][2], const pg8::Unit& u, int wr, int wc, int fr, int fq) const {
        const int row0 = u.pm * 256 + wr * 64 + fr, col0 = u.pn * 256 + wc * 32 + 8 * fq;
#pragma unroll
        for (int ai = 0; ai < 2; ++ai)
#pragma unroll
            for (int m = 0; m < 4; ++m) { const int row = row0 + ai * 128 + m * 16; const bf16* gp = gate + (size_t)row * 8192 + 3 * 2048 + col0;
#pragma unroll
                for (int bj = 0; bj < 2; ++bj) { const u32x4 a = *(const u32x4*)(gp + bj * 128); f32x4 v0, v1;
                    v0[0] = acc[ai][bj][m][0][0] * fmaxf(bflo(a[0]), 1e-30f); v0[1] = acc[ai][bj][m][0][1] * fmaxf(bfhi(a[0]), 1e-30f);
                    v0[2] = acc[ai][bj][m][0][2] * fmaxf(bflo(a[1]), 1e-30f); v0[3] = acc[ai][bj][m][0][3] * fmaxf(bfhi(a[1]), 1e-30f);
                    v1[0] = acc[ai][bj][m][1][0] * fmaxf(bflo(a[2]), 1e-30f); v1[1] = acc[ai][bj][m][1][1] * fmaxf(bfhi(a[2]), 1e-30f);
                    v1[2] = acc[ai][bj][m][1][2] * fmaxf(bflo(a[3]), 1e-30f); v1[3] = acc[ai][bj][m][1][3] * fmaxf(bfhi(a[3]), 1e-30f);
                    *(u32x4*)(O + (size_t)row * D + col0 + bj * 128) = pack8(v0, v1); } }
    }
};

#define XB_TMO      128
#define XB_XCNT(j)  (256  + 64 * (j))
#define XB_XSUB(j)  (1280 + 64 * (j))
#define XB_XGEN(j)  (2304 + 64 * (j))
#define XB_TOP      3328
#define XB_TOPGEN   3392
#define XCD_BAR_WORDS 3456
#define XB_SPIN_CAP (1u << 25)
__device__ __forceinline__ unsigned xb_ld(unsigned* p)              { return __hip_atomic_load(p, __ATOMIC_RELAXED, __HIP_MEMORY_SCOPE_AGENT); }
__device__ __forceinline__ unsigned xb_add(unsigned* p, unsigned v) { return __hip_atomic_fetch_add(p, v, __ATOMIC_RELAXED, __HIP_MEMORY_SCOPE_AGENT); }
__device__ __forceinline__ unsigned xb_xcc_id() { return (unsigned)__builtin_amdgcn_s_getreg((3 << 11) | 20) & 0xFu; }
#define XB_SPIN(cond, bar) do { unsigned _sp = 0; while (cond) { __builtin_amdgcn_s_sleep(1); \
    if ((++_sp & 255u) == 0u) { if (xb_ld(&(bar)[XB_TMO])) break; if (_sp > XB_SPIN_CAP) { atomicAdd(&(bar)[XB_TMO], 1u); break; } } } } while (0)
struct XcdBarrier { unsigned* bar; unsigned x; volatile LAS unsigned* st; };
__device__ __forceinline__ XcdBarrier xcd_barrier_post(unsigned* bar, volatile LAS unsigned* st) {
    XcdBarrier b; b.bar = bar; b.x = xb_xcc_id(); b.st = st;
    if (threadIdx.x == 0) (void)xb_add(&bar[XB_XCNT(b.x)], 1u);
    return b;
}
__device__ __forceinline__ void xcd_barrier_complete(unsigned* bar, unsigned x, unsigned& nloc, unsigned& nx) {
    const unsigned G = gridDim.x * gridDim.y * gridDim.z;
    unsigned sum, cnt, mine, sp = 0u;
    for (;;) {
        sum = 0u; cnt = 0u; mine = 0u;
#pragma unroll
        for (unsigned j = 0; j < 16; ++j) { const unsigned c = xb_ld(&bar[XB_XCNT(j)]); sum += c; cnt += (c > 0u) ? 1u : 0u; mine = (j == x) ? c : mine; }
        if (sum == G) break;
        __builtin_amdgcn_s_sleep(1);
        if ((++sp & 255u) == 0u) { if (xb_ld(&bar[XB_TMO])) break; if (sp > XB_SPIN_CAP) { atomicAdd(&bar[XB_TMO], 1u); break; } }
    }
    nloc = mine > 0u ? mine : 1u; nx = cnt > 0u ? cnt : 1u;
}
__device__ __forceinline__ void xcd_barrier(const XcdBarrier& b) {
    asm volatile("s_waitcnt vmcnt(0)" ::: "memory");
    __syncthreads();
    if (threadIdx.x == 0) {
        unsigned* bar = b.bar;
        __builtin_amdgcn_s_waitcnt(0);
        unsigned nloc = b.st[0], nx = b.st[1];
        if (nloc == 0u) { xcd_barrier_complete(bar, b.x, nloc, nx); b.st[0] = nloc; b.st[1] = nx; }
        const unsigned old = xb_add(&bar[XB_XSUB(b.x)], 1u);
        const unsigned gen = old / nloc;
        if (old + 1u == (gen + 1u) * nloc) {
            __builtin_amdgcn_fence(__ATOMIC_RELEASE, "agent");
            asm volatile("s_waitcnt vmcnt(0)" ::: "memory");
            const unsigned og = xb_add(&bar[XB_TOP], 1u);
            const unsigned tg = og / nx;
            if (og + 1u == (tg + 1u) * nx) xb_add(&bar[XB_TOPGEN], 1u);
            else XB_SPIN(xb_ld(&bar[XB_TOPGEN]) == tg, bar);
            __builtin_amdgcn_fence(__ATOMIC_ACQUIRE, "agent");
            xb_add(&bar[XB_XGEN(b.x)], 1u);
            asm volatile("s_waitcnt vmcnt(0)" ::: "memory");
        } else {
            XB_SPIN(xb_ld(&bar[XB_XGEN(b.x)]) == gen, bar);
            __builtin_amdgcn_fence(__ATOMIC_ACQUIRE, "agent");
            asm volatile("s_waitcnt vmcnt(0)" ::: "memory");
        }
    }
    __syncthreads();
}

constexpr size_t MiB = 1u << 20;
constexpr size_t WS_CTL = 0, CTL_ZERO_BYTES = 1 * MiB;
constexpr size_t WS_WL0 = 2 * MiB, WS_WLSTRIDE = 272 * MiB;
constexpr size_t WO_WIN = 0, WO_WBR = 48 * MiB, WO_WOUT = 56 * MiB, WO_WXQ = 64 * MiB, WO_WXK = 66 * MiB, WO_WXV = 68 * MiB, WO_WXO = 70 * MiB, WO_WUQ = 72 * MiB, WO_WUKV = 73 * MiB,
                 WO_W1C = 74 * MiB, WO_W2C = 75 * MiB, WO_BIASP = 76 * MiB, WO_B1C = 77 * MiB, WO_WRT = 78 * MiB, WO_WEIN = 80 * MiB, WO_WEOUT = 208 * MiB;
constexpr size_t WS_XLO = 546 * MiB, WS_XB = 674 * MiB, WS_GATE = 738 * MiB, WS_U2 = 994 * MiB, WS_ABR = 1114 * MiB, WS_MERGED = 1178 * MiB, WS_QH = 1242 * MiB, WS_KVH = 1266 * MiB,
                 WS_QM = 1298 * MiB, WS_KM = 1322 * MiB, WS_VTM = 1346 * MiB, WS_VTSEL = 1362 * MiB, WS_VTWIN = 1366 * MiB, WS_KC = 1370 * MiB, WS_VCT = 1371 * MiB, WS_HID = 1372 * MiB,
                 WS_OCMP = 1373 * MiB, WS_OWIN = 1389 * MiB, WS_SCORES = 1405 * MiB, WS_IDX = 1437 * MiB, WS_NV = 1439 * MiB, WS_RSTD = 1440 * MiB, WS_ROPE = 1441 * MiB, WS_QX = 1443 * MiB,
                 WS_OX = 1459 * MiB, WS_KX = 1475 * MiB, WS_VXT = 1476 * MiB, WS_MEMB = 1477 * MiB, WS_CSTAT = 1478 * MiB, WS_MOE = 1479 * MiB, WS_Y = 1481 * MiB, WS_END = 1609 * MiB;
constexpr size_t WS_XS = WS_GATE, WS_Y2 = WS_GATE + 160 * MiB, WS_HS = WS_GATE + 320 * MiB;
static_assert(WS_HS + 40 * MiB <= WS_ABR, "MoE overlay");
constexpr int CW_CNT = 1024;
constexpr int CW_BAR = 4096;
constexpr size_t MO_TOKE = 0, MO_TOKW = 128 * 1024, MO_TOKP = 256 * 1024, MO_ROWW = 384 * 1024, MO_TILEE = 640 * 1024, MO_NT = 644 * 1024, MO_ROWTOK = 768 * 1024;

constexpr int RING_BYTES = 131072;
constexpr int LDS_BYTES = 147456;
constexpr int MISC_OFF = LDS_BYTES - 512;

constexpr int NWAVES = 8;
struct Args { const void* in[39]; float* out; unsigned char* ws; int ph_lo, ph_hi, li, pad; };
static_assert(sizeof(Args) == 39 * 8 + 8 + 8 + 16, "Args has no padding");

struct Frame {
    LAS unsigned char* lds;
    int tid, lane, wave, G, gw, NGW;
    unsigned char* ws;
};

__device__ __forceinline__ int in_col(int n) {
    if (n < 8192) return 3640 + n;
    if (n < 8704) return n - 8192;
    if (n < 9472) return 512 + (n - 8704);
    if (n < 9984) return 1304 + (n - 9472);
    if (n < 10496) return 1816 + (n - 9984);
    if (n < 10752) return 2328 + (n - 10496);
    if (n < 11776) return 2616 + (n - 10752);
    const int c = n - 11776; if (c < 24) return 1280 + c; if (c >= 32 && c < 64) return 2584 + (c - 32); return -1;
}
struct Job { const float* W; const float* ks; bf16* WT; int ldw, ldt, kdst0, mode, nkb, nnb, nbatch; size_t sstride, dstride; };
__device__ __forceinline__ void transpose_load(const Job& J, int item, f32x4 (&v)[16], int lane) {
    const int per = J.nkb * J.nnb, e = item / per, r = item % per, kb = r / J.nnb, nb = r % J.nnb, k0 = kb * 64, n0 = nb * 64;
    const float* W = J.W + (size_t)e * J.sstride;
    const int nq = 4 * (lane & 15), nd = n0 + nq;
    int sc;
    if (J.mode == 1) sc = in_col(nd);
    else if (J.mode == 2) { const int T = nd >> 8, w = nd & 255; sc = (w < 128) ? (T * 128 + w) : (512 + T * 128 + (w - 128)); }
    else sc = nd;
#pragma unroll
    for (int i = 0; i < 16; ++i) { const int kk = (lane >> 4) + 4 * i; v[i] = (f32x4){0.f, 0.f, 0.f, 0.f};
        if (sc >= 0) v[i] = *(const f32x4*)(W + (size_t)(k0 + kk) * J.ldw + sc); }
}
__device__ __forceinline__ void transpose_store(const Job& J, int item, f32x4 (&v)[16], LAS float* scr, int lane) {
    const int per = J.nkb * J.nnb, e = item / per, r = item % per, kb = r / J.nnb, nb = r % J.nnb, k0 = kb * 64, n0 = nb * 64;
    bf16* WT = J.WT + (size_t)e * J.dstride;
    const int nq = 4 * (lane & 15);
#pragma unroll
    for (int i = 0; i < 16; ++i) { const int kk = (lane >> 4) + 4 * i;
        if (J.ks) v[i] = v[i] * J.ks[k0 + kk];
        LAS float* d = scr + kk * 65 + nq; d[0] = v[i][0]; d[1] = v[i][1]; d[2] = v[i][2]; d[3] = v[i][3]; }
    LDS_WAIT(); asm volatile("" ::: "memory");
    const int c = lane & 7;
#pragma unroll
    for (int j = 0; j < 8; ++j) { const int n = (lane >> 3) + 8 * j; const LAS float* s = scr + (8 * c) * 65 + n;
        u32x4 o; o.x = cvt_pk_bf16(s[0 * 65], s[1 * 65]); o.y = cvt_pk_bf16(s[2 * 65], s[3 * 65]); o.z = cvt_pk_bf16(s[4 * 65], s[5 * 65]); o.w = cvt_pk_bf16(s[6 * 65], s[7 * 65]);
        *(u32x4*)(WT + (size_t)(n0 + n) * J.ldt + J.kdst0 + k0 + 8 * c) = o; }
    LDS_WAIT(); asm volatile("" ::: "memory");
}
constexpr int NJOBS = 15;
__device__ __forceinline__ Job get_job(const Args& a, int l, int j) {
    unsigned char* wl = a.ws + WS_WL0 + (size_t)l * WS_WLSTRIDE;
    Job J; J.ks = nullptr; J.kdst0 = 0; J.mode = 0; J.nbatch = 1; J.sstride = 0; J.dstride = 0;
#define SRC(i, per) ((const float*)a.in[i] + (size_t)l * (per))
    switch (j) {
    case 0:  J.W = SRC(3, (size_t)D * IN_W); J.ldw = IN_W; J.WT = (bf16*)(wl + WO_WIN); J.ldt = D; J.mode = 1; J.nkb = 32; J.nnb = NIN / 64; break;
    case 1:  J.W = SRC(8, 512 * D);  J.ldw = D; J.WT = (bf16*)(wl + WO_WBR); J.ldt = D; J.kdst0 = 0;    J.nkb = 8; J.nnb = 32; break;
    case 2:  J.W = SRC(16, 512 * D); J.ldw = D; J.WT = (bf16*)(wl + WO_WBR); J.ldt = D; J.kdst0 = 1024; J.nkb = 8; J.nnb = 32; break;
    case 3:  J.W = SRC(21, 512 * D); J.ldw = D; J.WT = (bf16*)(wl + WO_WBR); J.ldt = D; J.kdst0 = 1536; J.nkb = 8; J.nnb = 32; break;
    case 4:  J.W = SRC(22, (size_t)D * D); J.ldw = D; J.WT = (bf16*)(wl + WO_WOUT); J.ldt = D; J.nkb = 32; J.nnb = 32; break;
    case 5:  J.W = SRC(13, 512 * 768); J.ldw = 768; J.ks = SRC(12, 512); J.WT = (bf16*)(wl + WO_WUQ); J.ldt = 512; J.nkb = 8; J.nnb = 12; break;
    case 6:  J.W = SRC(15, 256 * 1024); J.ldw = 1024; J.ks = SRC(14, 256); J.WT = (bf16*)(wl + WO_WUKV); J.ldt = 256; J.nkb = 4; J.nnb = 16; break;
    case 7:  J.W = SRC(25, D * 512); J.ldw = 512; J.WT = (bf16*)(wl + WO_WXQ); J.ldt = D; J.nkb = 32; J.nnb = 8; break;
    case 8:  J.W = SRC(26, D * 512); J.ldw = 512; J.WT = (bf16*)(wl + WO_WXK); J.ldt = D; J.nkb = 32; J.nnb = 8; break;
    case 9:  J.W = SRC(27, D * 512); J.ldw = 512; J.WT = (bf16*)(wl + WO_WXV); J.ldt = D; J.nkb = 32; J.nnb = 8; break;
    case 10: J.W = SRC(28, 512 * D); J.ldw = D; J.WT = (bf16*)(wl + WO_WXO); J.ldt = 512; J.nkb = 8; J.nnb = 32; break;
    case 11: J.W = SRC(35, (size_t)32 * D * 1024); J.ldw = 1024; J.WT = (bf16*)(wl + WO_WEIN); J.ldt = D; J.mode = 2; J.nkb = 32; J.nnb = 16; J.nbatch = 32; J.sstride = (size_t)D * 1024; J.dstride = (size_t)1024 * D; break;
    case 12: J.W = SRC(36, (size_t)32 * 512 * D); J.ldw = D; J.WT = (bf16*)(wl + WO_WEOUT); J.ldt = 512; J.nkb = 8; J.nnb = 32; J.nbatch = 32; J.sstride = (size_t)512 * D; J.dstride = (size_t)D * 512; break;
    case 13: J.W = SRC(6, 2 * 2048 * 128); J.ldw = 128; J.WT = (bf16*)(wl + WO_W1C); J.ldt = 2048; J.nkb = 32; J.nnb = 2; J.nbatch = 2; J.sstride = 2048 * 128; J.dstride = 128 * 2048; break;
    default: J.W = SRC(7, 2 * 128 * 64); J.ldw = 64; J.WT = (bf16*)(wl + WO_W2C); J.ldt = 128; J.nkb = 2; J.nnb = 1; J.nbatch = 2; J.sstride = 128 * 64; J.dstride = 64 * 128; break;
    }
#undef SRC
    return J;
}

struct Row { f32x4 v[8]; };
__device__ __forceinline__ void row_load(Row& r, const float* p, int lane) {
    asm volatile("" : "+v"(lane));
#pragma unroll
    for (int j = 0; j < 8; ++j) r.v[j] = *(const f32x4*)(p + 4 * lane + 256 * j);
}
__device__ __forceinline__ void row_store_f32(const Row& r, float* p, int lane) {
    asm volatile("" : "+v"(lane));
#pragma unroll
    for (int j = 0; j < 8; ++j) *(f32x4*)(p + 4 * lane + 256 * j) = r.v[j];
}
__device__ __forceinline__ void row_store_bf16(const Row& r, bf16* p, int lane) {
    asm volatile("" : "+v"(lane));
#pragma unroll
    for (int j = 0; j < 8; ++j) { u32x2 w; w.x = cvt_pk_bf16(r.v[j][0], r.v[j][1]); w.y = cvt_pk_bf16(r.v[j][2], r.v[j][3]); *(u32x2*)(p + 4 * lane + 256 * j) = w; }
}
__device__ __forceinline__ void row_load_bf16(Row& r, const bf16* p, int lane) {
    asm volatile("" : "+v"(lane));
#pragma unroll
    for (int j = 0; j < 8; ++j) { const u32x2 w = *(const u32x2*)(p + 4 * lane + 256 * j); r.v[j][0] = bflo(w.x); r.v[j][1] = bfhi(w.x); r.v[j][2] = bflo(w.y); r.v[j][3] = bfhi(w.y); }
}
struct RowRaw { u32x2 w[8]; };
__device__ __forceinline__ void row_fetch(RowRaw& q, const bf16* p, int lane) {
    asm volatile("" : "+v"(lane));
#pragma unroll
    for (int j = 0; j < 8; ++j) q.w[j] = *(const u32x2*)(p + 4 * lane + 256 * j);
}
__device__ __forceinline__ void row_unpack(Row& r, const RowRaw& q) {
#pragma unroll
    for (int j = 0; j < 8; ++j) { r.v[j][0] = bflo(q.w[j].x); r.v[j][1] = bfhi(q.w[j].x); r.v[j][2] = bflo(q.w[j].y); r.v[j][3] = bfhi(q.w[j].y); }
}
__device__ __forceinline__ void row_unpack_add(Row& r, const RowRaw& q) {
#pragma unroll
    for (int j = 0; j < 8; ++j) { r.v[j][0] += bflo(q.w[j].x); r.v[j][1] += bfhi(q.w[j].x); r.v[j][2] += bflo(q.w[j].y); r.v[j][3] += bfhi(q.w[j].y); }
}
__device__ __forceinline__ void row_store_hilo(const Row& r, bf16* ph, bf16* pl, int lane) {
    asm volatile("" : "+v"(lane));
#pragma unroll
    for (int j = 0; j < 8; ++j) { u32x2 h, l; h.x = cvt_pk_bf16(r.v[j][0], r.v[j][1]); h.y = cvt_pk_bf16(r.v[j][2], r.v[j][3]);
        l.x = cvt_pk_bf16(r.v[j][0] - bflo(h.x), r.v[j][1] - bfhi(h.x)); l.y = cvt_pk_bf16(r.v[j][2] - bflo(h.y), r.v[j][3] - bfhi(h.y));
        *(u32x2*)(ph + 4 * lane + 256 * j) = h; *(u32x2*)(pl + 4 * lane + 256 * j) = l; }
}
__device__ __forceinline__ void row_add_bf16(Row& r, const bf16* p, int lane) {
    asm volatile("" : "+v"(lane));
#pragma unroll
    for (int j = 0; j < 8; ++j) { const u32x2 w = *(const u32x2*)(p + 4 * lane + 256 * j); r.v[j][0] += bflo(w.x); r.v[j][1] += bfhi(w.x); r.v[j][2] += bflo(w.y); r.v[j][3] += bfhi(w.y); }
}
__device__ __forceinline__ void row_layernorm(Row& r, const float* g, const float* b, int lane) {
    asm volatile("" : "+v"(lane));
    float s = 0.f;
#pragma unroll
    for (int j = 0; j < 8; ++j) s += (r.v[j][0] + r.v[j][1]) + (r.v[j][2] + r.v[j][3]);
    const float mean = wave_sum(s) * (1.0f / D); float q = 0.f;
#pragma unroll
    for (int j = 0; j < 8; ++j) { r.v[j] = r.v[j] - mean; q += (r.v[j][0] * r.v[j][0] + r.v[j][1] * r.v[j][1]) + (r.v[j][2] * r.v[j][2] + r.v[j][3] * r.v[j][3]); }
    const float rstd = 1.0f / sqrtf(wave_sum(q) * (1.0f / D) + 1e-5f);
#pragma unroll
    for (int j = 0; j < 8; ++j) { const f32x4 gg = *(const f32x4*)(g + 4 * lane + 256 * j), bb = *(const f32x4*)(b + 4 * lane + 256 * j); r.v[j] = r.v[j] * rstd * gg + bb; }
}

__device__ __forceinline__ void row_layernorm2(Row& r0, Row& r1, const float* g, const float* b, int lane) {
    asm volatile("" : "+v"(lane));
    float s0 = 0.f, s1 = 0.f;
#pragma unroll
    for (int j = 0; j < 8; ++j) { s0 += (r0.v[j][0] + r0.v[j][1]) + (r0.v[j][2] + r0.v[j][3]); s1 += (r1.v[j][0] + r1.v[j][1]) + (r1.v[j][2] + r1.v[j][3]); }
#pragma unroll
    for (int o = 1; o < 64; o <<= 1) { s0 += __shfl_xor(s0, o); s1 += __shfl_xor(s1, o); }
    const float m0 = s0 * (1.0f / D), m1 = s1 * (1.0f / D); float q0 = 0.f, q1 = 0.f;
#pragma unroll
    for (int j = 0; j < 8; ++j) { r0.v[j] = r0.v[j] - m0; r1.v[j] = r1.v[j] - m1;
        q0 += (r0.v[j][0] * r0.v[j][0] + r0.v[j][1] * r0.v[j][1]) + (r0.v[j][2] * r0.v[j][2] + r0.v[j][3] * r0.v[j][3]);
        q1 += (r1.v[j][0] * r1.v[j][0] + r1.v[j][1] * r1.v[j][1]) + (r1.v[j][2] * r1.v[j][2] + r1.v[j][3] * r1.v[j][3]); }
#pragma unroll
    for (int o = 1; o < 64; o <<= 1) { q0 += __shfl_xor(q0, o); q1 += __shfl_xor(q1, o); }
    const float d0 = 1.0f / sqrtf(q0 * (1.0f / D) + 1e-5f), d1 = 1.0f / sqrtf(q1 * (1.0f / D) + 1e-5f);
#pragma unroll
    for (int j = 0; j < 8; ++j) { const f32x4 gg = *(const f32x4*)(g + 4 * lane + 256 * j), bb = *(const f32x4*)(b + 4 * lane + 256 * j); r0.v[j] = r0.v[j] * d0 * gg + bb; r1.v[j] = r1.v[j] * d1 * gg + bb; }
}
template <class AP, class BP>
__device__ __forceinline__ f32x4 sgemm16(const AP& ap, const BP& bp, int K, int lane) {
    const int r = lane & 15, G = lane >> 4; f32x4 acc = (f32x4){0.f, 0.f, 0.f, 0.f};
#pragma unroll 8
    for (int k0 = 0; k0 < K; k0 += 32) { const bf16x8 a = *(const bf16x8*)ap(r, k0 + 8 * G), b = *(const bf16x8*)bp(r, k0 + 8 * G);
        acc = __builtin_amdgcn_mfma_f32_16x16x32_bf16(a, b, acc, 0, 0, 0); }
    return acc;
}
__device__ __forceinline__ void transpose_tile64(const bf16* src, size_t sp, bf16* dst, size_t dp, LAS bf16* scr, int lane) {
    const int r8 = lane >> 3, pc = lane & 7;
#pragma unroll
    for (int c = 0; c < 8; ++c) { const int row = 8 * c + r8; const u32x4 v = *(const u32x4*)(src + (size_t)row * sp + 8 * pc); LAS unsigned* d = (LAS unsigned*)(scr + row * 66 + 8 * pc); d[0] = v.x; d[1] = v.y; d[2] = v.z; d[3] = v.w; }
    LDS_WAIT(); asm volatile("" ::: "memory");
#pragma unroll
    for (int c = 0; c < 8; ++c) { const int drow = 8 * c + r8; unsigned w[4];
#pragma unroll
        for (int q = 0; q < 4; ++q) { const unsigned lo = scr[(8 * pc + 2 * q) * 66 + drow], hi = scr[(8 * pc + 2 * q + 1) * 66 + drow]; w[q] = lo | (hi << 16); }
        *(u32x4*)(dst + (size_t)drow * dp + 8 * pc) = (u32x4){w[0], w[1], w[2], w[3]}; }
    LDS_WAIT(); asm volatile("" ::: "memory");
}
__device__ __forceinline__ float gelu_tanh(float x) { const float u = 0.7978845608028654f * (x + 0.044715f * x * x * x); return 0.5f * x * (1.0f + tanhf(u)); }

__device__ __forceinline__ void phase_prologue(const Args& a, Frame& F) {
    LAS float* scr = (LAS float*)(F.lds + F.wave * 16640);
    const int gw = F.gw, NGW = F.NGW, lane = F.lane;
    { int off = 0;
      for (int l = 0; l < DEPTH; ++l)
        for (int j = 0; j < NJOBS; ++j) { const Job J = get_job(a, l, j); const int n = J.nbatch * J.nkb * J.nnb;
            int st = (gw - off) % NGW; if (st < 0) st += NGW;
            f32x4 va[16], vb[16];
            if (st < n) transpose_load(J, st, va, lane);
#pragma unroll 1
            for (int it = st; it < n; it += 2 * NGW) {
                if (it + NGW < n) transpose_load(J, it + NGW, vb, lane);
                transpose_store(J, it, va, scr, lane);
                if (it + NGW < n) { if (it + 2 * NGW < n) transpose_load(J, it + 2 * NGW, va, lane); transpose_store(J, it + NGW, vb, scr, lane); } }
            off = (off + n) % NGW; } }
#pragma unroll 1
    for (int i = gw * 64 + lane; i < DEPTH * NIN; i += NGW * 64) { const int l = i / NIN, n = i % NIN; const int sc = in_col(n);
        ((float*)(a.ws + WS_WL0 + (size_t)l * WS_WLSTRIDE + WO_BIASP))[n] = sc >= 0 ? ((const float*)a.in[4])[(size_t)l * IN_W + sc] : 0.f; }
#pragma unroll 1
    for (int it = gw; it < DEPTH * 4 * 16 * 32; it += NGW) { const int nb = it & 31, cb = (it >> 5) & 15, g = (it >> 9) & 3, l = it >> 11; const int n = nb * 64 + lane;
        const float* wp = (const float*)a.in[9] + ((size_t)(l * 4 + g) * 128 + 8 * cb) * 128; const float* ps = (const float*)a.in[10] + l * 512 + 128 * g;
        const float* wo = (const float*)a.in[11] + ((size_t)l * 512 + 128 * g) * D + n;
        float acc[8];
#pragma unroll
        for (int i = 0; i < 8; ++i) acc[i] = 0.f;
        for (int d = 0; d < 128; ++d) { const float b = wo[(size_t)d * D] * ps[d];
#pragma unroll
            for (int i = 0; i < 8; ++i) acc[i] += wp[i * 128 + d] * b; }
        bf16* dst = (bf16*)(a.ws + WS_WL0 + (size_t)l * WS_WLSTRIDE + WO_WBR) + (size_t)n * D + 512 + 128 * g + 8 * cb;
        *(u32x4*)dst = (u32x4){cvt_pk_bf16(acc[0], acc[1]), cvt_pk_bf16(acc[2], acc[3]), cvt_pk_bf16(acc[4], acc[5]), cvt_pk_bf16(acc[6], acc[7])}; }
#pragma unroll 1
    for (int it = gw; it < DEPTH * 2; it += NGW) { const float* pos = (const float*)a.in[5] + (size_t)it * 2048; const float* w1 = (const float*)a.in[6] + (size_t)it * 2048 * 128;
        float a0 = 0.f, a1 = 0.f;
        for (int k = 0; k < 2048; ++k) { const float p = pos[k]; a0 += p * w1[(size_t)k * 128 + lane]; a1 += p * w1[(size_t)k * 128 + 64 + lane]; }
        float* dst = (float*)(a.ws + WS_WL0 + (size_t)(it >> 1) * WS_WLSTRIDE + WO_B1C) + (it & 1) * 128; dst[lane] = a0; dst[64 + lane] = a1; }
#pragma unroll 1
    for (int i = gw * 64 + lane; i < S * 16; i += NGW * 64) { const int t = i >> 4, k = i & 15; const float inv = powf(10000.0f, -(float)k / 16.0f); const float ang = (float)((const int*)a.in[2])[t] * inv;
        float sn, cs; sincosf(ang, &sn, &cs); ((f32x2*)(a.ws + WS_ROPE))[i] = (f32x2){cs, sn}; }
#pragma unroll 1
    for (int i = gw * 64 + lane; i < DEPTH * 48 * 2048; i += NGW * 64) { const int l = i / (48 * 2048), n = (i / 2048) % 48, k = i % 2048;
        float w = 0.f; if (n < 4) w = ((const float*)a.in[31])[((size_t)l * D + k) * 4 + n]; else if (n < 36) w = ((const float*)a.in[33])[((size_t)l * D + k) * 32 + (n - 4)];
        const unsigned short h = f2bf(w); const unsigned short lo = f2bf(w - bf2f(h));
        bf16* dst = (bf16*)(a.ws + WS_WL0 + (size_t)l * WS_WLSTRIDE + WO_WRT); dst[(size_t)n * 2048 + k] = h; dst[(size_t)(48 + n) * 2048 + k] = lo; }
#pragma unroll 1
    for (int r = gw; r < S + 256; r += NGW) { Row rw;
        if (r < S) { row_load(rw, (const float*)a.in[0] + (size_t)r * D, lane); row_store_bf16(rw, (bf16*)(a.ws + WS_XB) + (size_t)r * D, lane); }
        else { row_load(rw, (const float*)a.in[1] + (size_t)(r - S) * D, lane); row_store_bf16(rw, (bf16*)(a.ws + WS_MEMB) + (size_t)(r - S) * D, lane); } }
}

__device__ __forceinline__ int crow(int r, int hi) { return (r & 3) + 8 * (r >> 2) + 4 * hi; }
template <int DK, int DV, class V>
__device__ __forceinline__ void attn32(const V& v, int lane, float& m_fin, float& l_fin) {
    const int col = lane & 31, hi = lane >> 5;
    constexpr int NKS = DK / 16, NVB = DV / 32;
    bf16x8 qf[NKS];
    { const bf16* qp = v.qptr(col);
#pragma unroll
      for (int s = 0; s < NKS; ++s) qf[s] = *(const bf16x8*)(qp + 16 * s + 8 * hi); }
    f32x16 o[NVB];
#pragma unroll
    for (int b = 0; b < NVB; ++b)
#pragma unroll
        for (int r = 0; r < 16; ++r) o[b][r] = 0.f;
    float m_run = -INFINITY, l_run = 0.f;
    for (int T = v.tb; T < v.te; ++T) {
        const int key0 = 32 * T;
        const bf16* kp = v.kptr(key0 + col);
        f32x16 sacc;
#pragma unroll
        for (int r = 0; r < 16; ++r) sacc[r] = 0.f;
#pragma unroll
        for (int s = 0; s < NKS; ++s) { const bf16x8 kf = *(const bf16x8*)(kp + 16 * s + 8 * hi); sacc = __builtin_amdgcn_mfma_f32_32x32x16_bf16(kf, qf[s], sacc, 0, 0, 0); }
        float x[16]; float mt = -INFINITY;
#pragma unroll
        for (int r = 0; r < 16; ++r) { const int key = key0 + crow(r, hi); x[r] = v.valid(key, col) ? sacc[r] * v.scale2 : -INFINITY; mt = fmaxf(mt, x[r]); }
        mt = fmaxf(mt, __shfl_xor(mt, 32));
        const float m_new = fmaxf(m_run, mt);
        const float mref = (m_new == -INFINITY) ? 0.f : m_new;
        const float corr = __builtin_amdgcn_exp2f(m_run - mref);
        float ps = 0.f;
#pragma unroll
        for (int r = 0; r < 16; ++r) { x[r] = __builtin_amdgcn_exp2f(x[r] - mref); ps += x[r]; }
        l_run = l_run * corr + ps; m_run = m_new;
#pragma unroll
        for (int b = 0; b < NVB; ++b)
#pragma unroll
            for (int r = 0; r < 16; ++r) o[b][r] *= corr;
        bf16x8 pf[2];
#pragma unroll
        for (int s2 = 0; s2 < 2; ++s2) { const u32x4 w = (u32x4){cvt_pk_bf16(x[8 * s2 + 0], x[8 * s2 + 1]), cvt_pk_bf16(x[8 * s2 + 2], x[8 * s2 + 3]), cvt_pk_bf16(x[8 * s2 + 4], x[8 * s2 + 5]), cvt_pk_bf16(x[8 * s2 + 6], x[8 * s2 + 7])};
            pf[s2] = __builtin_bit_cast(bf16x8, w); }
#pragma unroll
        for (int b = 0; b < NVB; ++b) { const bf16* vp = v.vtptr(32 * b + col) + key0 + 4 * hi;
#pragma unroll
            for (int s2 = 0; s2 < 2; ++s2) { const u32x2 lo = *(const u32x2*)(vp + 16 * s2), hh = *(const u32x2*)(vp + 16 * s2 + 8);
                const bf16x8 vf = __builtin_bit_cast(bf16x8, (u32x4){lo.x, lo.y, hh.x, hh.y});
                o[b] = __builtin_amdgcn_mfma_f32_32x32x16_bf16(vf, pf[s2], o[b], 0, 0, 0); } }
    }
    const float l = l_run + __shfl_xor(l_run, 32);
    const float inv = l > 0.f ? 1.0f / l : 0.f;
#pragma unroll
    for (int b = 0; b < NVB; ++b)
#pragma unroll
        for (int i = 0; i < 4; ++i) v.store(col, 32 * b + 8 * i + 4 * hi, (f32x4){o[b][4 * i] * inv, o[b][4 * i + 1] * inv, o[b][4 * i + 2] * inv, o[b][4 * i + 3] * inv});
    m_fin = m_run; l_fin = l;
}
__device__ __forceinline__ void store4_bf16(bf16* p, const f32x4 v) { *(u32x2*)p = (u32x2){cvt_pk_bf16(v[0], v[1]), cvt_pk_bf16(v[2], v[3])}; }

struct VarMLA {
    const bf16* Q; const bf16* K; const bf16* Vt; bf16* O; int t0, hd, tb, te; float scale2;
    __device__ __forceinline__ const bf16* qptr(int col) const { return Q + (size_t)(t0 + col) * 768 + hd * 96; }
    __device__ __forceinline__ const bf16* kptr(int key) const { return K + (size_t)key * 768 + hd * 96; }
    __device__ __forceinline__ const bf16* vtptr(int dv) const { return Vt + (size_t)(hd * 64 + dv) * S; }
    __device__ __forceinline__ bool valid(int key, int col) const { return key <= t0 + col; }
    __device__ __forceinline__ void store(int col, int dv, const f32x4 x) const { store4_bf16(O + (size_t)(t0 + col) * D + 1024 + hd * 64 + dv, x); }
};
struct VarWin {
    const bf16* U2; const bf16* Vt; bf16* O; int t0, g, tb, te; float scale2;
    __device__ __forceinline__ const bf16* qptr(int col) const { return U2 + (size_t)(t0 + (col >> 2)) * U2W + U2_Q + (4 * g + (col & 3)) * 64; }
    __device__ __forceinline__ const bf16* kptr(int key) const { return U2 + (size_t)key * U2W + U2_KV + (4 * 2 + g) * 64; }
    __device__ __forceinline__ const bf16* vtptr(int dv) const { return Vt + (size_t)(g * 64 + dv) * S; }
    __device__ __forceinline__ bool valid(int key, int col) const { const int tok = t0 + (col >> 2); return key <= tok && key > tok - 512; }
    __device__ __forceinline__ void store(int col, int dv, const f32x4 x) const { store4_bf16(O + (size_t)(t0 + (col >> 2)) * 512 + (4 * g + (col & 3)) * 64 + dv, x); }
};
struct VarCmp {
    const bf16* U2; const bf16* KC; const bf16* Vt; bf16* O; int t0, g, tb, te; float scale2;
    __device__ __forceinline__ const bf16* qptr(int col) const { return U2 + (size_t)(t0 + (col >> 2)) * U2W + U2_Q + (4 * g + (col & 3)) * 64; }
    __device__ __forceinline__ const bf16* kptr(int c) const { return KC + (size_t)(g * 1024 + c) * 64; }
    __device__ __forceinline__ const bf16* vtptr(int dv) const { return Vt + (size_t)(g * 64 + dv) * 1024; }
    __device__ __forceinline__ bool valid(int c, int col) const { return 16 * c + 31 <= t0 + (col >> 2); }
    __device__ __forceinline__ void store(int col, int dv, const f32x4 x) const { store4_bf16(O + (size_t)(t0 + (col >> 2)) * 512 + (4 * g + (col & 3)) * 64 + dv, x); }
};
struct VarX {
    const bf16* Q; const bf16* K; const bf16* Vt; bf16* O; int t0, hd, tb, te; float scale2;
    __device__ __forceinline__ const bf16* qptr(int col) const { return Q + (size_t)(t0 + col) * 512 + hd * 128; }
    __device__ __forceinline__ const bf16* kptr(int key) const { return K + (size_t)key * 512 + hd * 128; }
    __device__ __forceinline__ const bf16* vtptr(int dv) const { return Vt + (size_t)(hd * 128 + dv) * 256; }
    __device__ __forceinline__ bool valid(int, int) const { return true; }
    __device__ __forceinline__ void store(int col, int dv, const f32x4 x) const { store4_bf16(O + (size_t)(t0 + col) * 512 + hd * 128 + dv, x); }
};
__device__ __forceinline__ void cmp_scores(const VarCmp& v, int lane, float m_fin, float l_fin, float* sc) {
    const int col = lane & 31, hi = lane >> 5;
    bf16x8 qf[4];
    { const bf16* qp = v.qptr(col);
#pragma unroll
      for (int s = 0; s < 4; ++s) qf[s] = *(const bf16x8*)(qp + 16 * s + 8 * hi); }
    const float mref = (m_fin == -INFINITY) ? 0.f : m_fin; const float inv = l_fin > 0.f ? 1.0f / l_fin : 0.f;
    float* dst = sc + (size_t)((v.t0 + (col >> 2)) * 2 + v.g) * 256;
    float carry = 0.f;
    for (int T = 0; T < 32; ++T) {
        float sv[4];
        if (T < v.te) {
            const int key0 = 32 * T; const bf16* kp = v.kptr(key0 + col);
            f32x16 sacc;
#pragma unroll
            for (int r = 0; r < 16; ++r) sacc[r] = 0.f;
#pragma unroll
            for (int s = 0; s < 4; ++s) { const bf16x8 kf = *(const bf16x8*)(kp + 16 * s + 8 * hi); sacc = __builtin_amdgcn_mfma_f32_32x32x16_bf16(kf, qf[s], sacc, 0, 0, 0); }
            float Gs[4], Es[4];
#pragma unroll
            for (int i = 0; i < 4; ++i) { float p[4];
#pragma unroll
                for (int q = 0; q < 4; ++q) { const int r = 4 * i + q; const int key = key0 + crow(r, hi); p[q] = v.valid(key, col) ? __builtin_amdgcn_exp2f(sacc[r] * v.scale2 - mref) * inv : 0.f; }
                Gs[i] = (p[0] + p[1]) + (p[2] + p[3]); Es[i] = p[3]; }
#pragma unroll
            for (int i = 0; i < 4; ++i) { Gs[i] += __shfl_xor(Gs[i], 1); Gs[i] += __shfl_xor(Gs[i], 2); Es[i] += __shfl_xor(Es[i], 1); Es[i] += __shfl_xor(Es[i], 2); }
            float eo[4];
#pragma unroll
            for (int i = 0; i < 4; ++i) eo[i] = __shfl_xor(Es[i], 32);
            if (hi) { sv[0] = Gs[0] + eo[0]; sv[1] = Gs[1] + eo[1]; sv[2] = Gs[2] + eo[2]; sv[3] = Gs[3] + eo[3]; }
            else { sv[0] = Gs[0] + carry; sv[1] = Gs[1] + eo[0]; sv[2] = Gs[2] + eo[1]; sv[3] = Gs[3] + eo[2]; }
            carry = eo[3];
        } else { sv[0] = hi ? 0.f : carry; sv[1] = 0.f; sv[2] = 0.f; sv[3] = 0.f; carry = 0.f; }
        if ((col & 3) == 0) {
#pragma unroll
            for (int i = 0; i < 4; ++i) dst[8 * T + 2 * i + hi] = sv[i]; }
    }
}

__device__ __forceinline__ void sel_attn_unit(const bf16* U2, const bf16* VTS, const bf16* OCMP, const bf16* OWIN, const int* idx, int nv, bf16* ABR, int t, int g, int lane) {
    const int c16 = lane & 15, G = lane >> 4;
    const float scale2 = 0.125f * LOG2E;
    bf16x8 qf[2];
    { const bf16* qp = U2 + (size_t)t * U2W + U2_Q + (4 * g + (c16 & 3)) * 64;
#pragma unroll
      for (int ks = 0; ks < 2; ++ks) { qf[ks] = *(const bf16x8*)(qp + 32 * ks + 8 * G); if (c16 >= 4) qf[ks] = (bf16x8){0, 0, 0, 0, 0, 0, 0, 0}; } }
    f32x4 o[4];
#pragma unroll
    for (int d = 0; d < 4; ++d) o[d] = (f32x4){0.f, 0.f, 0.f, 0.f};
    float m_run = -INFINITY, l_run = 0.f;
    for (int b = 0; b < nv; ++b) {
        const int blk = __builtin_amdgcn_readfirstlane(idx[b]); const int key0 = 64 * blk;
        f32x4 acc[4];
#pragma unroll
        for (int kt = 0; kt < 4; ++kt) { const bf16* kp = U2 + (size_t)(key0 + 16 * kt + c16) * U2W + U2_KV + (2 * 2 + g) * 64 + 8 * G;
            const bf16x8 k0 = *(const bf16x8*)kp, k1 = *(const bf16x8*)(kp + 32);
            acc[kt] = __builtin_amdgcn_mfma_f32_16x16x32_bf16(k0, qf[0], (f32x4){0.f, 0.f, 0.f, 0.f}, 0, 0, 0);
            acc[kt] = __builtin_amdgcn_mfma_f32_16x16x32_bf16(k1, qf[1], acc[kt], 0, 0, 0); }
        float mt = -INFINITY;
#pragma unroll
        for (int kt = 0; kt < 4; ++kt)
#pragma unroll
            for (int i = 0; i < 4; ++i) { const int key = key0 + 16 * kt + 4 * G + i; acc[kt][i] = (key <= t) ? acc[kt][i] * scale2 : -INFINITY; mt = fmaxf(mt, acc[kt][i]); }
        mt = fmaxf(mt, __shfl_xor(mt, 16)); mt = fmaxf(mt, __shfl_xor(mt, 32));
        const float m_new = fmaxf(m_run, mt); const float mref = (m_new == -INFINITY) ? 0.f : m_new;
        const float corr = __builtin_amdgcn_exp2f(m_run - mref); float ps = 0.f;
#pragma unroll
        for (int kt = 0; kt < 4; ++kt)
#pragma unroll
            for (int i = 0; i < 4; ++i) { acc[kt][i] = __builtin_amdgcn_exp2f(acc[kt][i] - mref); ps += acc[kt][i]; }
        l_run = l_run * corr + ps; m_run = m_new;
#pragma unroll
        for (int d = 0; d < 4; ++d) o[d] = o[d] * corr;
        bf16x8 pf[2];
#pragma unroll
        for (int u = 0; u < 2; ++u) pf[u] = __builtin_bit_cast(bf16x8, (u32x4){cvt_pk_bf16(acc[2 * u][0], acc[2 * u][1]), cvt_pk_bf16(acc[2 * u][2], acc[2 * u][3]), cvt_pk_bf16(acc[2 * u + 1][0], acc[2 * u + 1][1]), cvt_pk_bf16(acc[2 * u + 1][2], acc[2 * u + 1][3])});
#pragma unroll
        for (int d = 0; d < 4; ++d) { const bf16* vp = VTS + (size_t)(g * 64 + 16 * d + c16) * S + key0 + 4 * G;
#pragma unroll
            for (int u = 0; u < 2; ++u) { const u32x2 lo = *(const u32x2*)(vp + 32 * u), hh = *(const u32x2*)(vp + 32 * u + 16);
                o[d] = __builtin_amdgcn_mfma_f32_16x16x32_bf16(__builtin_bit_cast(bf16x8, (u32x4){lo.x, lo.y, hh.x, hh.y}), pf[u], o[d], 0, 0, 0); } }
    }
    float l = l_run; l += __shfl_xor(l, 16); l += __shfl_xor(l, 32);
    const float inv = l > 0.f ? 1.0f / l : 0.f;
    if (c16 < 4) { const int head = 4 * g + c16; const bf16* gp = U2 + (size_t)t * U2W + U2_G + head * 3;
        const float s0 = sigmoidf_(bf2f(gp[0])), s1 = sigmoidf_(bf2f(gp[1])) * inv, s2 = sigmoidf_(bf2f(gp[2]));
#pragma unroll
        for (int d = 0; d < 4; ++d) { const size_t off = (size_t)t * 512 + head * 64 + 16 * d + 4 * G; const u32x2 oc = *(const u32x2*)(OCMP + off), ow = *(const u32x2*)(OWIN + off);
            f32x4 r; r[0] = s0 * bflo(oc.x) + s1 * o[d][0] + s2 * bflo(ow.x); r[1] = s0 * bfhi(oc.x) + s1 * o[d][1] + s2 * bfhi(ow.x);
            r[2] = s0 * bflo(oc.y) + s1 * o[d][2] + s2 * bflo(ow.y); r[3] = s0 * bfhi(oc.y) + s1 * o[d][3] + s2 * bfhi(ow.y);
            store4_bf16(ABR + (size_t)t * D + head * 64 + 16 * d + 4 * G, r); } }
}
__device__ __forceinline__ bool selmask_test(const LAS unsigned* m8, int j) { return (m8[(j & 3) * 2 + (j >> 7)] >> ((j >> 2) & 31)) & 1u; }
__device__ __forceinline__ void topk_unit(const float* sc, int t, unsigned* mask_out, int lane) {
    const int cur = t >> 6;
    const f32x4 v = *(const f32x4*)(sc + 4 * lane);
    unsigned key[4];
#pragma unroll
    for (int q = 0; q < 4; ++q) { const int j = 4 * lane + q;
        key[q] = __float_as_uint(v[q]) + 1u;
        if (j == 0 || j == cur || j == cur - 1) key[q] = 0xffffffffu;
        if (j > cur) key[q] = 0u; }
    unsigned T = 0u;
#pragma unroll 1
    for (int bit = 31; bit >= 0; --bit) { const unsigned cand = T | (1u << bit);
        int cnt = 0;
#pragma unroll
        for (int q = 0; q < 4; ++q) cnt += __builtin_popcountll(__ballot(key[q] >= cand));
        if (cnt >= 16) T = cand; }
    unsigned long long G[4], E[4]; int cgt = 0;
#pragma unroll
    for (int q = 0; q < 4; ++q) { G[q] = __ballot(key[q] > T); E[q] = __ballot(key[q] == T && T != 0u); cgt += __builtin_popcountll(G[q]); }
    const int need = 16 - cgt;
    int below = 0;
#pragma unroll
    for (int q = 0; q < 4; ++q) below += (int)__builtin_amdgcn_mbcnt_hi((unsigned)(E[q] >> 32), __builtin_amdgcn_mbcnt_lo((unsigned)E[q], 0u));
    unsigned long long Sel[4]; int own = 0;
#pragma unroll
    for (int q = 0; q < 4; ++q) { const bool eq = (key[q] == T && T != 0u); const bool take = (key[q] > T) || (eq && (below + own) < need); own += eq ? 1 : 0; Sel[q] = __ballot(take); }
    unsigned w = 0u;
#pragma unroll
    for (int q = 0; q < 4; ++q) { if (lane == 2 * q) w = (unsigned)Sel[q]; if (lane == 2 * q + 1) w = (unsigned)(Sel[q] >> 32); }
    if (lane < 8) mask_out[lane] = w;
}

template <int NKS, int KP, int VP, int NVB, class MaskF>
__device__ __forceinline__ void att_step64n(const LAS unsigned char* kb, const LAS unsigned char* vb, const bf16x8 (&qf)[NKS], f32x16 (&o)[NVB], float& m_run, float& l_run, float scale2, bool use_mask, const MaskF& mask, int col, int hi) {
    f32x16 sacc[2];
#pragma unroll
    for (int u = 0; u < 2; ++u) {
#pragma unroll
        for (int r = 0; r < 16; ++r) sacc[u][r] = 0.f;
#pragma unroll
        for (int s = 0; s < NKS; ++s) { const bf16x8 kf = *(const LAS bf16x8*)(kb + ((32 * u + col) * KP + 16 * s + 8 * hi) * 2); sacc[u] = __builtin_amdgcn_mfma_f32_32x32x16_bf16(kf, qf[s], sacc[u], 0, 0, 0); } }
    float mt = -INFINITY;
#pragma unroll
    for (int u = 0; u < 2; ++u)
#pragma unroll
        for (int r = 0; r < 16; ++r) { float x = sacc[u][r] * scale2; if (use_mask) { if (!mask(u, r)) x = -INFINITY; } sacc[u][r] = x; mt = fmaxf(mt, x); }
    mt = fmaxf(mt, __shfl_xor(mt, 32));
    const float m_new = fmaxf(m_run, mt); const float mref = (m_new == -INFINITY) ? 0.f : m_new;
    if (__any(m_new != m_run)) {
        const float corr = __builtin_amdgcn_exp2f(m_run - mref); l_run *= corr; m_run = m_new;
#pragma unroll
        for (int b = 0; b < NVB; ++b)
#pragma unroll
            for (int r = 0; r < 16; ++r) o[b][r] *= corr; }
    float ps = 0.f;
#pragma unroll
    for (int u = 0; u < 2; ++u)
#pragma unroll
        for (int r = 0; r < 16; ++r) { sacc[u][r] = __builtin_amdgcn_exp2f(sacc[u][r] - mref); ps += sacc[u][r]; }
    l_run += ps;
#pragma unroll
    for (int u = 0; u < 2; ++u)
#pragma unroll
        for (int s2 = 0; s2 < 2; ++s2) { const bf16x8 pf = __builtin_bit_cast(bf16x8, (u32x4){cvt_pk_bf16(sacc[u][8 * s2 + 0], sacc[u][8 * s2 + 1]), cvt_pk_bf16(sacc[u][8 * s2 + 2], sacc[u][8 * s2 + 3]), cvt_pk_bf16(sacc[u][8 * s2 + 4], sacc[u][8 * s2 + 5]), cvt_pk_bf16(sacc[u][8 * s2 + 6], sacc[u][8 * s2 + 7])});
#pragma unroll
            for (int b = 0; b < NVB; ++b) { const LAS unsigned char* vp = vb + ((32 * b + col) * VP + 32 * u + 16 * s2 + 4 * hi) * 2;
                const u32x2 lo = *(const LAS u32x2*)vp, hh = *(const LAS u32x2*)(vp + 16);
                o[b] = __builtin_amdgcn_mfma_f32_32x32x16_bf16(__builtin_bit_cast(bf16x8, (u32x4){lo.x, lo.y, hh.x, hh.y}), pf, o[b], 0, 0, 0); } }
}

template <int NKS, int KP, int VP, class MaskF>
__device__ __forceinline__ void att_step64(const LAS unsigned char* kb, const LAS unsigned char* vb, const bf16x8 (&qf)[NKS], f32x16 (&o)[2], float& m_run, float& l_run, float scale2, bool use_mask, const MaskF& mask, int col, int hi) {
    att_step64n<NKS, KP, VP, 2>(kb, vb, qf, o, m_run, l_run, scale2, use_mask, mask, col, hi);
}

constexpr int SK_KP = 72, SK_VP = 132;
constexpr int SK_KB = 128 * SK_KP * 2, SK_VB = 64 * SK_VP * 2, SK_VOFF = 2 * SK_KB, SK_MOFF = SK_VOFF + 2 * SK_VB;
template <int MODE>
__device__ __forceinline__ void sel_unit(LAS unsigned char* lds, const bf16* U2, const bf16* VTS, const unsigned* SM, const bf16* OCMP, bf16* OWIN, bf16* ABR, int g, int qblk, int tid, int wave, int lane) {
    const int col = lane & 31, hi = lane >> 5;
    const int tl = 8 * wave + (col >> 2), t = 64 * qblk + tl, head = 4 * g + (col & 3);
    LAS unsigned* smask = (LAS unsigned*)(lds + SK_MOFF);
    __syncthreads();
    if (MODE == 0) smask[tid] = SM[(size_t)((64 * qblk + (tid >> 3)) * 2 + g) * 8 + (tid & 7)];
    bf16x8 qf[4];
    { const bf16* qp = U2 + (size_t)t * U2W + U2_Q + head * 64;
#pragma unroll
      for (int s = 0; s < 4; ++s) qf[s] = *(const bf16x8*)(qp + 16 * s + 8 * hi); }
    f32x16 o[2];
#pragma unroll
    for (int b = 0; b < 2; ++b)
#pragma unroll
        for (int r = 0; r < 16; ++r) o[b][r] = 0.f;
    float m_run = -INFINITY, l_run = 0.f;
    const float scale2 = 0.125f * LOG2E;
    const int jlo = (MODE == 1 && qblk > 8) ? qblk - 8 : 0;
    const int st0 = jlo >> 1, st1 = (qblk >> 1) + 1;
    const int kvsel = (MODE == 1) ? 4 : 2;
    const bf16* kg[2]; unsigned kl[2]; const bf16* vg[2]; unsigned vl[2];
#pragma unroll
    for (int i = 0; i < 2; ++i) { const int c = tid + 512 * i; { const int row = c >> 3, p = c & 7; kg[i] = U2 + (size_t)row * U2W + U2_KV + (kvsel * 2 + g) * 64 + 8 * p; kl[i] = (unsigned)(row * SK_KP + 8 * p) * 2u; }
        { const int row = c >> 4, p = c & 15; vg[i] = VTS + (size_t)(g * 64 + row) * S + 8 * p; vl[i] = (unsigned)(row * SK_VP + 8 * p) * 2u; } }
    u32x4 kr[2], vr[2];
    auto gload = [&](int step) { const int key0 = 128 * step;
#pragma unroll
        for (int i = 0; i < 2; ++i) { kr[i] = *(const u32x4*)(kg[i] + (size_t)key0 * U2W); vr[i] = *(const u32x4*)(vg[i] + key0); } };
    gload(st0);
#pragma unroll 1
    for (int st = st0; st < st1; ++st) {
        const int buf = st & 1;
        LAS unsigned char* kb = lds + buf * SK_KB; LAS unsigned char* vb = lds + SK_VOFF + buf * SK_VB;
#pragma unroll
        for (int i = 0; i < 2; ++i) { *(LAS u32x4*)(kb + kl[i]) = kr[i]; *(LAS u32x2*)(vb + vl[i]) = (u32x2){vr[i].x, vr[i].y}; *(LAS u32x2*)(vb + vl[i] + 8) = (u32x2){vr[i].z, vr[i].w}; }
        __syncthreads();
        if (st + 1 < st1) gload(st + 1);
#pragma unroll
        for (int h = 0; h < 2; ++h) { const int j = 2 * st + h;
            bool sel = (j >= jlo) && (j <= qblk);
            if (MODE == 0) sel = sel && selmask_test(smask + tl * 8, j);
            if (__any(sel)) { const int key0 = 64 * j; const bool diag = (j == qblk), first = (MODE == 1) && (j == qblk - 8);
                auto mask = [&](int u, int r) { const int key = key0 + 32 * u + crow(r, hi); return sel && (!diag || key <= t) && (!first || key > t - 512); };
                att_step64<4, SK_KP, SK_VP>(kb + h * 64 * SK_KP * 2, vb + h * 128, qf, o, m_run, l_run, scale2, MODE == 0 || diag || first, mask, col, hi); } }
    }
    const float l = l_run + __shfl_xor(l_run, 32); const float inv = l > 0.f ? 1.0f / l : 0.f;
    if (MODE == 1) {
#pragma unroll
        for (int b = 0; b < 2; ++b)
#pragma unroll
            for (int i = 0; i < 4; ++i) store4_bf16(OWIN + (size_t)t * 512 + head * 64 + 32 * b + 8 * i + 4 * hi, (f32x4){o[b][4 * i] * inv, o[b][4 * i + 1] * inv, o[b][4 * i + 2] * inv, o[b][4 * i + 3] * inv});
    } else {
        const bf16* gp = U2 + (size_t)t * U2W + U2_G + head * 3;
        const float s0 = sigmoidf_(bf2f(gp[0])), s1 = sigmoidf_(bf2f(gp[1])) * inv, s2g = sigmoidf_(bf2f(gp[2]));
#pragma unroll
        for (int b = 0; b < 2; ++b)
#pragma unroll
            for (int i = 0; i < 4; ++i) { const int dv = 32 * b + 8 * i + 4 * hi; const size_t off = (size_t)t * 512 + head * 64 + dv; const u32x2 oc = *(const u32x2*)(OCMP + off), ow = *(const u32x2*)(OWIN + off);
                f32x4 r; r[0] = s0 * bflo(oc.x) + s1 * o[b][4 * i] + s2g * bflo(ow.x); r[1] = s0 * bfhi(oc.x) + s1 * o[b][4 * i + 1] + s2g * bfhi(ow.x);
                r[2] = s0 * bflo(oc.y) + s1 * o[b][4 * i + 2] + s2g * bflo(ow.y); r[3] = s0 * bfhi(oc.y) + s1 * o[b][4 * i + 3] + s2g * bfhi(ow.y);
                store4_bf16(ABR + (size_t)t * D + head * 64 + dv, r); }
    }
}

__device__ __forceinline__ void cmp_unit(LAS unsigned char* lds, const bf16* U2, const bf16* KC, const bf16* VCT, bf16* OCMP, float* SC, int g, int qblk, int tid, int wave, int lane) {
    const int col = lane & 31, hi = lane >> 5;
    const int tl = 8 * wave + (col >> 2), t = 64 * qblk + tl, head = 4 * g + (col & 3);
    __syncthreads();
    bf16x8 qf[4];
    { const bf16* qp = U2 + (size_t)t * U2W + U2_Q + head * 64;
#pragma unroll
      for (int s = 0; s < 4; ++s) qf[s] = *(const bf16x8*)(qp + 16 * s + 8 * hi); }
    f32x16 o[2];
#pragma unroll
    for (int b = 0; b < 2; ++b)
#pragma unroll
        for (int r = 0; r < 16; ++r) o[b][r] = 0.f;
    float m_run = -INFINITY, l_run = 0.f;
    const float scale2 = 0.125f * LOG2E;
    const int nst = (4 * qblk + 3 + 127) >> 7;
    const int twmax = 64 * qblk + 8 * wave + 7; const int cw = (twmax >= 31) ? ((twmax - 31) >> 4) : -1;
    const int call = (64 * qblk >= 31) ? ((64 * qblk - 31) >> 4) : -1;
    const bf16* kg[2]; unsigned kl[2]; const bf16* vg[2]; unsigned vl[2];
#pragma unroll
    for (int i = 0; i < 2; ++i) { const int c = tid + 512 * i; { const int row = c >> 3, p = c & 7; kg[i] = KC + (size_t)(g * 1024 + row) * 64 + 8 * p; kl[i] = (unsigned)(row * SK_KP + 8 * p) * 2u; }
        { const int row = c >> 4, p = c & 15; vg[i] = VCT + (size_t)(g * 64 + row) * 1024 + 8 * p; vl[i] = (unsigned)(row * SK_VP + 8 * p) * 2u; } }
    u32x4 kr[2], vr[2];
#pragma unroll
    for (int i = 0; i < 2; ++i) { kr[i] = *(const u32x4*)kg[i]; vr[i] = *(const u32x4*)vg[i]; }
#pragma unroll 1
    for (int st = 0; st < nst; ++st) {
        const int buf = st & 1;
        LAS unsigned char* kb = lds + buf * SK_KB; LAS unsigned char* vb = lds + SK_VOFF + buf * SK_VB;
#pragma unroll
        for (int i = 0; i < 2; ++i) { *(LAS u32x4*)(kb + kl[i]) = kr[i]; *(LAS u32x2*)(vb + vl[i]) = (u32x2){vr[i].x, vr[i].y}; *(LAS u32x2*)(vb + vl[i] + 8) = (u32x2){vr[i].z, vr[i].w}; }
        __syncthreads();
        if (st + 1 < nst) {
#pragma unroll
            for (int i = 0; i < 2; ++i) { kr[i] = *(const u32x4*)(kg[i] + (size_t)128 * (st + 1) * 64); vr[i] = *(const u32x4*)(vg[i] + 128 * (st + 1)); } }
#pragma unroll
        for (int h = 0; h < 2; ++h) { const int c0 = 128 * st + 64 * h;
            if (c0 <= cw) { auto mask = [&](int u, int r) { return 16 * (c0 + 32 * u + crow(r, hi)) + 31 <= t; };
                att_step64<4, SK_KP, SK_VP>(kb + h * 64 * SK_KP * 2, vb + h * 128, qf, o, m_run, l_run, scale2, c0 + 63 > call, mask, col, hi); } }
    }
    const float l = l_run + __shfl_xor(l_run, 32); const float inv = l > 0.f ? 1.0f / l : 0.f;
#pragma unroll
    for (int b = 0; b < 2; ++b)
#pragma unroll
        for (int i = 0; i < 4; ++i) store4_bf16(OCMP + (size_t)t * 512 + head * 64 + 32 * b + 8 * i + 4 * hi, (f32x4){o[b][4 * i] * inv, o[b][4 * i + 1] * inv, o[b][4 * i + 2] * inv, o[b][4 * i + 3] * inv});
    const float mref = (m_run == -INFINITY) ? 0.f : m_run;
    float* dst = SC + (size_t)(t * 2 + g) * 256;
    float carry = 0.f;
    __syncthreads();
#pragma unroll
    for (int i = 0; i < 2; ++i) kr[i] = *(const u32x4*)kg[i];
#pragma unroll 1
    for (int st = 0; st < nst; ++st) {
        const int buf = st & 1; LAS unsigned char* kb = lds + buf * SK_KB;
#pragma unroll
        for (int i = 0; i < 2; ++i) *(LAS u32x4*)(kb + kl[i]) = kr[i];
        __syncthreads();
        if (st + 1 < nst) {
#pragma unroll
            for (int i = 0; i < 2; ++i) kr[i] = *(const u32x4*)(kg[i] + (size_t)128 * (st + 1) * 64); }
#pragma unroll
        for (int q4 = 0; q4 < 4; ++q4) { const int T = 4 * st + q4; float sv[4];
            if (32 * T <= cw) {
                const LAS unsigned char* kt = kb + q4 * 32 * SK_KP * 2;
                f32x16 sacc;
#pragma unroll
                for (int r = 0; r < 16; ++r) sacc[r] = 0.f;
#pragma unroll
                for (int s = 0; s < 4; ++s) { const bf16x8 kf = *(const LAS bf16x8*)(kt + (col * SK_KP + 16 * s + 8 * hi) * 2); sacc = __builtin_amdgcn_mfma_f32_32x32x16_bf16(kf, qf[s], sacc, 0, 0, 0); }
                float Gs[4], Es[4];
#pragma unroll
                for (int i = 0; i < 4; ++i) { float p[4];
#pragma unroll
                    for (int q = 0; q < 4; ++q) { const int r = 4 * i + q; const int c = 32 * T + crow(r, hi); p[q] = (16 * c + 31 <= t) ? __builtin_amdgcn_exp2f(sacc[r] * scale2 - mref) * inv : 0.f; }
                    Gs[i] = (p[0] + p[1]) + (p[2] + p[3]); Es[i] = p[3]; }
#pragma unroll
                for (int i = 0; i < 4; ++i) { Gs[i] += __shfl_xor(Gs[i], 1); Gs[i] += __shfl_xor(Gs[i], 2); Es[i] += __shfl_xor(Es[i], 1); Es[i] += __shfl_xor(Es[i], 2); }
                float eo[4];
#pragma unroll
                for (int i = 0; i < 4; ++i) eo[i] = __shfl_xor(Es[i], 32);
                if (hi) { sv[0] = Gs[0] + eo[0]; sv[1] = Gs[1] + eo[1]; sv[2] = Gs[2] + eo[2]; sv[3] = Gs[3] + eo[3]; }
                else { sv[0] = Gs[0] + carry; sv[1] = Gs[1] + eo[0]; sv[2] = Gs[2] + eo[1]; sv[3] = Gs[3] + eo[2]; }
                carry = eo[3];
            } else { sv[0] = hi ? 0.f : carry; sv[1] = 0.f; sv[2] = 0.f; sv[3] = 0.f; carry = 0.f; }
            if ((col & 3) == 0) {
#pragma unroll
                for (int i = 0; i < 4; ++i) dst[8 * T + 2 * i + hi] = sv[i]; } }
    }
#pragma unroll 1
    for (int T = 4 * nst; T < 32; ++T) {
        if ((col & 3) == 0) { dst[8 * T + hi] = (hi || T != 4 * nst) ? 0.f : carry; dst[8 * T + 2 + hi] = 0.f; dst[8 * T + 4 + hi] = 0.f; dst[8 * T + 6 + hi] = 0.f; } }
}

struct Sel16 { bf16x8 qf[2]; f32x4 o[4]; float m_run, l_run; };
template <int VP, class MaskF>
__device__ __forceinline__ void att16_block(const LAS unsigned char* kb, const LAS unsigned char* vb, Sel16& st, float scale2, const MaskF& mask, int c16, int G) {
    f32x4 acc[4];
#pragma unroll
    for (int kt = 0; kt < 4; ++kt) { const LAS unsigned char* kp = kb + ((16 * kt + c16) * SK_KP + 8 * G) * 2;
        const bf16x8 k0 = *(const LAS bf16x8*)kp, k1 = *(const LAS bf16x8*)(kp + 64);
        acc[kt] = __builtin_amdgcn_mfma_f32_16x16x32_bf16(k0, st.qf[0], (f32x4){0.f, 0.f, 0.f, 0.f}, 0, 0, 0);
        acc[kt] = __builtin_amdgcn_mfma_f32_16x16x32_bf16(k1, st.qf[1], acc[kt], 0, 0, 0); }
    float mt = -INFINITY;
#pragma unroll
    for (int kt = 0; kt < 4; ++kt)
#pragma unroll
        for (int i = 0; i < 4; ++i) { const float x = mask(16 * kt + 4 * G + i) ? acc[kt][i] * scale2 : -INFINITY; acc[kt][i] = x; mt = fmaxf(mt, x); }
    mt = fmaxf(mt, __shfl_xor(mt, 16)); mt = fmaxf(mt, __shfl_xor(mt, 32));
    const float m_new = fmaxf(st.m_run, mt); const float mref = (m_new == -INFINITY) ? 0.f : m_new;
    if (__any(m_new != st.m_run)) { const float corr = __builtin_amdgcn_exp2f(st.m_run - mref); st.l_run *= corr; st.m_run = m_new;
#pragma unroll
        for (int d = 0; d < 4; ++d) st.o[d] = st.o[d] * corr; }
    float ps = 0.f;
#pragma unroll
    for (int kt = 0; kt < 4; ++kt)
#pragma unroll
        for (int i = 0; i < 4; ++i) { acc[kt][i] = __builtin_amdgcn_exp2f(acc[kt][i] - mref); ps += acc[kt][i]; }
    st.l_run += ps;
#pragma unroll
    for (int u = 0; u < 2; ++u) {
        const bf16x8 pf = __builtin_bit_cast(bf16x8, (u32x4){cvt_pk_bf16(acc[2 * u][0], acc[2 * u][1]), cvt_pk_bf16(acc[2 * u][2], acc[2 * u][3]), cvt_pk_bf16(acc[2 * u + 1][0], acc[2 * u + 1][1]), cvt_pk_bf16(acc[2 * u + 1][2], acc[2 * u + 1][3])});
#pragma unroll
        for (int d = 0; d < 4; ++d) { const LAS unsigned char* vp = vb + ((16 * d + c16) * VP + 32 * u + 4 * G) * 2;
            const u32x2 lo = *(const LAS u32x2*)vp, hh = *(const LAS u32x2*)(vp + 32);
            st.o[d] = __builtin_amdgcn_mfma_f32_16x16x32_bf16(__builtin_bit_cast(bf16x8, (u32x4){lo.x, lo.y, hh.x, hh.y}), pf, st.o[d], 0, 0, 0); } }
}
constexpr int S16_NB = 4;
constexpr int S16_VP = S16_NB * 64 + 4;
constexpr int S16_KB = S16_NB * 64 * SK_KP * 2, S16_VB = 64 * S16_VP * 2, S16_VOFF = 2 * S16_KB, S16_MOFF = S16_VOFF + 2 * S16_VB;
static_assert(S16_MOFF + 2048 <= LDS_BYTES - 1536, "sel16 LDS map");
__device__ __forceinline__ void sel_unit16(LAS unsigned char* lds, const bf16* U2, const bf16* VTS, const unsigned* SM, const bf16* OCMP, const bf16* OWIN, bf16* ABR, int g, int qblk, int tid, int wave, int lane) {
    const int c16 = lane & 15, G = lane >> 4;
    const int head = 4 * g + (c16 & 3);
    LAS unsigned* smask = (LAS unsigned*)(lds + S16_MOFF);
    __syncthreads();
    smask[tid] = SM[(size_t)((64 * qblk + (tid >> 3)) * 2 + g) * 8 + (tid & 7)];
    Sel16 grp[2]; int tlg[2];
#pragma unroll
    for (int gi = 0; gi < 2; ++gi) { tlg[gi] = 8 * wave + 4 * gi + (c16 >> 2); const bf16* qp = U2 + (size_t)(64 * qblk + tlg[gi]) * U2W + U2_Q + head * 64 + 8 * G;
        grp[gi].qf[0] = *(const bf16x8*)qp; grp[gi].qf[1] = *(const bf16x8*)(qp + 32); grp[gi].m_run = -INFINITY; grp[gi].l_run = 0.f;
#pragma unroll
        for (int d = 0; d < 4; ++d) grp[gi].o[d] = (f32x4){0.f, 0.f, 0.f, 0.f}; }
    const float scale2 = 0.125f * LOG2E;
    const int st1 = qblk / S16_NB + 1;
    unsigned ko_[4], kl[4], vo_[4], vl[4];
    const bf16* Kb = U2 + U2_KV + (2 * 2 + g) * 64; const bf16* Vb = VTS + (size_t)(g * 64) * S;
#pragma unroll
    for (int i = 0; i < 4; ++i) { const int c = tid + 512 * i; { const int row = c >> 3, p = c & 7; ko_[i] = (unsigned)(row * U2W + 8 * p); kl[i] = (unsigned)(row * SK_KP + 8 * p) * 2u; }
        { const int row = c >> 5, p = c & 31; vo_[i] = (unsigned)(row * S + 8 * p); vl[i] = (unsigned)(row * S16_VP + 8 * p) * 2u; } }
    u32x4 kr[4], vr[4];
    auto gload = [&](int step) { int key0 = 64 * S16_NB * step; if (key0 + 64 * S16_NB > S) key0 = S - 64 * S16_NB;
        const bf16* kp = Kb + (size_t)key0 * U2W; const bf16* vp = Vb + key0;
#pragma unroll
        for (int i = 0; i < 4; ++i) { kr[i] = *(const u32x4*)(kp + ko_[i]); vr[i] = *(const u32x4*)(vp + vo_[i]); } };
    gload(0);
#pragma unroll 1
    for (int st = 0; st < st1; ++st) {
        const int buf = st & 1;
        LAS unsigned char* kb = lds + buf * S16_KB; LAS unsigned char* vb = lds + S16_VOFF + buf * S16_VB;
#pragma unroll
        for (int i = 0; i < 4; ++i) { *(LAS u32x4*)(kb + kl[i]) = kr[i]; *(LAS u32x2*)(vb + vl[i]) = (u32x2){vr[i].x, vr[i].y}; *(LAS u32x2*)(vb + vl[i] + 8) = (u32x2){vr[i].z, vr[i].w}; }
        __syncthreads();
        if (st + 1 < st1) gload(st + 1);
#pragma unroll
        for (int h = 0; h < S16_NB; ++h) { const int j = S16_NB * st + h;
            if (j <= qblk) {
#pragma unroll
                for (int gi = 0; gi < 2; ++gi) { const bool sel = selmask_test(smask + tlg[gi] * 8, j);
                    if (__any(sel)) { const int t = 64 * qblk + tlg[gi]; const int key0 = 64 * j; const bool diag = (j == qblk);
                        auto mask = [&](int k) { return sel && (!diag || key0 + k <= t); };
                        att16_block<S16_VP>(kb + h * 64 * SK_KP * 2, vb + h * 128, grp[gi], scale2, mask, c16, G); } } } }
    }
#pragma unroll
    for (int gi = 0; gi < 2; ++gi) { const int t = 64 * qblk + tlg[gi];
        float l = grp[gi].l_run; l += __shfl_xor(l, 16); l += __shfl_xor(l, 32); const float inv = l > 0.f ? 1.0f / l : 0.f;
        const bf16* gp = U2 + (size_t)t * U2W + U2_G + head * 3;
        const float s0 = sigmoidf_(bf2f(gp[0])), s1 = sigmoidf_(bf2f(gp[1])) * inv, s2g = sigmoidf_(bf2f(gp[2]));
#pragma unroll
        for (int d = 0; d < 4; ++d) { const int dv = 16 * d + 4 * G; const size_t off = (size_t)t * 512 + head * 64 + dv; const u32x2 oc = *(const u32x2*)(OCMP + off), ow = *(const u32x2*)(OWIN + off);
            f32x4 r; r[0] = s0 * bflo(oc.x) + s1 * grp[gi].o[d][0] + s2g * bflo(ow.x); r[1] = s0 * bfhi(oc.x) + s1 * grp[gi].o[d][1] + s2g * bfhi(ow.x);
            r[2] = s0 * bflo(oc.y) + s1 * grp[gi].o[d][2] + s2g * bflo(ow.y); r[3] = s0 * bfhi(oc.y) + s1 * grp[gi].o[d][3] + s2g * bfhi(ow.y);
            store4_bf16(ABR + (size_t)t * D + head * 64 + dv, r); } }
}

struct LP {
    unsigned char* ws; unsigned char* wl; int l;
    __device__ __forceinline__ bf16* w(size_t off) const { return (bf16*)(wl + off); }
    __device__ __forceinline__ bf16* b(size_t off) const { return (bf16*)(ws + off); }
    __device__ __forceinline__ float* f(size_t off) const { return (float*)(ws + off); }
    __device__ __forceinline__ int* i(size_t off) const { return (int*)(ws + off); }
};
#define INF32(a, idx, per) ((const float*)(a).in[idx] + (size_t)l * (per))

#ifndef BPARTS
#define BPARTS 31
#endif
#ifndef DUPSUB
#define DUPSUB 0
#endif
#define SUBREP(bit) for (int srep_ = 0; srep_ < 1 + ((DUPSUB >> (bit)) & 1); ++srep_)
__device__ __forceinline__ void phase_prep(const Args& a, Frame& F, const LP& P) {
    const int l = P.l, lane = F.lane, tid = F.tid;
    const bf16* U2 = P.b(WS_U2); bf16* ABR = P.b(WS_ABR);
    if (BPARTS & 1) { const float* cw = INF32(a, 17, 31 * 512); const float* cb = INF32(a, 18, 512); const float* lg = INF32(a, 19, 512); const float* lb = INF32(a, 20, 512);
      LAS bf16* hb = (LAS bf16*)F.lds;
      LAS float* cs = (LAS float*)(F.lds + 65536);
      const int c = tid;
      float w[31];
#pragma unroll
      for (int k = 0; k < 31; ++k) w[k] = cw[k * 512 + c];
      const float bias = cb[c];
#pragma unroll 1
      for (int tile = blockIdx.x; tile < S / 32; tile += F.G) { const int t0 = tile * 32;
          { u32x4 av[8], gv[8];
#pragma unroll
            for (int i = 0; i < 8; ++i) { const int item = tid + 512 * i, r = item >> 6, ch = (item & 63) * 8; int tok = t0 - 30 + r; tok = tok < 0 ? 0 : tok;
                const bf16* up = U2 + (size_t)tok * U2W + U2_CONV + ch;
                if (r < 62) { av[i] = *(const u32x4*)up; gv[i] = *(const u32x4*)(up + 512); } else { av[i] = (u32x4){0u, 0u, 0u, 0u}; gv[i] = av[i]; } }
#pragma unroll
            for (int i = 0; i < 8; ++i) { const int item = tid + 512 * i, r = item >> 6, ch = (item & 63) * 8; const bool ok = (t0 - 30 + r) >= 0;
                u32x4 o;
#pragma unroll
                for (int q = 0; q < 4; ++q) { const float h0 = bflo(av[i][q]) * sigmoidf_(bflo(gv[i][q])), h1 = bfhi(av[i][q]) * sigmoidf_(bfhi(gv[i][q])); o[q] = ok ? cvt_pk_bf16(h0, h1) : 0u; }
                if (r < 62) *(LAS u32x4*)(hb + r * 512 + ch) = o; } }
          __syncthreads();
          float hreg[62];
#pragma unroll
          for (int r = 0; r < 62; ++r) hreg[r] = bf2f(hb[r * 512 + c]);
#pragma unroll
          for (int i = 0; i < 32; ++i) { float acc = bias;
#pragma unroll
              for (int k = 0; k < 31; ++k) acc += w[k] * hreg[i + k];
              cs[i * 512 + c] = acc; }
          __syncthreads();
#pragma unroll
          for (int q = 0; q < 4; ++q) { const int tt = 4 * F.wave + q; float v[8]; float s = 0.f;
#pragma unroll
              for (int j = 0; j < 8; ++j) { v[j] = cs[tt * 512 + lane + 64 * j]; s += v[j]; }
              const float mean = wave_sum(s) * (1.0f / 512.0f); float qq = 0.f;
#pragma unroll
              for (int j = 0; j < 8; ++j) { v[j] -= mean; qq += v[j] * v[j]; }
              const float rstd = 1.0f / sqrtf(wave_sum(qq) * (1.0f / 512.0f) + 1e-5f);
#pragma unroll
              for (int j = 0; j < 8; ++j) { const int ch = lane + 64 * j; const float y = v[j] * rstd * lg[ch] + lb[ch]; ABR[(size_t)(t0 + tt) * D + 1536 + ch] = f2bf(y * sigmoidf_(y)); } }
          __syncthreads(); } }
    if (BPARTS & 2) { float* rq = P.f(WS_RSTD); float* rkv = rq + S;
      const int sub = lane >> 4, l16 = lane & 15;
#pragma unroll 1
      for (int t0 = 4 * F.gw; t0 < S; t0 += 4 * F.NGW) { const int t = t0 + sub; const bf16* row = U2 + (size_t)t * U2W;
          const u32x4 a0 = *(const u32x4*)(row + U2_CQ + 8 * l16), a1 = *(const u32x4*)(row + U2_CQ + 8 * l16 + 128), a2 = *(const u32x4*)(row + U2_CQ + 8 * l16 + 256), a3 = *(const u32x4*)(row + U2_CQ + 8 * l16 + 384);
          const u32x4 c0 = *(const u32x4*)(row + U2_CKV + 8 * l16), c1 = *(const u32x4*)(row + U2_CKV + 8 * l16 + 128);
          float s = 0.f, s2 = 0.f;
#pragma unroll
          for (int q = 0; q < 4; ++q) { float x; x = bflo(a0[q]); s += x * x; x = bfhi(a0[q]); s += x * x; x = bflo(a1[q]); s += x * x; x = bfhi(a1[q]); s += x * x;
              x = bflo(a2[q]); s += x * x; x = bfhi(a2[q]); s += x * x; x = bflo(a3[q]); s += x * x; x = bfhi(a3[q]); s += x * x;
              x = bflo(c0[q]); s2 += x * x; x = bfhi(c0[q]); s2 += x * x; x = bflo(c1[q]); s2 += x * x; x = bfhi(c1[q]); s2 += x * x; }
#pragma unroll
          for (int o = 1; o < 16; o <<= 1) { s += __shfl_xor(s, o); s2 += __shfl_xor(s2, o); }
          if (l16 == 0) { rq[t] = 1.0f / sqrtf(s * (1.0f / 512.0f) + 1e-6f); rkv[t] = 1.0f / sqrtf(s2 * (1.0f / 256.0f) + 1e-6f); } }
#pragma unroll 1
      for (int r0 = 8 * F.gw; r0 < S; r0 += 8 * F.NGW) { const int w = 2 << (lane >> 4); const bf16* col = U2 + U2_POOL + 8 * lane;
          float sum[8];
#pragma unroll
          for (int q = 0; q < 8; ++q) sum[q] = 0.f;
          for (int i = 1; i < w; ++i) { const int tt = r0 - i; if (tt >= 0) { const u32x4 v = *(const u32x4*)(col + (size_t)tt * U2W);
#pragma unroll
              for (int q = 0; q < 4; ++q) { sum[2 * q] += bflo(v[q]); sum[2 * q + 1] += bfhi(v[q]); } } }
#pragma unroll
          for (int k = 0; k < 8; ++k) { const int t = r0 + k; const u32x4 v = *(const u32x4*)(col + (size_t)t * U2W);
              const int to = t - w + 1; u32x4 vo = (u32x4){0u, 0u, 0u, 0u}; if (to >= 0) vo = *(const u32x4*)(col + (size_t)to * U2W);
              const int cnt = (t + 1 < w) ? (t + 1) : w; const float ic = 1.0f / (float)cnt; u32x4 o;
#pragma unroll
              for (int q = 0; q < 4; ++q) { sum[2 * q] += bflo(v[q]); sum[2 * q + 1] += bfhi(v[q]);
                  o[q] = cvt_pk_bf16(sum[2 * q] * ic - bflo(v[q]), sum[2 * q + 1] * ic - bfhi(v[q]));
                  sum[2 * q] -= bflo(vo[q]); sum[2 * q + 1] -= bfhi(vo[q]); }
              *(u32x4*)(ABR + (size_t)t * D + 512 + 8 * lane) = o; } } }
    if (BPARTS & 4) { LAS bf16* scr = (LAS bf16*)(F.lds + 65536 + F.wave * 8448);
#pragma unroll 1
      for (int it = F.gw; it < 2 * 2 * (S / 64); it += F.NGW) { const int tt = it % (S / 64), g = (it / (S / 64)) & 1, which = it / (2 * (S / 64));
          const bf16* src = U2 + (size_t)(tt * 64) * U2W + U2_KV + ((which ? 5 : 3) * 2 + g) * 64;
          bf16* dst = P.b(which ? WS_VTWIN : WS_VTSEL) + (size_t)(g * 64) * S + tt * 64;
          transpose_tile64(src, U2W, dst, S, scr, lane); } }
    if (BPARTS & 8) { bf16* HID = P.b(WS_HID); const float* b1c = (const float*)(P.wl + WO_B1C);
#pragma unroll 1
      for (int it = F.gw; it < 4 * 64 * 8; it += F.NGW) { const int nt = it & 7, mt = (it >> 3) & 63, jg = it >> 9, j = jg >> 1, g = jg & 1;
          const bf16* Ab = U2 + U2_KV + (j * 2 + g) * 64; const bf16* Bb = P.w(WO_W1C) + (size_t)j * 128 * 2048;
          auto ap = [&](int r, int k) { int n = 16 * mt + r; n = n > 1022 ? 1022 : n; return Ab + (size_t)(16 * n + (k >> 6)) * U2W + (k & 63); };
          auto bp = [&](int r, int k) { return Bb + (size_t)(16 * nt + r) * 2048 + k; };
          const f32x4 acc = sgemm16(ap, bp, 2048, lane);
          const int h = 16 * nt + (lane & 15); const float bb = b1c[j * 128 + h];
#pragma unroll
          for (int i = 0; i < 4; ++i) { const int n = 16 * mt + 4 * (lane >> 4) + i; HID[((size_t)jg * 1024 + n) * 128 + h] = f2bf(gelu_tanh(acc[i] + bb)); } } }
}
__device__ __forceinline__ void memkv_items(const LP& P, int first, int nw, int lane) {
    const int l = P.l; const bf16* MEMB = P.b(WS_MEMB); bf16* KX = P.b(WS_KX) + (size_t)l * 256 * 512; bf16* VXT = P.b(WS_VXT) + (size_t)l * 512 * 256;
#pragma unroll 1
    for (int it = first; it < 1024; it += nw) {
        if (it < 512) { const int mt = it >> 5, nt = it & 31;
            auto ap = [&](int r, int k) { return MEMB + (size_t)(16 * mt + r) * D + k; };
            auto bp = [&](int r, int k) { return P.w(WO_WXK) + (size_t)(16 * nt + r) * D + k; };
            const f32x4 acc = sgemm16(ap, bp, D, lane);
#pragma unroll
            for (int i = 0; i < 4; ++i) KX[(size_t)(16 * mt + 4 * (lane >> 4) + i) * 512 + 16 * nt + (lane & 15)] = f2bf(acc[i]);
        } else { const int q = it - 512, mt = q >> 4, nt = q & 15;
            auto ap = [&](int r, int k) { return P.w(WO_WXV) + (size_t)(16 * mt + r) * D + k; };
            auto bp = [&](int r, int k) { return MEMB + (size_t)(16 * nt + r) * D + k; };
            const f32x4 acc = sgemm16(ap, bp, D, lane);
#pragma unroll
            for (int i = 0; i < 4; ++i) VXT[(size_t)(16 * mt + 4 * (lane >> 4) + i) * 256 + 16 * nt + (lane & 15)] = f2bf(acc[i]); } }
}

__device__ __forceinline__ void phase_compress2(Frame& F, const LP& P) {
    const int lane = F.lane; const bf16* HID = P.b(WS_HID); const bf16* W2 = P.w(WO_W2C);
#pragma unroll 1
    for (int it = F.gw; it < 1024; it += F.NGW) {
        if (it < 512) { const int nt = it & 3, mt = (it >> 2) & 63, g = it >> 8;
            auto ap = [&](int r, int k) { return HID + ((size_t)(0 * 2 + g) * 1024 + 16 * mt + r) * 128 + k; };
            auto bp = [&](int r, int k) { return W2 + (size_t)(16 * nt + r) * 128 + k; };
            const f32x4 acc = sgemm16(ap, bp, 128, lane);
#pragma unroll
            for (int i = 0; i < 4; ++i) P.b(WS_KC)[((size_t)g * 1024 + 16 * mt + 4 * (lane >> 4) + i) * 64 + 16 * nt + (lane & 15)] = f2bf(acc[i]);
        } else { const int q = it - 512, nt = q & 63, mt = (q >> 6) & 3, g = q >> 8;
            auto ap = [&](int r, int k) { return W2 + (size_t)64 * 128 + (size_t)(16 * mt + r) * 128 + k; };
            auto bp = [&](int r, int k) { return HID + ((size_t)(1 * 2 + g) * 1024 + 16 * nt + r) * 128 + k; };
            const f32x4 acc = sgemm16(ap, bp, 128, lane);
#pragma unroll
            for (int i = 0; i < 4; ++i) P.b(WS_VCT)[((size_t)g * 64 + 16 * mt + 4 * (lane >> 4) + i) * 1024 + 16 * nt + (lane & 15)] = f2bf(acc[i]); } }
}

__device__ __forceinline__ void phase_d(Frame& F, const LP& P) {
    const int lane = F.lane;
    { const bf16* KVH = P.b(WS_KVH); const bf16* U2 = P.b(WS_U2); bf16* KR = P.b(WS_KM); const f32x2* rope = (const f32x2*)(P.ws + WS_ROPE);
#pragma unroll 1
      for (int i = F.gw * 64 + lane; i < S * 8; i += F.NGW * 64) { const int t = i >> 3, k = 2 * (i & 7);
          const bf16* kr = U2 + (size_t)t * U2W + U2_KR;
          const unsigned a = *(const unsigned*)(kr + k), b = *(const unsigned*)(kr + 16 + k); const f32x4 cs = *(const f32x4*)(rope + (size_t)t * 16 + k);
          const float x10 = bflo(a), x11 = bfhi(a), x20 = bflo(b), x21 = bfhi(b);
          *(unsigned*)(KR + (size_t)t * 32 + k) = cvt_pk_bf16(x10 * cs[0] - x20 * cs[1], x11 * cs[2] - x21 * cs[3]);
          *(unsigned*)(KR + (size_t)t * 32 + 16 + k) = cvt_pk_bf16(x20 * cs[0] + x10 * cs[1], x21 * cs[2] + x11 * cs[3]); }
      LAS bf16* scr = (LAS bf16*)(F.lds + F.wave * 8448);
#pragma unroll 1
      for (int it = F.gw; it < 8 * (S / 64); it += F.NGW) { const int tt = it % (S / 64), hd = it / (S / 64);
          transpose_tile64(KVH + (size_t)(tt * 64) * 1024 + hd * 128 + 64, 1024, P.b(WS_VTM) + (size_t)(hd * 64) * S + tt * 64, S, scr, lane); } }
    __syncthreads();
    SUBREP(3)
#pragma unroll 1
    for (int i = blockIdx.x; i < 512; i += F.G) { const int r = i >> 8, p = i & 255; const int qb = r ? 255 - (p >> 1) : (p >> 1);
        cmp_unit(F.lds, P.b(WS_U2), P.b(WS_KC), P.b(WS_VCT), P.b(WS_OCMP), P.f(WS_SCORES), p & 1, qb, F.tid, F.wave, lane); }
}


constexpr int MK_KP = 104, MK_VP = 132;
constexpr int MK_KB = 128 * MK_KP * 2, MK_VB = 64 * MK_VP * 2, MK_VOFF = 2 * MK_KB;
__device__ __forceinline__ void mla_unit(LAS unsigned char* lds, const bf16* Q, const bf16* KVH, const bf16* KR, const bf16* Vt, bf16* O, int hd, int qb, int tid, int wave, int lane) {
    const int col = lane & 31, hi = lane >> 5;
    const int q0 = qb * 256 + wave * 32;
    bf16x8 qf[6];
    { const bf16* qp = Q + (size_t)(q0 + col) * 768 + hd * 96;
#pragma unroll
      for (int s = 0; s < 6; ++s) qf[s] = *(const bf16x8*)(qp + 16 * s + 8 * hi); }
    f32x16 o[2];
#pragma unroll
    for (int b = 0; b < 2; ++b)
#pragma unroll
        for (int r = 0; r < 16; ++r) o[b][r] = 0.f;
    float m_run = -INFINITY, l_run = 0.f;
    const int nt = 2 * (qb + 1);
    const bf16* kg[3]; unsigned kl[3]; int kst[3]; const bf16* vg[2]; unsigned vl[2];
#pragma unroll
    for (int i = 0; i < 3; ++i) { const int c = tid + 512 * i, row = c / 12, p = c % 12; const bool nope = p < 8; kst[i] = nope ? 1024 : 32;
        kg[i] = nope ? KVH + (size_t)row * 1024 + hd * 128 + 8 * p : KR + (size_t)row * 32 + 8 * (p - 8); kl[i] = (unsigned)(row * MK_KP + 8 * p) * 2u; }
#pragma unroll
    for (int i = 0; i < 2; ++i) { const int c = tid + 512 * i, row = c >> 4, p = c & 15; vg[i] = Vt + (size_t)(hd * 64 + row) * S + 8 * p; vl[i] = (unsigned)(row * MK_VP + 8 * p) * 2u; }
    u32x4 kr[3], vr[2];
#pragma unroll
    for (int i = 0; i < 3; ++i) kr[i] = *(const u32x4*)kg[i];
#pragma unroll
    for (int i = 0; i < 2; ++i) vr[i] = *(const u32x4*)vg[i];
#pragma unroll 1
    for (int t = 0; t < nt; ++t) {
        const int buf = t & 1; const int key0 = 128 * t;
        LAS unsigned char* kb = lds + buf * MK_KB; LAS unsigned char* vb = lds + MK_VOFF + buf * MK_VB;
#pragma unroll
        for (int i = 0; i < 3; ++i) *(LAS u32x4*)(kb + kl[i]) = kr[i];
#pragma unroll
        for (int i = 0; i < 2; ++i) { *(LAS u32x2*)(vb + vl[i]) = (u32x2){vr[i].x, vr[i].y}; *(LAS u32x2*)(vb + vl[i] + 8) = (u32x2){vr[i].z, vr[i].w}; }
        __syncthreads();
        if (t + 1 < nt) {
#pragma unroll
            for (int i = 0; i < 3; ++i) kr[i] = *(const u32x4*)(kg[i] + (size_t)(key0 + 128) * kst[i]);
#pragma unroll
            for (int i = 0; i < 2; ++i) vr[i] = *(const u32x4*)(vg[i] + key0 + 128); }
#pragma unroll
        for (int h = 0; h < 2; ++h) { const int k0h = key0 + 64 * h;
            if (k0h <= q0 + 31) { auto mask = [&](int u, int r) { return k0h + 32 * u + crow(r, hi) <= q0 + col; };
                att_step64<6, MK_KP, MK_VP>(kb + h * 64 * MK_KP * 2, vb + h * 128, qf, o, m_run, l_run, 1.0f, k0h + 63 > q0, mask, col, hi); } }
    }
    const float l = l_run + __shfl_xor(l_run, 32); const float inv = l > 0.f ? 1.0f / l : 0.f;
    bf16* op = O + (size_t)(q0 + col) * D + 1024 + hd * 64;
#pragma unroll
    for (int b = 0; b < 2; ++b)
#pragma unroll
        for (int i = 0; i < 4; ++i) store4_bf16(op + 32 * b + 8 * i + 4 * hi, (f32x4){o[b][4 * i] * inv, o[b][4 * i + 1] * inv, o[b][4 * i + 2] * inv, o[b][4 * i + 3] * inv});
}

#define MLA_SB __builtin_amdgcn_sched_barrier(0)
template <bool HAS_NEXT, bool FINISH = true>
__device__ __forceinline__ void mla_stage1(const LAS unsigned char* kbn, const bf16x8 (&qf)[6], f32x16& cur, f32x16& nxt, bf16x8 (&pf)[2], float mref, float& l_run, int col, int hi) {
    const LAS unsigned char* kp0 = kbn + (col * MK_KP + 8 * hi) * 2;
    bf16x8 kf[6];
    if (HAS_NEXT) {
#pragma unroll
        for (int c = 0; c < 6; ++c) kf[c] = *(const LAS bf16x8*)(kp0 + 32 * c); }
    float ps = 0.f;
    MLA_SB;
#pragma unroll
    for (int c = 0; c < 6; ++c) {
        const int e0 = (16 * c + 5) / 6, e1 = (16 * (c + 1) + 5) / 6;
        if (FINISH) {
#pragma unroll
            for (int r = e0; r < e1; ++r) { const float pe = __builtin_amdgcn_exp2f(cur[r] - mref); cur[r] = pe; ps += pe; }
            asm volatile("" : "+v"(ps));
            if (c == 3) pf[0] = __builtin_bit_cast(bf16x8, (u32x4){cvt_pk_bf16(cur[0], cur[1]), cvt_pk_bf16(cur[2], cur[3]), cvt_pk_bf16(cur[4], cur[5]), cvt_pk_bf16(cur[6], cur[7])}); }
        if (HAS_NEXT) {
            if (c == 0) { f32x16 z;
#pragma unroll
                for (int r = 0; r < 16; ++r) z[r] = 0.f;
                nxt = __builtin_amdgcn_mfma_f32_32x32x16_bf16(kf[0], qf[0], z, 0, 0, 0); }
            else nxt = __builtin_amdgcn_mfma_f32_32x32x16_bf16(kf[c], qf[c], nxt, 0, 0, 0);
            asm volatile("" : "+v"(nxt)); }
        MLA_SB; }
    if (FINISH) pf[1] = __builtin_bit_cast(bf16x8, (u32x4){cvt_pk_bf16(cur[8], cur[9]), cvt_pk_bf16(cur[10], cur[11]), cvt_pk_bf16(cur[12], cur[13]), cvt_pk_bf16(cur[14], cur[15])});
    l_run += ps;
}
template <bool DO_PV, bool HAS_NEXT>
__device__ __forceinline__ void mla_stage2(const LAS unsigned char* vbc, const bf16x8 (&pf)[2], f32x16 (&o)[2], f32x16& nxt, float& m_run, float& l_run, float& mref, bool use_mask, int kn0, int qcol, int col, int hi) {
    const LAS unsigned char* vp0 = vbc + (col * MK_VP + 4 * hi) * 2; const LAS unsigned char* vp1 = vp0 + 32 * MK_VP * 2;
    u32x2 al[2], ah[2], bl[2], bh[2];
    if (DO_PV) {
#pragma unroll
        for (int c = 0; c < 2; ++c) { al[c] = *(const LAS u32x2*)(vp0 + 32 * c); ah[c] = *(const LAS u32x2*)(vp0 + 32 * c + 16); bl[c] = *(const LAS u32x2*)(vp1 + 32 * c); bh[c] = *(const LAS u32x2*)(vp1 + 32 * c + 16); } }
    if (HAS_NEXT && use_mask) {
        const int lim = qcol - kn0 - 4 * hi;
#pragma unroll
        for (int r = 0; r < 16; ++r) nxt[r] = ((r & 3) + 8 * (r >> 2) > lim) ? -INFINITY : nxt[r]; }
    float mt = -INFINITY;
    MLA_SB;
#pragma unroll
    for (int c = 0; c < 2; ++c) {
        if (HAS_NEXT) {
#pragma unroll
            for (int r = 8 * c; r < 8 * c + 8; ++r) mt = fmaxf(mt, nxt[r]);
            asm volatile("" : "+v"(mt)); }
        if (DO_PV) {
            o[0] = __builtin_amdgcn_mfma_f32_32x32x16_bf16(__builtin_bit_cast(bf16x8, (u32x4){al[c].x, al[c].y, ah[c].x, ah[c].y}), pf[c], o[0], 0, 0, 0);
            o[1] = __builtin_amdgcn_mfma_f32_32x32x16_bf16(__builtin_bit_cast(bf16x8, (u32x4){bl[c].x, bl[c].y, bh[c].x, bh[c].y}), pf[c], o[1], 0, 0, 0); }
        MLA_SB; }
    if (HAS_NEXT) {
        mt = fmaxf(mt, __shfl_xor(mt, 32));
        const float m_new = fmaxf(m_run, mt); const float mr = (m_new == -INFINITY) ? 0.f : m_new;
        if (__any(m_new != m_run)) { const float corr = __builtin_amdgcn_exp2f(m_run - mr); l_run *= corr; m_run = m_new;
#pragma unroll
            for (int b = 0; b < 2; ++b)
#pragma unroll
                for (int r = 0; r < 16; ++r) o[b][r] *= corr; }
        mref = mr; }
}
__device__ __forceinline__ void mla_unit_p(LAS unsigned char* lds, const bf16* Q, const bf16* KVH, const bf16* KR, const bf16* Vt, bf16* O, int hd, int qb, int tid, int wave, int lane) {
    const int col = lane & 31, hi = lane >> 5;
    const int q0 = qb * 256 + wave * 32, qcol = q0 + col;
    bf16x8 qf[6];
    { const bf16* qp = Q + (size_t)(q0 + col) * 768 + hd * 96;
#pragma unroll
      for (int s = 0; s < 6; ++s) qf[s] = *(const bf16x8*)(qp + 16 * s + 8 * hi); }
    f32x16 o[2];
#pragma unroll
    for (int b = 0; b < 2; ++b)
#pragma unroll
        for (int r = 0; r < 16; ++r) o[b][r] = 0.f;
    float m_run = -INFINITY, l_run = 0.f, mref = 0.f;
    const int ns = 2 * (qb + 1);
    const bf16* kg[3]; unsigned kl[3]; int kst[3]; const bf16* vg[2]; unsigned vl[2];
#pragma unroll
    for (int i = 0; i < 3; ++i) { const int c = tid + 512 * i, row = c / 12, p = c % 12; const bool nope = p < 8; kst[i] = nope ? 1024 : 32;
        kg[i] = nope ? KVH + (size_t)row * 1024 + hd * 128 + 8 * p : KR + (size_t)row * 32 + 8 * (p - 8); kl[i] = (unsigned)(row * MK_KP + 8 * p) * 2u; }
#pragma unroll
    for (int i = 0; i < 2; ++i) { const int c = tid + 512 * i, row = c >> 4, p = c & 15; vg[i] = Vt + (size_t)(hd * 64 + row) * S + 8 * p; vl[i] = (unsigned)(row * MK_VP + 8 * p) * 2u; }
    u32x4 kr[3], vr[2];
    auto gload = [&](int step) { const int key0 = 128 * step;
#pragma unroll
        for (int i = 0; i < 3; ++i) kr[i] = *(const u32x4*)(kg[i] + (size_t)key0 * kst[i]);
#pragma unroll
        for (int i = 0; i < 2; ++i) vr[i] = *(const u32x4*)(vg[i] + key0); };
    auto lwrite = [&](int buf) { LAS unsigned char* kb = lds + buf * MK_KB; LAS unsigned char* vb = lds + MK_VOFF + buf * MK_VB;
#pragma unroll
        for (int i = 0; i < 3; ++i) *(LAS u32x4*)(kb + kl[i]) = kr[i];
#pragma unroll
        for (int i = 0; i < 2; ++i) { *(LAS u32x2*)(vb + vl[i]) = (u32x2){vr[i].x, vr[i].y}; *(LAS u32x2*)(vb + vl[i] + 8) = (u32x2){vr[i].z, vr[i].w}; } };
    gload(0); lwrite(0); gload(1);
    __syncthreads();
    f32x16 sA, sB; bf16x8 pf[2];
    pf[0] = __builtin_bit_cast(bf16x8, (u32x4){0u, 0u, 0u, 0u}); pf[1] = pf[0];
    mla_stage1<true, false>(lds, qf, sB, sA, pf, 0.f, l_run, col, hi);
    mla_stage2<false, true>(lds, pf, o, sA, m_run, l_run, mref, 31 > q0, 0, qcol, col, hi);
#define MLA_TILE(CUR, NXT, KNEXT, VCUR, KN0) do { mla_stage1<true>(KNEXT, qf, CUR, NXT, pf, mref, l_run, col, hi); \
        mla_stage2<true, true>(VCUR, pf, o, NXT, m_run, l_run, mref, (KN0) + 31 > q0, KN0, qcol, col, hi); } while (0)
#pragma unroll 1
    for (int s = 0; s < ns; ++s) {
        const int buf = s & 1; const LAS unsigned char* kbs = lds + buf * MK_KB; const LAS unsigned char* vbs = lds + MK_VOFF + buf * MK_VB; const LAS unsigned char* kbn = lds + (buf ^ 1) * MK_KB;
        const int k0 = 128 * s;
        __syncthreads();
        if (s + 1 < ns) { lwrite(buf ^ 1); if (s + 2 < ns) gload(s + 2); }
        MLA_TILE(sA, sB, kbs + 32 * MK_KP * 2, vbs, k0 + 32);
        MLA_TILE(sB, sA, kbs + 64 * MK_KP * 2, vbs + 64, k0 + 64);
        MLA_TILE(sA, sB, kbs + 96 * MK_KP * 2, vbs + 128, k0 + 96);
        __syncthreads();
        if (s + 1 < ns) MLA_TILE(sB, sA, kbn, vbs + 192, k0 + 128);
        else { mla_stage1<false>(kbn, qf, sB, sA, pf, mref, l_run, col, hi); mla_stage2<true, false>(vbs + 192, pf, o, sA, m_run, l_run, mref, false, 0, qcol, col, hi); }
    }
#undef MLA_TILE
    const float l = l_run + __shfl_xor(l_run, 32); const float inv = l > 0.f ? 1.0f / l : 0.f;
    bf16* op = O + (size_t)(q0 + col) * D + 1024 + hd * 64;
#pragma unroll
    for (int b = 0; b < 2; ++b)
#pragma unroll
        for (int i = 0; i < 4; ++i) store4_bf16(op + 32 * b + 8 * i + 4 * hi, (f32x4){o[b][4 * i] * inv, o[b][4 * i + 1] * inv, o[b][4 * i + 2] * inv, o[b][4 * i + 3] * inv});
}

__device__ __forceinline__ void phase_e(Frame& F, const LP& P) {
    const int lane = F.lane;
    SUBREP(0)
#pragma unroll 1
    for (int i = blockIdx.x; i < 256; i += F.G) { const int hd = i & 7, p = i >> 3;
#pragma unroll 1
        for (int rep = 0; rep < 2; ++rep) mla_unit_p(F.lds, P.b(WS_QM), P.b(WS_KVH), P.b(WS_KM), P.b(WS_VTM), P.b(WS_ABR), hd, rep ? p : 63 - p, F.tid, F.wave, lane); }
    __syncthreads();
    SUBREP(1)
#pragma unroll 1
    for (int i = blockIdx.x; i < 512; i += F.G) sel_unit<1>(F.lds, P.b(WS_U2), P.b(WS_VTWIN), nullptr, nullptr, P.b(WS_OWIN), nullptr, i & 1, i >> 1, F.tid, F.wave, lane);
    __syncthreads();
    SUBREP(2)
#pragma unroll 1
    for (int u = F.gw; u < S * 2; u += F.NGW) { const int t = u >> 1;
        topk_unit(P.f(WS_SCORES) + (size_t)u * 256, t, (unsigned*)P.i(WS_IDX) + (size_t)u * 8, lane); }
}
__device__ __forceinline__ void phase_f(Frame& F, const LP& P) {
#pragma unroll 1
    for (int i = blockIdx.x; i < 256; i += F.G) { const int g = i & 1, p = i >> 1;
#pragma unroll 1
        for (int rep = 0; rep < 2; ++rep) sel_unit16(F.lds, P.b(WS_U2), P.b(WS_VTSEL), (const unsigned*)P.i(WS_IDX), P.b(WS_OCMP), P.b(WS_OWIN), P.b(WS_ABR), g, rep ? p : 255 - p, F.tid, F.wave, F.lane); }
}
constexpr int XK_KP = 136, XK_VP = 260, XK_VOFF = 256 * XK_KP * 2;
__device__ __forceinline__ void phase_xattn(Frame& F, const LP& P) {
    const int tid = F.tid, lane = F.lane, col = lane & 31, hi = lane >> 5;
    const bf16* KX = P.b(WS_KX) + (size_t)P.l * 256 * 512; const bf16* VXT = P.b(WS_VXT) + (size_t)P.l * 512 * 256;
    LAS unsigned char* kb = F.lds; LAS unsigned char* vb = F.lds + XK_VOFF;
#pragma unroll 1
    for (int unit = blockIdx.x; unit < 4 * (S / 256); unit += F.G) { const int hd = unit & 3, tb = unit >> 2;
        __syncthreads();
        { u32x4 kr[8], vr[8];
#pragma unroll
          for (int i = 0; i < 8; ++i) { const int c = tid + 512 * i; kr[i] = *(const u32x4*)(KX + (size_t)(c >> 4) * 512 + hd * 128 + 8 * (c & 15)); vr[i] = *(const u32x4*)(VXT + (size_t)(hd * 128 + (c >> 5)) * 256 + 8 * (c & 31)); }
#pragma unroll
          for (int i = 0; i < 8; ++i) { const int c = tid + 512 * i; *(LAS u32x4*)(kb + ((c >> 4) * XK_KP + 8 * (c & 15)) * 2) = kr[i];
              LAS unsigned char* vd = vb + ((c >> 5) * XK_VP + 8 * (c & 31)) * 2; *(LAS u32x2*)vd = (u32x2){vr[i].x, vr[i].y}; *(LAS u32x2*)(vd + 8) = (u32x2){vr[i].z, vr[i].w}; } }
        __syncthreads();
        const int q0 = tb * 256 + F.wave * 32;
        bf16x8 qf[8];
        { const bf16* qp = P.b(WS_QX) + (size_t)(q0 + col) * 512 + hd * 128;
#pragma unroll
          for (int s = 0; s < 8; ++s) qf[s] = *(const bf16x8*)(qp + 16 * s + 8 * hi); }
        f32x16 o[4];
#pragma unroll
        for (int b = 0; b < 4; ++b)
#pragma unroll
            for (int r = 0; r < 16; ++r) o[b][r] = 0.f;
        float m_run = -INFINITY, l_run = 0.f;
        auto mask = [&](int, int) { return true; };
#pragma unroll
        for (int st = 0; st < 4; ++st) att_step64n<8, XK_KP, XK_VP, 4>(kb + st * 64 * XK_KP * 2, vb + st * 128, qf, o, m_run, l_run, 1.0f, false, mask, col, hi);
        const float l = l_run + __shfl_xor(l_run, 32); const float inv = l > 0.f ? 1.0f / l : 0.f;
        bf16* op = P.b(WS_OX) + (size_t)(q0 + col) * 512 + hd * 128;
#pragma unroll
        for (int b = 0; b < 4; ++b)
#pragma unroll
            for (int i = 0; i < 4; ++i) store4_bf16(op + 32 * b + 8 * i + 4 * hi, (f32x4){o[b][4 * i] * inv, o[b][4 * i + 1] * inv, o[b][4 * i + 2] * inv, o[b][4 * i + 3] * inv}); }
}

__device__ __forceinline__ void phase_ln(const Args& a, Frame& F, const LP& P, int gi, int bi) {
    const int l = P.l; const float* g = INF32(a, gi, D); const float* b = INF32(a, bi, D);
    RowRaw na, nb;
    if (2 * F.gw < S) { row_fetch(na, P.b(WS_Y) + (size_t)(2 * F.gw) * D, F.lane); row_fetch(nb, P.b(WS_Y) + (size_t)(2 * F.gw + 1) * D, F.lane); }
#pragma unroll 1
    for (int r = 2 * F.gw; r < S; r += 2 * F.NGW) { Row ra, rb; row_unpack(ra, na); row_unpack(rb, nb);
        const int rn = r + 2 * F.NGW;
        if (rn < S) { row_fetch(na, P.b(WS_Y) + (size_t)rn * D, F.lane); row_fetch(nb, P.b(WS_Y) + (size_t)(rn + 1) * D, F.lane); }
        row_layernorm2(ra, rb, g, b, F.lane);
        row_store_bf16(ra, P.b(WS_XB) + (size_t)r * D, F.lane); row_store_bf16(rb, P.b(WS_XB) + (size_t)(r + 1) * D, F.lane); }
}
__device__ __forceinline__ void phase_ln_router(const Args& a, Frame& F, const LP& P) {
    const int l = P.l, lane = F.lane, wave = F.wave, tid = F.tid; const float* g = INF32(a, 29, D); const float* b = INF32(a, 30, D);
    const float* bg = INF32(a, 32, 4); const float* br = INF32(a, 34, 32);
    int* toke = (int*)(P.ws + WS_MOE + MO_TOKE); float* tokw = (float*)(P.ws + WS_MOE + MO_TOKW); int* tokr = (int*)(P.ws + WS_MOE + MO_TOKP);
    unsigned* cnt = (unsigned*)(P.ws + WS_CTL) + CW_CNT + 128 * l;
    LAS float* lgs = (LAS float*)F.lds; LAS unsigned* hist = (LAS unsigned*)(F.lds + 131072); LAS unsigned* gbase = (LAS unsigned*)(F.lds + 131072 + 128);
    constexpr int RP = 264; LAS unsigned char* sxh = F.lds; LAS unsigned char* sxl = sxh + 64 * RP * 2; LAS unsigned char* swh = sxl + 64 * RP * 2; LAS unsigned char* swl = swh + 48 * RP * 2;
    const bf16* WRT = P.w(WO_WRT);
#pragma unroll 1
    for (int base = 64 * blockIdx.x; base < S; base += 64 * F.G) {
        if (tid < 32) hist[tid] = 0u;
        RowRaw na, nb; row_fetch(na, P.b(WS_Y) + (size_t)(base + 8 * wave) * D, lane); row_fetch(nb, P.b(WS_Y) + (size_t)(base + 8 * wave + 1) * D, lane);
#pragma unroll 1
        for (int i = 0; i < 8; i += 2) { const int r = base + 8 * wave + i; Row ra, rb; row_unpack(ra, na); row_unpack(rb, nb);
            if (i + 2 < 8) { row_fetch(na, P.b(WS_Y) + (size_t)(r + 2) * D, lane); row_fetch(nb, P.b(WS_Y) + (size_t)(r + 3) * D, lane); }
            row_layernorm2(ra, rb, g, b, lane);
            row_store_hilo(ra, P.b(WS_XB) + (size_t)r * D, P.b(WS_XLO) + (size_t)r * D, lane); row_store_hilo(rb, P.b(WS_XB) + (size_t)(r + 1) * D, P.b(WS_XLO) + (size_t)(r + 1) * D, lane); }
        VM_WAIT(); __syncthreads();
        int e1 = 0, e2 = 0, r1 = 0, r2 = 0; float w1 = 0.f, w2 = 0.f;
        { const int tt = wave & 3, kh = wave >> 2;
            const int rr = lane & 15, Gq = lane >> 4;
            f32x4 acc[3];
#pragma unroll
            for (int n = 0; n < 3; ++n) acc[n] = (f32x4){0.f, 0.f, 0.f, 0.f};
            u32x4 stg[14];
            auto gld = [&](int ch) { const int k0 = 256 * ch;
#pragma unroll
                for (int i = 0; i < 14; ++i) { const int c = tid + 512 * (i < 4 ? i : i < 8 ? i - 4 : i < 11 ? i - 8 : i - 11), row = c >> 5, pc = c & 31;
                    const bf16* src = i < 4 ? P.b(WS_XB) + (size_t)(base + row) * D : i < 8 ? P.b(WS_XLO) + (size_t)(base + row) * D : i < 11 ? WRT + (size_t)row * 2048 : WRT + (size_t)(48 + row) * 2048;
                    stg[i] = *(const u32x4*)(src + k0 + 8 * pc); } };
            gld(0);
#pragma unroll 1
            for (int ch = 0; ch < 8; ++ch) {
#pragma unroll
                for (int i = 0; i < 14; ++i) { const int c = tid + 512 * (i < 4 ? i : i < 8 ? i - 4 : i < 11 ? i - 8 : i - 11), row = c >> 5, pc = c & 31;
                    LAS unsigned char* dstb = i < 4 ? sxh : i < 8 ? sxl : i < 11 ? swh : swl; *(LAS u32x4*)(dstb + (row * RP + 8 * pc) * 2) = stg[i]; }
                __syncthreads();
                if (ch + 1 < 8) gld(ch + 1);
#pragma unroll
                for (int ks = 0; ks < 4; ++ks) { const int ko = (32 * (4 * kh + ks) + 8 * Gq) * 2;
                    const bf16x8 ah = *(const LAS bf16x8*)(sxh + (16 * tt + rr) * RP * 2 + ko), al = *(const LAS bf16x8*)(sxl + (16 * tt + rr) * RP * 2 + ko);
#pragma unroll
                    for (int n = 0; n < 3; ++n) { const bf16x8 bh = *(const LAS bf16x8*)(swh + (16 * n + rr) * RP * 2 + ko), bl = *(const LAS bf16x8*)(swl + (16 * n + rr) * RP * 2 + ko);
                        acc[n] = __builtin_amdgcn_mfma_f32_16x16x32_bf16(ah, bh, acc[n], 0, 0, 0); acc[n] = __builtin_amdgcn_mfma_f32_16x16x32_bf16(al, bh, acc[n], 0, 0, 0); acc[n] = __builtin_amdgcn_mfma_f32_16x16x32_bf16(ah, bl, acc[n], 0, 0, 0); } }
                __syncthreads(); }
            LAS float* lp = lgs + (kh * 4 + tt) * 768;
#pragma unroll
            for (int n = 0; n < 3; ++n)
#pragma unroll
                for (int i = 0; i < 4; ++i) lp[(4 * Gq + i) * 48 + 16 * n + rr] = acc[n][i]; }
        LDS_WAIT(); __syncthreads();
        if (wave < 4) {
            LAS float* lw_ = lgs + wave * 768;
            if (lane < 16) {
                const LAS float* lg = lw_ + lane * 48; const LAS float* lg2 = lg + 4 * 768;
                float gl[4]; int gs = 0;
#pragma unroll
                for (int e = 0; e < 4; ++e) gl[e] = (lg[e] + lg2[e]) + bg[e];
                float gmax = gl[0];
#pragma unroll
                for (int e = 1; e < 4; ++e) { if (gl[e] > gmax) { gmax = gl[e]; gs = e; } }
                float gsum = 0.f;
#pragma unroll
                for (int e = 0; e < 4; ++e) gsum += __expf(gl[e] - gmax);
                const float gwt = 1.0f / gsum;
                float el[8];
#pragma unroll
                for (int e = 0; e < 8; ++e) el[e] = (lg[4 + 8 * gs + e] + lg2[4 + 8 * gs + e]) + br[gs * 8 + e];
                int i1 = 0; float m1 = el[0];
#pragma unroll
                for (int e = 1; e < 8; ++e) if (el[e] > m1) { m1 = el[e]; i1 = e; }
                int i2 = -1; float m2 = -INFINITY;
#pragma unroll
                for (int e = 0; e < 8; ++e) if (e != i1 && el[e] > m2) { m2 = el[e]; i2 = e; }
                const float rx = __expf(m2 - m1); const float p1 = 1.0f / (1.0f + rx), p2 = rx * p1;
                e1 = gs * 8 + i1; e2 = gs * 8 + i2; w1 = gwt * p1; w2 = gwt * p2;
                r1 = (int)__hip_atomic_fetch_add(hist + e1, 1u, __ATOMIC_RELAXED, __HIP_MEMORY_SCOPE_WORKGROUP);
                r2 = (int)__hip_atomic_fetch_add(hist + e2, 1u, __ATOMIC_RELAXED, __HIP_MEMORY_SCOPE_WORKGROUP);
            }
        }
        LDS_WAIT(); __syncthreads();
        if (tid < 32) { const unsigned h = hist[tid]; gbase[tid] = h ? atomicAdd(cnt + tid, h) : 0u; }
        LDS_WAIT(); __syncthreads();
        if (wave < 4 && lane < 16) { const int t = base + 16 * wave + lane;
            toke[2 * t] = e1; toke[2 * t + 1] = e2; tokw[2 * t] = w1; tokw[2 * t + 1] = w2; tokr[2 * t] = (int)gbase[e1] + r1; tokr[2 * t + 1] = (int)gbase[e2] + r2; }
        __syncthreads();
    }
}
__device__ __forceinline__ void phase_moe_assign(Frame& F, const LP& P) {
    const int lane = F.lane;
    unsigned* cnt = (unsigned*)(P.ws + WS_CTL) + CW_CNT + 128 * P.l;
    const unsigned c = lane < 32 ? __hip_atomic_load(cnt + lane, __ATOMIC_RELAXED, __HIP_MEMORY_SCOPE_AGENT) : 0u;
    const unsigned padded = (c + 255u) & ~255u;
    unsigned incl = padded;
#pragma unroll
    for (int o = 1; o < 32; o <<= 1) { const unsigned v = __shfl_up(incl, o); if ((lane & 31) >= o) incl += v; }
    const unsigned pstart = incl - padded;
    if (F.gw == 0) {
        int* tile_e = (int*)(P.ws + WS_MOE + MO_TILEE); int* ntp = (int*)(P.ws + WS_MOE + MO_NT);
        if (lane < 32) for (unsigned r = pstart; r < incl; r += 256) tile_e[r >> 8] = lane;
        const unsigned total = __shfl(incl, 31); if (lane == 0) *ntp = (int)(total >> 8);
    }
    const int* toke = (const int*)(P.ws + WS_MOE + MO_TOKE); const float* tokw = (const float*)(P.ws + WS_MOE + MO_TOKW);
    int* tokp = (int*)(P.ws + WS_MOE + MO_TOKP); float* roww = (float*)(P.ws + WS_MOE + MO_ROWW); int* rowtok = (int*)(P.ws + WS_MOE + MO_ROWTOK);
    if (F.gw < 32) {
        const unsigned lo = __shfl(pstart, F.gw) + __shfl(c, F.gw), hi_ = __shfl(incl, F.gw);
        for (unsigned r = lo + lane; r < hi_; r += 64) { rowtok[r] = 0; roww[r] = 0.f; } }
#pragma unroll 1
    for (int i = F.gw * 64 + lane; i < 2 * S; i += F.NGW * 64) { const int e = toke[i];
        unsigned ps = 0u;
#pragma unroll
        for (int q = 0; q < 32; ++q) { const unsigned v = __shfl(pstart, q); ps = (e == q) ? v : ps; }
        const unsigned pos = (unsigned)tokp[i] + ps;
        tokp[i] = (int)pos; roww[pos] = tokw[i]; rowtok[pos] = i >> 1; }
}
__device__ __forceinline__ void phase_moe_combine(const Args& a, Frame& F, const LP& P, bool last) {
    const int l = P.l; const float* g = INF32(a, 37, D); const float* b = INF32(a, 38, D); const int* tokp = (const int*)(P.ws + WS_MOE + MO_TOKP);
    const int step = 2 * F.NGW; const int r0 = 2 * F.gw;
    RowRaw xa, xb_, ya0, ya1, yb0, yb1; int4 pn = {0, 0, 0, 0};
    if (r0 < S) { const int4 p = *(const int4*)(tokp + 2 * r0);
        row_fetch(xa, P.b(WS_XB) + (size_t)r0 * D, F.lane); row_fetch(xb_, P.b(WS_XB) + (size_t)(r0 + 1) * D, F.lane);
        row_fetch(ya0, P.b(WS_Y2) + (size_t)p.x * D, F.lane); row_fetch(yb0, P.b(WS_Y2) + (size_t)p.z * D, F.lane);
        row_fetch(ya1, P.b(WS_Y2) + (size_t)p.y * D, F.lane); row_fetch(yb1, P.b(WS_Y2) + (size_t)p.w * D, F.lane);
        if (r0 + step < S) pn = *(const int4*)(tokp + 2 * (r0 + step)); }
#pragma unroll 1
    for (int r = r0; r < S; r += step) { Row ra, rb;
        row_unpack(ra, xa); row_unpack(rb, xb_);
#pragma unroll
        for (int j = 0; j < 8; ++j) { ra.v[j] = ra.v[j] * DN_ALPHA; rb.v[j] = rb.v[j] * DN_ALPHA; }
        row_unpack_add(ra, ya0); row_unpack_add(rb, yb0); row_unpack_add(ra, ya1); row_unpack_add(rb, yb1);
        const int rn = r + step;
        if (rn < S) { const int4 p = pn;
            row_fetch(xa, P.b(WS_XB) + (size_t)rn * D, F.lane); row_fetch(xb_, P.b(WS_XB) + (size_t)(rn + 1) * D, F.lane);
            row_fetch(ya0, P.b(WS_Y2) + (size_t)p.x * D, F.lane); row_fetch(yb0, P.b(WS_Y2) + (size_t)p.z * D, F.lane);
            row_fetch(ya1, P.b(WS_Y2) + (size_t)p.y * D, F.lane); row_fetch(yb1, P.b(WS_Y2) + (size_t)p.w * D, F.lane);
            if (rn + step < S) pn = *(const int4*)(tokp + 2 * (rn + step)); }
        row_layernorm2(ra, rb, g, b, F.lane);
        if (last) { row_store_f32(ra, a.out + (size_t)r * D, F.lane); row_store_f32(rb, a.out + (size_t)(r + 1) * D, F.lane); }
        else { row_store_bf16(ra, P.b(WS_XB) + (size_t)r * D, F.lane); row_store_bf16(rb, P.b(WS_XB) + (size_t)(r + 1) * D, F.lane); } }
}

constexpr int NPH_LAYER = 17, NPHASES = 1 + DEPTH * NPH_LAYER;
__global__ void __launch_bounds__(NWAVES * 64, 2) mk_fwd(Args a) {
    extern __shared__ __attribute__((aligned(16))) unsigned char lds_raw[];
    Frame F;
    F.lds = (LAS unsigned char*)lds_raw;
    F.tid = threadIdx.x; F.lane = F.tid & 63; F.wave = __builtin_amdgcn_readfirstlane(F.tid >> 6);
    F.G = gridDim.x; F.gw = blockIdx.x * NWAVES + F.wave; F.NGW = F.G * NWAVES; F.ws = a.ws;
    volatile LAS unsigned* MISC = (volatile LAS unsigned*)(F.lds + MISC_OFF);
    if (F.tid < 32) MISC[F.tid] = 0u;
    __syncthreads();
    unsigned* ctl = (unsigned*)(a.ws + WS_CTL);
    XcdBarrier bar = xcd_barrier_post(ctl + CW_BAR + a.li * XCD_BAR_WORDS, MISC + 8);
    const int lo = a.ph_lo, hi = a.ph_hi;
#if defined(PHMASK)
#define IN(k) (((PHMASK >> (((k) == 0) ? 0 : (((k) - 1) % NPH_LAYER) + 1)) & 1) && lo <= (k) && (k) < hi)
#elif defined(PHSEL)
#define IN(k) ((((k) == 0) ? 0 : (((k) - 1) % NPH_LAYER) + 1) == PHSEL && lo <= (k) && (k) < hi)
#else
#define IN(k) (lo <= (k) && (k) < hi)
#endif
#define SEAM(k) do { if (IN((k) + 1)) xcd_barrier(bar); } while (0)
#ifdef DIAG_P1
#define STAMP(k) do { if (blockIdx.x == 0 && threadIdx.x == 0) ((volatile LAS unsigned long long*)(F.lds + MISC_OFF - 1024))[(k)] = wall_clock64(); } while (0)
#else
#define STAMP(k) do {} while (0)
#endif
#ifndef DUPMASK
#define DUPMASK 0
#endif
#define REPB(k) for (int rep_ = 0; rep_ < 1 + ((DUPMASK >> (k)) & 1); ++rep_) { if (rep_) xcd_barrier(bar);
#define REPE }
#define FRESH() do { int t_ = threadIdx.x; asm volatile("" : "+v"(t_)); F.tid = t_; F.lane = t_ & 63; F.wave = __builtin_amdgcn_readfirstlane(t_ >> 6); F.gw = blockIdx.x * NWAVES + F.wave; } while (0)
    const int G = F.G, bx = blockIdx.x;

    if (IN(0)) { FRESH(); STAMP(0); REPB(0) phase_prologue(a, F); REPE SEAM(0); }

    for (int l = 0; l < DEPTH; ++l) {
        LP P; P.ws = a.ws; P.wl = a.ws + WS_WL0 + (size_t)l * WS_WLSTRIDE; P.l = l;
        const int pb = 1 + NPH_LAYER * l;
        if (IN(pb + 0)) { FRESH(); STAMP(pb + 0); REPB(1) pg8::Gemm g{P.b(WS_XB), P.w(WO_WIN), D, D, D, nullptr}; pg8::StaticOrder so; so.init(S, NIN, G, bx);
            EpiIn E{P.b(WS_GATE), P.b(WS_U2), (const float*)(P.wl + WO_BIASP)}; pg8::gemm_phase(F.lds, g, so, E);
            { const int nun = (S / 256) * (NIN / 256), rem = nun % G, nlight = rem ? G - rem : G;
              FRESH(); if (bx >= G - nlight) memkv_items(P, (bx - (G - nlight)) * NWAVES + F.wave, nlight * NWAVES, F.lane); }
            REPE SEAM(pb + 0); }
        if (IN(pb + 1)) { FRESH(); STAMP(pb + 1); REPB(2) phase_prep(a, F, P); REPE SEAM(pb + 1); }
        if (IN(pb + 2)) { FRESH(); STAMP(pb + 2); REPB(3)
            { pg8::Gemm g{P.b(WS_U2) + U2_CQ, P.w(WO_WUQ), U2W, 512, 512, nullptr}; pg8::StaticOrder so; so.init(S, 768, G, bx);
              EpiQM<WS_QM, WS_RSTD, WS_ROPE> E{P.ws}; pg8::gemm_phase(F.lds, g, so, E); }
            { pg8::Gemm g{P.b(WS_U2) + U2_CKV, P.w(WO_WUKV), U2W, 256, 256, nullptr}; pg8::StaticOrder so; so.init(S, 1024, G, bx);
              EpiScale E{P.b(WS_KVH), 1024, P.f(WS_RSTD) + S, 1.0f, 0}; pg8::gemm_phase(F.lds, g, so, E); }
            phase_compress2(F, P); REPE SEAM(pb + 2); }
        if (IN(pb + 3)) { FRESH(); STAMP(pb + 3); REPB(4) phase_d(F, P); REPE SEAM(pb + 3); }
        if (IN(pb + 4)) { FRESH(); STAMP(pb + 4); REPB(5) phase_e(F, P); REPE SEAM(pb + 4); }
        if (IN(pb + 5)) { FRESH(); STAMP(pb + 5); REPB(6) phase_f(F, P); REPE SEAM(pb + 5); }
        if (IN(pb + 6)) { FRESH(); STAMP(pb + 6); REPB(7) pg8::Gemm g{P.b(WS_ABR), P.w(WO_WBR), D, D, D, nullptr}; pg8::StaticOrder so; so.init(S, D, G, bx);
            EpiMerge E{P.b(WS_GATE), P.b(WS_MERGED)};
            for (int sk_ = 0; sk_ < ((bx >> 3) & 3); ++sk_) __builtin_amdgcn_s_sleep(100);
            pg8::gemm_phase(F.lds, g, so, E); REPE SEAM(pb + 6); }
        if (IN(pb + 7)) { FRESH(); STAMP(pb + 7); REPB(8) pg8::Gemm g{P.b(WS_MERGED), P.w(WO_WOUT), D, D, D, nullptr}; pg8::StaticOrder so; so.init(S, D, G, bx);
            EpiResid E{P.b(WS_XB), P.b(WS_Y)}; pg8::gemm_phase(F.lds, g, so, E); REPE SEAM(pb + 7); }
        if (IN(pb + 8)) { FRESH(); STAMP(pb + 8); REPB(9) phase_ln(a, F, P, 23, 24); REPE SEAM(pb + 8); }
        if (IN(pb + 9)) { FRESH(); STAMP(pb + 9); REPB(10) pg8::Gemm g{P.b(WS_XB), P.w(WO_WXQ), D, D, D, nullptr}; pg8::StaticOrder so; so.init(S, 512, G, bx);
            EpiScale E{P.b(WS_QX), 512, nullptr, 0.08838834764831845f * LOG2E, 0}; pg8::gemm_phase(F.lds, g, so, E); REPE SEAM(pb + 9); }
        if (IN(pb + 10)) { FRESH(); STAMP(pb + 10); REPB(11) phase_xattn(F, P); REPE SEAM(pb + 10); }
        if (IN(pb + 11)) { FRESH(); STAMP(pb + 11); REPB(12) pg8::Gemm g{P.b(WS_OX), P.w(WO_WXO), 512, 512, 512, nullptr}; pg8::StaticOrder so; so.init(S, D, G, bx);
            EpiResid E{P.b(WS_XB), P.b(WS_Y)}; pg8::gemm_phase(F.lds, g, so, E); REPE SEAM(pb + 11); }
        if (IN(pb + 12)) { FRESH(); STAMP(pb + 12); REPB(13) phase_ln_router(a, F, P); REPE SEAM(pb + 12); }
        if (IN(pb + 13)) { FRESH(); STAMP(pb + 13); REPB(14) phase_moe_assign(F, P); REPE SEAM(pb + 13); }
        if (IN(pb + 14)) { FRESH(); STAMP(pb + 14); REPB(15) const int* te = (const int*)(P.ws + WS_MOE + MO_TILEE); const int ntl = *(const int*)(P.ws + WS_MOE + MO_NT);
            pg8::Gemm g{P.b(WS_XB), P.w(WO_WEIN), D, D, D, (const int*)(P.ws + WS_MOE + MO_ROWTOK)}; pg8::GroupedGather so{te, ntl, 4, G, bx};
            EpiGlu E{P.b(WS_HS)}; pg8::gemm_phase(F.lds, g, so, E); REPE SEAM(pb + 14); }
        if (IN(pb + 15)) { FRESH(); STAMP(pb + 15); REPB(16) const int* te = (const int*)(P.ws + WS_MOE + MO_TILEE); const int ntl = *(const int*)(P.ws + WS_MOE + MO_NT);
            pg8::Gemm g{P.b(WS_HS), P.w(WO_WEOUT), 512, 512, 512, nullptr}; pg8::GroupedOrder so{te, ntl, 8, G, bx};
            EpiScale E{P.b(WS_Y2), D, (const float*)(P.ws + WS_MOE + MO_ROWW), 1.0f, 8}; pg8::gemm_phase(F.lds, g, so, E); REPE SEAM(pb + 15); }
        if (IN(pb + 16)) { FRESH(); STAMP(pb + 16); REPB(17) phase_moe_combine(a, F, P, l == DEPTH - 1); REPE SEAM(pb + 16); }
    }
#ifdef DIAG_P1
    STAMP(NPHASES);
    __syncthreads();
    if (blockIdx.x == 0) {
        volatile LAS unsigned long long* ts = (volatile LAS unsigned long long*)(F.lds + MISC_OFF - 1024);
        const float t1 = (float)(ts[DIAG_P1 + DIAG_N1] - ts[DIAG_P1]) * 0.01f, t2 = (float)(ts[DIAG_P2 + DIAG_N2] - ts[DIAG_P2]) * 0.01f;
        const float c1 = sqrtf(t1 * 0.1f);
        for (size_t i = threadIdx.x; i < (size_t)S * D; i += 512) a.out[i] = (i == 0) ? t2 : c1;
    }
#endif
#undef IN
#undef SEAM
}

#ifndef MK_PER_PHASE
#define MK_PER_PHASE 0
#endif
extern "C" void kernel_launch(void* const* d_in, const int* in_sizes, int n_in, void* d_out, int out_size, void* d_ws, size_t ws_size, hipStream_t stream) {
    static int grid = 0;
    if (grid == 0) {
        if (n_in != 39 || out_size != S * D || ws_size < WS_END) { fprintf(stderr, "kernel_launch: unexpected problem (n_in %d, out %d, ws %zu)\n", n_in, out_size, ws_size); grid = -1; return; }
        int dev = 0, cus = 0;
        if (hipGetDevice(&dev) != hipSuccess || hipDeviceGetAttribute(&cus, hipDeviceAttributeMultiprocessorCount, dev) != hipSuccess) { grid = -1; return; }
        if (hipFuncSetAttribute((const void*)mk_fwd, hipFuncAttributeMaxDynamicSharedMemorySize, LDS_BYTES) != hipSuccess) { fprintf(stderr, "kernel_launch: hipFuncSetAttribute failed\n"); grid = -1; return; }
        int per_cu = 0;
        if (hipOccupancyMaxActiveBlocksPerMultiprocessor(&per_cu, (const void*)mk_fwd, NWAVES * 64, LDS_BYTES) != hipSuccess || per_cu < 1) fprintf(stderr, "kernel_launch: occupancy query reports %d\n", per_cu);
        (void)hipGetLastError();
        grid = cus;
    }
    if (grid < 0) return;
    if (hipMemsetAsync((char*)d_ws + WS_CTL, 0, CTL_ZERO_BYTES, stream) != hipSuccess) return;
    Args a{};
    for (int i = 0; i < 39; ++i) a.in[i] = d_in[i];
    a.out = (float*)d_out; a.ws = (unsigned char*)d_ws; a.pad = 0;
#if MK_PER_PHASE
#ifndef MK_LAST
#define MK_LAST NPHASES
#endif
    for (int p = 0; p < MK_LAST; ++p) { a.ph_lo = p; a.ph_hi = p + 1; a.li = p; hipLaunchKernelGGL(mk_fwd, dim3(grid), dim3(NWAVES * 64), LDS_BYTES, stream, a); }
#else
    a.ph_lo = 0; a.ph_hi = NPHASES; a.li = 0;
    hipLaunchKernelGGL(mk_fwd, dim3(grid), dim3(NWAVES * 64), LDS_BYTES, stream, a);
#endif
}
```

```cpp
#include <hip/hip_runtime.h>
#include <cstdio>
#include <cstdint>

#define LAS __attribute__((address_space(3)))
#define GAS __attribute__((address_space(1)))
typedef unsigned short bf16;
typedef short bf16x8 __attribute__((ext_vector_type(8)));
typedef short s16x4 __attribute__((ext_vector_type(4)));
typedef float f32x2 __attribute__((ext_vector_type(2)));
typedef float f32x4 __attribute__((ext_vector_type(4)));
typedef float f32x16 __attribute__((ext_vector_type(16)));
typedef unsigned u32x2 __attribute__((ext_vector_type(2)));
typedef unsigned u32x4 __attribute__((ext_vector_type(4)));

constexpr int S = 16384, D = 2048, DEPTH = 2;
constexpr int IN_W = 11832;
constexpr int NIN = 12032;
constexpr int U2W = 3840;
constexpr int U2_Q = 0, U2_KV = 512, U2_POOL = 1280, U2_CQ = 1792, U2_CKV = 2304, U2_CONV = 2560, U2_G = 3584, U2_KR = 3616;
constexpr int NCMP = 1023;
constexpr int RMAX = 40960;
constexpr float DN_ALPHA = 1.4142135623730951f;
constexpr float LOG2E = 1.4426950408889634f;

typedef __bf16 bf16x2_t __attribute__((ext_vector_type(2)));
__device__ __forceinline__ unsigned cvt_pk_bf16(float lo, float hi) { const f32x2 v = {lo, hi}; const bf16x2_t b = __builtin_convertvector(v, bf16x2_t); return __builtin_bit_cast(unsigned, b); }
__device__ __forceinline__ float bf2f(unsigned short b) { return __uint_as_float(((unsigned)b) << 16); }
__device__ __forceinline__ float bflo(unsigned w) { return __uint_as_float(w << 16); }
__device__ __forceinline__ float bfhi(unsigned w) { return __uint_as_float(w & 0xffff0000u); }
__device__ __forceinline__ unsigned short f2bf(float f) { return (unsigned short)(cvt_pk_bf16(f, 0.f) & 0xffffu); }
template <int CTRL> __device__ __forceinline__ float dpp_f(float x) { return __uint_as_float((unsigned)__builtin_amdgcn_update_dpp(0, (int)__float_as_uint(x), CTRL, 0xF, 0xF, true)); }
__device__ __forceinline__ float lane_xor1(float x) { return dpp_f<0xB1>(x); }
__device__ __forceinline__ float lane_xor2(float x) { return dpp_f<0x4E>(x); }
__device__ __forceinline__ float row16_sum(float x) { x += dpp_f<0xB1>(x); x += dpp_f<0x4E>(x); x += dpp_f<0x141>(x); x += dpp_f<0x140>(x); return x; }
__device__ __forceinline__ float xsum16(float x) { const auto r = __builtin_amdgcn_permlane16_swap(__float_as_uint(x), __float_as_uint(x), false, false); return __uint_as_float(r[0]) + __uint_as_float(r[1]); }
__device__ __forceinline__ float xsum32(float x) { const auto r = __builtin_amdgcn_permlane32_swap(__float_as_uint(x), __float_as_uint(x), false, false); return __uint_as_float(r[0]) + __uint_as_float(r[1]); }
__device__ __forceinline__ float xmax16(float x) { const auto r = __builtin_amdgcn_permlane16_swap(__float_as_uint(x), __float_as_uint(x), false, false); return fmaxf(__uint_as_float(r[0]), __uint_as_float(r[1])); }
__device__ __forceinline__ float xmax32(float x) { const auto r = __builtin_amdgcn_permlane32_swap(__float_as_uint(x), __float_as_uint(x), false, false); return fmaxf(__uint_as_float(r[0]), __uint_as_float(r[1])); }
__device__ __forceinline__ float lane_xor32(float x, int hi) { const auto r = __builtin_amdgcn_permlane32_swap(__float_as_uint(x), __float_as_uint(x), false, false); return __uint_as_float(hi ? r[0] : r[1]); }
__device__ __forceinline__ float wave_sum(float v) { return xsum32(xsum16(row16_sum(v))); }
__device__ __forceinline__ float sigmoidf_(float x) { return 1.0f / (1.0f + __expf(-x)); }
#define LDS_WAIT() asm volatile("s_waitcnt lgkmcnt(0)" ::: "memory")
#define VM_WAIT() asm volatile("s_waitcnt vmcnt(0)" ::: "memory")

namespace pg8 {
constexpr int BM = 256, BK = 64, HALF = 128, HTB = HALF * BK * 2, STAGE_BYTES = 8 * HTB, NXCD = 8, WGM = 8;
__host__ __device__ __forceinline__ int lds_byte(int r, int c) { const int st = (r >> 4) * 2 + (c >> 5), rr = r & 15, cc = c & 31, ob = rr * 64 + cc * 2; return st * 1024 + (ob ^ (((ob >> 9) & 1) << 5)); }
__host__ __device__ __forceinline__ void stage_rc(int b, int& R, int& C) { const int st = b / 1024, sb = b % 1024, swz = sb ^ (((sb >> 9) & 1) << 5); R = (st >> 1) * 16 + swz / 64; C = (st & 1) * 32 + (swz % 64) / 2; }
__host__ __device__ __forceinline__ int perm32(int rho) { const int n = rho >> 4, i = rho & 15; return 8 * (i >> 2) + 4 * n + (i & 3); }

struct Unit { int pm, pn; };
struct Gemm { const bf16* A; const bf16* Bt; int lda, ldb, K; const int* rowtok; };

struct StaticOrder {
    static constexpr bool GATHER = false;
    int nM, nN, nwg, G, c;
    __device__ void init(int M, int N, int G_, int c_) { nM = M / BM; nN = N / BM; nwg = nM * nN; G = G_; c = c_; }
    __device__ bool next(int i, Unit& u) const {
        const long L = (long)i * G + c; if (L >= nwg) return false;
        int wgid = (int)L; { const int q = nwg / NXCD, r = nwg % NXCD, xcd = wgid % NXCD, off = wgid / NXCD; wgid = (xcd < r ? xcd * (q + 1) : r * (q + 1) + (xcd - r) * q) + off; }
        const int nig = WGM * nN, gid = wgid / nig, fm = gid * WGM, gsz = (nM - fm) < WGM ? (nM - fm) : WGM;
        u.pm = fm + ((wgid % nig) % gsz); u.pn = (wgid % nig) / gsz; return true;
    }
};
template <bool GATHER_> struct GroupedOrderT {
    static constexpr bool GATHER = GATHER_;
    const int* tile_expert; int ntiles, npn, G, c;
    __device__ bool next(int i, Unit& u) const {
        const long L = (long)i * G + c; if (L >= (long)ntiles * npn) return false;
        const int rt = (int)(L / npn), pn = (int)(L % npn);
        u.pm = rt; u.pn = __builtin_amdgcn_readfirstlane(tile_expert[rt]) * npn + pn; return true;
    }
};
typedef GroupedOrderT<false> GroupedOrder; typedef GroupedOrderT<true> GroupedGather;

template <class Epi, class Sched>
__device__ __forceinline__ void gemm_phase(LAS unsigned char* lds, const Gemm g, const Sched& S, const Epi& E) {
    int tid = threadIdx.x; asm volatile("" : "+v"(tid));
    const int wid = __builtin_amdgcn_readfirstlane(tid >> 6), lane = tid & 63, wr = wid >> 2, wc = wid & 3, fr = lane & 15, fq = lane >> 4;
    const int K = g.K, nt = K / BK;
    constexpr bool GATHER = Sched::GATHER;
    unsigned voffB[2], vAc[2][2], vAn[2][2]; int Rr[2], Cc[2];
#pragma unroll
    for (int i = 0; i < 2; ++i) { int R, C; stage_rc(tid * 16 + i * 8192, R, C); const int Rb = Epi::PERM ? ((R & ~31) + perm32(R & 31)) : R; Rr[i] = R; Cc[i] = C;
        voffB[i] = (unsigned)(Rb * g.ldb + C) * 2u;
#pragma unroll
        for (int h = 0; h < 2; ++h) { vAc[h][i] = (unsigned)((R + h * HALF) * g.lda + C) * 2u; vAn[h][i] = vAc[h][i]; } }
    const size_t kstep = (size_t)(BK * 2);
    const size_t hstepB = (size_t)HALF * g.ldb * 2;
    const size_t tstepA = (size_t)2 * HALF * g.lda * 2, tstepB = 2 * hstepB;
    const unsigned ldsw = (unsigned)wid * 1024u;
    const int aoff = lds_byte(wr * 64 + fr, fq * 8), boff = lds_byte(wc * 32 + fr, fq * 8);
#define PG8_GOFF(v, u) do { _Pragma("unroll") for (int _h = 0; _h < 2; ++_h) _Pragma("unroll") for (int _i = 0; _i < 2; ++_i) { \
        const int _t = g.rowtok[(u).pm * 256 + _h * HALF + Rr[_i]]; (v)[_h][_i] = (unsigned)(_t * g.lda + Cc[_i]) * 2u; } \
        _Pragma("unroll") for (int _h = 0; _h < 2; ++_h) _Pragma("unroll") for (int _i = 0; _i < 2; ++_i) asm volatile("" : "+v"((v)[_h][_i])); } while (0)
#define PG8_SA(b, h) (((b) * 2 + (h)) * HTB)
#define PG8_SB(b, h) ((4 + (b) * 2 + (h)) * HTB)
#define PG8_STAGE(bufoff, gbase, voff) do { _Pragma("unroll") for (int _i = 0; _i < 2; ++_i) \
        __builtin_amdgcn_global_load_lds((const unsigned*)((const char*)(gbase) + (voff)[_i]), (LAS unsigned*)(lds + (bufoff) + ldsw + _i * 8192), 16, 0, 0); } while (0)
#define PG8_LDA(dst, b, h) do { _Pragma("unroll") for (int m = 0; m < 4; ++m) _Pragma("unroll") for (int k = 0; k < 2; ++k) dst[m][k] = *(const LAS bf16x8*)(lds + PG8_SA(b, h) + aoff + m * 2048 + k * 1024); } while (0)
#define PG8_LDB(dst, b, h) do { _Pragma("unroll") for (int n = 0; n < 2; ++n) _Pragma("unroll") for (int k = 0; k < 2; ++k) dst[n][k] = *(const LAS bf16x8*)(lds + PG8_SB(b, h) + boff + n * 2048 + k * 1024); } while (0)
#define PG8_MMA(ai, bj, At, Bt) do { __builtin_amdgcn_s_setprio(1); _Pragma("unroll") for (int m = 0; m < 4; ++m) _Pragma("unroll") for (int n = 0; n < 2; ++n) _Pragma("unroll") for (int k = 0; k < 2; ++k) \
        acc[ai][bj][m][n] = __builtin_amdgcn_mfma_f32_16x16x32_bf16(Bt[n][k], At[m][k], acc[ai][bj][m][n], 0, 0, 0); __builtin_amdgcn_s_setprio(0); } while (0)
#define PG8_WAIT_V(n) asm volatile("s_waitcnt vmcnt(" #n ")" ::: "memory")
#define PG8_WAIT_L(n) asm volatile("s_waitcnt lgkmcnt(" #n ")" ::: "memory")
#define PG8_BAR __builtin_amdgcn_s_barrier()
#define PG8_SCHED __builtin_amdgcn_sched_barrier(0)
    Unit cur, nxt; int ui = 0;
    if (!S.next(0, cur)) return;
    f32x4 acc[2][2][4][2];
#pragma unroll
    for (int a = 0; a < 2; ++a)
#pragma unroll
        for (int b = 0; b < 2; ++b)
#pragma unroll
            for (int m = 0; m < 4; ++m)
#pragma unroll
                for (int n = 0; n < 2; ++n) acc[a][b][m][n] = (f32x4){0.f, 0.f, 0.f, 0.f};
    bf16x8 At[4][2], B0[2][2], B1[2][2];
    if constexpr (GATHER) PG8_GOFF(vAc, cur);
    const char* cA = (const char*)g.A + (GATHER ? (size_t)0 : (size_t)cur.pm * tstepA); const char* cB = (const char*)g.Bt + (size_t)cur.pn * tstepB;
    PG8_STAGE(PG8_SB(0, 0), cB, voffB); PG8_STAGE(PG8_SB(0, 1), cB + hstepB, voffB); PG8_STAGE(PG8_SA(0, 0), cA, vAc[0]); PG8_STAGE(PG8_SA(0, 1), cA, vAc[1]);
    if (wr == 1) PG8_BAR;
    PG8_WAIT_V(2); PG8_BAR;
    PG8_STAGE(PG8_SB(1, 0), cB + kstep, voffB); PG8_STAGE(PG8_SA(1, 0), cA + kstep, vAc[0]); PG8_STAGE(PG8_SB(1, 1), cB + hstepB + kstep, voffB);
    PG8_WAIT_V(6); PG8_BAR;
    for (;;) {
        const bool has_next = S.next(ui + 1, nxt);
        if constexpr (GATHER) { if (has_next) PG8_GOFF(vAn, nxt); }
        const char* nA = GATHER ? cA : (has_next ? (const char*)g.A + (size_t)nxt.pm * tstepA : cA); const char* nB = has_next ? (const char*)g.Bt + (size_t)nxt.pn * tstepB : cB;
        for (int t = 0; t < nt; t += 2) {
            const bool last = (t == nt - 2);
            const char* a1 = cA + (size_t)(t + 1) * kstep;
            const char* a2 = last ? nA : cA + (size_t)(t + 2) * kstep; const char* b2 = last ? nB : cB + (size_t)(t + 2) * kstep;
            const char* a3 = a2 + kstep; const char* b3 = b2 + kstep;
            unsigned v2[2][2];
#pragma unroll
            for (int h = 0; h < 2; ++h)
#pragma unroll
                for (int i = 0; i < 2; ++i) v2[h][i] = (GATHER && last && has_next) ? vAn[h][i] : vAc[h][i];
            if constexpr (Epi::MIDK > 0) { if (t > 0 && (t % Epi::MIDK) == 0) { if (wr == 0) PG8_BAR; PG8_SCHED; E.mid(acc, cur, t / Epi::MIDK, wr, wc, fr, fq); PG8_SCHED; if (wr == 1) PG8_BAR; } }
            PG8_LDB(B0, 0, 0); PG8_LDB(B1, 0, 1); PG8_SCHED; PG8_LDA(At, 0, 0); PG8_STAGE(PG8_SA(1, 1), a1, vAc[1]);
            PG8_WAIT_V(8); PG8_WAIT_L(0); PG8_BAR; PG8_MMA(0, 0, At, B0); PG8_MMA(0, 1, At, B1); PG8_BAR; PG8_SCHED;
            PG8_LDA(At, 0, 1); PG8_STAGE(PG8_SB(0, 0), b2, voffB); PG8_STAGE(PG8_SB(0, 1), b2 + hstepB, voffB); PG8_STAGE(PG8_SA(0, 0), a2, v2[0]);
            PG8_WAIT_V(8); PG8_WAIT_L(0); PG8_BAR; PG8_MMA(1, 0, At, B0); PG8_MMA(1, 1, At, B1); PG8_BAR; PG8_SCHED;
            PG8_LDB(B0, 1, 0); PG8_LDB(B1, 1, 1); PG8_SCHED; PG8_LDA(At, 1, 0); PG8_STAGE(PG8_SA(0, 1), a2, v2[1]);
            PG8_WAIT_V(8); PG8_WAIT_L(0); PG8_BAR; PG8_MMA(0, 0, At, B0); PG8_MMA(0, 1, At, B1); PG8_BAR; PG8_SCHED;
            PG8_LDA(At, 1, 1); PG8_STAGE(PG8_SB(1, 0), b3, voffB); PG8_STAGE(PG8_SB(1, 1), b3 + hstepB, voffB); PG8_STAGE(PG8_SA(1, 0), a3, v2[0]);
            PG8_WAIT_V(8); PG8_WAIT_L(0); PG8_BAR; PG8_MMA(1, 0, At, B0); PG8_MMA(1, 1, At, B1); PG8_BAR; PG8_SCHED;
        }
        if (wr == 0) PG8_BAR;
        E(acc, cur, wr, wc, fr, fq);
        if (!has_next) break;
#pragma unroll
        for (int a = 0; a < 2; ++a)
#pragma unroll
            for (int b = 0; b < 2; ++b)
#pragma unroll
                for (int m = 0; m < 4; ++m)
#pragma unroll
                    for (int n = 0; n < 2; ++n) acc[a][b][m][n] = (f32x4){0.f, 0.f, 0.f, 0.f};
        cur = nxt; cA = nA; cB = nB; ++ui;
        if constexpr (GATHER) {
#pragma unroll
            for (int h = 0; h < 2; ++h)
#pragma unroll
                for (int i = 0; i < 2; ++i) vAc[h][i] = vAn[h][i]; }
        if (wr == 1) PG8_BAR;
    }
    PG8_WAIT_V(0);
    PG8_BAR;
#undef PG8_GOFF
#undef PG8_SA
#undef PG8_SB
#undef PG8_STAGE
#undef PG8_LDA
#undef PG8_LDB
#undef PG8_MMA
#undef PG8_WAIT_V
#undef PG8_WAIT_L
#undef PG8_BAR
#undef PG8_SCHED
}
}

__device__ __forceinline__ float fast_sigmoid(float x) { return __builtin_amdgcn_rcpf(1.0f + __builtin_amdgcn_exp2f(-x * LOG2E)); }
__device__ __forceinline__ u32x4 pack8(const f32x4 v0, const f32x4 v1) { u32x4 w; w.x = cvt_pk_bf16(v0[0], v0[1]); w.y = cvt_pk_bf16(v0[2], v0[3]); w.z = cvt_pk_bf16(v1[0], v1[1]); w.w = cvt_pk_bf16(v1[2], v1[3]); return w; }

struct EpiIn {
    static constexpr bool PERM = true; static constexpr int MIDK = 0;
    bf16* gate; bf16* u2; const float* bias;
    __device__ __forceinline__ void operator()(const f32x4 (&acc)[2][2][4][2], const pg8::Unit& u, int wr, int wc, int fr, int fq) const {
        const int row0 = u.pm * 256 + wr * 64 + fr; const bool isg = u.pn < 32;
        bf16* base = isg ? gate : u2; const int ldc = isg ? 8192 : U2W; const int colt = isg ? u.pn * 256 : (u.pn - 32) * 256;
        const int col0 = colt + wc * 32 + 8 * fq, bcol0 = u.pn * 256 + wc * 32 + 8 * fq;
        f32x4 bv[2][2];
#pragma unroll
        for (int bj = 0; bj < 2; ++bj)
#pragma unroll
            for (int n = 0; n < 2; ++n) bv[bj][n] = *(const f32x4*)(bias + bcol0 + bj * 128 + 4 * n);
#pragma unroll
        for (int ai = 0; ai < 2; ++ai)
#pragma unroll
            for (int m = 0; m < 4; ++m) { bf16* rowp = base + (size_t)(row0 + ai * 128 + m * 16) * ldc + col0;
#pragma unroll
                for (int bj = 0; bj < 2; ++bj) { f32x4 v0 = acc[ai][bj][m][0] + bv[bj][0], v1 = acc[ai][bj][m][1] + bv[bj][1];
                    if (isg) {
#pragma unroll
                        for (int j = 0; j < 4; ++j) { v0[j] = fast_sigmoid(v0[j]); v1[j] = fast_sigmoid(v1[j]); } }
                    *(u32x4*)(rowp + bj * 128) = pack8(v0, v1); } }
    }
};
struct EpiScale {
    static constexpr bool PERM = true; static constexpr int MIDK = 0;
    bf16* O; int ldc; const float* rowscale; float cs; int npn_mod;
    __device__ __forceinline__ void operator()(const f32x4 (&acc)[2][2][4][2], const pg8::Unit& u, int wr, int wc, int fr, int fq) const {
        const int row0 = u.pm * 256 + wr * 64 + fr; const int pnl = npn_mod ? (u.pn % npn_mod) : u.pn;
        const int col0 = pnl * 256 + wc * 32 + 8 * fq;
#pragma unroll
        for (int ai = 0; ai < 2; ++ai)
#pragma unroll
            for (int m = 0; m < 4; ++m) { const int row = row0 + ai * 128 + m * 16; const float sc = (rowscale ? rowscale[row] : 1.0f) * cs;
                bf16* rowp = O + (size_t)row * ldc + col0;
#pragma unroll
                for (int bj = 0; bj < 2; ++bj) *(u32x4*)(rowp + bj * 128) = pack8(acc[ai][bj][m][0] * sc, acc[ai][bj][m][1] * sc); }
    }
};
template <size_t OFF_O, size_t OFF_RS, size_t OFF_ROPE>
struct EpiQM {
    static constexpr bool PERM = true; static constexpr int MIDK = 0;
    unsigned char* ws;
    __device__ __forceinline__ void operator()(const f32x4 (&acc)[2][2][4][2], const pg8::Unit& u, int wr, int wc, int fr, int fq) const {
        const int row0 = u.pm * 256 + wr * 64 + fr; const int col0 = u.pn * 256 + wc * 32 + 8 * fq;
        bf16* O = (bf16*)(ws + OFF_O); const float* rowscale = (const float*)(ws + OFF_RS); const f32x2* rope = (const f32x2*)(ws + OFF_ROPE);
        const float qs = 0.10206207261596577f * LOG2E;
#pragma unroll
        for (int ai = 0; ai < 2; ++ai)
#pragma unroll
            for (int m = 0; m < 4; ++m) { const int row = row0 + ai * 128 + m * 16; const float sc = rowscale[row] * qs;
                asm volatile("" ::: "memory");
                bf16* rowp = O + (size_t)row * 768 + col0;
#pragma unroll
                for (int bj = 0; bj < 2; ++bj) { f32x4 v0 = acc[ai][bj][m][0] * sc, v1 = acc[ai][bj][m][1] * sc;
                    if ((8 * u.pn + 4 * bj + wc) % 3 == 2) {
                        const f32x4* rp = (const f32x4*)(rope + (size_t)row * 16 + 8 * (fq & 1));
                        const float sg = fq < 2 ? -1.0f : 1.0f;
                        { const f32x4 c01 = rp[0], c23 = rp[1]; const float q0 = __shfl_xor(v0[0], 32), q1 = __shfl_xor(v0[1], 32), q2 = __shfl_xor(v0[2], 32), q3 = __shfl_xor(v0[3], 32);
                          v0[0] = v0[0] * c01[0] + sg * q0 * c01[1]; v0[1] = v0[1] * c01[2] + sg * q1 * c01[3]; v0[2] = v0[2] * c23[0] + sg * q2 * c23[1]; v0[3] = v0[3] * c23[2] + sg * q3 * c23[3]; }
                        asm volatile("" ::: "memory");
                        { const f32x4 c45 = rp[2], c67 = rp[3]; const float q0 = __shfl_xor(v1[0], 32), q1 = __shfl_xor(v1[1], 32), q2 = __shfl_xor(v1[2], 32), q3 = __shfl_xor(v1[3], 32);
                          v1[0] = v1[0] * c45[0] + sg * q0 * c45[1]; v1[1] = v1[1] * c45[2] + sg * q1 * c45[3]; v1[2] = v1[2] * c67[0] + sg * q2 * c67[1]; v1[3] = v1[3] * c67[2] + sg * q3 * c67[3]; } }
                    *(u32x4*)(rowp + bj * 128) = pack8(v0, v1); } }
    }
};
struct EpiGlu {
    static constexpr bool PERM = true; static constexpr int MIDK = 0;
    bf16* H;
    __device__ __forceinline__ void operator()(const f32x4 (&acc)[2][2][4][2], const pg8::Unit& u, int wr, int wc, int fr, int fq) const {
        const int row0 = u.pm * 256 + wr * 64 + fr; const int col0 = (u.pn & 3) * 128 + wc * 32 + 8 * fq;
#pragma unroll
        for (int ai = 0; ai < 2; ++ai)
#pragma unroll
            for (int m = 0; m < 4; ++m) { f32x4 o[2];
#pragma unroll
                for (int n = 0; n < 2; ++n)
#pragma unroll
                    for (int j = 0; j < 4; ++j) { const float a = acc[ai][0][m][n][j], b = acc[ai][1][m][n][j]; o[n][j] = a * fast_sigmoid(a) * b; }
                *(u32x4*)(H + (size_t)(row0 + ai * 128 + m * 16) * 512 + col0) = pack8(o[0], o[1]); }
    }
};
struct EpiResid {
    static constexpr bool PERM = true; static constexpr int MIDK = 0;
    const bf16* X; bf16* Y;
    __device__ __forceinline__ void operator()(const f32x4 (&acc)[2][2][4][2], const pg8::Unit& u, int wr, int wc, int fr, int fq) const {
        const int row0 = u.pm * 256 + wr * 64 + fr, col0 = u.pn * 256 + wc * 32 + 8 * fq;
#pragma unroll
        for (int ai = 0; ai < 2; ++ai)
#pragma unroll
            for (int m = 0; m < 4; ++m) { const size_t ro = (size_t)(row0 + ai * 128 + m * 16) * D + col0;
#pragma unroll
                for (int bj = 0; bj < 2; ++bj) { const u32x4 xv = *(const u32x4*)(X + ro + bj * 128); f32x4 v0, v1;
                    v0[0] = bflo(xv.x) * DN_ALPHA + acc[ai][bj][m][0][0]; v0[1] = bfhi(xv.x) * DN_ALPHA + acc[ai][bj][m][0][1]; v0[2] = bflo(xv.y) * DN_ALPHA + acc[ai][bj][m][0][2]; v0[3] = bfhi(xv.y) * DN_ALPHA + acc[ai][bj][m][0][3];
                    v1[0] = bflo(xv.z) * DN_ALPHA + acc[ai][bj][m][1][0]; v1[1] = bfhi(xv.z) * DN_ALPHA + acc[ai][bj][m][1][1]; v1[2] = bflo(xv.w) * DN_ALPHA + acc[ai][bj][m][1][2]; v1[3] = bfhi(xv.w) * DN_ALPHA + acc[ai][bj][m][1][3];
                    *(u32x4*)(Y + ro + bj * 128) = pack8(v0, v1); } }
    }
};
struct EpiMerge {
    static constexpr bool PERM = true; static constexpr int MIDK = 8;
    const bf16* gate; bf16* O;
    __device__ __forceinline__ void mid(f32x4 (&acc)[2][2][4][2], const pg8::Unit& u, int seg, int wr, int wc, int fr, int fq) const {
        int row0 = u.pm * 256 + wr * 64 + fr; const int col0 = u.pn * 256 + wc * 32 + 8 * fq; asm volatile("" : "+v"(row0));
#pragma unroll
        for (int ai = 0; ai < 2; ++ai)
#pragma unroll
            for (int m = 0; m < 4; ++m) { const bf16* gp = gate + (size_t)(row0 + ai * 128 + m * 16) * 8192 + (size_t)(seg - 1) * 2048 + col0;
#pragma unroll
                for (int bj = 0; bj < 2; ++bj) { const u32x4 a = *(const u32x4*)(gp + bj * 128), b = *(const u32x4*)(gp + 2048 + bj * 128);
#pragma unroll
                    for (int q = 0; q < 4; ++q) { const float r0 = fmaxf(bflo(a[q]), 1e-30f) * __builtin_amdgcn_rcpf(fmaxf(bflo(b[q]), 1e-30f)), r1 = fmaxf(bfhi(a[q]), 1e-30f) * __builtin_amdgcn_rcpf(fmaxf(bfhi(b[q]), 1e-30f));
                        acc[ai][bj][m][q >> 1][(q & 1) * 2] *= r0; acc[ai][bj][m][q >> 1][(q & 1) * 2 + 1] *= r1; } }
                asm volatile("" ::: "memory"); }
    }
    __device__ __forceinline__ void operator()(const f32x4 (&acc)[2][2][4][2], const pg8::Unit& u, int wr, int wc, int fr, int fq) const {
        const int row0 = u.pm * 256 + wr * 64 + fr, col0 = u.pn * 256 + wc * 32 + 8 * fq;
#pragma unroll
        for (int ai = 0; ai < 2; ++ai)
#pragma unroll
            for (int m = 0; m < 4; ++m) { const int row = row0 + ai * 128 + m * 16; const bf16* gp = gate + (size_t)row * 8192 + 3 * 2048 + col0;
#pragma unroll
                for (int bj = 0; bj < 2; ++bj) { const u32x4 a = *(const u32x4*)(gp + bj * 128); f32x4 v0, v1;
                    v0[0] = acc[ai][bj][m][0][0] * fmaxf(bflo(a[0]), 1e-30f); v0[1] = acc[ai][bj][m][0][1] * fmaxf(bfhi(a[0]), 1e-30f);
                    v0[2] = acc[ai][bj][m][0][2] * fmaxf(bflo(a[1]), 1e-30f); v0[3] = acc[ai][bj][m][0][3] * fmaxf(bfhi(a[1]), 1e-30f);
                    v1[0] = acc[ai][bj][m][1][0] * fmaxf(bflo(a[2]), 1e-30f); v1[1] = acc[ai][bj][m][1][1] * fmaxf(bfhi(a[2]), 1e-30f);
                    v1[2] = acc[ai][bj][m][1][2] * fmaxf(bflo(a[3]), 1e-30f); v1[3] = acc[ai][bj][m][1][3] * fmaxf(bfhi(a[3]), 1e-30f);
                    *(u32x4*)(O + (size_t)row * D + col0 + bj * 128) = pack8(v0, v1); } }
    }
};

#define XB_TMO      128
#define XB_XCNT(j)  (256  + 64 * (j))
#define XB_XSUB(j)  (1280 + 64 * (j))
#define XB_XGEN(j)  (2304 + 64 * (j))
#define XB_TOP      3328
#define XB_TOPGEN   3392
#define XCD_BAR_WORDS 3456
#define XB_SPIN_CAP (1u << 25)
__device__ __forceinline__ unsigned xb_ld(unsigned* p)              { return __hip_atomic_load(p, __ATOMIC_RELAXED, __HIP_MEMORY_SCOPE_AGENT); }
__device__ __forceinline__ unsigned xb_add(unsigned* p, unsigned v) { return __hip_atomic_fetch_add(p, v, __ATOMIC_RELAXED, __HIP_MEMORY_SCOPE_AGENT); }
__device__ __forceinline__ unsigned xb_xcc_id() { return (unsigned)__builtin_amdgcn_s_getreg((3 << 11) | 20) & 0xFu; }
#define XB_SPIN(cond, bar) do { unsigned _sp = 0; while (cond) { __builtin_amdgcn_s_sleep(1); \
    if ((++_sp & 255u) == 0u) { if (xb_ld(&(bar)[XB_TMO])) break; if (_sp > XB_SPIN_CAP) { atomicAdd(&(bar)[XB_TMO], 1u); break; } } } } while (0)
struct XcdBarrier { unsigned* bar; unsigned x; volatile LAS unsigned* st; };
__device__ __forceinline__ XcdBarrier xcd_barrier_post(unsigned* bar, volatile LAS unsigned* st) {
    XcdBarrier b; b.bar = bar; b.x = xb_xcc_id(); b.st = st;
    if (threadIdx.x == 0) (void)xb_add(&bar[XB_XCNT(b.x)], 1u);
    return b;
}
__device__ __forceinline__ void xcd_barrier_complete(unsigned* bar, unsigned x, unsigned& nloc, unsigned& nx) {
    const unsigned G = gridDim.x * gridDim.y * gridDim.z;
    unsigned sum, cnt, mine, sp = 0u;
    for (;;) {
        sum = 0u; cnt = 0u; mine = 0u;
#pragma unroll
        for (unsigned j = 0; j < 16; ++j) { const unsigned c = xb_ld(&bar[XB_XCNT(j)]); sum += c; cnt += (c > 0u) ? 1u : 0u; mine = (j == x) ? c : mine; }
        if (sum == G) break;
        __builtin_amdgcn_s_sleep(1);
        if ((++sp & 255u) == 0u) { if (xb_ld(&bar[XB_TMO])) break; if (sp > XB_SPIN_CAP) { atomicAdd(&bar[XB_TMO], 1u); break; } }
    }
    nloc = mine > 0u ? mine : 1u; nx = cnt > 0u ? cnt : 1u;
}
__device__ __forceinline__ void xcd_barrier(const XcdBarrier& b) {
    asm volatile("s_waitcnt vmcnt(0)" ::: "memory");
    __syncthreads();
    if (threadIdx.x == 0) {
        unsigned* bar = b.bar;
        __builtin_amdgcn_s_waitcnt(0);
        unsigned nloc = b.st[0], nx = b.st[1];
        if (nloc == 0u) { xcd_barrier_complete(bar, b.x, nloc, nx); b.st[0] = nloc; b.st[1] = nx; }
        const unsigned old = xb_add(&bar[XB_XSUB(b.x)], 1u);
        const unsigned gen = old / nloc;
        if (old + 1u == (gen + 1u) * nloc) {
            __builtin_amdgcn_fence(__ATOMIC_RELEASE, "agent");
            asm volatile("s_waitcnt vmcnt(0)" ::: "memory");
            const unsigned og = xb_add(&bar[XB_TOP], 1u);
            const unsigned tg = og / nx;
            if (og + 1u == (tg + 1u) * nx) xb_add(&bar[XB_TOPGEN], 1u);
            else XB_SPIN(xb_ld(&bar[XB_TOPGEN]) == tg, bar);
            __builtin_amdgcn_fence(__ATOMIC_ACQUIRE, "agent");
            xb_add(&bar[XB_XGEN(b.x)], 1u);
            asm volatile("s_waitcnt vmcnt(0)" ::: "memory");
        } else {
            XB_SPIN(xb_ld(&bar[XB_XGEN(b.x)]) == gen, bar);
            __builtin_amdgcn_fence(__ATOMIC_ACQUIRE, "agent");
            asm volatile("s_waitcnt vmcnt(0)" ::: "memory");
        }
    }
    __syncthreads();
}

constexpr size_t MiB = 1u << 20;
constexpr size_t WS_CTL = 0, CTL_ZERO_BYTES = 1 * MiB;
constexpr size_t WS_WL0 = 2 * MiB, WS_WLSTRIDE = 272 * MiB;
constexpr size_t WO_WIN = 0, WO_WBR = 48 * MiB, WO_WOUT = 56 * MiB, WO_WXQ = 64 * MiB, WO_WXK = 66 * MiB, WO_WXV = 68 * MiB, WO_WXO = 70 * MiB, WO_WUQ = 72 * MiB, WO_WUKV = 73 * MiB,
                 WO_W1C = 74 * MiB, WO_W2C = 75 * MiB, WO_BIASP = 76 * MiB, WO_B1C = 77 * MiB, WO_WRT = 78 * MiB, WO_WEIN = 80 * MiB, WO_WEOUT = 208 * MiB;
constexpr size_t WS_XLO = 546 * MiB, WS_XB = 674 * MiB, WS_GATE = 738 * MiB, WS_U2 = 994 * MiB, WS_ABR = 1114 * MiB, WS_MERGED = 1178 * MiB, WS_QH = 1242 * MiB, WS_KVH = 1266 * MiB,
                 WS_QM = 1298 * MiB, WS_KM = 1322 * MiB, WS_VTM = 1346 * MiB, WS_VTSEL = 1362 * MiB, WS_VTWIN = 1366 * MiB, WS_KC = 1370 * MiB, WS_VCT = 1371 * MiB, WS_HID = 1372 * MiB,
                 WS_OCMP = 1373 * MiB, WS_OWIN = 1389 * MiB, WS_SCORES = 1405 * MiB, WS_IDX = 1437 * MiB, WS_NV = 1439 * MiB, WS_RSTD = 1440 * MiB, WS_ROPE = 1441 * MiB, WS_QX = 1443 * MiB,
                 WS_OX = 1459 * MiB, WS_KX = 1475 * MiB, WS_VXT = 1476 * MiB, WS_MEMB = 1477 * MiB, WS_CSTAT = 1478 * MiB, WS_MOE = 1479 * MiB, WS_Y = 1481 * MiB, WS_END = 1609 * MiB;
constexpr size_t WS_XS = WS_GATE, WS_Y2 = WS_GATE + 160 * MiB, WS_HS = WS_GATE + 320 * MiB;
static_assert(WS_HS + 40 * MiB <= WS_ABR, "MoE overlay");
constexpr int CW_CNT = 1024;
constexpr int CW_BAR = 4096;
constexpr size_t MO_TOKE = 0, MO_TOKW = 128 * 1024, MO_TOKP = 256 * 1024, MO_ROWW = 384 * 1024, MO_TILEE = 640 * 1024, MO_NT = 644 * 1024, MO_ROWTOK = 768 * 1024;

constexpr int RING_BYTES = 131072;
constexpr int LDS_BYTES = 147456;
constexpr int MISC_OFF = LDS_BYTES - 512;

constexpr int NWAVES = 8;
struct Args { const void* in[39]; float* out; unsigned char* ws; int ph_lo, ph_hi, li, pad; };
static_assert(sizeof(Args) == 39 * 8 + 8 + 8 + 16, "Args has no padding");

struct Frame {
    LAS unsigned char* lds;
    int tid, lane, wave, G, gw, NGW;
    unsigned char* ws;
};

__device__ __forceinline__ int in_col(int n) {
    if (n < 8192) return 3640 + n;
    if (n < 8704) return n - 8192;
    if (n < 9472) return 512 + (n - 8704);
    if (n < 9984) return 1304 + (n - 9472);
    if (n < 10496) return 1816 + (n - 9984);
    if (n < 10752) return 2328 + (n - 10496);
    if (n < 11776) return 2616 + (n - 10752);
    const int c = n - 11776; if (c < 24) return 1280 + c; if (c >= 32 && c < 64) return 2584 + (c - 32); return -1;
}
struct Job { const float* W; const float* ks; bf16* WT; int ldw, ldt, kdst0, mode, nkb, nnb, nbatch; size_t sstride, dstride; };
__device__ __forceinline__ void transpose_load(const Job& J, int item, f32x4 (&v)[16], int lane) {
    const int per = J.nkb * J.nnb, e = item / per, r = item % per, kb = r / J.nnb, nb = r % J.nnb, k0 = kb * 64, n0 = nb * 64;
    const float* W = J.W + (size_t)e * J.sstride;
    const int nq = 4 * (lane & 15), nd = n0 + nq;
    int sc;
    if (J.mode == 1) sc = in_col(nd);
    else if (J.mode == 2) { const int T = nd >> 8, w = nd & 255; sc = (w < 128) ? (T * 128 + w) : (512 + T * 128 + (w - 128)); }
    else sc = nd;
#pragma unroll
    for (int i = 0; i < 16; ++i) { const int kk = (lane >> 4) + 4 * i; v[i] = (f32x4){0.f, 0.f, 0.f, 0.f};
        if (sc >= 0) v[i] = *(const f32x4*)(W + (size_t)(k0 + kk) * J.ldw + sc); }
}
__device__ __forceinline__ void transpose_store(const Job& J, int item, f32x4 (&v)[16], LAS float* scr, int lane) {
    const int per = J.nkb * J.nnb, e = item / per, r = item % per, kb = r / J.nnb, nb = r % J.nnb, k0 = kb * 64, n0 = nb * 64;
    bf16* WT = J.WT + (size_t)e * J.dstride;
    const int nq = 4 * (lane & 15);
#pragma unroll
    for (int i = 0; i < 16; ++i) { const int kk = (lane >> 4) + 4 * i;
        if (J.ks) v[i] = v[i] * J.ks[k0 + kk];
        LAS float* d = scr + kk * 65 + nq; d[0] = v[i][0]; d[1] = v[i][1]; d[2] = v[i][2]; d[3] = v[i][3]; }
    LDS_WAIT(); asm volatile("" ::: "memory");
    const int c = lane & 7;
#pragma unroll
    for (int j = 0; j < 8; ++j) { const int n = (lane >> 3) + 8 * j; const LAS float* s = scr + (8 * c) * 65 + n;
        u32x4 o; o.x = cvt_pk_bf16(s[0 * 65], s[1 * 65]); o.y = cvt_pk_bf16(s[2 * 65], s[3 * 65]); o.z = cvt_pk_bf16(s[4 * 65], s[5 * 65]); o.w = cvt_pk_bf16(s[6 * 65], s[7 * 65]);
        *(u32x4*)(WT + (size_t)(n0 + n) * J.ldt + J.kdst0 + k0 + 8 * c) = o; }
    LDS_WAIT(); asm volatile("" ::: "memory");
}
constexpr int NJOBS = 15;
__device__ __forceinline__ Job get_job(const Args& a, int l, int j) {
    unsigned char* wl = a.ws + WS_WL0 + (size_t)l * WS_WLSTRIDE;
    Job J; J.ks = nullptr; J.kdst0 = 0; J.mode = 0; J.nbatch = 1; J.sstride = 0; J.dstride = 0;
#define SRC(i, per) ((const float*)a.in[i] + (size_t)l * (per))
    switch (j) {
    case 0:  J.W = SRC(3, (size_t)D * IN_W); J.ldw = IN_W; J.WT = (bf16*)(wl + WO_WIN); J.ldt = D; J.mode = 1; J.nkb = 32; J.nnb = NIN / 64; break;
    case 1:  J.W = SRC(8, 512 * D);  J.ldw = D; J.WT = (bf16*)(wl + WO_WBR); J.ldt = D; J.kdst0 = 0;    J.nkb = 8; J.nnb = 32; break;
    case 2:  J.W = SRC(16, 512 * D); J.ldw = D; J.WT = (bf16*)(wl + WO_WBR); J.ldt = D; J.kdst0 = 1024; J.nkb = 8; J.nnb = 32; break;
    case 3:  J.W = SRC(21, 512 * D); J.ldw = D; J.WT = (bf16*)(wl + WO_WBR); J.ldt = D; J.kdst0 = 1536; J.nkb = 8; J.nnb = 32; break;
    case 4:  J.W = SRC(22, (size_t)D * D); J.ldw = D; J.WT = (bf16*)(wl + WO_WOUT); J.ldt = D; J.nkb = 32; J.nnb = 32; break;
    case 5:  J.W = SRC(13, 512 * 768); J.ldw = 768; J.ks = SRC(12, 512); J.WT = (bf16*)(wl + WO_WUQ); J.ldt = 512; J.nkb = 8; J.nnb = 12; break;
    case 6:  J.W = SRC(15, 256 * 1024); J.ldw = 1024; J.ks = SRC(14, 256); J.WT = (bf16*)(wl + WO_WUKV); J.ldt = 256; J.nkb = 4; J.nnb = 16; break;
    case 7:  J.W = SRC(25, D * 512); J.ldw = 512; J.WT = (bf16*)(wl + WO_WXQ); J.ldt = D; J.nkb = 32; J.nnb = 8; break;
    case 8:  J.W = SRC(26, D * 512); J.ldw = 512; J.WT = (bf16*)(wl + WO_WXK); J.ldt = D; J.nkb = 32; J.nnb = 8; break;
    case 9:  J.W = SRC(27, D * 512); J.ldw = 512; J.WT = (bf16*)(wl + WO_WXV); J.ldt = D; J.nkb = 32; J.nnb = 8; break;
    case 10: J.W = SRC(28, 512 * D); J.ldw = D; J.WT = (bf16*)(wl + WO_WXO); J.ldt = 512; J.nkb = 8; J.nnb = 32; break;
    case 11: J.W = SRC(35, (size_t)32 * D * 1024); J.ldw = 1024; J.WT = (bf16*)(wl + WO_WEIN); J.ldt = D; J.mode = 2; J.nkb = 32; J.nnb = 16; J.nbatch = 32; J.sstride = (size_t)D * 1024; J.dstride = (size_t)1024 * D; break;
    case 12: J.W = SRC(36, (size_t)32 * 512 * D); J.ldw = D; J.WT = (bf16*)(wl + WO_WEOUT); J.ldt = 512; J.nkb = 8; J.nnb = 32; J.nbatch = 32; J.sstride = (size_t)512 * D; J.dstride = (size_t)D * 512; break;
    case 13: J.W = SRC(6, 2 * 2048 * 128); J.ldw = 128; J.WT = (bf16*)(wl + WO_W1C); J.ldt = 2048; J.nkb = 32; J.nnb = 2; J.nbatch = 2; J.sstride = 2048 * 128; J.dstride = 128 * 2048; break;
    default: J.W = SRC(7, 2 * 128 * 64); J.ldw = 64; J.WT = (bf16*)(wl + WO_W2C); J.ldt = 128; J.nkb = 2; J.nnb = 1; J.nbatch = 2; J.sstride = 128 * 64; J.dstride = 64 * 128; break;
    }
#undef SRC
    return J;
}

struct Row { f32x4 v[8]; };
__device__ __forceinline__ void row_load(Row& r, const float* p, int lane) {
    asm volatile("" : "+v"(lane));
#pragma unroll
    for (int j = 0; j < 8; ++j) r.v[j] = *(const f32x4*)(p + 4 * lane + 256 * j);
}
__device__ __forceinline__ void row_store_f32(const Row& r, float* p, int lane) {
    asm volatile("" : "+v"(lane));
#pragma unroll
    for (int j = 0; j < 8; ++j) *(f32x4*)(p + 4 * lane + 256 * j) = r.v[j];
}
__device__ __forceinline__ void row_store_bf16(const Row& r, bf16* p, int lane) {
    asm volatile("" : "+v"(lane));
#pragma unroll
    for (int j = 0; j < 8; ++j) { u32x2 w; w.x = cvt_pk_bf16(r.v[j][0], r.v[j][1]); w.y = cvt_pk_bf16(r.v[j][2], r.v[j][3]); *(u32x2*)(p + 4 * lane + 256 * j) = w; }
}
__device__ __forceinline__ void row_load_bf16(Row& r, const bf16* p, int lane) {
    asm volatile("" : "+v"(lane));
#pragma unroll
    for (int j = 0; j < 8; ++j) { const u32x2 w = *(const u32x2*)(p + 4 * lane + 256 * j); r.v[j][0] = bflo(w.x); r.v[j][1] = bfhi(w.x); r.v[j][2] = bflo(w.y); r.v[j][3] = bfhi(w.y); }
}
struct RowRaw { u32x2 w[8]; };
__device__ __forceinline__ void row_fetch(RowRaw& q, const bf16* p, int lane) {
    asm volatile("" : "+v"(lane));
#pragma unroll
    for (int j = 0; j < 8; ++j) q.w[j] = *(const u32x2*)(p + 4 * lane + 256 * j);
}
__device__ __forceinline__ void row_unpack(Row& r, const RowRaw& q) {
#pragma unroll
    for (int j = 0; j < 8; ++j) { r.v[j][0] = bflo(q.w[j].x); r.v[j][1] = bfhi(q.w[j].x); r.v[j][2] = bflo(q.w[j].y); r.v[j][3] = bfhi(q.w[j].y); }
}
__device__ __forceinline__ void row_unpack_add(Row& r, const RowRaw& q) {
#pragma unroll
    for (int j = 0; j < 8; ++j) { r.v[j][0] += bflo(q.w[j].x); r.v[j][1] += bfhi(q.w[j].x); r.v[j][2] += bflo(q.w[j].y); r.v[j][3] += bfhi(q.w[j].y); }
}
__device__ __forceinline__ void row_store_hilo(const Row& r, bf16* ph, bf16* pl, int lane) {
    asm volatile("" : "+v"(lane));
#pragma unroll
    for (int j = 0; j < 8; ++j) { u32x2 h, l; h.x = cvt_pk_bf16(r.v[j][0], r.v[j][1]); h.y = cvt_pk_bf16(r.v[j][2], r.v[j][3]);
        l.x = cvt_pk_bf16(r.v[j][0] - bflo(h.x), r.v[j][1] - bfhi(h.x)); l.y = cvt_pk_bf16(r.v[j][2] - bflo(h.y), r.v[j][3] - bfhi(h.y));
        *(u32x2*)(ph + 4 * lane + 256 * j) = h; *(u32x2*)(pl + 4 * lane + 256 * j) = l; }
}
__device__ __forceinline__ void row_add_bf16(Row& r, const bf16* p, int lane) {
    asm volatile("" : "+v"(lane));
#pragma unroll
    for (int j = 0; j < 8; ++j) { const u32x2 w = *(const u32x2*)(p + 4 * lane + 256 * j); r.v[j][0] += bflo(w.x); r.v[j][1] += bfhi(w.x); r.v[j][2] += bflo(w.y); r.v[j][3] += bfhi(w.y); }
}
__device__ __forceinline__ void row_layernorm(Row& r, const float* g, const float* b, int lane) {
    asm volatile("" : "+v"(lane));
    float s = 0.f;
#pragma unroll
    for (int j = 0; j < 8; ++j) s += (r.v[j][0] + r.v[j][1]) + (r.v[j][2] + r.v[j][3]);
    const float mean = wave_sum(s) * (1.0f / D); float q = 0.f;
#pragma unroll
    for (int j = 0; j < 8; ++j) { r.v[j] = r.v[j] - mean; q += (r.v[j][0] * r.v[j][0] + r.v[j][1] * r.v[j][1]) + (r.v[j][2] * r.v[j][2] + r.v[j][3] * r.v[j][3]); }
    const float rstd = 1.0f / sqrtf(wave_sum(q) * (1.0f / D) + 1e-5f);
#pragma unroll
    for (int j = 0; j < 8; ++j) { const f32x4 gg = *(const f32x4*)(g + 4 * lane + 256 * j), bb = *(const f32x4*)(b + 4 * lane + 256 * j); r.v[j] = r.v[j] * rstd * gg + bb; }
}

__device__ __forceinline__ void row_layernorm2(Row& r0, Row& r1, const float* g, const float* b, int lane) {
    asm volatile("" : "+v"(lane));
    float s0 = 0.f, s1 = 0.f;
#pragma unroll
    for (int j = 0; j < 8; ++j) { s0 += (r0.v[j][0] + r0.v[j][1]) + (r0.v[j][2] + r0.v[j][3]); s1 += (r1.v[j][0] + r1.v[j][1]) + (r1.v[j][2] + r1.v[j][3]); }
#pragma unroll
    for (int o = 0; o < 1; ++o) { s0 = wave_sum(s0); s1 = wave_sum(s1); }
    const float m0 = s0 * (1.0f / D), m1 = s1 * (1.0f / D); float q0 = 0.f, q1 = 0.f;
#pragma unroll
    for (int j = 0; j < 8; ++j) { r0.v[j] = r0.v[j] - m0; r1.v[j] = r1.v[j] - m1;
        q0 += (r0.v[j][0] * r0.v[j][0] + r0.v[j][1] * r0.v[j][1]) + (r0.v[j][2] * r0.v[j][2] + r0.v[j][3] * r0.v[j][3]);
        q1 += (r1.v[j][0] * r1.v[j][0] + r1.v[j][1] * r1.v[j][1]) + (r1.v[j][2] * r1.v[j][2] + r1.v[j][3] * r1.v[j][3]); }
#pragma unroll
    for (int o = 0; o < 1; ++o) { q0 = wave_sum(q0); q1 = wave_sum(q1); }
    const float d0 = 1.0f / sqrtf(q0 * (1.0f / D) + 1e-5f), d1 = 1.0f / sqrtf(q1 * (1.0f / D) + 1e-5f);
#pragma unroll
    for (int j = 0; j < 8; ++j) { const f32x4 gg = *(const f32x4*)(g + 4 * lane + 256 * j), bb = *(const f32x4*)(b + 4 * lane + 256 * j); r0.v[j] = r0.v[j] * d0 * gg + bb; r1.v[j] = r1.v[j] * d1 * gg + bb; }
}
template <class AP, class BP>
__device__ __forceinline__ f32x4 sgemm16(const AP& ap, const BP& bp, int K, int lane) {
    const int r = lane & 15, G = lane >> 4; f32x4 acc = (f32x4){0.f, 0.f, 0.f, 0.f};
#pragma unroll 8
    for (int k0 = 0; k0 < K; k0 += 32) { const bf16x8 a = *(const bf16x8*)ap(r, k0 + 8 * G), b = *(const bf16x8*)bp(r, k0 + 8 * G);
        acc = __builtin_amdgcn_mfma_f32_16x16x32_bf16(a, b, acc, 0, 0, 0); }
    return acc;
}
__device__ __forceinline__ void transpose_tile64(const bf16* src, size_t sp, bf16* dst, size_t dp, LAS bf16* scr, int lane) {
    const int r8 = lane >> 3, pc = lane & 7;
#pragma unroll
    for (int c = 0; c < 8; ++c) { const int row = 8 * c + r8; const u32x4 v = *(const u32x4*)(src + (size_t)row * sp + 8 * pc); LAS unsigned* d = (LAS unsigned*)(scr + row * 66 + 8 * pc); d[0] = v.x; d[1] = v.y; d[2] = v.z; d[3] = v.w; }
    LDS_WAIT(); asm volatile("" ::: "memory");
#pragma unroll
    for (int c = 0; c < 8; ++c) { const int drow = 8 * c + r8; unsigned w[4];
#pragma unroll
        for (int q = 0; q < 4; ++q) { const unsigned lo = scr[(8 * pc + 2 * q) * 66 + drow], hi = scr[(8 * pc + 2 * q + 1) * 66 + drow]; w[q] = lo | (hi << 16); }
        *(u32x4*)(dst + (size_t)drow * dp + 8 * pc) = (u32x4){w[0], w[1], w[2], w[3]}; }
    LDS_WAIT(); asm volatile("" ::: "memory");
}
__device__ __forceinline__ float gelu_tanh(float x) { const float u = 0.7978845608028654f * (x + 0.044715f * x * x * x); return 0.5f * x * (1.0f + tanhf(u)); }

__device__ __forceinline__ void phase_prologue(const Args& a, Frame& F) {
    LAS float* scr = (LAS float*)(F.lds + F.wave * 16640);
    const int gw = F.gw, NGW = F.NGW, lane = F.lane;
    { int off = 0;
      for (int l = 0; l < DEPTH; ++l)
        for (int j = 0; j < NJOBS; ++j) { const Job J = get_job(a, l, j); const int n = J.nbatch * J.nkb * J.nnb;
            int st = (gw - off) % NGW; if (st < 0) st += NGW;
            f32x4 va[16], vb[16];
            if (st < n) transpose_load(J, st, va, lane);
#pragma unroll 1
            for (int it = st; it < n; it += 2 * NGW) {
                if (it + NGW < n) transpose_load(J, it + NGW, vb, lane);
                transpose_store(J, it, va, scr, lane);
                if (it + NGW < n) { if (it + 2 * NGW < n) transpose_load(J, it + 2 * NGW, va, lane); transpose_store(J, it + NGW, vb, scr, lane); } }
            off = (off + n) % NGW; } }
#pragma unroll 1
    for (int i = gw * 64 + lane; i < DEPTH * NIN; i += NGW * 64) { const int l = i / NIN, n = i % NIN; const int sc = in_col(n);
        ((float*)(a.ws + WS_WL0 + (size_t)l * WS_WLSTRIDE + WO_BIASP))[n] = sc >= 0 ? ((const float*)a.in[4])[(size_t)l * IN_W + sc] : 0.f; }
#pragma unroll 1
    for (int it = gw; it < DEPTH * 4 * 16 * 32; it += NGW) { const int nb = it & 31, cb = (it >> 5) & 15, g = (it >> 9) & 3, l = it >> 11; const int n = nb * 64 + lane;
        const float* wp = (const float*)a.in[9] + ((size_t)(l * 4 + g) * 128 + 8 * cb) * 128; const float* ps = (const float*)a.in[10] + l * 512 + 128 * g;
        const float* wo = (const float*)a.in[11] + ((size_t)l * 512 + 128 * g) * D + n;
        float acc[8];
#pragma unroll
        for (int i = 0; i < 8; ++i) acc[i] = 0.f;
        for (int d = 0; d < 128; ++d) { const float b = wo[(size_t)d * D] * ps[d];
#pragma unroll
            for (int i = 0; i < 8; ++i) acc[i] += wp[i * 128 + d] * b; }
        bf16* dst = (bf16*)(a.ws + WS_WL0 + (size_t)l * WS_WLSTRIDE + WO_WBR) + (size_t)n * D + 512 + 128 * g + 8 * cb;
        *(u32x4*)dst = (u32x4){cvt_pk_bf16(acc[0], acc[1]), cvt_pk_bf16(acc[2], acc[3]), cvt_pk_bf16(acc[4], acc[5]), cvt_pk_bf16(acc[6], acc[7])}; }
#pragma unroll 1
    for (int it = gw; it < DEPTH * 2; it += NGW) { const float* pos = (const float*)a.in[5] + (size_t)it * 2048; const float* w1 = (const float*)a.in[6] + (size_t)it * 2048 * 128;
        float a0 = 0.f, a1 = 0.f;
        for (int k = 0; k < 2048; ++k) { const float p = pos[k]; a0 += p * w1[(size_t)k * 128 + lane]; a1 += p * w1[(size_t)k * 128 + 64 + lane]; }
        float* dst = (float*)(a.ws + WS_WL0 + (size_t)(it >> 1) * WS_WLSTRIDE + WO_B1C) + (it & 1) * 128; dst[lane] = a0; dst[64 + lane] = a1; }
#pragma unroll 1
    for (int i = gw * 64 + lane; i < S * 16; i += NGW * 64) { const int t = i >> 4, k = i & 15; const float inv = powf(10000.0f, -(float)k / 16.0f); const float ang = (float)((const int*)a.in[2])[t] * inv;
        float sn, cs; sincosf(ang, &sn, &cs); ((f32x2*)(a.ws + WS_ROPE))[i] = (f32x2){cs, sn}; }
#pragma unroll 1
    for (int i = gw * 64 + lane; i < DEPTH * 48 * 2048; i += NGW * 64) { const int l = i / (48 * 2048), n = (i / 2048) % 48, k = i % 2048;
        float w = 0.f; if (n < 4) w = ((const float*)a.in[31])[((size_t)l * D + k) * 4 + n]; else if (n < 36) w = ((const float*)a.in[33])[((size_t)l * D + k) * 32 + (n - 4)];
        const unsigned short h = f2bf(w); const unsigned short lo = f2bf(w - bf2f(h));
        bf16* dst = (bf16*)(a.ws + WS_WL0 + (size_t)l * WS_WLSTRIDE + WO_WRT); dst[(size_t)n * 2048 + k] = h; dst[(size_t)(48 + n) * 2048 + k] = lo; }
#pragma unroll 1
    for (int r = gw; r < S + 256; r += NGW) { Row rw;
        if (r < S) { row_load(rw, (const float*)a.in[0] + (size_t)r * D, lane); row_store_bf16(rw, (bf16*)(a.ws + WS_XB) + (size_t)r * D, lane); }
        else { row_load(rw, (const float*)a.in[1] + (size_t)(r - S) * D, lane); row_store_bf16(rw, (bf16*)(a.ws + WS_MEMB) + (size_t)(r - S) * D, lane); } }
}

__device__ __forceinline__ int crow(int r, int hi) { return (r & 3) + 8 * (r >> 2) + 4 * hi; }
template <int DK, int DV, class V>
__device__ __forceinline__ void attn32(const V& v, int lane, float& m_fin, float& l_fin) {
    const int col = lane & 31, hi = lane >> 5;
    constexpr int NKS = DK / 16, NVB = DV / 32;
    bf16x8 qf[NKS];
    { const bf16* qp = v.qptr(col);
#pragma unroll
      for (int s = 0; s < NKS; ++s) qf[s] = *(const bf16x8*)(qp + 16 * s + 8 * hi); }
    f32x16 o[NVB];
#pragma unroll
    for (int b = 0; b < NVB; ++b)
#pragma unroll
        for (int r = 0; r < 16; ++r) o[b][r] = 0.f;
    float m_run = -INFINITY, l_run = 0.f;
    for (int T = v.tb; T < v.te; ++T) {
        const int key0 = 32 * T;
        const bf16* kp = v.kptr(key0 + col);
        f32x16 sacc;
#pragma unroll
        for (int r = 0; r < 16; ++r) sacc[r] = 0.f;
#pragma unroll
        for (int s = 0; s < NKS; ++s) { const bf16x8 kf = *(const bf16x8*)(kp + 16 * s + 8 * hi); sacc = __builtin_amdgcn_mfma_f32_32x32x16_bf16(kf, qf[s], sacc, 0, 0, 0); }
        float x[16]; float mt = -INFINITY;
#pragma unroll
        for (int r = 0; r < 16; ++r) { const int key = key0 + crow(r, hi); x[r] = v.valid(key, col) ? sacc[r] * v.scale2 : -INFINITY; mt = fmaxf(mt, x[r]); }
        mt = fmaxf(mt, __shfl_xor(mt, 32));
        const float m_new = fmaxf(m_run, mt);
        const float mref = (m_new == -INFINITY) ? 0.f : m_new;
        const float corr = __builtin_amdgcn_exp2f(m_run - mref);
        float ps = 0.f;
#pragma unroll
        for (int r = 0; r < 16; ++r) { x[r] = __builtin_amdgcn_exp2f(x[r] - mref); ps += x[r]; }
        l_run = l_run * corr + ps; m_run = m_new;
#pragma unroll
        for (int b = 0; b < NVB; ++b)
#pragma unroll
            for (int r = 0; r < 16; ++r) o[b][r] *= corr;
        bf16x8 pf[2];
#pragma unroll
        for (int s2 = 0; s2 < 2; ++s2) { const u32x4 w = (u32x4){cvt_pk_bf16(x[8 * s2 + 0], x[8 * s2 + 1]), cvt_pk_bf16(x[8 * s2 + 2], x[8 * s2 + 3]), cvt_pk_bf16(x[8 * s2 + 4], x[8 * s2 + 5]), cvt_pk_bf16(x[8 * s2 + 6], x[8 * s2 + 7])};
            pf[s2] = __builtin_bit_cast(bf16x8, w); }
#pragma unroll
        for (int b = 0; b < NVB; ++b) { const bf16* vp = v.vtptr(32 * b + col) + key0 + 4 * hi;
#pragma unroll
            for (int s2 = 0; s2 < 2; ++s2) { const u32x2 lo = *(const u32x2*)(vp + 16 * s2), hh = *(const u32x2*)(vp + 16 * s2 + 8);
                const bf16x8 vf = __builtin_bit_cast(bf16x8, (u32x4){lo.x, lo.y, hh.x, hh.y});
                o[b] = __builtin_amdgcn_mfma_f32_32x32x16_bf16(vf, pf[s2], o[b], 0, 0, 0); } }
    }
    const float l = l_run + __shfl_xor(l_run, 32);
    const float inv = l > 0.f ? 1.0f / l : 0.f;
#pragma unroll
    for (int b = 0; b < NVB; ++b)
#pragma unroll
        for (int i = 0; i < 4; ++i) v.store(col, 32 * b + 8 * i + 4 * hi, (f32x4){o[b][4 * i] * inv, o[b][4 * i + 1] * inv, o[b][4 * i + 2] * inv, o[b][4 * i + 3] * inv});
    m_fin = m_run; l_fin = l;
}
__device__ __forceinline__ void store4_bf16(bf16* p, const f32x4 v) { *(u32x2*)p = (u32x2){cvt_pk_bf16(v[0], v[1]), cvt_pk_bf16(v[2], v[3])}; }

struct VarMLA {
    const bf16* Q; const bf16* K; const bf16* Vt; bf16* O; int t0, hd, tb, te; float scale2;
    __device__ __forceinline__ const bf16* qptr(int col) const { return Q + (size_t)(t0 + col) * 768 + hd * 96; }
    __device__ __forceinline__ const bf16* kptr(int key) const { return K + (size_t)key * 768 + hd * 96; }
    __device__ __forceinline__ const bf16* vtptr(int dv) const { return Vt + (size_t)(hd * 64 + dv) * S; }
    __device__ __forceinline__ bool valid(int key, int col) const { return key <= t0 + col; }
    __device__ __forceinline__ void store(int col, int dv, const f32x4 x) const { store4_bf16(O + (size_t)(t0 + col) * D + 1024 + hd * 64 + dv, x); }
};
struct VarWin {
    const bf16* U2; const bf16* Vt; bf16* O; int t0, g, tb, te; float scale2;
    __device__ __forceinline__ const bf16* qptr(int col) const { return U2 + (size_t)(t0 + (col >> 2)) * U2W + U2_Q + (4 * g + (col & 3)) * 64; }
    __device__ __forceinline__ const bf16* kptr(int key) const { return U2 + (size_t)key * U2W + U2_KV + (4 * 2 + g) * 64; }
    __device__ __forceinline__ const bf16* vtptr(int dv) const { return Vt + (size_t)(g * 64 + dv) * S; }
    __device__ __forceinline__ bool valid(int key, int col) const { const int tok = t0 + (col >> 2); return key <= tok && key > tok - 512; }
    __device__ __forceinline__ void store(int col, int dv, const f32x4 x) const { store4_bf16(O + (size_t)(t0 + (col >> 2)) * 512 + (4 * g + (col & 3)) * 64 + dv, x); }
};
struct VarCmp {
    const bf16* U2; const bf16* KC; const bf16* Vt; bf16* O; int t0, g, tb, te; float scale2;
    __device__ __forceinline__ const bf16* qptr(int col) const { return U2 + (size_t)(t0 + (col >> 2)) * U2W + U2_Q + (4 * g + (col & 3)) * 64; }
    __device__ __forceinline__ const bf16* kptr(int c) const { return KC + (size_t)(g * 1024 + c) * 64; }
    __device__ __forceinline__ const bf16* vtptr(int dv) const { return Vt + (size_t)(g * 64 + dv) * 1024; }
    __device__ __forceinline__ bool valid(int c, int col) const { return 16 * c + 31 <= t0 + (col >> 2); }
    __device__ __forceinline__ void store(int col, int dv, const f32x4 x) const { store4_bf16(O + (size_t)(t0 + (col >> 2)) * 512 + (4 * g + (col & 3)) * 64 + dv, x); }
};
struct VarX {
    const bf16* Q; const bf16* K; const bf16* Vt; bf16* O; int t0, hd, tb, te; float scale2;
    __device__ __forceinline__ const bf16* qptr(int col) const { return Q + (size_t)(t0 + col) * 512 + hd * 128; }
    __device__ __forceinline__ const bf16* kptr(int key) const { return K + (size_t)key * 512 + hd * 128; }
    __device__ __forceinline__ const bf16* vtptr(int dv) const { return Vt + (size_t)(hd * 128 + dv) * 256; }
    __device__ __forceinline__ bool valid(int, int) const { return true; }
    __device__ __forceinline__ void store(int col, int dv, const f32x4 x) const { store4_bf16(O + (size_t)(t0 + col) * 512 + hd * 128 + dv, x); }
};
__device__ __forceinline__ void cmp_scores(const VarCmp& v, int lane, float m_fin, float l_fin, float* sc) {
    const int col = lane & 31, hi = lane >> 5;
    bf16x8 qf[4];
    { const bf16* qp = v.qptr(col);
#pragma unroll
      for (int s = 0; s < 4; ++s) qf[s] = *(const bf16x8*)(qp + 16 * s + 8 * hi); }
    const float mref = (m_fin == -INFINITY) ? 0.f : m_fin; const float inv = l_fin > 0.f ? 1.0f / l_fin : 0.f;
    float* dst = sc + (size_t)((v.t0 + (col >> 2)) * 2 + v.g) * 256;
    float carry = 0.f;
    for (int T = 0; T < 32; ++T) {
        float sv[4];
        if (T < v.te) {
            const int key0 = 32 * T; const bf16* kp = v.kptr(key0 + col);
            f32x16 sacc;
#pragma unroll
            for (int r = 0; r < 16; ++r) sacc[r] = 0.f;
#pragma unroll
            for (int s = 0; s < 4; ++s) { const bf16x8 kf = *(const bf16x8*)(kp + 16 * s + 8 * hi); sacc = __builtin_amdgcn_mfma_f32_32x32x16_bf16(kf, qf[s], sacc, 0, 0, 0); }
            float Gs[4], Es[4];
#pragma unroll
            for (int i = 0; i < 4; ++i) { float p[4];
#pragma unroll
                for (int q = 0; q < 4; ++q) { const int r = 4 * i + q; const int key = key0 + crow(r, hi); p[q] = v.valid(key, col) ? __builtin_amdgcn_exp2f(sacc[r] * v.scale2 - mref) * inv : 0.f; }
                Gs[i] = (p[0] + p[1]) + (p[2] + p[3]); Es[i] = p[3]; }
#pragma unroll
            for (int i = 0; i < 4; ++i) { Gs[i] += __shfl_xor(Gs[i], 1); Gs[i] += __shfl_xor(Gs[i], 2); Es[i] += __shfl_xor(Es[i], 1); Es[i] += __shfl_xor(Es[i], 2); }
            float eo[4];
#pragma unroll
            for (int i = 0; i < 4; ++i) eo[i] = __shfl_xor(Es[i], 32);
            if (hi) { sv[0] = Gs[0] + eo[0]; sv[1] = Gs[1] + eo[1]; sv[2] = Gs[2] + eo[2]; sv[3] = Gs[3] + eo[3]; }
            else { sv[0] = Gs[0] + carry; sv[1] = Gs[1] + eo[0]; sv[2] = Gs[2] + eo[1]; sv[3] = Gs[3] + eo[2]; }
            carry = eo[3];
        } else { sv[0] = hi ? 0.f : carry; sv[1] = 0.f; sv[2] = 0.f; sv[3] = 0.f; carry = 0.f; }
        if ((col & 3) == 0) {
#pragma unroll
            for (int i = 0; i < 4; ++i) dst[8 * T + 2 * i + hi] = sv[i]; }
    }
}

__device__ __forceinline__ void sel_attn_unit(const bf16* U2, const bf16* VTS, const bf16* OCMP, const bf16* OWIN, const int* idx, int nv, bf16* ABR, int t, int g, int lane) {
    const int c16 = lane & 15, G = lane >> 4;
    const float scale2 = 0.125f * LOG2E;
    bf16x8 qf[2];
    { const bf16* qp = U2 + (size_t)t * U2W + U2_Q + (4 * g + (c16 & 3)) * 64;
#pragma unroll
      for (int ks = 0; ks < 2; ++ks) { qf[ks] = *(const bf16x8*)(qp + 32 * ks + 8 * G); if (c16 >= 4) qf[ks] = (bf16x8){0, 0, 0, 0, 0, 0, 0, 0}; } }
    f32x4 o[4];
#pragma unroll
    for (int d = 0; d < 4; ++d) o[d] = (f32x4){0.f, 0.f, 0.f, 0.f};
    float m_run = -INFINITY, l_run = 0.f;
    for (int b = 0; b < nv; ++b) {
        const int blk = __builtin_amdgcn_readfirstlane(idx[b]); const int key0 = 64 * blk;
        f32x4 acc[4];
#pragma unroll
        for (int kt = 0; kt < 4; ++kt) { const bf16* kp = U2 + (size_t)(key0 + 16 * kt + c16) * U2W + U2_KV + (2 * 2 + g) * 64 + 8 * G;
            const bf16x8 k0 = *(const bf16x8*)kp, k1 = *(const bf16x8*)(kp + 32);
            acc[kt] = __builtin_amdgcn_mfma_f32_16x16x32_bf16(k0, qf[0], (f32x4){0.f, 0.f, 0.f, 0.f}, 0, 0, 0);
            acc[kt] = __builtin_amdgcn_mfma_f32_16x16x32_bf16(k1, qf[1], acc[kt], 0, 0, 0); }
        float mt = -INFINITY;
#pragma unroll
        for (int kt = 0; kt < 4; ++kt)
#pragma unroll
            for (int i = 0; i < 4; ++i) { const int key = key0 + 16 * kt + 4 * G + i; acc[kt][i] = (key <= t) ? acc[kt][i] * scale2 : -INFINITY; mt = fmaxf(mt, acc[kt][i]); }
        mt = fmaxf(mt, __shfl_xor(mt, 16)); mt = fmaxf(mt, __shfl_xor(mt, 32));
        const float m_new = fmaxf(m_run, mt); const float mref = (m_new == -INFINITY) ? 0.f : m_new;
        const float corr = __builtin_amdgcn_exp2f(m_run - mref); float ps = 0.f;
#pragma unroll
        for (int kt = 0; kt < 4; ++kt)
#pragma unroll
            for (int i = 0; i < 4; ++i) { acc[kt][i] = __builtin_amdgcn_exp2f(acc[kt][i] - mref); ps += acc[kt][i]; }
        l_run = l_run * corr + ps; m_run = m_new;
#pragma unroll
        for (int d = 0; d < 4; ++d) o[d] = o[d] * corr;
        bf16x8 pf[2];
#pragma unroll
        for (int u = 0; u < 2; ++u) pf[u] = __builtin_bit_cast(bf16x8, (u32x4){cvt_pk_bf16(acc[2 * u][0], acc[2 * u][1]), cvt_pk_bf16(acc[2 * u][2], acc[2 * u][3]), cvt_pk_bf16(acc[2 * u + 1][0], acc[2 * u + 1][1]), cvt_pk_bf16(acc[2 * u + 1][2], acc[2 * u + 1][3])});
#pragma unroll
        for (int d = 0; d < 4; ++d) { const bf16* vp = VTS + (size_t)(g * 64 + 16 * d + c16) * S + key0 + 4 * G;
#pragma unroll
            for (int u = 0; u < 2; ++u) { const u32x2 lo = *(const u32x2*)(vp + 32 * u), hh = *(const u32x2*)(vp + 32 * u + 16);
                o[d] = __builtin_amdgcn_mfma_f32_16x16x32_bf16(__builtin_bit_cast(bf16x8, (u32x4){lo.x, lo.y, hh.x, hh.y}), pf[u], o[d], 0, 0, 0); } }
    }
    float l = l_run; l += __shfl_xor(l, 16); l += __shfl_xor(l, 32);
    const float inv = l > 0.f ? 1.0f / l : 0.f;
    if (c16 < 4) { const int head = 4 * g + c16; const bf16* gp = U2 + (size_t)t * U2W + U2_G + head * 3;
        const float s0 = sigmoidf_(bf2f(gp[0])), s1 = sigmoidf_(bf2f(gp[1])) * inv, s2 = sigmoidf_(bf2f(gp[2]));
#pragma unroll
        for (int d = 0; d < 4; ++d) { const size_t off = (size_t)t * 512 + head * 64 + 16 * d + 4 * G; const u32x2 oc = *(const u32x2*)(OCMP + off), ow = *(const u32x2*)(OWIN + off);
            f32x4 r; r[0] = s0 * bflo(oc.x) + s1 * o[d][0] + s2 * bflo(ow.x); r[1] = s0 * bfhi(oc.x) + s1 * o[d][1] + s2 * bfhi(ow.x);
            r[2] = s0 * bflo(oc.y) + s1 * o[d][2] + s2 * bflo(ow.y); r[3] = s0 * bfhi(oc.y) + s1 * o[d][3] + s2 * bfhi(ow.y);
            store4_bf16(ABR + (size_t)t * D + head * 64 + 16 * d + 4 * G, r); } }
}
__device__ __forceinline__ bool selmask_test(const LAS unsigned* m8, int j) { return (m8[(j & 3) * 2 + (j >> 7)] >> ((j >> 2) & 31)) & 1u; }
__device__ __forceinline__ void topk_unit(const float* sc, int t, unsigned* mask_out, int lane) {
    const int cur = t >> 6;
    const f32x4 v = *(const f32x4*)(sc + 4 * lane);
    unsigned key[4];
#pragma unroll
    for (int q = 0; q < 4; ++q) { const int j = 4 * lane + q;
        key[q] = __float_as_uint(v[q]) + 1u;
        if (j == 0 || j == cur || j == cur - 1) key[q] = 0xffffffffu;
        if (j > cur) key[q] = 0u; }
    unsigned T = 0u;
#pragma unroll 1
    for (int bit = 31; bit >= 0; --bit) { const unsigned cand = T | (1u << bit);
        int cnt = 0;
#pragma unroll
        for (int q = 0; q < 4; ++q) cnt += __builtin_popcountll(__ballot(key[q] >= cand));
        if (cnt >= 16) T = cand; }
    unsigned long long G[4], E[4]; int cgt = 0;
#pragma unroll
    for (int q = 0; q < 4; ++q) { G[q] = __ballot(key[q] > T); E[q] = __ballot(key[q] == T && T != 0u); cgt += __builtin_popcountll(G[q]); }
    const int need = 16 - cgt;
    int below = 0;
#pragma unroll
    for (int q = 0; q < 4; ++q) below += (int)__builtin_amdgcn_mbcnt_hi((unsigned)(E[q] >> 32), __builtin_amdgcn_mbcnt_lo((unsigned)E[q], 0u));
    unsigned long long Sel[4]; int own = 0;
#pragma unroll
    for (int q = 0; q < 4; ++q) { const bool eq = (key[q] == T && T != 0u); const bool take = (key[q] > T) || (eq && (below + own) < need); own += eq ? 1 : 0; Sel[q] = __ballot(take); }
    unsigned w = 0u;
#pragma unroll
    for (int q = 0; q < 4; ++q) { if (lane == 2 * q) w = (unsigned)Sel[q]; if (lane == 2 * q + 1) w = (unsigned)(Sel[q] >> 32); }
    if (lane < 8) mask_out[lane] = w;
}

template <int NKS, int KP, int VP, int NVB, class MaskF>
__device__ __forceinline__ void att_step64n(const LAS unsigned char* kb, const LAS unsigned char* vb, const bf16x8 (&qf)[NKS], f32x16 (&o)[NVB], float& m_run, float& l_run, float scale2, bool use_mask, const MaskF& mask, int col, int hi) {
    f32x16 sacc[2];
#pragma unroll
    for (int u = 0; u < 2; ++u) {
#pragma unroll
        for (int r = 0; r < 16; ++r) sacc[u][r] = 0.f;
#pragma unroll
        for (int s = 0; s < NKS; ++s) { const bf16x8 kf = *(const LAS bf16x8*)(kb + ((32 * u + col) * KP + 16 * s + 8 * hi) * 2); sacc[u] = __builtin_amdgcn_mfma_f32_32x32x16_bf16(kf, qf[s], sacc[u], 0, 0, 0); } }
    float mt = -INFINITY;
#pragma unroll
    for (int u = 0; u < 2; ++u)
#pragma unroll
        for (int r = 0; r < 16; ++r) { float x = sacc[u][r] * scale2; if (use_mask) { if (!mask(u, r)) x = -INFINITY; } sacc[u][r] = x; mt = fmaxf(mt, x); }
    mt = xmax32(mt);
    const float m_new = fmaxf(m_run, mt); const float mref = (m_new == -INFINITY) ? 0.f : m_new;
    if (__any(m_new != m_run)) {
        const float corr = __builtin_amdgcn_exp2f(m_run - mref); l_run *= corr; m_run = m_new;
#pragma unroll
        for (int b = 0; b < NVB; ++b)
#pragma unroll
            for (int r = 0; r < 16; ++r) o[b][r] *= corr; }
    float ps = 0.f;
#pragma unroll
    for (int u = 0; u < 2; ++u)
#pragma unroll
        for (int r = 0; r < 16; ++r) { sacc[u][r] = __builtin_amdgcn_exp2f(sacc[u][r] - mref); ps += sacc[u][r]; }
    l_run += ps;
#pragma unroll
    for (int u = 0; u < 2; ++u)
#pragma unroll
        for (int s2 = 0; s2 < 2; ++s2) { const bf16x8 pf = __builtin_bit_cast(bf16x8, (u32x4){cvt_pk_bf16(sacc[u][8 * s2 + 0], sacc[u][8 * s2 + 1]), cvt_pk_bf16(sacc[u][8 * s2 + 2], sacc[u][8 * s2 + 3]), cvt_pk_bf16(sacc[u][8 * s2 + 4], sacc[u][8 * s2 + 5]), cvt_pk_bf16(sacc[u][8 * s2 + 6], sacc[u][8 * s2 + 7])});
#pragma unroll
            for (int b = 0; b < NVB; ++b) { const LAS unsigned char* vp = vb + ((32 * b + col) * VP + 32 * u + 16 * s2 + 4 * hi) * 2;
                const u32x2 lo = *(const LAS u32x2*)vp, hh = *(const LAS u32x2*)(vp + 16);
                o[b] = __builtin_amdgcn_mfma_f32_32x32x16_bf16(__builtin_bit_cast(bf16x8, (u32x4){lo.x, lo.y, hh.x, hh.y}), pf, o[b], 0, 0, 0); } }
}

template <int NKS, int KP, int VP, class MaskF>
__device__ __forceinline__ void att_step64(const LAS unsigned char* kb, const LAS unsigned char* vb, const bf16x8 (&qf)[NKS], f32x16 (&o)[2], float& m_run, float& l_run, float scale2, bool use_mask, const MaskF& mask, int col, int hi) {
    att_step64n<NKS, KP, VP, 2>(kb, vb, qf, o, m_run, l_run, scale2, use_mask, mask, col, hi);
}

constexpr int SK_KP = 72, SK_VP = 132;
constexpr int SK_KB = 128 * SK_KP * 2, SK_VB = 64 * SK_VP * 2, SK_VOFF = 2 * SK_KB, SK_MOFF = SK_VOFF + 2 * SK_VB;
template <int MODE>
__device__ __forceinline__ void sel_unit(LAS unsigned char* lds, const bf16* U2, const bf16* VTS, const unsigned* SM, const bf16* OCMP, bf16* OWIN, bf16* ABR, int g, int qblk, int tid, int wave, int lane) {
    const int col = lane & 31, hi = lane >> 5;
    const int tl = 8 * wave + (col >> 2), t = 64 * qblk + tl, head = 4 * g + (col & 3);
    LAS unsigned* smask = (LAS unsigned*)(lds + SK_MOFF);
    __syncthreads();
    if (MODE == 0) smask[tid] = SM[(size_t)((64 * qblk + (tid >> 3)) * 2 + g) * 8 + (tid & 7)];
    bf16x8 qf[4];
    { const bf16* qp = U2 + (size_t)t * U2W + U2_Q + head * 64;
#pragma unroll
      for (int s = 0; s < 4; ++s) qf[s] = *(const bf16x8*)(qp + 16 * s + 8 * hi); }
    f32x16 o[2];
#pragma unroll
    for (int b = 0; b < 2; ++b)
#pragma unroll
        for (int r = 0; r < 16; ++r) o[b][r] = 0.f;
    float m_run = -INFINITY, l_run = 0.f;
    const float scale2 = 0.125f * LOG2E;
    const int jlo = (MODE == 1 && qblk > 8) ? qblk - 8 : 0;
    const int st0 = jlo >> 1, st1 = (qblk >> 1) + 1;
    const int kvsel = (MODE == 1) ? 4 : 2;
    const bf16* kg[2]; unsigned kl[2]; const bf16* vg[2]; unsigned vl[2];
#pragma unroll
    for (int i = 0; i < 2; ++i) { const int c = tid + 512 * i; { const int row = c >> 3, p = c & 7; kg[i] = U2 + (size_t)row * U2W + U2_KV + (kvsel * 2 + g) * 64 + 8 * p; kl[i] = (unsigned)(row * SK_KP + 8 * p) * 2u; }
        { const int row = c >> 4, p = c & 15; vg[i] = VTS + (size_t)(g * 64 + row) * S + 8 * p; vl[i] = (unsigned)(row * SK_VP + 8 * p) * 2u; } }
    u32x4 kr[2], vr[2];
    auto gload = [&](int step) { const int key0 = 128 * step;
#pragma unroll
        for (int i = 0; i < 2; ++i) { kr[i] = *(const u32x4*)(kg[i] + (size_t)key0 * U2W); vr[i] = *(const u32x4*)(vg[i] + key0); } };
    gload(st0);
#pragma unroll 1
    for (int st = st0; st < st1; ++st) {
        const int buf = st & 1;
        LAS unsigned char* kb = lds + buf * SK_KB; LAS unsigned char* vb = lds + SK_VOFF + buf * SK_VB;
#pragma unroll
        for (int i = 0; i < 2; ++i) { *(LAS u32x4*)(kb + kl[i]) = kr[i]; *(LAS u32x2*)(vb + vl[i]) = (u32x2){vr[i].x, vr[i].y}; *(LAS u32x2*)(vb + vl[i] + 8) = (u32x2){vr[i].z, vr[i].w}; }
        __syncthreads();
        if (st + 1 < st1) gload(st + 1);
#pragma unroll
        for (int h = 0; h < 2; ++h) { const int j = 2 * st + h;
            bool sel = (j >= jlo) && (j <= qblk);
            if (MODE == 0) sel = sel && selmask_test(smask + tl * 8, j);
            if (__any(sel)) { const int key0 = 64 * j; const bool diag = (j == qblk), first = (MODE == 1) && (j == qblk - 8);
                auto mask = [&](int u, int r) { const int key = key0 + 32 * u + crow(r, hi); return sel && (!diag || key <= t) && (!first || key > t - 512); };
                att_step64<4, SK_KP, SK_VP>(kb + h * 64 * SK_KP * 2, vb + h * 128, qf, o, m_run, l_run, scale2, MODE == 0 || diag || first, mask, col, hi); } }
    }
    const float l = l_run + __shfl_xor(l_run, 32); const float inv = l > 0.f ? 1.0f / l : 0.f;
    if (MODE == 1) {
#pragma unroll
        for (int b = 0; b < 2; ++b)
#pragma unroll
            for (int i = 0; i < 4; ++i) store4_bf16(OWIN + (size_t)t * 512 + head * 64 + 32 * b + 8 * i + 4 * hi, (f32x4){o[b][4 * i] * inv, o[b][4 * i + 1] * inv, o[b][4 * i + 2] * inv, o[b][4 * i + 3] * inv});
    } else {
        const bf16* gp = U2 + (size_t)t * U2W + U2_G + head * 3;
        const float s0 = sigmoidf_(bf2f(gp[0])), s1 = sigmoidf_(bf2f(gp[1])) * inv, s2g = sigmoidf_(bf2f(gp[2]));
#pragma unroll
        for (int b = 0; b < 2; ++b)
#pragma unroll
            for (int i = 0; i < 4; ++i) { const int dv = 32 * b + 8 * i + 4 * hi; const size_t off = (size_t)t * 512 + head * 64 + dv; const u32x2 oc = *(const u32x2*)(OCMP + off), ow = *(const u32x2*)(OWIN + off);
                f32x4 r; r[0] = s0 * bflo(oc.x) + s1 * o[b][4 * i] + s2g * bflo(ow.x); r[1] = s0 * bfhi(oc.x) + s1 * o[b][4 * i + 1] + s2g * bfhi(ow.x);
                r[2] = s0 * bflo(oc.y) + s1 * o[b][4 * i + 2] + s2g * bflo(ow.y); r[3] = s0 * bfhi(oc.y) + s1 * o[b][4 * i + 3] + s2g * bfhi(ow.y);
                store4_bf16(ABR + (size_t)t * D + head * 64 + dv, r); }
    }
}

__device__ __forceinline__ void cmp_unit(LAS unsigned char* lds, const bf16* U2, const bf16* KC, const bf16* VCT, bf16* OCMP, float* SC, int g, int qblk, int tid, int wave, int lane) {
    const int col = lane & 31, hi = lane >> 5;
    const int tl = 8 * wave + (col >> 2), t = 64 * qblk + tl, head = 4 * g + (col & 3);
    __syncthreads();
    bf16x8 qf[4];
    { const bf16* qp = U2 + (size_t)t * U2W + U2_Q + head * 64;
#pragma unroll
      for (int s = 0; s < 4; ++s) qf[s] = *(const bf16x8*)(qp + 16 * s + 8 * hi); }
    f32x16 o[2];
#pragma unroll
    for (int b = 0; b < 2; ++b)
#pragma unroll
        for (int r = 0; r < 16; ++r) o[b][r] = 0.f;
    float m_run = -INFINITY, l_run = 0.f;
    const float scale2 = 0.125f * LOG2E;
    const int nst = (4 * qblk + 3 + 127) >> 7;
    const int twmax = 64 * qblk + 8 * wave + 7; const int cw = (twmax >= 31) ? ((twmax - 31) >> 4) : -1;
    const int call = (64 * qblk >= 31) ? ((64 * qblk - 31) >> 4) : -1;
    const bf16* kg[2]; unsigned kl[2]; const bf16* vg[2]; unsigned vl[2];
#pragma unroll
    for (int i = 0; i < 2; ++i) { const int c = tid + 512 * i; { const int row = c >> 3, p = c & 7; kg[i] = KC + (size_t)(g * 1024 + row) * 64 + 8 * p; kl[i] = (unsigned)(row * SK_KP + 8 * p) * 2u; }
        { const int row = c >> 4, p = c & 15; vg[i] = VCT + (size_t)(g * 64 + row) * 1024 + 8 * p; vl[i] = (unsigned)(row * SK_VP + 8 * p) * 2u; } }
    u32x4 kr[2], vr[2];
#pragma unroll
    for (int i = 0; i < 2; ++i) { kr[i] = *(const u32x4*)kg[i]; vr[i] = *(const u32x4*)vg[i]; }
#pragma unroll 1
    for (int st = 0; st < nst; ++st) {
        const int buf = st & 1;
        LAS unsigned char* kb = lds + buf * SK_KB; LAS unsigned char* vb = lds + SK_VOFF + buf * SK_VB;
#pragma unroll
        for (int i = 0; i < 2; ++i) { *(LAS u32x4*)(kb + kl[i]) = kr[i]; *(LAS u32x2*)(vb + vl[i]) = (u32x2){vr[i].x, vr[i].y}; *(LAS u32x2*)(vb + vl[i] + 8) = (u32x2){vr[i].z, vr[i].w}; }
        __syncthreads();
        if (st + 1 < nst) {
#pragma unroll
            for (int i = 0; i < 2; ++i) { kr[i] = *(const u32x4*)(kg[i] + (size_t)128 * (st + 1) * 64); vr[i] = *(const u32x4*)(vg[i] + 128 * (st + 1)); } }
#pragma unroll
        for (int h = 0; h < 2; ++h) { const int c0 = 128 * st + 64 * h;
            if (c0 <= cw) { auto mask = [&](int u, int r) { return 16 * (c0 + 32 * u + crow(r, hi)) + 31 <= t; };
                att_step64<4, SK_KP, SK_VP>(kb + h * 64 * SK_KP * 2, vb + h * 128, qf, o, m_run, l_run, scale2, c0 + 63 > call, mask, col, hi); } }
    }
    const float l = l_run + __shfl_xor(l_run, 32); const float inv = l > 0.f ? 1.0f / l : 0.f;
#pragma unroll
    for (int b = 0; b < 2; ++b)
#pragma unroll
        for (int i = 0; i < 4; ++i) store4_bf16(OCMP + (size_t)t * 512 + head * 64 + 32 * b + 8 * i + 4 * hi, (f32x4){o[b][4 * i] * inv, o[b][4 * i + 1] * inv, o[b][4 * i + 2] * inv, o[b][4 * i + 3] * inv});
    const float mref = (m_run == -INFINITY) ? 0.f : m_run;
    float* dst = SC + (size_t)(t * 2 + g) * 256;
    float carry = 0.f;
    __syncthreads();
#pragma unroll
    for (int i = 0; i < 2; ++i) kr[i] = *(const u32x4*)kg[i];
#pragma unroll 1
    for (int st = 0; st < nst; ++st) {
        const int buf = st & 1; LAS unsigned char* kb = lds + buf * SK_KB;
#pragma unroll
        for (int i = 0; i < 2; ++i) *(LAS u32x4*)(kb + kl[i]) = kr[i];
        __syncthreads();
        if (st + 1 < nst) {
#pragma unroll
            for (int i = 0; i < 2; ++i) kr[i] = *(const u32x4*)(kg[i] + (size_t)128 * (st + 1) * 64); }
#pragma unroll
        for (int q4 = 0; q4 < 4; ++q4) { const int T = 4 * st + q4; float sv[4];
            if (32 * T <= cw) {
                const LAS unsigned char* kt = kb + q4 * 32 * SK_KP * 2;
                f32x16 sacc;
#pragma unroll
                for (int r = 0; r < 16; ++r) sacc[r] = 0.f;
#pragma unroll
                for (int s = 0; s < 4; ++s) { const bf16x8 kf = *(const LAS bf16x8*)(kt + (col * SK_KP + 16 * s + 8 * hi) * 2); sacc = __builtin_amdgcn_mfma_f32_32x32x16_bf16(kf, qf[s], sacc, 0, 0, 0); }
                float Gs[4], Es[4];
#pragma unroll
                for (int i = 0; i < 4; ++i) { float p[4];
#pragma unroll
                    for (int q = 0; q < 4; ++q) { const int r = 4 * i + q; const int c = 32 * T + crow(r, hi); p[q] = (16 * c + 31 <= t) ? __builtin_amdgcn_exp2f(sacc[r] * scale2 - mref) * inv : 0.f; }
                    Gs[i] = (p[0] + p[1]) + (p[2] + p[3]); Es[i] = p[3]; }
#pragma unroll
                for (int i = 0; i < 4; ++i) { Gs[i] += lane_xor1(Gs[i]); Gs[i] += lane_xor2(Gs[i]); Es[i] += lane_xor1(Es[i]); Es[i] += lane_xor2(Es[i]); }
                float eo[4];
#pragma unroll
                for (int i = 0; i < 4; ++i) eo[i] = lane_xor32(Es[i], hi);
                if (hi) { sv[0] = Gs[0] + eo[0]; sv[1] = Gs[1] + eo[1]; sv[2] = Gs[2] + eo[2]; sv[3] = Gs[3] + eo[3]; }
                else { sv[0] = Gs[0] + carry; sv[1] = Gs[1] + eo[0]; sv[2] = Gs[2] + eo[1]; sv[3] = Gs[3] + eo[2]; }
                carry = eo[3];
            } else { sv[0] = hi ? 0.f : carry; sv[1] = 0.f; sv[2] = 0.f; sv[3] = 0.f; carry = 0.f; }
            if ((col & 3) == 0) {
#pragma unroll
                for (int i = 0; i < 4; ++i) dst[8 * T + 2 * i + hi] = sv[i]; } }
    }
#pragma unroll 1
    for (int T = 4 * nst; T < 32; ++T) {
        if ((col & 3) == 0) { dst[8 * T + hi] = (hi || T != 4 * nst) ? 0.f : carry; dst[8 * T + 2 + hi] = 0.f; dst[8 * T + 4 + hi] = 0.f; dst[8 * T + 6 + hi] = 0.f; } }
}

struct Sel16 { bf16x8 qf[2]; f32x4 o[4]; float m_run, l_run; };
template <int VP, class MaskF>
__device__ __forceinline__ void att16_block(const LAS unsigned char* kb, const LAS unsigned char* vb, Sel16& st, float scale2, const MaskF& mask, int c16, int G) {
    f32x4 acc[4];
#pragma unroll
    for (int kt = 0; kt < 4; ++kt) { const LAS unsigned char* kp = kb + ((16 * kt + c16) * SK_KP + 8 * G) * 2;
        const bf16x8 k0 = *(const LAS bf16x8*)kp, k1 = *(const LAS bf16x8*)(kp + 64);
        acc[kt] = __builtin_amdgcn_mfma_f32_16x16x32_bf16(k0, st.qf[0], (f32x4){0.f, 0.f, 0.f, 0.f}, 0, 0, 0);
        acc[kt] = __builtin_amdgcn_mfma_f32_16x16x32_bf16(k1, st.qf[1], acc[kt], 0, 0, 0); }
    float mt = -INFINITY;
#pragma unroll
    for (int kt = 0; kt < 4; ++kt)
#pragma unroll
        for (int i = 0; i < 4; ++i) { const float x = mask(16 * kt + 4 * G + i) ? acc[kt][i] * scale2 : -INFINITY; acc[kt][i] = x; mt = fmaxf(mt, x); }
    mt = xmax32(xmax16(mt));
    const float m_new = fmaxf(st.m_run, mt); const float mref = (m_new == -INFINITY) ? 0.f : m_new;
    if (__any(m_new != st.m_run)) { const float corr = __builtin_amdgcn_exp2f(st.m_run - mref); st.l_run *= corr; st.m_run = m_new;
#pragma unroll
        for (int d = 0; d < 4; ++d) st.o[d] = st.o[d] * corr; }
    float ps = 0.f;
#pragma unroll
    for (int kt = 0; kt < 4; ++kt)
#pragma unroll
        for (int i = 0; i < 4; ++i) { acc[kt][i] = __builtin_amdgcn_exp2f(acc[kt][i] - mref); ps += acc[kt][i]; }
    st.l_run += ps;
#pragma unroll
    for (int u = 0; u < 2; ++u) {
        const bf16x8 pf = __builtin_bit_cast(bf16x8, (u32x4){cvt_pk_bf16(acc[2 * u][0], acc[2 * u][1]), cvt_pk_bf16(acc[2 * u][2], acc[2 * u][3]), cvt_pk_bf16(acc[2 * u + 1][0], acc[2 * u + 1][1]), cvt_pk_bf16(acc[2 * u + 1][2], acc[2 * u + 1][3])});
#pragma unroll
        for (int d = 0; d < 4; ++d) { const LAS unsigned char* vp = vb + ((16 * d + c16) * VP + 32 * u + 4 * G) * 2;
            const u32x2 lo = *(const LAS u32x2*)vp, hh = *(const LAS u32x2*)(vp + 32);
            st.o[d] = __builtin_amdgcn_mfma_f32_16x16x32_bf16(__builtin_bit_cast(bf16x8, (u32x4){lo.x, lo.y, hh.x, hh.y}), pf, st.o[d], 0, 0, 0); } }
}
constexpr int S16_NB = 4;
constexpr int S16_VP = S16_NB * 64 + 4;
constexpr int S16_KB = S16_NB * 64 * SK_KP * 2, S16_VB = 64 * S16_VP * 2, S16_VOFF = 2 * S16_KB, S16_MOFF = S16_VOFF + 2 * S16_VB;
static_assert(S16_MOFF + 2048 <= LDS_BYTES - 1536, "sel16 LDS map");
__device__ __forceinline__ void sel_unit16(LAS unsigned char* lds, const bf16* U2, const bf16* VTS, const unsigned* SM, const bf16* OCMP, const bf16* OWIN, bf16* ABR, int g, int qblk, int tid, int wave, int lane) {
    const int c16 = lane & 15, G = lane >> 4;
    const int head = 4 * g + (c16 & 3);
    LAS unsigned* smask = (LAS unsigned*)(lds + S16_MOFF);
    __syncthreads();
    smask[tid] = SM[(size_t)((64 * qblk + (tid >> 3)) * 2 + g) * 8 + (tid & 7)];
    Sel16 grp[2]; int tlg[2];
#pragma unroll
    for (int gi = 0; gi < 2; ++gi) { tlg[gi] = 8 * wave + 4 * gi + (c16 >> 2); const bf16* qp = U2 + (size_t)(64 * qblk + tlg[gi]) * U2W + U2_Q + head * 64 + 8 * G;
        grp[gi].qf[0] = *(const bf16x8*)qp; grp[gi].qf[1] = *(const bf16x8*)(qp + 32); grp[gi].m_run = -INFINITY; grp[gi].l_run = 0.f;
#pragma unroll
        for (int d = 0; d < 4; ++d) grp[gi].o[d] = (f32x4){0.f, 0.f, 0.f, 0.f}; }
    const float scale2 = 0.125f * LOG2E;
    const int st1 = qblk / S16_NB + 1;
    unsigned ko_[4], kl[4], vo_[4], vl[4];
    const bf16* Kb = U2 + U2_KV + (2 * 2 + g) * 64; const bf16* Vb = VTS + (size_t)(g * 64) * S;
#pragma unroll
    for (int i = 0; i < 4; ++i) { const int c = tid + 512 * i; { const int row = c >> 3, p = c & 7; ko_[i] = (unsigned)(row * U2W + 8 * p); kl[i] = (unsigned)(row * SK_KP + 8 * p) * 2u; }
        { const int row = c >> 5, p = c & 31; vo_[i] = (unsigned)(row * S + 8 * p); vl[i] = (unsigned)(row * S16_VP + 8 * p) * 2u; } }
    u32x4 kr[4], vr[4];
    auto gload = [&](int step) { int key0 = 64 * S16_NB * step; if (key0 + 64 * S16_NB > S) key0 = S - 64 * S16_NB;
        const bf16* kp = Kb + (size_t)key0 * U2W; const bf16* vp = Vb + key0;
#pragma unroll
        for (int i = 0; i < 4; ++i) { kr[i] = *(const u32x4*)(kp + ko_[i]); vr[i] = *(const u32x4*)(vp + vo_[i]); } };
    gload(0);
#pragma unroll 1
    for (int st = 0; st < st1; ++st) {
        const int buf = st & 1;
        LAS unsigned char* kb = lds + buf * S16_KB; LAS unsigned char* vb = lds + S16_VOFF + buf * S16_VB;
#pragma unroll
        for (int i = 0; i < 4; ++i) { *(LAS u32x4*)(kb + kl[i]) = kr[i]; *(LAS u32x2*)(vb + vl[i]) = (u32x2){vr[i].x, vr[i].y}; *(LAS u32x2*)(vb + vl[i] + 8) = (u32x2){vr[i].z, vr[i].w}; }
        __syncthreads();
        if (st + 1 < st1) gload(st + 1);
#pragma unroll
        for (int h = 0; h < S16_NB; ++h) { const int j = S16_NB * st + h;
            if (j <= qblk) {
#pragma unroll
                for (int gi = 0; gi < 2; ++gi) { const bool sel = selmask_test(smask + tlg[gi] * 8, j);
                    if (__any(sel)) { const int t = 64 * qblk + tlg[gi]; const int key0 = 64 * j; const bool diag = (j == qblk);
                        auto mask = [&](int k) { return sel && (!diag || key0 + k <= t); };
                        att16_block<S16_VP>(kb + h * 64 * SK_KP * 2, vb + h * 128, grp[gi], scale2, mask, c16, G); } } } }
    }
#pragma unroll
    for (int gi = 0; gi < 2; ++gi) { const int t = 64 * qblk + tlg[gi];
        float l = grp[gi].l_run; l += __shfl_xor(l, 16); l += __shfl_xor(l, 32); const float inv = l > 0.f ? 1.0f / l : 0.f;
        const bf16* gp = U2 + (size_t)t * U2W + U2_G + head * 3;
        const float s0 = sigmoidf_(bf2f(gp[0])), s1 = sigmoidf_(bf2f(gp[1])) * inv, s2g = sigmoidf_(bf2f(gp[2]));
#pragma unroll
        for (int d = 0; d < 4; ++d) { const int dv = 16 * d + 4 * G; const size_t off = (size_t)t * 512 + head * 64 + dv; const u32x2 oc = *(const u32x2*)(OCMP + off), ow = *(const u32x2*)(OWIN + off);
            f32x4 r; r[0] = s0 * bflo(oc.x) + s1 * grp[gi].o[d][0] + s2g * bflo(ow.x); r[1] = s0 * bfhi(oc.x) + s1 * grp[gi].o[d][1] + s2g * bfhi(ow.x);
            r[2] = s0 * bflo(oc.y) + s1 * grp[gi].o[d][2] + s2g * bflo(ow.y); r[3] = s0 * bfhi(oc.y) + s1 * grp[gi].o[d][3] + s2g * bfhi(ow.y);
            store4_bf16(ABR + (size_t)t * D + head * 64 + dv, r); } }
}

struct LP {
    unsigned char* ws; unsigned char* wl; int l;
    __device__ __forceinline__ bf16* w(size_t off) const { return (bf16*)(wl + off); }
    __device__ __forceinline__ bf16* b(size_t off) const { return (bf16*)(ws + off); }
    __device__ __forceinline__ float* f(size_t off) const { return (float*)(ws + off); }
    __device__ __forceinline__ int* i(size_t off) const { return (int*)(ws + off); }
};
#define INF32(a, idx, per) ((const float*)(a).in[idx] + (size_t)l * (per))

#ifndef BPARTS
#define BPARTS 31
#endif
#ifndef DUPSUB
#define DUPSUB 0
#endif
#define SUBREP(bit) for (int srep_ = 0; srep_ < 1 + ((DUPSUB >> (bit)) & 1); ++srep_)
__device__ __forceinline__ void phase_prep(const Args& a, Frame& F, const LP& P) {
    const int l = P.l, lane = F.lane, tid = F.tid;
    const bf16* U2 = P.b(WS_U2); bf16* ABR = P.b(WS_ABR);
    if (BPARTS & 1) { const float* cw = INF32(a, 17, 31 * 512); const float* cb = INF32(a, 18, 512); const float* lg = INF32(a, 19, 512); const float* lb = INF32(a, 20, 512);
      LAS bf16* hb = (LAS bf16*)F.lds;
      LAS float* cs = (LAS float*)(F.lds + 65536);
      const int c = tid;
      float w[31];
#pragma unroll
      for (int k = 0; k < 31; ++k) w[k] = cw[k * 512 + c];
      const float bias = cb[c];
#pragma unroll 1
      for (int tile = blockIdx.x; tile < S / 32; tile += F.G) { const int t0 = tile * 32;
          { u32x4 av[8], gv[8];
#pragma unroll
            for (int i = 0; i < 8; ++i) { const int item = tid + 512 * i, r = item >> 6, ch = (item & 63) * 8; int tok = t0 - 30 + r; tok = tok < 0 ? 0 : tok;
                const bf16* up = U2 + (size_t)tok * U2W + U2_CONV + ch;
                if (r < 62) { av[i] = *(const u32x4*)up; gv[i] = *(const u32x4*)(up + 512); } else { av[i] = (u32x4){0u, 0u, 0u, 0u}; gv[i] = av[i]; } }
#pragma unroll
            for (int i = 0; i < 8; ++i) { const int item = tid + 512 * i, r = item >> 6, ch = (item & 63) * 8; const bool ok = (t0 - 30 + r) >= 0;
                u32x4 o;
#pragma unroll
                for (int q = 0; q < 4; ++q) { const float h0 = bflo(av[i][q]) * sigmoidf_(bflo(gv[i][q])), h1 = bfhi(av[i][q]) * sigmoidf_(bfhi(gv[i][q])); o[q] = ok ? cvt_pk_bf16(h0, h1) : 0u; }
                if (r < 62) *(LAS u32x4*)(hb + r * 512 + ch) = o; } }
          __syncthreads();
          float hreg[62];
#pragma unroll
          for (int r = 0; r < 62; ++r) hreg[r] = bf2f(hb[r * 512 + c]);
#pragma unroll
          for (int i = 0; i < 32; ++i) { float acc = bias;
#pragma unroll
              for (int k = 0; k < 31; ++k) acc += w[k] * hreg[i + k];
              cs[i * 512 + c] = acc; }
          __syncthreads();
#pragma unroll
          for (int q = 0; q < 4; ++q) { const int tt = 4 * F.wave + q; float v[8]; float s = 0.f;
#pragma unroll
              for (int j = 0; j < 8; ++j) { v[j] = cs[tt * 512 + lane + 64 * j]; s += v[j]; }
              const float mean = wave_sum(s) * (1.0f / 512.0f); float qq = 0.f;
#pragma unroll
              for (int j = 0; j < 8; ++j) { v[j] -= mean; qq += v[j] * v[j]; }
              const float rstd = 1.0f / sqrtf(wave_sum(qq) * (1.0f / 512.0f) + 1e-5f);
#pragma unroll
              for (int j = 0; j < 8; ++j) { const int ch = lane + 64 * j; const float y = v[j] * rstd * lg[ch] + lb[ch]; ABR[(size_t)(t0 + tt) * D + 1536 + ch] = f2bf(y * sigmoidf_(y)); } }
          __syncthreads(); } }
    if (BPARTS & 2) { float* rq = P.f(WS_RSTD); float* rkv = rq + S;
      const int sub = lane >> 4, l16 = lane & 15;
#pragma unroll 1
      for (int t0 = 4 * F.gw; t0 < S; t0 += 4 * F.NGW) { const int t = t0 + sub; const bf16* row = U2 + (size_t)t * U2W;
          const u32x4 a0 = *(const u32x4*)(row + U2_CQ + 8 * l16), a1 = *(const u32x4*)(row + U2_CQ + 8 * l16 + 128), a2 = *(const u32x4*)(row + U2_CQ + 8 * l16 + 256), a3 = *(const u32x4*)(row + U2_CQ + 8 * l16 + 384);
          const u32x4 c0 = *(const u32x4*)(row + U2_CKV + 8 * l16), c1 = *(const u32x4*)(row + U2_CKV + 8 * l16 + 128);
          float s = 0.f, s2 = 0.f;
#pragma unroll
          for (int q = 0; q < 4; ++q) { float x; x = bflo(a0[q]); s += x * x; x = bfhi(a0[q]); s += x * x; x = bflo(a1[q]); s += x * x; x = bfhi(a1[q]); s += x * x;
              x = bflo(a2[q]); s += x * x; x = bfhi(a2[q]); s += x * x; x = bflo(a3[q]); s += x * x; x = bfhi(a3[q]); s += x * x;
              x = bflo(c0[q]); s2 += x * x; x = bfhi(c0[q]); s2 += x * x; x = bflo(c1[q]); s2 += x * x; x = bfhi(c1[q]); s2 += x * x; }
#pragma unroll
          for (int o = 0; o < 1; ++o) { s = row16_sum(s); s2 = row16_sum(s2); }
          if (l16 == 0) { rq[t] = 1.0f / sqrtf(s * (1.0f / 512.0f) + 1e-6f); rkv[t] = 1.0f / sqrtf(s2 * (1.0f / 256.0f) + 1e-6f); } }
#pragma unroll 1
      for (int r0 = 8 * F.gw; r0 < S; r0 += 8 * F.NGW) { const int w = 2 << (lane >> 4); const bf16* col = U2 + U2_POOL + 8 * lane;
          float sum[8];
#pragma unroll
          for (int q = 0; q < 8; ++q) sum[q] = 0.f;
          for (int i = 1; i < w; ++i) { const int tt = r0 - i; if (tt >= 0) { const u32x4 v = *(const u32x4*)(col + (size_t)tt * U2W);
#pragma unroll
              for (int q = 0; q < 4; ++q) { sum[2 * q] += bflo(v[q]); sum[2 * q + 1] += bfhi(v[q]); } } }
#pragma unroll
          for (int k = 0; k < 8; ++k) { const int t = r0 + k; const u32x4 v = *(const u32x4*)(col + (size_t)t * U2W);
              const int to = t - w + 1; u32x4 vo = (u32x4){0u, 0u, 0u, 0u}; if (to >= 0) vo = *(const u32x4*)(col + (size_t)to * U2W);
              const int cnt = (t + 1 < w) ? (t + 1) : w; const float ic = 1.0f / (float)cnt; u32x4 o;
#pragma unroll
              for (int q = 0; q < 4; ++q) { sum[2 * q] += bflo(v[q]); sum[2 * q + 1] += bfhi(v[q]);
                  o[q] = cvt_pk_bf16(sum[2 * q] * ic - bflo(v[q]), sum[2 * q + 1] * ic - bfhi(v[q]));
                  sum[2 * q] -= bflo(vo[q]); sum[2 * q + 1] -= bfhi(vo[q]); }
              *(u32x4*)(ABR + (size_t)t * D + 512 + 8 * lane) = o; } } }
    if (BPARTS & 4) { LAS bf16* scr = (LAS bf16*)(F.lds + 65536 + F.wave * 8448);
#pragma unroll 1
      for (int it = F.gw; it < 2 * 2 * (S / 64); it += F.NGW) { const int tt = it % (S / 64), g = (it / (S / 64)) & 1, which = it / (2 * (S / 64));
          const bf16* src = U2 + (size_t)(tt * 64) * U2W + U2_KV + ((which ? 5 : 3) * 2 + g) * 64;
          bf16* dst = P.b(which ? WS_VTWIN : WS_VTSEL) + (size_t)(g * 64) * S + tt * 64;
          transpose_tile64(src, U2W, dst, S, scr, lane); } }
    if (BPARTS & 8) { bf16* HID = P.b(WS_HID); const float* b1c = (const float*)(P.wl + WO_B1C);
#pragma unroll 1
      for (int it = F.gw; it < 4 * 64 * 8; it += F.NGW) { const int nt = it & 7, mt = (it >> 3) & 63, jg = it >> 9, j = jg >> 1, g = jg & 1;
          const bf16* Ab = U2 + U2_KV + (j * 2 + g) * 64; const bf16* Bb = P.w(WO_W1C) + (size_t)j * 128 * 2048;
          auto ap = [&](int r, int k) { int n = 16 * mt + r; n = n > 1022 ? 1022 : n; return Ab + (size_t)(16 * n + (k >> 6)) * U2W + (k & 63); };
          auto bp = [&](int r, int k) { return Bb + (size_t)(16 * nt + r) * 2048 + k; };
          const f32x4 acc = sgemm16(ap, bp, 2048, lane);
          const int h = 16 * nt + (lane & 15); const float bb = b1c[j * 128 + h];
#pragma unroll
          for (int i = 0; i < 4; ++i) { const int n = 16 * mt + 4 * (lane >> 4) + i; HID[((size_t)jg * 1024 + n) * 128 + h] = f2bf(gelu_tanh(acc[i] + bb)); } } }
}
__device__ __forceinline__ void memkv_items(const LP& P, int first, int nw, int lane) {
    const int l = P.l; const bf16* MEMB = P.b(WS_MEMB); bf16* KX = P.b(WS_KX) + (size_t)l * 256 * 512; bf16* VXT = P.b(WS_VXT) + (size_t)l * 512 * 256;
#pragma unroll 1
    for (int it = first; it < 1024; it += nw) {
        if (it < 512) { const int mt = it >> 5, nt = it & 31;
            auto ap = [&](int r, int k) { return MEMB + (size_t)(16 * mt + r) * D + k; };
            auto bp = [&](int r, int k) { return P.w(WO_WXK) + (size_t)(16 * nt + r) * D + k; };
            const f32x4 acc = sgemm16(ap, bp, D, lane);
#pragma unroll
            for (int i = 0; i < 4; ++i) KX[(size_t)(16 * mt + 4 * (lane >> 4) + i) * 512 + 16 * nt + (lane & 15)] = f2bf(acc[i]);
        } else { const int q = it - 512, mt = q >> 4, nt = q & 15;
            auto ap = [&](int r, int k) { return P.w(WO_WXV) + (size_t)(16 * mt + r) * D + k; };
            auto bp = [&](int r, int k) { return MEMB + (size_t)(16 * nt + r) * D + k; };
            const f32x4 acc = sgemm16(ap, bp, D, lane);
#pragma unroll
            for (int i = 0; i < 4; ++i) VXT[(size_t)(16 * mt + 4 * (lane >> 4) + i) * 256 + 16 * nt + (lane & 15)] = f2bf(acc[i]); } }
}

__device__ __forceinline__ void phase_compress2(Frame& F, const LP& P) {
    const int lane = F.lane; const bf16* HID = P.b(WS_HID); const bf16* W2 = P.w(WO_W2C);
#pragma unroll 1
    for (int it = F.gw; it < 1024; it += F.NGW) {
        if (it < 512) { const int nt = it & 3, mt = (it >> 2) & 63, g = it >> 8;
            auto ap = [&](int r, int k) { return HID + ((size_t)(0 * 2 + g) * 1024 + 16 * mt + r) * 128 + k; };
            auto bp = [&](int r, int k) { return W2 + (size_t)(16 * nt + r) * 128 + k; };
            const f32x4 acc = sgemm16(ap, bp, 128, lane);
#pragma unroll
            for (int i = 0; i < 4; ++i) P.b(WS_KC)[((size_t)g * 1024 + 16 * mt + 4 * (lane >> 4) + i) * 64 + 16 * nt + (lane & 15)] = f2bf(acc[i]);
        } else { const int q = it - 512, nt = q & 63, mt = (q >> 6) & 3, g = q >> 8;
            auto ap = [&](int r, int k) { return W2 + (size_t)64 * 128 + (size_t)(16 * mt + r) * 128 + k; };
            auto bp = [&](int r, int k) { return HID + ((size_t)(1 * 2 + g) * 1024 + 16 * nt + r) * 128 + k; };
            const f32x4 acc = sgemm16(ap, bp, 128, lane);
#pragma unroll
            for (int i = 0; i < 4; ++i) P.b(WS_VCT)[((size_t)g * 64 + 16 * mt + 4 * (lane >> 4) + i) * 1024 + 16 * nt + (lane & 15)] = f2bf(acc[i]); } }
}

__device__ __forceinline__ void phase_d(Frame& F, const LP& P) {
    const int lane = F.lane;
    { const bf16* KVH = P.b(WS_KVH); const bf16* U2 = P.b(WS_U2); bf16* KR = P.b(WS_KM); const f32x2* rope = (const f32x2*)(P.ws + WS_ROPE);
#pragma unroll 1
      for (int i = F.gw * 64 + lane; i < S * 8; i += F.NGW * 64) { const int t = i >> 3, k = 2 * (i & 7);
          const bf16* kr = U2 + (size_t)t * U2W + U2_KR;
          const unsigned a = *(const unsigned*)(kr + k), b = *(const unsigned*)(kr + 16 + k); const f32x4 cs = *(const f32x4*)(rope + (size_t)t * 16 + k);
          const float x10 = bflo(a), x11 = bfhi(a), x20 = bflo(b), x21 = bfhi(b);
          *(unsigned*)(KR + (size_t)t * 32 + k) = cvt_pk_bf16(x10 * cs[0] - x20 * cs[1], x11 * cs[2] - x21 * cs[3]);
          *(unsigned*)(KR + (size_t)t * 32 + 16 + k) = cvt_pk_bf16(x20 * cs[0] + x10 * cs[1], x21 * cs[2] + x11 * cs[3]); }
      LAS bf16* scr = (LAS bf16*)(F.lds + F.wave * 8448);
#pragma unroll 1
      for (int it = F.gw; it < 8 * (S / 64); it += F.NGW) { const int tt = it % (S / 64), hd = it / (S / 64);
          transpose_tile64(KVH + (size_t)(tt * 64) * 1024 + hd * 128 + 64, 1024, P.b(WS_VTM) + (size_t)(hd * 64) * S + tt * 64, S, scr, lane); } }
    __syncthreads();
    SUBREP(3)
#pragma unroll 1
    for (int i = blockIdx.x; i < 512; i += F.G) { const int r = i >> 8, p = i & 255; const int qb = r ? 255 - (p >> 1) : (p >> 1);
        cmp_unit(F.lds, P.b(WS_U2), P.b(WS_KC), P.b(WS_VCT), P.b(WS_OCMP), P.f(WS_SCORES), p & 1, qb, F.tid, F.wave, lane); }
}


constexpr int MK_KP = 104, MK_VP = 132;
constexpr int MK_KB = 128 * MK_KP * 2, MK_VB = 64 * MK_VP * 2, MK_VOFF = 2 * MK_KB;
__device__ __forceinline__ void mla_unit(LAS unsigned char* lds, const bf16* Q, const bf16* KVH, const bf16* KR, const bf16* Vt, bf16* O, int hd, int qb, int tid, int wave, int lane) {
    const int col = lane & 31, hi = lane >> 5;
    const int q0 = qb * 256 + wave * 32;
    bf16x8 qf[6];
    { const bf16* qp = Q + (size_t)(q0 + col) * 768 + hd * 96;
#pragma unroll
      for (int s = 0; s < 6; ++s) qf[s] = *(const bf16x8*)(qp + 16 * s + 8 * hi); }
    f32x16 o[2];
#pragma unroll
    for (int b = 0; b < 2; ++b)
#pragma unroll
        for (int r = 0; r < 16; ++r) o[b][r] = 0.f;
    float m_run = -INFINITY, l_run = 0.f;
    const int nt = 2 * (qb + 1);
    const bf16* kg[3]; unsigned kl[3]; int kst[3]; const bf16* vg[2]; unsigned vl[2];
#pragma unroll
    for (int i = 0; i < 3; ++i) { const int c = tid + 512 * i, row = c / 12, p = c % 12; const bool nope = p < 8; kst[i] = nope ? 1024 : 32;
        kg[i] = nope ? KVH + (size_t)row * 1024 + hd * 128 + 8 * p : KR + (size_t)row * 32 + 8 * (p - 8); kl[i] = (unsigned)(row * MK_KP + 8 * p) * 2u; }
#pragma unroll
    for (int i = 0; i < 2; ++i) { const int c = tid + 512 * i, row = c >> 4, p = c & 15; vg[i] = Vt + (size_t)(hd * 64 + row) * S + 8 * p; vl[i] = (unsigned)(row * MK_VP + 8 * p) * 2u; }
    u32x4 kr[3], vr[2];
#pragma unroll
    for (int i = 0; i < 3; ++i) kr[i] = *(const u32x4*)kg[i];
#pragma unroll
    for (int i = 0; i < 2; ++i) vr[i] = *(const u32x4*)vg[i];
#pragma unroll 1
    for (int t = 0; t < nt; ++t) {
        const int buf = t & 1; const int key0 = 128 * t;
        LAS unsigned char* kb = lds + buf * MK_KB; LAS unsigned char* vb = lds + MK_VOFF + buf * MK_VB;
#pragma unroll
        for (int i = 0; i < 3; ++i) *(LAS u32x4*)(kb + kl[i]) = kr[i];
#pragma unroll
        for (int i = 0; i < 2; ++i) { *(LAS u32x2*)(vb + vl[i]) = (u32x2){vr[i].x, vr[i].y}; *(LAS u32x2*)(vb + vl[i] + 8) = (u32x2){vr[i].z, vr[i].w}; }
        __syncthreads();
        if (t + 1 < nt) {
#pragma unroll
            for (int i = 0; i < 3; ++i) kr[i] = *(const u32x4*)(kg[i] + (size_t)(key0 + 128) * kst[i]);
#pragma unroll
            for (int i = 0; i < 2; ++i) vr[i] = *(const u32x4*)(vg[i] + key0 + 128); }
#pragma unroll
        for (int h = 0; h < 2; ++h) { const int k0h = key0 + 64 * h;
            if (k0h <= q0 + 31) { auto mask = [&](int u, int r) { return k0h + 32 * u + crow(r, hi) <= q0 + col; };
                att_step64<6, MK_KP, MK_VP>(kb + h * 64 * MK_KP * 2, vb + h * 128, qf, o, m_run, l_run, 1.0f, k0h + 63 > q0, mask, col, hi); } }
    }
    const float l = l_run + __shfl_xor(l_run, 32); const float inv = l > 0.f ? 1.0f / l : 0.f;
    bf16* op = O + (size_t)(q0 + col) * D + 1024 + hd * 64;
#pragma unroll
    for (int b = 0; b < 2; ++b)
#pragma unroll
        for (int i = 0; i < 4; ++i) store4_bf16(op + 32 * b + 8 * i + 4 * hi, (f32x4){o[b][4 * i] * inv, o[b][4 * i + 1] * inv, o[b][4 * i + 2] * inv, o[b][4 * i + 3] * inv});
}

#define MLA_SB __builtin_amdgcn_sched_barrier(0)
template <bool HAS_NEXT, bool FINISH = true>
__device__ __forceinline__ void mla_stage1(const LAS unsigned char* kbn, const bf16x8 (&qf)[6], f32x16& cur, f32x16& nxt, bf16x8 (&pf)[2], float mref, float& l_run, int col, int hi) {
    const LAS unsigned char* kp0 = kbn + (col * MK_KP + 8 * hi) * 2;
    bf16x8 kf[6];
    if (HAS_NEXT) {
#pragma unroll
        for (int c = 0; c < 6; ++c) kf[c] = *(const LAS bf16x8*)(kp0 + 32 * c); }
    float ps = 0.f;
    MLA_SB;
#pragma unroll
    for (int c = 0; c < 6; ++c) {
        const int e0 = (16 * c + 5) / 6, e1 = (16 * (c + 1) + 5) / 6;
        if (FINISH) {
#pragma unroll
            for (int r = e0; r < e1; ++r) { const float pe = __builtin_amdgcn_exp2f(cur[r] - mref); cur[r] = pe; ps += pe; }
            asm volatile("" : "+v"(ps));
            if (c == 3) pf[0] = __builtin_bit_cast(bf16x8, (u32x4){cvt_pk_bf16(cur[0], cur[1]), cvt_pk_bf16(cur[2], cur[3]), cvt_pk_bf16(cur[4], cur[5]), cvt_pk_bf16(cur[6], cur[7])}); }
        if (HAS_NEXT) {
            if (c == 0) { f32x16 z;
#pragma unroll
                for (int r = 0; r < 16; ++r) z[r] = 0.f;
                nxt = __builtin_amdgcn_mfma_f32_32x32x16_bf16(kf[0], qf[0], z, 0, 0, 0); }
            else nxt = __builtin_amdgcn_mfma_f32_32x32x16_bf16(kf[c], qf[c], nxt, 0, 0, 0);
            asm volatile("" : "+v"(nxt)); }
        MLA_SB; }
    if (FINISH) pf[1] = __builtin_bit_cast(bf16x8, (u32x4){cvt_pk_bf16(cur[8], cur[9]), cvt_pk_bf16(cur[10], cur[11]), cvt_pk_bf16(cur[12], cur[13]), cvt_pk_bf16(cur[14], cur[15])});
    l_run += ps;
}
template <bool DO_PV, bool HAS_NEXT>
__device__ __forceinline__ void mla_stage2(const LAS unsigned char* vbc, const bf16x8 (&pf)[2], f32x16 (&o)[2], f32x16& nxt, float& m_run, float& l_run, float& mref, bool use_mask, int kn0, int qcol, int col, int hi) {
    const LAS unsigned char* vp0 = vbc + (col * MK_VP + 4 * hi) * 2; const LAS unsigned char* vp1 = vp0 + 32 * MK_VP * 2;
    u32x2 al[2], ah[2], bl[2], bh[2];
    if (DO_PV) {
#pragma unroll
        for (int c = 0; c < 2; ++c) { al[c] = *(const LAS u32x2*)(vp0 + 32 * c); ah[c] = *(const LAS u32x2*)(vp0 + 32 * c + 16); bl[c] = *(const LAS u32x2*)(vp1 + 32 * c); bh[c] = *(const LAS u32x2*)(vp1 + 32 * c + 16); } }
    if (HAS_NEXT && use_mask) {
        const int lim = qcol - kn0 - 4 * hi;
#pragma unroll
        for (int r = 0; r < 16; ++r) nxt[r] = ((r & 3) + 8 * (r >> 2) > lim) ? -INFINITY : nxt[r]; }
    float mt = -INFINITY;
    MLA_SB;
#pragma unroll
    for (int c = 0; c < 2; ++c) {
        if (HAS_NEXT) {
#pragma unroll
            for (int r = 8 * c; r < 8 * c + 8; ++r) mt = fmaxf(mt, nxt[r]);
            asm volatile("" : "+v"(mt)); }
        if (DO_PV) {
            o[0] = __builtin_amdgcn_mfma_f32_32x32x16_bf16(__builtin_bit_cast(bf16x8, (u32x4){al[c].x, al[c].y, ah[c].x, ah[c].y}), pf[c], o[0], 0, 0, 0);
            o[1] = __builtin_amdgcn_mfma_f32_32x32x16_bf16(__builtin_bit_cast(bf16x8, (u32x4){bl[c].x, bl[c].y, bh[c].x, bh[c].y}), pf[c], o[1], 0, 0, 0); }
        MLA_SB; }
    if (HAS_NEXT) {
        mt = xmax32(mt);
        const float m_new = fmaxf(m_run, mt); const float mr = (m_new == -INFINITY) ? 0.f : m_new;
        if (__any(m_new != m_run)) { const float corr = __builtin_amdgcn_exp2f(m_run - mr); l_run *= corr; m_run = m_new;
#pragma unroll
            for (int b = 0; b < 2; ++b)
#pragma unroll
                for (int r = 0; r < 16; ++r) o[b][r] *= corr; }
        mref = mr; }
}
__device__ __forceinline__ void mla_unit_p(LAS unsigned char* lds, const bf16* Q, const bf16* KVH, const bf16* KR, const bf16* Vt, bf16* O, int hd, int qb, int tid, int wave, int lane) {
    const int col = lane & 31, hi = lane >> 5;
    const int q0 = qb * 256 + wave * 32, qcol = q0 + col;
    bf16x8 qf[6];
    { const bf16* qp = Q + (size_t)(q0 + col) * 768 + hd * 96;
#pragma unroll
      for (int s = 0; s < 6; ++s) qf[s] = *(const bf16x8*)(qp + 16 * s + 8 * hi); }
    f32x16 o[2];
#pragma unroll
    for (int b = 0; b < 2; ++b)
#pragma unroll
        for (int r = 0; r < 16; ++r) o[b][r] = 0.f;
    float m_run = -INFINITY, l_run = 0.f, mref = 0.f;
    const int ns = 2 * (qb + 1);
    const bf16* kg[3]; unsigned kl[3]; int kst[3]; const bf16* vg[2]; unsigned vl[2];
#pragma unroll
    for (int i = 0; i < 3; ++i) { const int c = tid + 512 * i, row = c / 12, p = c % 12; const bool nope = p < 8; kst[i] = nope ? 1024 : 32;
        kg[i] = nope ? KVH + (size_t)row * 1024 + hd * 128 + 8 * p : KR + (size_t)row * 32 + 8 * (p - 8); kl[i] = (unsigned)(row * MK_KP + 8 * p) * 2u; }
#pragma unroll
    for (int i = 0; i < 2; ++i) { const int c = tid + 512 * i, row = c >> 4, p = c & 15; vg[i] = Vt + (size_t)(hd * 64 + row) * S + 8 * p; vl[i] = (unsigned)(row * MK_VP + 8 * p) * 2u; }
    u32x4 kr[3], vr[2];
    auto gload = [&](int step) { const int key0 = 128 * step;
#pragma unroll
        for (int i = 0; i < 3; ++i) kr[i] = *(const u32x4*)(kg[i] + (size_t)key0 * kst[i]);
#pragma unroll
        for (int i = 0; i < 2; ++i) vr[i] = *(const u32x4*)(vg[i] + key0); };
    auto lwrite = [&](int buf) { LAS unsigned char* kb = lds + buf * MK_KB; LAS unsigned char* vb = lds + MK_VOFF + buf * MK_VB;
#pragma unroll
        for (int i = 0; i < 3; ++i) *(LAS u32x4*)(kb + kl[i]) = kr[i];
#pragma unroll
        for (int i = 0; i < 2; ++i) { *(LAS u32x2*)(vb + vl[i]) = (u32x2){vr[i].x, vr[i].y}; *(LAS u32x2*)(vb + vl[i] + 8) = (u32x2){vr[i].z, vr[i].w}; } };
    gload(0); lwrite(0); gload(1);
    __syncthreads();
    f32x16 sA, sB; bf16x8 pf[2];
    pf[0] = __builtin_bit_cast(bf16x8, (u32x4){0u, 0u, 0u, 0u}); pf[1] = pf[0];
    mla_stage1<true, false>(lds, qf, sB, sA, pf, 0.f, l_run, col, hi);
    mla_stage2<false, true>(lds, pf, o, sA, m_run, l_run, mref, 31 > q0, 0, qcol, col, hi);
#define MLA_TILE(CUR, NXT, KNEXT, VCUR, KN0) do { mla_stage1<true>(KNEXT, qf, CUR, NXT, pf, mref, l_run, col, hi); \
        mla_stage2<true, true>(VCUR, pf, o, NXT, m_run, l_run, mref, (KN0) + 31 > q0, KN0, qcol, col, hi); } while (0)
#pragma unroll 1
    for (int s = 0; s < ns; ++s) {
        const int buf = s & 1; const LAS unsigned char* kbs = lds + buf * MK_KB; const LAS unsigned char* vbs = lds + MK_VOFF + buf * MK_VB; const LAS unsigned char* kbn = lds + (buf ^ 1) * MK_KB;
        const int k0 = 128 * s;
        __syncthreads();
        if (s + 1 < ns) { lwrite(buf ^ 1); if (s + 2 < ns) gload(s + 2); }
        MLA_TILE(sA, sB, kbs + 32 * MK_KP * 2, vbs, k0 + 32);
        MLA_TILE(sB, sA, kbs + 64 * MK_KP * 2, vbs + 64, k0 + 64);
        MLA_TILE(sA, sB, kbs + 96 * MK_KP * 2, vbs + 128, k0 + 96);
        __syncthreads();
        if (s + 1 < ns) MLA_TILE(sB, sA, kbn, vbs + 192, k0 + 128);
        else { mla_stage1<false>(kbn, qf, sB, sA, pf, mref, l_run, col, hi); mla_stage2<true, false>(vbs + 192, pf, o, sA, m_run, l_run, mref, false, 0, qcol, col, hi); }
    }
#undef MLA_TILE
    const float l = l_run + __shfl_xor(l_run, 32); const float inv = l > 0.f ? 1.0f / l : 0.f;
    bf16* op = O + (size_t)(q0 + col) * D + 1024 + hd * 64;
#pragma unroll
    for (int b = 0; b < 2; ++b)
#pragma unroll
        for (int i = 0; i < 4; ++i) store4_bf16(op + 32 * b + 8 * i + 4 * hi, (f32x4){o[b][4 * i] * inv, o[b][4 * i + 1] * inv, o[b][4 * i + 2] * inv, o[b][4 * i + 3] * inv});
}

__device__ __forceinline__ void phase_e(Frame& F, const LP& P) {
    const int lane = F.lane;
    SUBREP(0)
#pragma unroll 1
    for (int i = blockIdx.x; i < 256; i += F.G) { const int hd = i & 7, p = i >> 3;
#pragma unroll 1
        for (int rep = 0; rep < 2; ++rep) mla_unit_p(F.lds, P.b(WS_QM), P.b(WS_KVH), P.b(WS_KM), P.b(WS_VTM), P.b(WS_ABR), hd, rep ? 63 - p : p, F.tid, F.wave, lane); }
    __syncthreads();
    SUBREP(1)
#pragma unroll 1
    for (int i = blockIdx.x; i < 512; i += F.G) sel_unit<1>(F.lds, P.b(WS_U2), P.b(WS_VTWIN), nullptr, nullptr, P.b(WS_OWIN), nullptr, i & 1, i >> 1, F.tid, F.wave, lane);
    __syncthreads();
    SUBREP(2)
#pragma unroll 1
    for (int u = F.gw; u < S * 2; u += F.NGW) { const int t = u >> 1;
        topk_unit(P.f(WS_SCORES) + (size_t)u * 256, t, (unsigned*)P.i(WS_IDX) + (size_t)u * 8, lane); }
}
__device__ __forceinline__ void phase_f(Frame& F, const LP& P) {
#pragma unroll 1
    for (int i = blockIdx.x; i < 256; i += F.G) { const int g = i & 1, p = i >> 1;
#pragma unroll 1
        for (int rep = 0; rep < 2; ++rep) sel_unit16(F.lds, P.b(WS_U2), P.b(WS_VTSEL), (const unsigned*)P.i(WS_IDX), P.b(WS_OCMP), P.b(WS_OWIN), P.b(WS_ABR), g, rep ? 255 - p : p, F.tid, F.wave, F.lane); }
}
constexpr int XK_KP = 136, XK_VP = 260, XK_VOFF = 256 * XK_KP * 2;
__device__ __forceinline__ void phase_xattn(Frame& F, const LP& P) {
    const int tid = F.tid, lane = F.lane, col = lane & 31, hi = lane >> 5;
    const bf16* KX = P.b(WS_KX) + (size_t)P.l * 256 * 512; const bf16* VXT = P.b(WS_VXT) + (size_t)P.l * 512 * 256;
    LAS unsigned char* kb = F.lds; LAS unsigned char* vb = F.lds + XK_VOFF;
#pragma unroll 1
    for (int unit = blockIdx.x; unit < 4 * (S / 256); unit += F.G) { const int hd = unit & 3, tb = unit >> 2;
        __syncthreads();
        { u32x4 kr[8], vr[8];
#pragma unroll
          for (int i = 0; i < 8; ++i) { const int c = tid + 512 * i; kr[i] = *(const u32x4*)(KX + (size_t)(c >> 4) * 512 + hd * 128 + 8 * (c & 15)); vr[i] = *(const u32x4*)(VXT + (size_t)(hd * 128 + (c >> 5)) * 256 + 8 * (c & 31)); }
#pragma unroll
          for (int i = 0; i < 8; ++i) { const int c = tid + 512 * i; *(LAS u32x4*)(kb + ((c >> 4) * XK_KP + 8 * (c & 15)) * 2) = kr[i];
              LAS unsigned char* vd = vb + ((c >> 5) * XK_VP + 8 * (c & 31)) * 2; *(LAS u32x2*)vd = (u32x2){vr[i].x, vr[i].y}; *(LAS u32x2*)(vd + 8) = (u32x2){vr[i].z, vr[i].w}; } }
        __syncthreads();
        const int q0 = tb * 256 + F.wave * 32;
        bf16x8 qf[8];
        { const bf16* qp = P.b(WS_QX) + (size_t)(q0 + col) * 512 + hd * 128;
#pragma unroll
          for (int s = 0; s < 8; ++s) qf[s] = *(const bf16x8*)(qp + 16 * s + 8 * hi); }
        f32x16 o[4];
#pragma unroll
        for (int b = 0; b < 4; ++b)
#pragma unroll
            for (int r = 0; r < 16; ++r) o[b][r] = 0.f;
        float m_run = -INFINITY, l_run = 0.f;
        auto mask = [&](int, int) { return true; };
#pragma unroll
        for (int st = 0; st < 4; ++st) att_step64n<8, XK_KP, XK_VP, 4>(kb + st * 64 * XK_KP * 2, vb + st * 128, qf, o, m_run, l_run, 1.0f, false, mask, col, hi);
        const float l = l_run + __shfl_xor(l_run, 32); const float inv = l > 0.f ? 1.0f / l : 0.f;
        bf16* op = P.b(WS_OX) + (size_t)(q0 + col) * 512 + hd * 128;
#pragma unroll
        for (int b = 0; b < 4; ++b)
#pragma unroll
            for (int i = 0; i < 4; ++i) store4_bf16(op + 32 * b + 8 * i + 4 * hi, (f32x4){o[b][4 * i] * inv, o[b][4 * i + 1] * inv, o[b][4 * i + 2] * inv, o[b][4 * i + 3] * inv}); }
}

__device__ __forceinline__ void phase_ln(const Args& a, Frame& F, const LP& P, int gi, int bi) {
    const int l = P.l; const float* g = INF32(a, gi, D); const float* b = INF32(a, bi, D);
    RowRaw na, nb;
    if (2 * F.gw < S) { row_fetch(na, P.b(WS_Y) + (size_t)(2 * F.gw) * D, F.lane); row_fetch(nb, P.b(WS_Y) + (size_t)(2 * F.gw + 1) * D, F.lane); }
#pragma unroll 1
    for (int r = 2 * F.gw; r < S; r += 2 * F.NGW) { Row ra, rb; row_unpack(ra, na); row_unpack(rb, nb);
        const int rn = r + 2 * F.NGW;
        if (rn < S) { row_fetch(na, P.b(WS_Y) + (size_t)rn * D, F.lane); row_fetch(nb, P.b(WS_Y) + (size_t)(rn + 1) * D, F.lane); }
        row_layernorm2(ra, rb, g, b, F.lane);
        row_store_bf16(ra, P.b(WS_XB) + (size_t)r * D, F.lane); row_store_bf16(rb, P.b(WS_XB) + (size_t)(r + 1) * D, F.lane); }
}
__device__ __forceinline__ void phase_ln_router(const Args& a, Frame& F, const LP& P) {
    const int l = P.l, lane = F.lane, wave = F.wave, tid = F.tid; const float* g = INF32(a, 29, D); const float* b = INF32(a, 30, D);
    const float* bg = INF32(a, 32, 4); const float* br = INF32(a, 34, 32);
    int* toke = (int*)(P.ws + WS_MOE + MO_TOKE); float* tokw = (float*)(P.ws + WS_MOE + MO_TOKW); int* tokr = (int*)(P.ws + WS_MOE + MO_TOKP);
    unsigned* cnt = (unsigned*)(P.ws + WS_CTL) + CW_CNT + 128 * l;
    LAS float* lgs = (LAS float*)F.lds; LAS unsigned* hist = (LAS unsigned*)(F.lds + 131072); LAS unsigned* gbase = (LAS unsigned*)(F.lds + 131072 + 128);
    constexpr int RP = 264; LAS unsigned char* sxh = F.lds; LAS unsigned char* sxl = sxh + 64 * RP * 2; LAS unsigned char* swh = sxl + 64 * RP * 2; LAS unsigned char* swl = swh + 48 * RP * 2;
    const bf16* WRT = P.w(WO_WRT);
#pragma unroll 1
    for (int base = 64 * blockIdx.x; base < S; base += 64 * F.G) {
        if (tid < 32) hist[tid] = 0u;
        RowRaw na, nb; row_fetch(na, P.b(WS_Y) + (size_t)(base + 8 * wave) * D, lane); row_fetch(nb, P.b(WS_Y) + (size_t)(base + 8 * wave + 1) * D, lane);
#pragma unroll 1
        for (int i = 0; i < 8; i += 2) { const int r = base + 8 * wave + i; Row ra, rb; row_unpack(ra, na); row_unpack(rb, nb);
            if (i + 2 < 8) { row_fetch(na, P.b(WS_Y) + (size_t)(r + 2) * D, lane); row_fetch(nb, P.b(WS_Y) + (size_t)(r + 3) * D, lane); }
            row_layernorm2(ra, rb, g, b, lane);
            row_store_hilo(ra, P.b(WS_XB) + (size_t)r * D, P.b(WS_XLO) + (size_t)r * D, lane); row_store_hilo(rb, P.b(WS_XB) + (size_t)(r + 1) * D, P.b(WS_XLO) + (size_t)(r + 1) * D, lane); }
        VM_WAIT(); __syncthreads();
        int e1 = 0, e2 = 0, r1 = 0, r2 = 0; float w1 = 0.f, w2 = 0.f;
        { const int tt = wave & 3, kh = wave >> 2;
            const int rr = lane & 15, Gq = lane >> 4;
            f32x4 acc[3];
#pragma unroll
            for (int n = 0; n < 3; ++n) acc[n] = (f32x4){0.f, 0.f, 0.f, 0.f};
            u32x4 stg[14];
            auto gld = [&](int ch) { const int k0 = 256 * ch;
#pragma unroll
                for (int i = 0; i < 14; ++i) { const int c = tid + 512 * (i < 4 ? i : i < 8 ? i - 4 : i < 11 ? i - 8 : i - 11), row = c >> 5, pc = c & 31;
                    const bf16* src = i < 4 ? P.b(WS_XB) + (size_t)(base + row) * D : i < 8 ? P.b(WS_XLO) + (size_t)(base + row) * D : i < 11 ? WRT + (size_t)row * 2048 : WRT + (size_t)(48 + row) * 2048;
                    stg[i] = *(const u32x4*)(src + k0 + 8 * pc); } };
            gld(0);
#pragma unroll 1
            for (int ch = 0; ch < 8; ++ch) {
#pragma unroll
                for (int i = 0; i < 14; ++i) { const int c = tid + 512 * (i < 4 ? i : i < 8 ? i - 4 : i < 11 ? i - 8 : i - 11), row = c >> 5, pc = c & 31;
                    LAS unsigned char* dstb = i < 4 ? sxh : i < 8 ? sxl : i < 11 ? swh : swl; *(LAS u32x4*)(dstb + (row * RP + 8 * pc) * 2) = stg[i]; }
                __syncthreads();
                if (ch + 1 < 8) gld(ch + 1);
#pragma unroll
                for (int ks = 0; ks < 4; ++ks) { const int ko = (32 * (4 * kh + ks) + 8 * Gq) * 2;
                    const bf16x8 ah = *(const LAS bf16x8*)(sxh + (16 * tt + rr) * RP * 2 + ko), al = *(const LAS bf16x8*)(sxl + (16 * tt + rr) * RP * 2 + ko);
#pragma unroll
                    for (int n = 0; n < 3; ++n) { const bf16x8 bh = *(const LAS bf16x8*)(swh + (16 * n + rr) * RP * 2 + ko), bl = *(const LAS bf16x8*)(swl + (16 * n + rr) * RP * 2 + ko);
                        acc[n] = __builtin_amdgcn_mfma_f32_16x16x32_bf16(ah, bh, acc[n], 0, 0, 0); acc[n] = __builtin_amdgcn_mfma_f32_16x16x32_bf16(al, bh, acc[n], 0, 0, 0); acc[n] = __builtin_amdgcn_mfma_f32_16x16x32_bf16(ah, bl, acc[n], 0, 0, 0); } }
                __syncthreads(); }
            LAS float* lp = lgs + (kh * 4 + tt) * 768;
#pragma unroll
            for (int n = 0; n < 3; ++n)
#pragma unroll
                for (int i = 0; i < 4; ++i) lp[(4 * Gq + i) * 48 + 16 * n + rr] = acc[n][i]; }
        LDS_WAIT(); __syncthreads();
        if (wave < 4) {
            LAS float* lw_ = lgs + wave * 768;
            if (lane < 16) {
                const LAS float* lg = lw_ + lane * 48; const LAS float* lg2 = lg + 4 * 768;
                float gl[4]; int gs = 0;
#pragma unroll
                for (int e = 0; e < 4; ++e) gl[e] = (lg[e] + lg2[e]) + bg[e];
                float gmax = gl[0];
#pragma unroll
                for (int e = 1; e < 4; ++e) { if (gl[e] > gmax) { gmax = gl[e]; gs = e; } }
                float gsum = 0.f;
#pragma unroll
                for (int e = 0; e < 4; ++e) gsum += __expf(gl[e] - gmax);
                const float gwt = 1.0f / gsum;
                float el[8];
#pragma unroll
                for (int e = 0; e < 8; ++e) el[e] = (lg[4 + 8 * gs + e] + lg2[4 + 8 * gs + e]) + br[gs * 8 + e];
                int i1 = 0; float m1 = el[0];
#pragma unroll
                for (int e = 1; e < 8; ++e) if (el[e] > m1) { m1 = el[e]; i1 = e; }
                int i2 = -1; float m2 = -INFINITY;
#pragma unroll
                for (int e = 0; e < 8; ++e) if (e != i1 && el[e] > m2) { m2 = el[e]; i2 = e; }
                const float rx = __expf(m2 - m1); const float p1 = 1.0f / (1.0f + rx), p2 = rx * p1;
                e1 = gs * 8 + i1; e2 = gs * 8 + i2; w1 = gwt * p1; w2 = gwt * p2;
                r1 = (int)__hip_atomic_fetch_add(hist + e1, 1u, __ATOMIC_RELAXED, __HIP_MEMORY_SCOPE_WORKGROUP);
                r2 = (int)__hip_atomic_fetch_add(hist + e2, 1u, __ATOMIC_RELAXED, __HIP_MEMORY_SCOPE_WORKGROUP);
            }
        }
        LDS_WAIT(); __syncthreads();
        if (tid < 32) { const unsigned h = hist[tid]; gbase[tid] = h ? atomicAdd(cnt + tid, h) : 0u; }
        LDS_WAIT(); __syncthreads();
        if (wave < 4 && lane < 16) { const int t = base + 16 * wave + lane;
            toke[2 * t] = e1; toke[2 * t + 1] = e2; tokw[2 * t] = w1; tokw[2 * t + 1] = w2; tokr[2 * t] = (int)gbase[e1] + r1; tokr[2 * t + 1] = (int)gbase[e2] + r2; }
        __syncthreads();
    }
}
__device__ __forceinline__ void phase_moe_assign(Frame& F, const LP& P) {
    const int lane = F.lane;
    unsigned* cnt = (unsigned*)(P.ws + WS_CTL) + CW_CNT + 128 * P.l;
    const unsigned c = lane < 32 ? __hip_atomic_load(cnt + lane, __ATOMIC_RELAXED, __HIP_MEMORY_SCOPE_AGENT) : 0u;
    const unsigned padded = (c + 255u) & ~255u;
    unsigned incl = padded;
#pragma unroll
    for (int o = 1; o < 32; o <<= 1) { const unsigned v = __shfl_up(incl, o); if ((lane & 31) >= o) incl += v; }
    const unsigned pstart = incl - padded;
    if (F.gw == 0) {
        int* tile_e = (int*)(P.ws + WS_MOE + MO_TILEE); int* ntp = (int*)(P.ws + WS_MOE + MO_NT);
        if (lane < 32) for (unsigned r = pstart; r < incl; r += 256) tile_e[r >> 8] = lane;
        const unsigned total = __shfl(incl, 31); if (lane == 0) *ntp = (int)(total >> 8);
    }
    const int* toke = (const int*)(P.ws + WS_MOE + MO_TOKE); const float* tokw = (const float*)(P.ws + WS_MOE + MO_TOKW);
    int* tokp = (int*)(P.ws + WS_MOE + MO_TOKP); float* roww = (float*)(P.ws + WS_MOE + MO_ROWW); int* rowtok = (int*)(P.ws + WS_MOE + MO_ROWTOK);
    if (F.gw < 32) {
        const unsigned lo = __shfl(pstart, F.gw) + __shfl(c, F.gw), hi_ = __shfl(incl, F.gw);
        for (unsigned r = lo + lane; r < hi_; r += 64) { rowtok[r] = 0; roww[r] = 0.f; } }
#pragma unroll 1
    for (int i = F.gw * 64 + lane; i < 2 * S; i += F.NGW * 64) { const int e = toke[i];
        unsigned ps = 0u;
#pragma unroll
        for (int q = 0; q < 32; ++q) { const unsigned v = __shfl(pstart, q); ps = (e == q) ? v : ps; }
        const unsigned pos = (unsigned)tokp[i] + ps;
        tokp[i] = (int)pos; roww[pos] = tokw[i]; rowtok[pos] = i >> 1; }
}
__device__ __forceinline__ void phase_moe_combine(const Args& a, Frame& F, const LP& P, bool last) {
    const int l = P.l; const float* g = INF32(a, 37, D); const float* b = INF32(a, 38, D); const int* tokp = (const int*)(P.ws + WS_MOE + MO_TOKP);
    const int step = 2 * F.NGW; const int r0 = 2 * F.gw;
    RowRaw xa, xb_, ya0, ya1, yb0, yb1; int4 pn = {0, 0, 0, 0};
    if (r0 < S) { const int4 p = *(const int4*)(tokp + 2 * r0);
        row_fetch(xa, P.b(WS_XB) + (size_t)r0 * D, F.lane); row_fetch(xb_, P.b(WS_XB) + (size_t)(r0 + 1) * D, F.lane);
        row_fetch(ya0, P.b(WS_Y2) + (size_t)p.x * D, F.lane); row_fetch(yb0, P.b(WS_Y2) + (size_t)p.z * D, F.lane);
        row_fetch(ya1, P.b(WS_Y2) + (size_t)p.y * D, F.lane); row_fetch(yb1, P.b(WS_Y2) + (size_t)p.w * D, F.lane);
        if (r0 + step < S) pn = *(const int4*)(tokp + 2 * (r0 + step)); }
#pragma unroll 1
    for (int r = r0; r < S; r += step) { Row ra, rb;
        row_unpack(ra, xa); row_unpack(rb, xb_);
#pragma unroll
        for (int j = 0; j < 8; ++j) { ra.v[j] = ra.v[j] * DN_ALPHA; rb.v[j] = rb.v[j] * DN_ALPHA; }
        row_unpack_add(ra, ya0); row_unpack_add(rb, yb0); row_unpack_add(ra, ya1); row_unpack_add(rb, yb1);
        const int rn = r + step;
        if (rn < S) { const int4 p = pn;
            row_fetch(xa, P.b(WS_XB) + (size_t)rn * D, F.lane); row_fetch(xb_, P.b(WS_XB) + (size_t)(rn + 1) * D, F.lane);
            row_fetch(ya0, P.b(WS_Y2) + (size_t)p.x * D, F.lane); row_fetch(yb0, P.b(WS_Y2) + (size_t)p.z * D, F.lane);
            row_fetch(ya1, P.b(WS_Y2) + (size_t)p.y * D, F.lane); row_fetch(yb1, P.b(WS_Y2) + (size_t)p.w * D, F.lane);
            if (rn + step < S) pn = *(const int4*)(tokp + 2 * (rn + step)); }
        row_layernorm2(ra, rb, g, b, F.lane);
        if (last) { row_store_f32(ra, a.out + (size_t)r * D, F.lane); row_store_f32(rb, a.out + (size_t)(r + 1) * D, F.lane); }
        else { row_store_bf16(ra, P.b(WS_XB) + (size_t)r * D, F.lane); row_store_bf16(rb, P.b(WS_XB) + (size_t)(r + 1) * D, F.lane); } }
}

constexpr int NPH_LAYER = 17, NPHASES = 1 + DEPTH * NPH_LAYER;
__global__ void __launch_bounds__(NWAVES * 64, 2) mk_fwd(Args a) {
    extern __shared__ __attribute__((aligned(16))) unsigned char lds_raw[];
    Frame F;
    F.lds = (LAS unsigned char*)lds_raw;
    F.tid = threadIdx.x; F.lane = F.tid & 63; F.wave = __builtin_amdgcn_readfirstlane(F.tid >> 6);
    F.G = gridDim.x; F.gw = blockIdx.x * NWAVES + F.wave; F.NGW = F.G * NWAVES; F.ws = a.ws;
    volatile LAS unsigned* MISC = (volatile LAS unsigned*)(F.lds + MISC_OFF);
    if (F.tid < 32) MISC[F.tid] = 0u;
    __syncthreads();
    unsigned* ctl = (unsigned*)(a.ws + WS_CTL);
    XcdBarrier bar = xcd_barrier_post(ctl + CW_BAR + a.li * XCD_BAR_WORDS, MISC + 8);
    const int lo = a.ph_lo, hi = a.ph_hi;
#if defined(PHMASK)
#define IN(k) (((PHMASK >> (((k) == 0) ? 0 : (((k) - 1) % NPH_LAYER) + 1)) & 1) && lo <= (k) && (k) < hi)
#elif defined(PHSEL)
#define IN(k) ((((k) == 0) ? 0 : (((k) - 1) % NPH_LAYER) + 1) == PHSEL && lo <= (k) && (k) < hi)
#else
#define IN(k) (lo <= (k) && (k) < hi)
#endif
#define SEAM(k) do { if (IN((k) + 1)) xcd_barrier(bar); } while (0)
#ifdef DIAG_P1
#define STAMP(k) do { if (blockIdx.x == 0 && threadIdx.x == 0) ((volatile LAS unsigned long long*)(F.lds + MISC_OFF - 1024))[(k)] = wall_clock64(); } while (0)
#else
#define STAMP(k) do {} while (0)
#endif
#ifndef DUPMASK
#define DUPMASK 0
#endif
#define REPB(k) for (int rep_ = 0; rep_ < 1 + ((DUPMASK >> (k)) & 1); ++rep_) { if (rep_) xcd_barrier(bar);
#define REPE }
#define FRESH() do { int t_ = threadIdx.x; asm volatile("" : "+v"(t_)); F.tid = t_; F.lane = t_ & 63; F.wave = __builtin_amdgcn_readfirstlane(t_ >> 6); F.gw = blockIdx.x * NWAVES + F.wave; } while (0)
    const int G = F.G, bx = blockIdx.x;

    if (IN(0)) { FRESH(); STAMP(0); REPB(0) phase_prologue(a, F); REPE SEAM(0); }

    for (int l = 0; l < DEPTH; ++l) {
        LP P; P.ws = a.ws; P.wl = a.ws + WS_WL0 + (size_t)l * WS_WLSTRIDE; P.l = l;
        const int pb = 1 + NPH_LAYER * l;
        if (IN(pb + 0)) { FRESH(); STAMP(pb + 0); REPB(1) pg8::Gemm g{P.b(WS_XB), P.w(WO_WIN), D, D, D, nullptr}; pg8::StaticOrder so; so.init(S, NIN, G, bx);
            EpiIn E{P.b(WS_GATE), P.b(WS_U2), (const float*)(P.wl + WO_BIASP)}; pg8::gemm_phase(F.lds, g, so, E);
            { const int nun = (S / 256) * (NIN / 256), rem = nun % G, nlight = rem ? G - rem : G;
              FRESH(); if (bx >= G - nlight) memkv_items(P, (bx - (G - nlight)) * NWAVES + F.wave, nlight * NWAVES, F.lane); }
            REPE SEAM(pb + 0); }
        if (IN(pb + 1)) { FRESH(); STAMP(pb + 1); REPB(2) phase_prep(a, F, P); REPE SEAM(pb + 1); }
        if (IN(pb + 2)) { FRESH(); STAMP(pb + 2); REPB(3)
            { pg8::Gemm g{P.b(WS_U2) + U2_CQ, P.w(WO_WUQ), U2W, 512, 512, nullptr}; pg8::StaticOrder so; so.init(S, 768, G, bx);
              EpiQM<WS_QM, WS_RSTD, WS_ROPE> E{P.ws}; pg8::gemm_phase(F.lds, g, so, E); }
            { pg8::Gemm g{P.b(WS_U2) + U2_CKV, P.w(WO_WUKV), U2W, 256, 256, nullptr}; pg8::StaticOrder so; so.init(S, 1024, G, bx);
              EpiScale E{P.b(WS_KVH), 1024, P.f(WS_RSTD) + S, 1.0f, 0}; pg8::gemm_phase(F.lds, g, so, E); }
            phase_compress2(F, P); REPE SEAM(pb + 2); }
        if (IN(pb + 3)) { FRESH(); STAMP(pb + 3); REPB(4) phase_d(F, P); REPE SEAM(pb + 3); }
        if (IN(pb + 4)) { FRESH(); STAMP(pb + 4); REPB(5) phase_e(F, P); REPE SEAM(pb + 4); }
        if (IN(pb + 5)) { FRESH(); STAMP(pb + 5); REPB(6) phase_f(F, P); REPE SEAM(pb + 5); }
        if (IN(pb + 6)) { FRESH(); STAMP(pb + 6); REPB(7) pg8::Gemm g{P.b(WS_ABR), P.w(WO_WBR), D, D, D, nullptr}; pg8::StaticOrder so; so.init(S, D, G, bx);
            EpiMerge E{P.b(WS_GATE), P.b(WS_MERGED)};
            for (int sk_ = 0; sk_ < ((bx >> 3) & 3); ++sk_) __builtin_amdgcn_s_sleep(100);
            pg8::gemm_phase(F.lds, g, so, E); REPE SEAM(pb + 6); }
        if (IN(pb + 7)) { FRESH(); STAMP(pb + 7); REPB(8) pg8::Gemm g{P.b(WS_MERGED), P.w(WO_WOUT), D, D, D, nullptr}; pg8::StaticOrder so; so.init(S, D, G, bx);
            EpiResid E{P.b(WS_XB), P.b(WS_Y)}; pg8::gemm_phase(F.lds, g, so, E); REPE SEAM(pb + 7); }
        if (IN(pb + 8)) { FRESH(); STAMP(pb + 8); REPB(9) phase_ln(a, F, P, 23, 24); REPE SEAM(pb + 8); }
        if (IN(pb + 9)) { FRESH(); STAMP(pb + 9); REPB(10) pg8::Gemm g{P.b(WS_XB), P.w(WO_WXQ), D, D, D, nullptr}; pg8::StaticOrder so; so.init(S, 512, G, bx);
            EpiScale E{P.b(WS_QX), 512, nullptr, 0.08838834764831845f * LOG2E, 0}; pg8::gemm_phase(F.lds, g, so, E); REPE SEAM(pb + 9); }
        if (IN(pb + 10)) { FRESH(); STAMP(pb + 10); REPB(11) phase_xattn(F, P); REPE SEAM(pb + 10); }
        if (IN(pb + 11)) { FRESH(); STAMP(pb + 11); REPB(12) pg8::Gemm g{P.b(WS_OX), P.w(WO_WXO), 512, 512, 512, nullptr}; pg8::StaticOrder so; so.init(S, D, G, bx);
            EpiResid E{P.b(WS_XB), P.b(WS_Y)}; pg8::gemm_phase(F.lds, g, so, E); REPE SEAM(pb + 11); }
        if (IN(pb + 12)) { FRESH(); STAMP(pb + 12); REPB(13) phase_ln_router(a, F, P); REPE SEAM(pb + 12); }
        if (IN(pb + 13)) { FRESH(); STAMP(pb + 13); REPB(14) phase_moe_assign(F, P); REPE SEAM(pb + 13); }
        if (IN(pb + 14)) { FRESH(); STAMP(pb + 14); REPB(15) const int* te = (const int*)(P.ws + WS_MOE + MO_TILEE); const int ntl = *(const int*)(P.ws + WS_MOE + MO_NT);
            pg8::Gemm g{P.b(WS_XB), P.w(WO_WEIN), D, D, D, (const int*)(P.ws + WS_MOE + MO_ROWTOK)}; pg8::GroupedGather so{te, ntl, 4, G, bx};
            EpiGlu E{P.b(WS_HS)}; pg8::gemm_phase(F.lds, g, so, E); REPE SEAM(pb + 14); }
        if (IN(pb + 15)) { FRESH(); STAMP(pb + 15); REPB(16) const int* te = (const int*)(P.ws + WS_MOE + MO_TILEE); const int ntl = *(const int*)(P.ws + WS_MOE + MO_NT);
            pg8::Gemm g{P.b(WS_HS), P.w(WO_WEOUT), 512, 512, 512, nullptr}; pg8::GroupedOrder so{te, ntl, 8, G, bx};
            EpiScale E{P.b(WS_Y2), D, (const float*)(P.ws + WS_MOE + MO_ROWW), 1.0f, 8}; pg8::gemm_phase(F.lds, g, so, E); REPE SEAM(pb + 15); }
        if (IN(pb + 16)) { FRESH(); STAMP(pb + 16); REPB(17) phase_moe_combine(a, F, P, l == DEPTH - 1); REPE SEAM(pb + 16); }
    }
#ifdef DIAG_P1
    STAMP(NPHASES);
    __syncthreads();
    if (blockIdx.x == 0) {
        volatile LAS unsigned long long* ts = (volatile LAS unsigned long long*)(F.lds + MISC_OFF - 1024);
        const float t1 = (float)(ts[DIAG_P1 + DIAG_N1] - ts[DIAG_P1]) * 0.01f, t2 = (float)(ts[DIAG_P2 + DIAG_N2] - ts[DIAG_P2]) * 0.01f;
        const float c1 = sqrtf(t1 * 0.1f);
        for (size_t i = threadIdx.x; i < (size_t)S * D; i += 512) a.out[i] = (i == 0) ? t2 : c1;
    }
#endif
#undef IN
#undef SEAM
}

#ifndef MK_PER_PHASE
#define MK_PER_PHASE 0
#endif
extern "C" void kernel_launch(void* const* d_in, const int* in_sizes, int n_in, void* d_out, int out_size, void* d_ws, size_t ws_size, hipStream_t stream) {
    static int grid = 0;
    if (grid == 0) {
        if (n_in != 39 || out_size != S * D || ws_size < WS_END) { fprintf(stderr, "kernel_launch: unexpected problem (n_in %d, out %d, ws %zu)\n", n_in, out_size, ws_size); grid = -1; return; }
        int dev = 0, cus = 0;
        if (hipGetDevice(&dev) != hipSuccess || hipDeviceGetAttribute(&cus, hipDeviceAttributeMultiprocessorCount, dev) != hipSuccess) { grid = -1; return; }
        if (hipFuncSetAttribute((const void*)mk_fwd, hipFuncAttributeMaxDynamicSharedMemorySize, LDS_BYTES) != hipSuccess) { fprintf(stderr, "kernel_launch: hipFuncSetAttribute failed\n"); grid = -1; return; }
        int per_cu = 0;
        if (hipOccupancyMaxActiveBlocksPerMultiprocessor(&per_cu, (const void*)mk_fwd, NWAVES * 64, LDS_BYTES) != hipSuccess || per_cu < 1) fprintf(stderr, "kernel_launch: occupancy query reports %d\n", per_cu);
        (void)hipGetLastError();
        grid = cus;
    }
    if (grid < 0) return;
    if (hipMemsetAsync((char*)d_ws + WS_CTL, 0, CTL_ZERO_BYTES, stream) != hipSuccess) return;
    Args a{};
    for (int i = 0; i < 39; ++i) a.in[i] = d_in[i];
    a.out = (float*)d_out; a.ws = (unsigned char*)d_ws; a.pad = 0;
#if MK_PER_PHASE
#ifndef MK_LAST
#define MK_LAST NPHASES
#endif
    for (int p = 0; p < MK_LAST; ++p) { a.ph_lo = p; a.ph_hi = p + 1; a.li = p; hipLaunchKernelGGL(mk_fwd, dim3(grid), dim3(NWAVES * 64), LDS_BYTES, stream, a); }
#else
    a.ph_lo = 0; a.ph_hi = NPHASES; a.li = 0;
    hipLaunchKernelGGL(mk_fwd, dim3(grid), dim3(NWAVES * 64), LDS_BYTES, stream, a);
#endif
}
```

```cpp
#include <hip/hip_runtime.h>
#include <cstdio>
#include <cstdint>

#define LAS __attribute__((address_space(3)))
#define GAS __attribute__((address_space(1)))
typedef unsigned short bf16;
typedef short bf16x8 __attribute__((ext_vector_type(8)));
typedef short s16x4 __attribute__((ext_vector_type(4)));
typedef float f32x2 __attribute__((ext_vector_type(2)));
typedef float f32x4 __attribute__((ext_vector_type(4)));
typedef float f32x16 __attribute__((ext_vector_type(16)));
typedef unsigned u32x2 __attribute__((ext_vector_type(2)));
typedef unsigned u32x4 __attribute__((ext_vector_type(4)));

constexpr int S = 16384, D = 2048, DEPTH = 2;
constexpr int IN_W = 11832;
constexpr int NIN = 12032;
constexpr int U2W = 3840;
constexpr int U2_Q = 0, U2_KV = 512, U2_POOL = 1280, U2_CQ = 1792, U2_CKV = 2304, U2_CONV = 2560, U2_G = 3584, U2_KR = 3616;
constexpr int NCMP = 1023;
constexpr int RMAX = 40960;
constexpr float DN_ALPHA = 1.4142135623730951f;
constexpr float LOG2E = 1.4426950408889634f;

typedef __bf16 bf16x2_t __attribute__((ext_vector_type(2)));
__device__ __forceinline__ unsigned cvt_pk_bf16(float lo, float hi) { const f32x2 v = {lo, hi}; const bf16x2_t b = __builtin_convertvector(v, bf16x2_t); return __builtin_bit_cast(unsigned, b); }
__device__ __forceinline__ float bf2f(unsigned short b) { return __uint_as_float(((unsigned)b) << 16); }
__device__ __forceinline__ float bflo(unsigned w) { return __uint_as_float(w << 16); }
__device__ __forceinline__ float bfhi(unsigned w) { return __uint_as_float(w & 0xffff0000u); }
__device__ __forceinline__ unsigned short f2bf(float f) { return (unsigned short)(cvt_pk_bf16(f, 0.f) & 0xffffu); }
template <int CTRL> __device__ __forceinline__ float dpp_f(float x) { return __uint_as_float((unsigned)__builtin_amdgcn_update_dpp(0, (int)__float_as_uint(x), CTRL, 0xF, 0xF, true)); }
__device__ __forceinline__ float lane_xor1(float x) { return dpp_f<0xB1>(x); }
__device__ __forceinline__ float lane_xor2(float x) { return dpp_f<0x4E>(x); }
__device__ __forceinline__ float row16_sum(float x) { x += dpp_f<0xB1>(x); x += dpp_f<0x4E>(x); x += dpp_f<0x141>(x); x += dpp_f<0x140>(x); return x; }
__device__ __forceinline__ float xsum16(float x) { const auto r = __builtin_amdgcn_permlane16_swap(__float_as_uint(x), __float_as_uint(x), false, false); return __uint_as_float(r[0]) + __uint_as_float(r[1]); }
__device__ __forceinline__ float xsum32(float x) { const auto r = __builtin_amdgcn_permlane32_swap(__float_as_uint(x), __float_as_uint(x), false, false); return __uint_as_float(r[0]) + __uint_as_float(r[1]); }
__device__ __forceinline__ float xmax16(float x) { const auto r = __builtin_amdgcn_permlane16_swap(__float_as_uint(x), __float_as_uint(x), false, false); return fmaxf(__uint_as_float(r[0]), __uint_as_float(r[1])); }
__device__ __forceinline__ float xmax32(float x) { const auto r = __builtin_amdgcn_permlane32_swap(__float_as_uint(x), __float_as_uint(x), false, false); return fmaxf(__uint_as_float(r[0]), __uint_as_float(r[1])); }
__device__ __forceinline__ float lane_xor32(float x, int hi) { const auto r = __builtin_amdgcn_permlane32_swap(__float_as_uint(x), __float_as_uint(x), false, false); return __uint_as_float(hi ? r[0] : r[1]); }
__device__ __forceinline__ float wave_sum(float v) { return xsum32(xsum16(row16_sum(v))); }
__device__ __forceinline__ float sigmoidf_(float x) { return 1.0f / (1.0f + __expf(-x)); }
#define LDS_WAIT() asm volatile("s_waitcnt lgkmcnt(0)" ::: "memory")
#define VM_WAIT() asm volatile("s_waitcnt vmcnt(0)" ::: "memory")

namespace pg8 {
constexpr int BM = 256, BK = 64, HALF = 128, HTB = HALF * BK * 2, STAGE_BYTES = 8 * HTB, NXCD = 8, WGM = 8;
__host__ __device__ __forceinline__ int lds_byte(int r, int c) { const int st = (r >> 4) * 2 + (c >> 5), rr = r & 15, cc = c & 31, ob = rr * 64 + cc * 2; return st * 1024 + (ob ^ (((ob >> 9) & 1) << 5)); }
__host__ __device__ __forceinline__ void stage_rc(int b, int& R, int& C) { const int st = b / 1024, sb = b % 1024, swz = sb ^ (((sb >> 9) & 1) << 5); R = (st >> 1) * 16 + swz / 64; C = (st & 1) * 32 + (swz % 64) / 2; }
__host__ __device__ __forceinline__ int perm32(int rho) { const int n = rho >> 4, i = rho & 15; return 8 * (i >> 2) + 4 * n + (i & 3); }

struct Unit { int pm, pn; };
struct Gemm { const bf16* A; const bf16* Bt; int lda, ldb, K; const int* rowtok; };

struct StaticOrder {
    static constexpr bool GATHER = false;
    int nM, nN, nwg, G, c;
    __device__ void init(int M, int N, int G_, int c_) { nM = M / BM; nN = N / BM; nwg = nM * nN; G = G_; c = c_; }
    __device__ bool next(int i, Unit& u) const {
        const long L = (long)i * G + c; if (L >= nwg) return false;
        int wgid = (int)L; { const int q = nwg / NXCD, r = nwg % NXCD, xcd = wgid % NXCD, off = wgid / NXCD; wgid = (xcd < r ? xcd * (q + 1) : r * (q + 1) + (xcd - r) * q) + off; }
        const int nig = WGM * nN, gid = wgid / nig, fm = gid * WGM, gsz = (nM - fm) < WGM ? (nM - fm) : WGM;
        u.pm = fm + ((wgid % nig) % gsz); u.pn = (wgid % nig) / gsz; return true;
    }
};
template <bool GATHER_> struct GroupedOrderT {
    static constexpr bool GATHER = GATHER_;
    const int* tile_expert; int ntiles, npn, G, c;
    __device__ bool next(int i, Unit& u) const {
        const long L = (long)i * G + c; if (L >= (long)ntiles * npn) return false;
        const int rt = (int)(L / npn), pn = (int)(L % npn);
        u.pm = rt; u.pn = __builtin_amdgcn_readfirstlane(tile_expert[rt]) * npn + pn; return true;
    }
};
typedef GroupedOrderT<false> GroupedOrder; typedef GroupedOrderT<true> GroupedGather;

template <class Epi, class Sched>
__device__ __forceinline__ void gemm_phase(LAS unsigned char* lds, const Gemm g, const Sched& S, const Epi& E) {
    int tid = threadIdx.x; asm volatile("" : "+v"(tid));
    const int wid = __builtin_amdgcn_readfirstlane(tid >> 6), lane = tid & 63, wr = wid >> 2, wc = wid & 3, fr = lane & 15, fq = lane >> 4;
    const int K = g.K, nt = K / BK;
    constexpr bool GATHER = Sched::GATHER;
    unsigned voffB[2], vAc[2][2], vAn[2][2]; int Rr[2], Cc[2];
#pragma unroll
    for (int i = 0; i < 2; ++i) { int R, C; stage_rc(tid * 16 + i * 8192, R, C); const int Rb = Epi::PERM ? ((R & ~31) + perm32(R & 31)) : R; Rr[i] = R; Cc[i] = C;
        voffB[i] = (unsigned)(Rb * g.ldb + C) * 2u;
#pragma unroll
        for (int h = 0; h < 2; ++h) { vAc[h][i] = (unsigned)((R + h * HALF) * g.lda + C) * 2u; vAn[h][i] = vAc[h][i]; } }
    const size_t kstep = (size_t)(BK * 2);
    const size_t hstepB = (size_t)HALF * g.ldb * 2;
    const size_t tstepA = (size_t)2 * HALF * g.lda * 2, tstepB = 2 * hstepB;
    const unsigned ldsw = (unsigned)wid * 1024u;
    const int aoff = lds_byte(wr * 64 + fr, fq * 8), boff = lds_byte(wc * 32 + fr, fq * 8);
#define PG8_GOFF(v, u) do { _Pragma("unroll") for (int _h = 0; _h < 2; ++_h) _Pragma("unroll") for (int _i = 0; _i < 2; ++_i) { \
        const int _t = g.rowtok[(u).pm * 256 + _h * HALF + Rr[_i]]; (v)[_h][_i] = (unsigned)(_t * g.lda + Cc[_i]) * 2u; } \
        _Pragma("unroll") for (int _h = 0; _h < 2; ++_h) _Pragma("unroll") for (int _i = 0; _i < 2; ++_i) asm volatile("" : "+v"((v)[_h][_i])); } while (0)
#define PG8_SA(b, h) (((b) * 2 + (h)) * HTB)
#define PG8_SB(b, h) ((4 + (b) * 2 + (h)) * HTB)
#define PG8_STAGE(bufoff, gbase, voff) do { _Pragma("unroll") for (int _i = 0; _i < 2; ++_i) \
        __builtin_amdgcn_global_load_lds((const unsigned*)((const char*)(gbase) + (voff)[_i]), (LAS unsigned*)(lds + (bufoff) + ldsw + _i * 8192), 16, 0, 0); } while (0)
#define PG8_LDA(dst, b, h) do { _Pragma("unroll") for (int m = 0; m < 4; ++m) _Pragma("unroll") for (int k = 0; k < 2; ++k) dst[m][k] = *(const LAS bf16x8*)(lds + PG8_SA(b, h) + aoff + m * 2048 + k * 1024); } while (0)
#define PG8_LDB(dst, b, h) do { _Pragma("unroll") for (int n = 0; n < 2; ++n) _Pragma("unroll") for (int k = 0; k < 2; ++k) dst[n][k] = *(const LAS bf16x8*)(lds + PG8_SB(b, h) + boff + n * 2048 + k * 1024); } while (0)
#define PG8_MMA(ai, bj, At, Bt) do { __builtin_amdgcn_s_setprio(1); _Pragma("unroll") for (int m = 0; m < 4; ++m) _Pragma("unroll") for (int n = 0; n < 2; ++n) _Pragma("unroll") for (int k = 0; k < 2; ++k) \
        acc[ai][bj][m][n] = __builtin_amdgcn_mfma_f32_16x16x32_bf16(Bt[n][k], At[m][k], acc[ai][bj][m][n], 0, 0, 0); __builtin_amdgcn_s_setprio(0); } while (0)
#define PG8_WAIT_V(n) asm volatile("s_waitcnt vmcnt(" #n ")" ::: "memory")
#define PG8_WAIT_L(n) asm volatile("s_waitcnt lgkmcnt(" #n ")" ::: "memory")
#define PG8_BAR __builtin_amdgcn_s_barrier()
#define PG8_SCHED __builtin_amdgcn_sched_barrier(0)
    Unit cur, nxt; int ui = 0;
    if (!S.next(0, cur)) return;
    f32x4 acc[2][2][4][2];
#pragma unroll
    for (int a = 0; a < 2; ++a)
#pragma unroll
        for (int b = 0; b < 2; ++b)
#pragma unroll
            for (int m = 0; m < 4; ++m)
#pragma unroll
                for (int n = 0; n < 2; ++n) acc[a][b][m][n] = (f32x4){0.f, 0.f, 0.f, 0.f};
    bf16x8 At[4][2], B0[2][2], B1[2][2];
    if constexpr (GATHER) PG8_GOFF(vAc, cur);
    const char* cA = (const char*)g.A + (GATHER ? (size_t)0 : (size_t)cur.pm * tstepA); const char* cB = (const char*)g.Bt + (size_t)cur.pn * tstepB;
    PG8_STAGE(PG8_SB(0, 0), cB, voffB); PG8_STAGE(PG8_SB(0, 1), cB + hstepB, voffB); PG8_STAGE(PG8_SA(0, 0), cA, vAc[0]); PG8_STAGE(PG8_SA(0, 1), cA, vAc[1]);
    if (wr == 1) PG8_BAR;
    PG8_WAIT_V(2); PG8_BAR;
    PG8_STAGE(PG8_SB(1, 0), cB + kstep, voffB); PG8_STAGE(PG8_SA(1, 0), cA + kstep, vAc[0]); PG8_STAGE(PG8_SB(1, 1), cB + hstepB + kstep, voffB);
    PG8_WAIT_V(6); PG8_BAR;
    for (;;) {
        const bool has_next = S.next(ui + 1, nxt);
        if constexpr (GATHER) { if (has_next) PG8_GOFF(vAn, nxt); }
        const char* nA = GATHER ? cA : (has_next ? (const char*)g.A + (size_t)nxt.pm * tstepA : cA); const char* nB = has_next ? (const char*)g.Bt + (size_t)nxt.pn * tstepB : cB;
        for (int t = 0; t < nt; t += 2) {
            const bool last = (t == nt - 2);
            const char* a1 = cA + (size_t)(t + 1) * kstep;
            const char* a2 = last ? nA : cA + (size_t)(t + 2) * kstep; const char* b2 = last ? nB : cB + (size_t)(t + 2) * kstep;
            const char* a3 = a2 + kstep; const char* b3 = b2 + kstep;
            unsigned v2[2][2];
#pragma unroll
            for (int h = 0; h < 2; ++h)
#pragma unroll
                for (int i = 0; i < 2; ++i) v2[h][i] = (GATHER && last && has_next) ? vAn[h][i] : vAc[h][i];
            if constexpr (Epi::MIDK > 0) { if (t > 0 && (t % Epi::MIDK) == 0) { if (wr == 0) PG8_BAR; PG8_SCHED; E.mid(acc, cur, t / Epi::MIDK, wr, wc, fr, fq); PG8_SCHED; if (wr == 1) PG8_BAR; } }
            PG8_LDB(B0, 0, 0); PG8_LDB(B1, 0, 1); PG8_SCHED; PG8_LDA(At, 0, 0); PG8_STAGE(PG8_SA(1, 1), a1, vAc[1]);
            PG8_WAIT_V(8); PG8_WAIT_L(0); PG8_BAR; PG8_MMA(0, 0, At, B0); PG8_MMA(0, 1, At, B1); PG8_BAR; PG8_SCHED;
            PG8_LDA(At, 0, 1); PG8_STAGE(PG8_SB(0, 0), b2, voffB); PG8_STAGE(PG8_SB(0, 1), b2 + hstepB, voffB); PG8_STAGE(PG8_SA(0, 0), a2, v2[0]);
            PG8_WAIT_V(8); PG8_WAIT_L(0); PG8_BAR; PG8_MMA(1, 0, At, B0); PG8_MMA(1, 1, At, B1); PG8_BAR; PG8_SCHED;
            PG8_LDB(B0, 1, 0); PG8_LDB(B1, 1, 1); PG8_SCHED; PG8_LDA(At, 1, 0); PG8_STAGE(PG8_SA(0, 1), a2, v2[1]);
            PG8_WAIT_V(8); PG8_WAIT_L(0); PG8_BAR; PG8_MMA(0, 0, At, B0); PG8_MMA(0, 1, At, B1); PG8_BAR; PG8_SCHED;
            PG8_LDA(At, 1, 1); PG8_STAGE(PG8_SB(1, 0), b3, voffB); PG8_STAGE(PG8_SB(1, 1), b3 + hstepB, voffB); PG8_STAGE(PG8_SA(1, 0), a3, v2[0]);
            PG8_WAIT_V(8); PG8_WAIT_L(0); PG8_BAR; PG8_MMA(1, 0, At, B0); PG8_MMA(1, 1, At, B1); PG8_BAR; PG8_SCHED;
        }
        if (wr == 0) PG8_BAR;
        E(acc, cur, wr, wc, fr, fq);
        if (!has_next) break;
#pragma unroll
        for (int a = 0; a < 2; ++a)
#pragma unroll
            for (int b = 0; b < 2; ++b)
#pragma unroll
                for (int m = 0; m < 4; ++m)
#pragma unroll
                    for (int n = 0; n < 2; ++n) acc[a][b][m][n] = (f32x4){0.f, 0.f, 0.f, 0.f};
        cur = nxt; cA = nA; cB = nB; ++ui;
        if constexpr (GATHER) {
#pragma unroll
            for (int h = 0; h < 2; ++h)
#pragma unroll
                for (int i = 0; i < 2; ++i) vAc[h][i] = vAn[h][i]; }
        if (wr == 1) PG8_BAR;
    }
    PG8_WAIT_V(0);
    PG8_BAR;
#undef PG8_GOFF
#undef PG8_SA
#undef PG8_SB
#undef PG8_STAGE
#undef PG8_LDA
#undef PG8_LDB
#undef PG8_MMA
#undef PG8_WAIT_V
#undef PG8_WAIT_L
#undef PG8_BAR
#undef PG8_SCHED
}
}

__device__ __forceinline__ float fast_sigmoid(float x) { return __builtin_amdgcn_rcpf(1.0f + __builtin_amdgcn_exp2f(-x * LOG2E)); }
__device__ __forceinline__ u32x4 pack8(const f32x4 v0, const f32x4 v1) { u32x4 w; w.x = cvt_pk_bf16(v0[0], v0[1]); w.y = cvt_pk_bf16(v0[2], v0[3]); w.z = cvt_pk_bf16(v1[0], v1[1]); w.w = cvt_pk_bf16(v1[2], v1[3]); return w; }

struct EpiIn {
    static constexpr bool PERM = true; static constexpr int MIDK = 0;
    bf16* gate; bf16* u2; const float* bias;
    __device__ __forceinline__ void operator()(const f32x4 (&acc)[2][2][4][2], const pg8::Unit& u, int wr, int wc, int fr, int fq) const {
        const int row0 = u.pm * 256 + wr * 64 + fr; const bool isg = u.pn < 32;
        bf16* base = isg ? gate : u2; const int ldc = isg ? 8192 : U2W; const int colt = isg ? u.pn * 256 : (u.pn - 32) * 256;
        const int col0 = colt + wc * 32 + 8 * fq, bcol0 = u.pn * 256 + wc * 32 + 8 * fq;
        f32x4 bv[2][2];
#pragma unroll
        for (int bj = 0; bj < 2; ++bj)
#pragma unroll
            for (int n = 0; n < 2; ++n) bv[bj][n] = *(const f32x4*)(bias + bcol0 + bj * 128 + 4 * n);
#pragma unroll
        for (int ai = 0; ai < 2; ++ai)
#pragma unroll
            for (int m = 0; m < 4; ++m) { bf16* rowp = base + (size_t)(row0 + ai * 128 + m * 16) * ldc + col0;
#pragma unroll
                for (int bj = 0; bj < 2; ++bj) { f32x4 v0 = acc[ai][bj][m][0] + bv[bj][0], v1 = acc[ai][bj][m][1] + bv[bj][1];
                    if (isg) {
#pragma unroll
                        for (int j = 0; j < 4; ++j) { v0[j] = fast_sigmoid(v0[j]); v1[j] = fast_sigmoid(v1[j]); } }
                    *(u32x4*)(rowp + bj * 128) = pack8(v0, v1); } }
    }
};
struct EpiScale {
    static constexpr bool PERM = true; static constexpr int MIDK = 0;
    bf16* O; int ldc; const float* rowscale; float cs; int npn_mod;
    __device__ __forceinline__ void operator()(const f32x4 (&acc)[2][2][4][2], const pg8::Unit& u, int wr, int wc, int fr, int fq) const {
        const int row0 = u.pm * 256 + wr * 64 + fr; const int pnl = npn_mod ? (u.pn % npn_mod) : u.pn;
        const int col0 = pnl * 256 + wc * 32 + 8 * fq;
#pragma unroll
        for (int ai = 0; ai < 2; ++ai)
#pragma unroll
            for (int m = 0; m < 4; ++m) { const int row = row0 + ai * 128 + m * 16; const float sc = (rowscale ? rowscale[row] : 1.0f) * cs;
                bf16* rowp = O + (size_t)row * ldc + col0;
#pragma unroll
                for (int bj = 0; bj < 2; ++bj) *(u32x4*)(rowp + bj * 128) = pack8(acc[ai][bj][m][0] * sc, acc[ai][bj][m][1] * sc); }
    }
};
template <size_t OFF_O, size_t OFF_RS, size_t OFF_ROPE>
struct EpiQM {
    static constexpr bool PERM = true; static constexpr int MIDK = 0;
    unsigned char* ws;
    __device__ __forceinline__ void operator()(const f32x4 (&acc)[2][2][4][2], const pg8::Unit& u, int wr, int wc, int fr, int fq) const {
        const int row0 = u.pm * 256 + wr * 64 + fr; const int col0 = u.pn * 256 + wc * 32 + 8 * fq;
        bf16* O = (bf16*)(ws + OFF_O); const float* rowscale = (const float*)(ws + OFF_RS); const f32x2* rope = (const f32x2*)(ws + OFF_ROPE);
        const float qs = 0.10206207261596577f * LOG2E;
#pragma unroll
        for (int ai = 0; ai < 2; ++ai)
#pragma unroll
            for (int m = 0; m < 4; ++m) { const int row = row0 + ai * 128 + m * 16; const float sc = rowscale[row] * qs;
                asm volatile("" ::: "memory");
                bf16* rowp = O + (size_t)row * 768 + col0;
#pragma unroll
                for (int bj = 0; bj < 2; ++bj) { f32x4 v0 = acc[ai][bj][m][0] * sc, v1 = acc[ai][bj][m][1] * sc;
                    if ((8 * u.pn + 4 * bj + wc) % 3 == 2) {
                        const f32x4* rp = (const f32x4*)(rope + (size_t)row * 16 + 8 * (fq & 1));
                        const float sg = fq < 2 ? -1.0f : 1.0f;
                        { const f32x4 c01 = rp[0], c23 = rp[1]; const float q0 = __shfl_xor(v0[0], 32), q1 = __shfl_xor(v0[1], 32), q2 = __shfl_xor(v0[2], 32), q3 = __shfl_xor(v0[3], 32);
                          v0[0] = v0[0] * c01[0] + sg * q0 * c01[1]; v0[1] = v0[1] * c01[2] + sg * q1 * c01[3]; v0[2] = v0[2] * c23[0] + sg * q2 * c23[1]; v0[3] = v0[3] * c23[2] + sg * q3 * c23[3]; }
                        asm volatile("" ::: "memory");
                        { const f32x4 c45 = rp[2], c67 = rp[3]; const float q0 = __shfl_xor(v1[0], 32), q1 = __shfl_xor(v1[1], 32), q2 = __shfl_xor(v1[2], 32), q3 = __shfl_xor(v1[3], 32);
                          v1[0] = v1[0] * c45[0] + sg * q0 * c45[1]; v1[1] = v1[1] * c45[2] + sg * q1 * c45[3]; v1[2] = v1[2] * c67[0] + sg * q2 * c67[1]; v1[3] = v1[3] * c67[2] + sg * q3 * c67[3]; } }
                    *(u32x4*)(rowp + bj * 128) = pack8(v0, v1); } }
    }
};
struct EpiGlu {
    static constexpr bool PERM = true; static constexpr int MIDK = 0;
    bf16* H;
    __device__ __forceinline__ void operator()(const f32x4 (&acc)[2][2][4][2], const pg8::Unit& u, int wr, int wc, int fr, int fq) const {
        const int row0 = u.pm * 256 + wr * 64 + fr; const int col0 = (u.pn & 3) * 128 + wc * 32 + 8 * fq;
#pragma unroll
        for (int ai = 0; ai < 2; ++ai)
#pragma unroll
            for (int m = 0; m < 4; ++m) { f32x4 o[2];
#pragma unroll
                for (int n = 0; n < 2; ++n)
#pragma unroll
                    for (int j = 0; j < 4; ++j) { const float a = acc[ai][0][m][n][j], b = acc[ai][1][m][n][j]; o[n][j] = a * fast_sigmoid(a) * b; }
                *(u32x4*)(H + (size_t)(row0 + ai * 128 + m * 16) * 512 + col0) = pack8(o[0], o[1]); }
    }
};
struct EpiResid {
    static constexpr bool PERM = true; static constexpr int MIDK = 0;
    const bf16* X; bf16* Y;
    __device__ __forceinline__ void operator()(const f32x4 (&acc)[2][2][4][2], const pg8::Unit& u, int wr, int wc, int fr, int fq) const {
        const int row0 = u.pm * 256 + wr * 64 + fr, col0 = u.pn * 256 + wc * 32 + 8 * fq;
#pragma unroll
        for (int ai = 0; ai < 2; ++ai)
#pragma unroll
            for (int m = 0; m < 4; ++m) { const size_t ro = (size_t)(row0 + ai * 128 + m * 16) * D + col0;
#pragma unroll
                for (int bj = 0; bj < 2; ++bj) { const u32x4 xv = *(const u32x4*)(X + ro + bj * 128); f32x4 v0, v1;
                    v0[0] = bflo(xv.x) * DN_ALPHA + acc[ai][bj][m][0][0]; v0[1] = bfhi(xv.x) * DN_ALPHA + acc[ai][bj][m][0][1]; v0[2] = bflo(xv.y) * DN_ALPHA + acc[ai][bj][m][0][2]; v0[3] = bfhi(xv.y) * DN_ALPHA + acc[ai][bj][m][0][3];
                    v1[0] = bflo(xv.z) * DN_ALPHA + acc[ai][bj][m][1][0]; v1[1] = bfhi(xv.z) * DN_ALPHA + acc[ai][bj][m][1][1]; v1[2] = bflo(xv.w) * DN_ALPHA + acc[ai][bj][m][1][2]; v1[3] = bfhi(xv.w) * DN_ALPHA + acc[ai][bj][m][1][3];
                    *(u32x4*)(Y + ro + bj * 128) = pack8(v0, v1); } }
    }
};
struct EpiMerge {
    static constexpr bool PERM = true; static constexpr int MIDK = 8;
    const bf16* gate; bf16* O;
    __device__ __forceinline__ void mid(f32x4 (&acc)[2][2][4][2], const pg8::Unit& u, int seg, int wr, int wc, int fr, int fq) const {
        int row0 = u.pm * 256 + wr * 64 + fr; const int col0 = u.pn * 256 + wc * 32 + 8 * fq; asm volatile("" : "+v"(row0));
#pragma unroll
        for (int ai = 0; ai < 2; ++ai)
#pragma unroll
            for (int m = 0; m < 4; ++m) { const bf16* gp = gate + (size_t)(row0 + ai * 128 + m * 16) * 8192 + (size_t)(seg - 1) * 2048 + col0;
#pragma unroll
                for (int bj = 0; bj < 2; ++bj) { const u32x4 a = *(const u32x4*)(gp + bj * 128), b = *(const u32x4*)(gp + 2048 + bj * 128);
#pragma unroll
                    for (int q = 0; q < 4; ++q) { const float r0 = fmaxf(bflo(a[q]), 1e-30f) * __builtin_amdgcn_rcpf(fmaxf(bflo(b[q]), 1e-30f)), r1 = fmaxf(bfhi(a[q]), 1e-30f) * __builtin_amdgcn_rcpf(fmaxf(bfhi(b[q]), 1e-30f));
                        acc[ai][bj][m][q >> 1][(q & 1) * 2] *= r0; acc[ai][bj][m][q >> 1][(q & 1) * 2 + 1] *= r1; } }
                asm volatile("" ::: "memory"); }
    }
    __device__ __forceinline__ void operator()(const f32x4 (&acc)[2][2][4][2], const pg8::Unit& u, int wr, int wc, int fr, int fq) const {
        const int row0 = u.pm * 256 + wr * 64 + fr, col0 = u.pn * 256 + wc * 32 + 8 * fq;
#pragma unroll
        for (int ai = 0; ai < 2; ++ai)
#pragma unroll
            for (int m = 0; m < 4; ++m) { const int row = row0 + ai * 128 + m * 16; const bf16* gp = gate + (size_t)row * 8192 + 3 * 2048 + col0;
#pragma unroll
                for (int bj = 0; bj < 2; ++bj) { const u32x4 a = *(const u32x4*)(gp + bj * 128); f32x4 v0, v1;
                    v0[0] = acc[ai][bj][m][0][0] * fmaxf(bflo(a[0]), 1e-30f); v0[1] = acc[ai][bj][m][0][1] * fmaxf(bfhi(a[0]), 1e-30f);
                    v0[2] = acc[ai][bj][m][0][2] * fmaxf(bflo(a[1]), 1e-30f); v0[3] = acc[ai][bj][m][0][3] * fmaxf(bfhi(a[1]), 1e-30f);
                    v1[0] = acc[ai][bj][m][1][0] * fmaxf(bflo(a[2]), 1e-30f); v1[1] = acc[ai][bj][m][1][1] * fmaxf(bfhi(a[2]), 1e-30f);
                    v1[2] = acc[ai][bj][m][1][2] * fmaxf(bflo(a[3]), 1e-30f); v1[3] = acc[ai][bj][m][1][3] * fmaxf(bfhi(a[3]), 1e-30f);
                    *(u32x4*)(O + (size_t)row * D + col0 + bj * 128) = pack8(v0, v1); } }
    }
};

#define XB_TMO      128
#define XB_XCNT(j)  (256  + 64 * (j))
#define XB_XSUB(j)  (1280 + 64 * (j))
#define XB_XGEN(j)  (2304 + 64 * (j))
#define XB_TOP      3328
#define XB_TOPGEN   3392
#define XCD_BAR_WORDS 3456
#define XB_SPIN_CAP (1u << 25)
__device__ __forceinline__ unsigned xb_ld(unsigned* p)              { return __hip_atomic_load(p, __ATOMIC_RELAXED, __HIP_MEMORY_SCOPE_AGENT); }
__device__ __forceinline__ unsigned xb_add(unsigned* p, unsigned v) { return __hip_atomic_fetch_add(p, v, __ATOMIC_RELAXED, __HIP_MEMORY_SCOPE_AGENT); }
__device__ __forceinline__ unsigned xb_xcc_id() { return (unsigned)__builtin_amdgcn_s_getreg((3 << 11) | 20) & 0xFu; }
#define XB_SPIN(cond, bar) do { unsigned _sp = 0; while (cond) { __builtin_amdgcn_s_sleep(1); \
    if ((++_sp & 255u) == 0u) { if (xb_ld(&(bar)[XB_TMO])) break; if (_sp > XB_SPIN_CAP) { atomicAdd(&(bar)[XB_TMO], 1u); break; } } } } while (0)
struct XcdBarrier { unsigned* bar; unsigned x; volatile LAS unsigned* st; };
__device__ __forceinline__ XcdBarrier xcd_barrier_post(unsigned* bar, volatile LAS unsigned* st) {
    XcdBarrier b; b.bar = bar; b.x = xb_xcc_id(); b.st = st;
    if (threadIdx.x == 0) (void)xb_add(&bar[XB_XCNT(b.x)], 1u);
    return b;
}
__device__ __forceinline__ void xcd_barrier_complete(unsigned* bar, unsigned x, unsigned& nloc, unsigned& nx) {
    const unsigned G = gridDim.x * gridDim.y * gridDim.z;
    unsigned sum, cnt, mine, sp = 0u;
    for (;;) {
        sum = 0u; cnt = 0u; mine = 0u;
#pragma unroll
        for (unsigned j = 0; j < 16; ++j) { const unsigned c = xb_ld(&bar[XB_XCNT(j)]); sum += c; cnt += (c > 0u) ? 1u : 0u; mine = (j == x) ? c : mine; }
        if (sum == G) break;
        __builtin_amdgcn_s_sleep(1);
        if ((++sp & 255u) == 0u) { if (xb_ld(&bar[XB_TMO])) break; if (sp > XB_SPIN_CAP) { atomicAdd(&bar[XB_TMO], 1u); break; } }
    }
    nloc = mine > 0u ? mine : 1u; nx = cnt > 0u ? cnt : 1u;
}
__device__ __forceinline__ void xcd_barrier(const XcdBarrier& b) {
    asm volatile("s_waitcnt vmcnt(0)" ::: "memory");
    __syncthreads();
    if (threadIdx.x == 0) {
        unsigned* bar = b.bar;
        __builtin_amdgcn_s_waitcnt(0);
        unsigned nloc = b.st[0], nx = b.st[1];
        if (nloc == 0u) { xcd_barrier_complete(bar, b.x, nloc, nx); b.st[0] = nloc; b.st[1] = nx; }
        const unsigned old = xb_add(&bar[XB_XSUB(b.x)], 1u);
        const unsigned gen = old / nloc;
        if (old + 1u == (gen + 1u) * nloc) {
            __builtin_amdgcn_fence(__ATOMIC_RELEASE, "agent");
            asm volatile("s_waitcnt vmcnt(0)" ::: "memory");
            const unsigned og = xb_add(&bar[XB_TOP], 1u);
            const unsigned tg = og / nx;
            if (og + 1u == (tg + 1u) * nx) xb_add(&bar[XB_TOPGEN], 1u);
            else XB_SPIN(xb_ld(&bar[XB_TOPGEN]) == tg, bar);
            __builtin_amdgcn_fence(__ATOMIC_ACQUIRE, "agent");
            xb_add(&bar[XB_XGEN(b.x)], 1u);
            asm volatile("s_waitcnt vmcnt(0)" ::: "memory");
        } else {
            XB_SPIN(xb_ld(&bar[XB_XGEN(b.x)]) == gen, bar);
            __builtin_amdgcn_fence(__ATOMIC_ACQUIRE, "agent");
            asm volatile("s_waitcnt vmcnt(0)" ::: "memory");
        }
    }
    __syncthreads();
}

constexpr size_t MiB = 1u << 20;
constexpr size_t WS_CTL = 0, CTL_ZERO_BYTES = 1 * MiB;
constexpr size_t WS_WL0 = 2 * MiB, WS_WLSTRIDE = 272 * MiB;
constexpr size_t WO_WIN = 0, WO_WBR = 48 * MiB, WO_WOUT = 56 * MiB, WO_WXQ = 64 * MiB, WO_WXK = 66 * MiB, WO_WXV = 68 * MiB, WO_WXO = 70 * MiB, WO_WUQ = 72 * MiB, WO_WUKV = 73 * MiB,
                 WO_W1C = 74 * MiB, WO_W2C = 75 * MiB, WO_BIASP = 76 * MiB, WO_B1C = 77 * MiB, WO_WRT = 78 * MiB, WO_WEIN = 80 * MiB, WO_WEOUT = 208 * MiB;
constexpr size_t WS_XLO = 546 * MiB, WS_XB = 674 * MiB, WS_GATE = 738 * MiB, WS_U2 = 994 * MiB, WS_ABR = 1114 * MiB, WS_MERGED = 1178 * MiB, WS_QH = 1242 * MiB, WS_KVH = 1266 * MiB,
                 WS_QM = 1298 * MiB, WS_KM = 1322 * MiB, WS_VTM = 1346 * MiB, WS_VTSEL = 1362 * MiB, WS_VTWIN = 1366 * MiB, WS_KC = 1370 * MiB, WS_VCT = 1371 * MiB, WS_HID = 1372 * MiB,
                 WS_OCMP = 1373 * MiB, WS_OWIN = 1389 * MiB, WS_SCORES = 1405 * MiB, WS_IDX = 1437 * MiB, WS_NV = 1439 * MiB, WS_RSTD = 1440 * MiB, WS_ROPE = 1441 * MiB, WS_QX = 1443 * MiB,
                 WS_OX = 1459 * MiB, WS_KX = 1475 * MiB, WS_VXT = 1476 * MiB, WS_MEMB = 1477 * MiB, WS_CSTAT = 1478 * MiB, WS_MOE = 1479 * MiB, WS_Y = 1481 * MiB, WS_END = 1609 * MiB;
constexpr size_t WS_XS = WS_GATE, WS_Y2 = WS_GATE + 160 * MiB, WS_HS = WS_GATE + 320 * MiB;
static_assert(WS_HS + 40 * MiB <= WS_ABR, "MoE overlay");
constexpr int CW_CNT = 1024;
constexpr int CW_BAR = 4096;
constexpr size_t MO_TOKE = 0, MO_TOKW = 128 * 1024, MO_TOKP = 256 * 1024, MO_ROWW = 384 * 1024, MO_TILEE = 640 * 1024, MO_NT = 644 * 1024, MO_ROWTOK = 768 * 1024;

constexpr int RING_BYTES = 131072;
constexpr int LDS_BYTES = 147456;
constexpr int MISC_OFF = LDS_BYTES - 512;

constexpr int NWAVES = 8;
struct Args { const void* in[39]; float* out; unsigned char* ws; int ph_lo, ph_hi, li, pad; };
static_assert(sizeof(Args) == 39 * 8 + 8 + 8 + 16, "Args has no padding");

struct Frame {
    LAS unsigned char* lds;
    int tid, lane, wave, G, gw, NGW;
    unsigned char* ws;
};

__device__ __forceinline__ int in_col(int n) {
    if (n < 8192) return 3640 + n;
    if (n < 8704) return n - 8192;
    if (n < 9472) return 512 + (n - 8704);
    if (n < 9984) return 1304 + (n - 9472);
    if (n < 10496) return 1816 + (n - 9984);
    if (n < 10752) return 2328 + (n - 10496);
    if (n < 11776) return 2616 + (n - 10752);
    const int c = n - 11776; if (c < 24) return 1280 + c; if (c >= 32 && c < 64) return 2584 + (c - 32); return -1;
}
struct Job { const float* W; const float* ks; bf16* WT; int ldw, ldt, kdst0, mode, nkb, nnb, nbatch; size_t sstride, dstride; };
__device__ __forceinline__ void transpose_load(const Job& J, int item, f32x4 (&v)[16], int lane) {
    const int per = J.nkb * J.nnb, e = item / per, r = item % per, kb = r / J.nnb, nb = r % J.nnb, k0 = kb * 64, n0 = nb * 64;
    const float* W = J.W + (size_t)e * J.sstride;
    const int nq = 4 * (lane & 15), nd = n0 + nq;
    int sc;
    if (J.mode == 1) sc = in_col(nd);
    else if (J.mode == 2) { const int T = nd >> 8, w = nd & 255; sc = (w < 128) ? (T * 128 + w) : (512 + T * 128 + (w - 128)); }
    else sc = nd;
#pragma unroll
    for (int i = 0; i < 16; ++i) { const int kk = (lane >> 4) + 4 * i; v[i] = (f32x4){0.f, 0.f, 0.f, 0.f};
        if (sc >= 0) v[i] = *(const f32x4*)(W + (size_t)(k0 + kk) * J.ldw + sc); }
}
__device__ __forceinline__ void transpose_store(const Job& J, int item, f32x4 (&v)[16], LAS float* scr, int lane) {
    const int per = J.nkb * J.nnb, e = item / per, r = item % per, kb = r / J.nnb, nb = r % J.nnb, k0 = kb * 64, n0 = nb * 64;
    bf16* WT = J.WT + (size_t)e * J.dstride;
    const int nq = 4 * (lane & 15);
#pragma unroll
    for (int i = 0; i < 16; ++i) { const int kk = (lane >> 4) + 4 * i;
        if (J.ks) v[i] = v[i] * J.ks[k0 + kk];
        LAS float* d = scr + kk * 65 + nq; d[0] = v[i][0]; d[1] = v[i][1]; d[2] = v[i][2]; d[3] = v[i][3]; }
    LDS_WAIT(); asm volatile("" ::: "memory");
    const int c = lane & 7;
#pragma unroll
    for (int j = 0; j < 8; ++j) { const int n = (lane >> 3) + 8 * j; const LAS float* s = scr + (8 * c) * 65 + n;
        u32x4 o; o.x = cvt_pk_bf16(s[0 * 65], s[1 * 65]); o.y = cvt_pk_bf16(s[2 * 65], s[3 * 65]); o.z = cvt_pk_bf16(s[4 * 65], s[5 * 65]); o.w = cvt_pk_bf16(s[6 * 65], s[7 * 65]);
        *(u32x4*)(WT + (size_t)(n0 + n) * J.ldt + J.kdst0 + k0 + 8 * c) = o; }
    LDS_WAIT(); asm volatile("" ::: "memory");
}
constexpr int NJOBS = 15;
__device__ __forceinline__ Job get_job(const Args& a, int l, int j) {
    unsigned char* wl = a.ws + WS_WL0 + (size_t)l * WS_WLSTRIDE;
    Job J; J.ks = nullptr; J.kdst0 = 0; J.mode = 0; J.nbatch = 1; J.sstride = 0; J.dstride = 0;
#define SRC(i, per) ((const float*)a.in[i] + (size_t)l * (per))
    switch (j) {
    case 0:  J.W = SRC(3, (size_t)D * IN_W); J.ldw = IN_W; J.WT = (bf16*)(wl + WO_WIN); J.ldt = D; J.mode = 1; J.nkb = 32; J.nnb = NIN / 64; break;
    case 1:  J.W = SRC(8, 512 * D);  J.ldw = D; J.WT = (bf16*)(wl + WO_WBR); J.ldt = D; J.kdst0 = 0;    J.nkb = 8; J.nnb = 32; break;
    case 2:  J.W = SRC(16, 512 * D); J.ldw = D; J.WT = (bf16*)(wl + WO_WBR); J.ldt = D; J.kdst0 = 1024; J.nkb = 8; J.nnb = 32; break;
    case 3:  J.W = SRC(21, 512 * D); J.ldw = D; J.WT = (bf16*)(wl + WO_WBR); J.ldt = D; J.kdst0 = 1536; J.nkb = 8; J.nnb = 32; break;
    case 4:  J.W = SRC(22, (size_t)D * D); J.ldw = D; J.WT = (bf16*)(wl + WO_WOUT); J.ldt = D; J.nkb = 32; J.nnb = 32; break;
    case 5:  J.W = SRC(13, 512 * 768); J.ldw = 768; J.ks = SRC(12, 512); J.WT = (bf16*)(wl + WO_WUQ); J.ldt = 512; J.nkb = 8; J.nnb = 12; break;
    case 6:  J.W = SRC(15, 256 * 1024); J.ldw = 1024; J.ks = SRC(14, 256); J.WT = (bf16*)(wl + WO_WUKV); J.ldt = 256; J.nkb = 4; J.nnb = 16; break;
    case 7:  J.W = SRC(25, D * 512); J.ldw = 512; J.WT = (bf16*)(wl + WO_WXQ); J.ldt = D; J.nkb = 32; J.nnb = 8; break;
    case 8:  J.W = SRC(26, D * 512); J.ldw = 512; J.WT = (bf16*)(wl + WO_WXK); J.ldt = D; J.nkb = 32; J.nnb = 8; break;
    case 9:  J.W = SRC(27, D * 512); J.ldw = 512; J.WT = (bf16*)(wl + WO_WXV); J.ldt = D; J.nkb = 32; J.nnb = 8; break;
    case 10: J.W = SRC(28, 512 * D); J.ldw = D; J.WT = (bf16*)(wl + WO_WXO); J.ldt = 512; J.nkb = 8; J.nnb = 32; break;
    case 11: J.W = SRC(35, (size_t)32 * D * 1024); J.ldw = 1024; J.WT = (bf16*)(wl + WO_WEIN); J.ldt = D; J.mode = 2; J.nkb = 32; J.nnb = 16; J.nbatch = 32; J.sstride = (size_t)D * 1024; J.dstride = (size_t)1024 * D; break;
    case 12: J.W = SRC(36, (size_t)32 * 512 * D); J.ldw = D; J.WT = (bf16*)(wl + WO_WEOUT); J.ldt = 512; J.nkb = 8; J.nnb = 32; J.nbatch = 32; J.sstride = (size_t)512 * D; J.dstride = (size_t)D * 512; break;
    case 13: J.W = SRC(6, 2 * 2048 * 128); J.ldw = 128; J.WT = (bf16*)(wl + WO_W1C); J.ldt = 2048; J.nkb = 32; J.nnb = 2; J.nbatch = 2; J.sstride = 2048 * 128; J.dstride = 128 * 2048; break;
    default: J.W = SRC(7, 2 * 128 * 64); J.ldw = 64; J.WT = (bf16*)(wl + WO_W2C); J.ldt = 128; J.nkb = 2; J.nnb = 1; J.nbatch = 2; J.sstride = 128 * 64; J.dstride = 64 * 128; break;
    }
#undef SRC
    return J;
}

struct Row { f32x4 v[8]; };
__device__ __forceinline__ void row_load(Row& r, const float* p, int lane) {
    asm volatile("" : "+v"(lane));
#pragma unroll
    for (int j = 0; j < 8; ++j) r.v[j] = *(const f32x4*)(p + 4 * lane + 256 * j);
}
__device__ __forceinline__ void row_store_f32(const Row& r, float* p, int lane) {
    asm volatile("" : "+v"(lane));
#pragma unroll
    for (int j = 0; j < 8; ++j) *(f32x4*)(p + 4 * lane + 256 * j) = r.v[j];
}
__device__ __forceinline__ void row_store_bf16(const Row& r, bf16* p, int lane) {
    asm volatile("" : "+v"(lane));
#pragma unroll
    for (int j = 0; j < 8; ++j) { u32x2 w; w.x = cvt_pk_bf16(r.v[j][0], r.v[j][1]); w.y = cvt_pk_bf16(r.v[j][2], r.v[j][3]); *(u32x2*)(p + 4 * lane + 256 * j) = w; }
}
__device__ __forceinline__ void row_load_bf16(Row& r, const bf16* p, int lane) {
    asm volatile("" : "+v"(lane));
#pragma unroll
    for (int j = 0; j < 8; ++j) { const u32x2 w = *(const u32x2*)(p + 4 * lane + 256 * j); r.v[j][0] = bflo(w.x); r.v[j][1] = bfhi(w.x); r.v[j][2] = bflo(w.y); r.v[j][3] = bfhi(w.y); }
}
struct RowRaw { u32x2 w[8]; };
__device__ __forceinline__ void row_fetch(RowRaw& q, const bf16* p, int lane) {
    asm volatile("" : "+v"(lane));
#pragma unroll
    for (int j = 0; j < 8; ++j) q.w[j] = *(const u32x2*)(p + 4 * lane + 256 * j);
}
__device__ __forceinline__ void row_unpack(Row& r, const RowRaw& q) {
#pragma unroll
    for (int j = 0; j < 8; ++j) { r.v[j][0] = bflo(q.w[j].x); r.v[j][1] = bfhi(q.w[j].x); r.v[j][2] = bflo(q.w[j].y); r.v[j][3] = bfhi(q.w[j].y); }
}
__device__ __forceinline__ void row_unpack_add(Row& r, const RowRaw& q) {
#pragma unroll
    for (int j = 0; j < 8; ++j) { r.v[j][0] += bflo(q.w[j].x); r.v[j][1] += bfhi(q.w[j].x); r.v[j][2] += bflo(q.w[j].y); r.v[j][3] += bfhi(q.w[j].y); }
}
__device__ __forceinline__ void row_store_hilo(const Row& r, bf16* ph, bf16* pl, int lane) {
    asm volatile("" : "+v"(lane));
#pragma unroll
    for (int j = 0; j < 8; ++j) { u32x2 h, l; h.x = cvt_pk_bf16(r.v[j][0], r.v[j][1]); h.y = cvt_pk_bf16(r.v[j][2], r.v[j][3]);
        l.x = cvt_pk_bf16(r.v[j][0] - bflo(h.x), r.v[j][1] - bfhi(h.x)); l.y = cvt_pk_bf16(r.v[j][2] - bflo(h.y), r.v[j][3] - bfhi(h.y));
        *(u32x2*)(ph + 4 * lane + 256 * j) = h; *(u32x2*)(pl + 4 * lane + 256 * j) = l; }
}
__device__ __forceinline__ void row_add_bf16(Row& r, const bf16* p, int lane) {
    asm volatile("" : "+v"(lane));
#pragma unroll
    for (int j = 0; j < 8; ++j) { const u32x2 w = *(const u32x2*)(p + 4 * lane + 256 * j); r.v[j][0] += bflo(w.x); r.v[j][1] += bfhi(w.x); r.v[j][2] += bflo(w.y); r.v[j][3] += bfhi(w.y); }
}
__device__ __forceinline__ void row_layernorm(Row& r, const float* g, const float* b, int lane) {
    asm volatile("" : "+v"(lane));
    float s = 0.f;
#pragma unroll
    for (int j = 0; j < 8; ++j) s += (r.v[j][0] + r.v[j][1]) + (r.v[j][2] + r.v[j][3]);
    const float mean = wave_sum(s) * (1.0f / D); float q = 0.f;
#pragma unroll
    for (int j = 0; j < 8; ++j) { r.v[j] = r.v[j] - mean; q += (r.v[j][0] * r.v[j][0] + r.v[j][1] * r.v[j][1]) + (r.v[j][2] * r.v[j][2] + r.v[j][3] * r.v[j][3]); }
    const float rstd = 1.0f / sqrtf(wave_sum(q) * (1.0f / D) + 1e-5f);
#pragma unroll
    for (int j = 0; j < 8; ++j) { const f32x4 gg = *(const f32x4*)(g + 4 * lane + 256 * j), bb = *(const f32x4*)(b + 4 * lane + 256 * j); r.v[j] = r.v[j] * rstd * gg + bb; }
}

__device__ __forceinline__ void row_layernorm2(Row& r0, Row& r1, const float* g, const float* b, int lane) {
    asm volatile("" : "+v"(lane));
    float s0 = 0.f, s1 = 0.f;
#pragma unroll
    for (int j = 0; j < 8; ++j) { s0 += (r0.v[j][0] + r0.v[j][1]) + (r0.v[j][2] + r0.v[j][3]); s1 += (r1.v[j][0] + r1.v[j][1]) + (r1.v[j][2] + r1.v[j][3]); }
#pragma unroll
    for (int o = 0; o < 1; ++o) { s0 = wave_sum(s0); s1 = wave_sum(s1); }
    const float m0 = s0 * (1.0f / D), m1 = s1 * (1.0f / D); float q0 = 0.f, q1 = 0.f;
#pragma unroll
    for (int j = 0; j < 8; ++j) { r0.v[j] = r0.v[j] - m0; r1.v[j] = r1.v[j] - m1;
        q0 += (r0.v[j][0] * r0.v[j][0] + r0.v[j][1] * r0.v[j][1]) + (r0.v[j][2] * r0.v[j][2] + r0.v[j][3] * r0.v[j][3]);
        q1 += (r1.v[j][0] * r1.v[j][0] + r1.v[j][1] * r1.v[j][1]) + (r1.v[j][2] * r1.v[j][2] + r1.v[j][3] * r1.v[j][3]); }
#pragma unroll
    for (int o = 0; o < 1; ++o) { q0 = wave_sum(q0); q1 = wave_sum(q1); }
    const float d0 = 1.0f / sqrtf(q0 * (1.0f / D) + 1e-5f), d1 = 1.0f / sqrtf(q1 * (1.0f / D) + 1e-5f);
#pragma unroll
    for (int j = 0; j < 8; ++j) { const f32x4 gg = *(const f32x4*)(g + 4 * lane + 256 * j), bb = *(const f32x4*)(b + 4 * lane + 256 * j); r0.v[j] = r0.v[j] * d0 * gg + bb; r1.v[j] = r1.v[j] * d1 * gg + bb; }
}
template <class AP, class BP>
__device__ __forceinline__ f32x4 sgemm16(const AP& ap, const BP& bp, int K, int lane) {
    const int r = lane & 15, G = lane >> 4; f32x4 acc = (f32x4){0.f, 0.f, 0.f, 0.f};
#pragma unroll 8
    for (int k0 = 0; k0 < K; k0 += 32) { const bf16x8 a = *(const bf16x8*)ap(r, k0 + 8 * G), b = *(const bf16x8*)bp(r, k0 + 8 * G);
        acc = __builtin_amdgcn_mfma_f32_16x16x32_bf16(a, b, acc, 0, 0, 0); }
    return acc;
}
__device__ __forceinline__ void transpose_tile64(const bf16* src, size_t sp, bf16* dst, size_t dp, LAS bf16* scr, int lane) {
    const int r8 = lane >> 3, pc = lane & 7;
#pragma unroll
    for (int c = 0; c < 8; ++c) { const int row = 8 * c + r8; const u32x4 v = *(const u32x4*)(src + (size_t)row * sp + 8 * pc); LAS unsigned* d = (LAS unsigned*)(scr + row * 66 + 8 * pc); d[0] = v.x; d[1] = v.y; d[2] = v.z; d[3] = v.w; }
    LDS_WAIT(); asm volatile("" ::: "memory");
#pragma unroll
    for (int c = 0; c < 8; ++c) { const int drow = 8 * c + r8; unsigned w[4];
#pragma unroll
        for (int q = 0; q < 4; ++q) { const unsigned lo = scr[(8 * pc + 2 * q) * 66 + drow], hi = scr[(8 * pc + 2 * q + 1) * 66 + drow]; w[q] = lo | (hi << 16); }
        *(u32x4*)(dst + (size_t)drow * dp + 8 * pc) = (u32x4){w[0], w[1], w[2], w[3]}; }
    LDS_WAIT(); asm volatile("" ::: "memory");
}
__device__ __forceinline__ float gelu_tanh(float x) { const float u = 0.7978845608028654f * (x + 0.044715f * x * x * x); return 0.5f * x * (1.0f + tanhf(u)); }

__device__ __forceinline__ void phase_prologue(const Args& a, Frame& F) {
    LAS float* scr = (LAS float*)(F.lds + F.wave * 16640);
    const int gw = F.gw, NGW = F.NGW, lane = F.lane;
    { int off = 0;
      for (int l = 0; l < DEPTH; ++l)
        for (int j = 0; j < NJOBS; ++j) { const Job J = get_job(a, l, j); const int n = J.nbatch * J.nkb * J.nnb;
            int st = (gw - off) % NGW; if (st < 0) st += NGW;
            f32x4 va[16], vb[16];
            if (st < n) transpose_load(J, st, va, lane);
#pragma unroll 1
            for (int it = st; it < n; it += 2 * NGW) {
                if (it + NGW < n) transpose_load(J, it + NGW, vb, lane);
                transpose_store(J, it, va, scr, lane);
                if (it + NGW < n) { if (it + 2 * NGW < n) transpose_load(J, it + 2 * NGW, va, lane); transpose_store(J, it + NGW, vb, scr, lane); } }
            off = (off + n) % NGW; } }
#pragma unroll 1
    for (int i = gw * 64 + lane; i < DEPTH * NIN; i += NGW * 64) { const int l = i / NIN, n = i % NIN; const int sc = in_col(n);
        ((float*)(a.ws + WS_WL0 + (size_t)l * WS_WLSTRIDE + WO_BIASP))[n] = sc >= 0 ? ((const float*)a.in[4])[(size_t)l * IN_W + sc] : 0.f; }
#pragma unroll 1
    for (int it = gw; it < DEPTH * 4 * 16 * 32; it += NGW) { const int nb = it & 31, cb = (it >> 5) & 15, g = (it >> 9) & 3, l = it >> 11; const int n = nb * 64 + lane;
        const float* wp = (const float*)a.in[9] + ((size_t)(l * 4 + g) * 128 + 8 * cb) * 128; const float* ps = (const float*)a.in[10] + l * 512 + 128 * g;
        const float* wo = (const float*)a.in[11] + ((size_t)l * 512 + 128 * g) * D + n;
        float acc[8];
#pragma unroll
        for (int i = 0; i < 8; ++i) acc[i] = 0.f;
        for (int d = 0; d < 128; ++d) { const float b = wo[(size_t)d * D] * ps[d];
#pragma unroll
            for (int i = 0; i < 8; ++i) acc[i] += wp[i * 128 + d] * b; }
        bf16* dst = (bf16*)(a.ws + WS_WL0 + (size_t)l * WS_WLSTRIDE + WO_WBR) + (size_t)n * D + 512 + 128 * g + 8 * cb;
        *(u32x4*)dst = (u32x4){cvt_pk_bf16(acc[0], acc[1]), cvt_pk_bf16(acc[2], acc[3]), cvt_pk_bf16(acc[4], acc[5]), cvt_pk_bf16(acc[6], acc[7])}; }
#pragma unroll 1
    for (int it = gw; it < DEPTH * 2; it += NGW) { const float* pos = (const float*)a.in[5] + (size_t)it * 2048; const float* w1 = (const float*)a.in[6] + (size_t)it * 2048 * 128;
        float a0 = 0.f, a1 = 0.f;
        for (int k = 0; k < 2048; ++k) { const float p = pos[k]; a0 += p * w1[(size_t)k * 128 + lane]; a1 += p * w1[(size_t)k * 128 + 64 + lane]; }
        float* dst = (float*)(a.ws + WS_WL0 + (size_t)(it >> 1) * WS_WLSTRIDE + WO_B1C) + (it & 1) * 128; dst[lane] = a0; dst[64 + lane] = a1; }
#pragma unroll 1
    for (int i = gw * 64 + lane; i < S * 16; i += NGW * 64) { const int t = i >> 4, k = i & 15; const float inv = powf(10000.0f, -(float)k / 16.0f); const float ang = (float)((const int*)a.in[2])[t] * inv;
        float sn, cs; sincosf(ang, &sn, &cs); ((f32x2*)(a.ws + WS_ROPE))[i] = (f32x2){cs, sn}; }
#pragma unroll 1
    for (int i = gw * 64 + lane; i < DEPTH * 48 * 2048; i += NGW * 64) { const int l = i / (48 * 2048), n = (i / 2048) % 48, k = i % 2048;
        float w = 0.f; if (n < 4) w = ((const float*)a.in[31])[((size_t)l * D + k) * 4 + n]; else if (n < 36) w = ((const float*)a.in[33])[((size_t)l * D + k) * 32 + (n - 4)];
        const unsigned short h = f2bf(w); const unsigned short lo = f2bf(w - bf2f(h));
        bf16* dst = (bf16*)(a.ws + WS_WL0 + (size_t)l * WS_WLSTRIDE + WO_WRT); dst[(size_t)n * 2048 + k] = h; dst[(size_t)(48 + n) * 2048 + k] = lo; }
#pragma unroll 1
    for (int r = gw; r < S + 256; r += NGW) { Row rw;
        if (r < S) { row_load(rw, (const float*)a.in[0] + (size_t)r * D, lane); row_store_bf16(rw, (bf16*)(a.ws + WS_XB) + (size_t)r * D, lane); }
        else { row_load(rw, (const float*)a.in[1] + (size_t)(r - S) * D, lane); row_store_bf16(rw, (bf16*)(a.ws + WS_MEMB) + (size_t)(r - S) * D, lane); } }
}

__device__ __forceinline__ int crow(int r, int hi) { return (r & 3) + 8 * (r >> 2) + 4 * hi; }
template <int DK, int DV, class V>
__device__ __forceinline__ void attn32(const V& v, int lane, float& m_fin, float& l_fin) {
    const int col = lane & 31, hi = lane >> 5;
    constexpr int NKS = DK / 16, NVB = DV / 32;
    bf16x8 qf[NKS];
    { const bf16* qp = v.qptr(col);
#pragma unroll
      for (int s = 0; s < NKS; ++s) qf[s] = *(const bf16x8*)(qp + 16 * s + 8 * hi); }
    f32x16 o[NVB];
#pragma unroll
    for (int b = 0; b < NVB; ++b)
#pragma unroll
        for (int r = 0; r < 16; ++r) o[b][r] = 0.f;
    float m_run = -INFINITY, l_run = 0.f;
    for (int T = v.tb; T < v.te; ++T) {
        const int key0 = 32 * T;
        const bf16* kp = v.kptr(key0 + col);
        f32x16 sacc;
#pragma unroll
        for (int r = 0; r < 16; ++r) sacc[r] = 0.f;
#pragma unroll
        for (int s = 0; s < NKS; ++s) { const bf16x8 kf = *(const bf16x8*)(kp + 16 * s + 8 * hi); sacc = __builtin_amdgcn_mfma_f32_32x32x16_bf16(kf, qf[s], sacc, 0, 0, 0); }
        float x[16]; float mt = -INFINITY;
#pragma unroll
        for (int r = 0; r < 16; ++r) { const int key = key0 + crow(r, hi); x[r] = v.valid(key, col) ? sacc[r] * v.scale2 : -INFINITY; mt = fmaxf(mt, x[r]); }
        mt = fmaxf(mt, __shfl_xor(mt, 32));
        const float m_new = fmaxf(m_run, mt);
        const float mref = (m_new == -INFINITY) ? 0.f : m_new;
        const float corr = __builtin_amdgcn_exp2f(m_run - mref);
        float ps = 0.f;
#pragma unroll
        for (int r = 0; r < 16; ++r) { x[r] = __builtin_amdgcn_exp2f(x[r] - mref); ps += x[r]; }
        l_run = l_run * corr + ps; m_run = m_new;
#pragma unroll
        for (int b = 0; b < NVB; ++b)
#pragma unroll
            for (int r = 0; r < 16; ++r) o[b][r] *= corr;
        bf16x8 pf[2];
#pragma unroll
        for (int s2 = 0; s2 < 2; ++s2) { const u32x4 w = (u32x4){cvt_pk_bf16(x[8 * s2 + 0], x[8 * s2 + 1]), cvt_pk_bf16(x[8 * s2 + 2], x[8 * s2 + 3]), cvt_pk_bf16(x[8 * s2 + 4], x[8 * s2 + 5]), cvt_pk_bf16(x[8 * s2 + 6], x[8 * s2 + 7])};
            pf[s2] = __builtin_bit_cast(bf16x8, w); }
#pragma unroll
        for (int b = 0; b < NVB; ++b) { const bf16* vp = v.vtptr(32 * b + col) + key0 + 4 * hi;
#pragma unroll
            for (int s2 = 0; s2 < 2; ++s2) { const u32x2 lo = *(const u32x2*)(vp + 16 * s2), hh = *(const u32x2*)(vp + 16 * s2 + 8);
                const bf16x8 vf = __builtin_bit_cast(bf16x8, (u32x4){lo.x, lo.y, hh.x, hh.y});
                o[b] = __builtin_amdgcn_mfma_f32_32x32x16_bf16(vf, pf[s2], o[b], 0, 0, 0); } }
    }
    const float l = l_run + __shfl_xor(l_run, 32);
    const float inv = l > 0.f ? 1.0f / l : 0.f;
#pragma unroll
    for (int b = 0; b < NVB; ++b)
#pragma unroll
        for (int i = 0; i < 4; ++i) v.store(col, 32 * b + 8 * i + 4 * hi, (f32x4){o[b][4 * i] * inv, o[b][4 * i + 1] * inv, o[b][4 * i + 2] * inv, o[b][4 * i + 3] * inv});
    m_fin = m_run; l_fin = l;
}
__device__ __forceinline__ void store4_bf16(bf16* p, const f32x4 v) { *(u32x2*)p = (u32x2){cvt_pk_bf16(v[0], v[1]), cvt_pk_bf16(v[2], v[3])}; }

struct VarMLA {
    const bf16* Q; const bf16* K; const bf16* Vt; bf16* O; int t0, hd, tb, te; float scale2;
    __device__ __forceinline__ const bf16* qptr(int col) const { return Q + (size_t)(t0 + col) * 768 + hd * 96; }
    __device__ __forceinline__ const bf16* kptr(int key) const { return K + (size_t)key * 768 + hd * 96; }
    __device__ __forceinline__ const bf16* vtptr(int dv) const { return Vt + (size_t)(hd * 64 + dv) * S; }
    __device__ __forceinline__ bool valid(int key, int col) const { return key <= t0 + col; }
    __device__ __forceinline__ void store(int col, int dv, const f32x4 x) const { store4_bf16(O + (size_t)(t0 + col) * D + 1024 + hd * 64 + dv, x); }
};
struct VarWin {
    const bf16* U2; const bf16* Vt; bf16* O; int t0, g, tb, te; float scale2;
    __device__ __forceinline__ const bf16* qptr(int col) const { return U2 + (size_t)(t0 + (col >> 2)) * U2W + U2_Q + (4 * g + (col & 3)) * 64; }
    __device__ __forceinline__ const bf16* kptr(int key) const { return U2 + (size_t)key * U2W + U2_KV + (4 * 2 + g) * 64; }
    __device__ __forceinline__ const bf16* vtptr(int dv) const { return Vt + (size_t)(g * 64 + dv) * S; }
    __device__ __forceinline__ bool valid(int key, int col) const { const int tok = t0 + (col >> 2); return key <= tok && key > tok - 512; }
    __device__ __forceinline__ void store(int col, int dv, const f32x4 x) const { store4_bf16(O + (size_t)(t0 + (col >> 2)) * 512 + (4 * g + (col & 3)) * 64 + dv, x); }
};
struct VarCmp {
    const bf16* U2; const bf16* KC; const bf16* Vt; bf16* O; int t0, g, tb, te; float scale2;
    __device__ __forceinline__ const bf16* qptr(int col) const { return U2 + (size_t)(t0 + (col >> 2)) * U2W + U2_Q + (4 * g + (col & 3)) * 64; }
    __device__ __forceinline__ const bf16* kptr(int c) const { return KC + (size_t)(g * 1024 + c) * 64; }
    __device__ __forceinline__ const bf16* vtptr(int dv) const { return Vt + (size_t)(g * 64 + dv) * 1024; }
    __device__ __forceinline__ bool valid(int c, int col) const { return 16 * c + 31 <= t0 + (col >> 2); }
    __device__ __forceinline__ void store(int col, int dv, const f32x4 x) const { store4_bf16(O + (size_t)(t0 + (col >> 2)) * 512 + (4 * g + (col & 3)) * 64 + dv, x); }
};
struct VarX {
    const bf16* Q; const bf16* K; const bf16* Vt; bf16* O; int t0, hd, tb, te; float scale2;
    __device__ __forceinline__ const bf16* qptr(int col) const { return Q + (size_t)(t0 + col) * 512 + hd * 128; }
    __device__ __forceinline__ const bf16* kptr(int key) const { return K + (size_t)key * 512 + hd * 128; }
    __device__ __forceinline__ const bf16* vtptr(int dv) const { return Vt + (size_t)(hd * 128 + dv) * 256; }
    __device__ __forceinline__ bool valid(int, int) const { return true; }
    __device__ __forceinline__ void store(int col, int dv, const f32x4 x) const { store4_bf16(O + (size_t)(t0 + col) * 512 + hd * 128 + dv, x); }
};
__device__ __forceinline__ void cmp_scores(const VarCmp& v, int lane, float m_fin, float l_fin, float* sc) {
    const int col = lane & 31, hi = lane >> 5;
    bf16x8 qf[4];
    { const bf16* qp = v.qptr(col);
#pragma unroll
      for (int s = 0; s < 4; ++s) qf[s] = *(const bf16x8*)(qp + 16 * s + 8 * hi); }
    const float mref = (m_fin == -INFINITY) ? 0.f : m_fin; const float inv = l_fin > 0.f ? 1.0f / l_fin : 0.f;
    float* dst = sc + (size_t)((v.t0 + (col >> 2)) * 2 + v.g) * 256;
    float carry = 0.f;
    for (int T = 0; T < 32; ++T) {
        float sv[4];
        if (T < v.te) {
            const int key0 = 32 * T; const bf16* kp = v.kptr(key0 + col);
            f32x16 sacc;
#pragma unroll
            for (int r = 0; r < 16; ++r) sacc[r] = 0.f;
#pragma unroll
            for (int s = 0; s < 4; ++s) { const bf16x8 kf = *(const bf16x8*)(kp + 16 * s + 8 * hi); sacc = __builtin_amdgcn_mfma_f32_32x32x16_bf16(kf, qf[s], sacc, 0, 0, 0); }
            float Gs[4], Es[4];
#pragma unroll
            for (int i = 0; i < 4; ++i) { float p[4];
#pragma unroll
                for (int q = 0; q < 4; ++q) { const int r = 4 * i + q; const int key = key0 + crow(r, hi); p[q] = v.valid(key, col) ? __builtin_amdgcn_exp2f(sacc[r] * v.scale2 - mref) * inv : 0.f; }
                Gs[i] = (p[0] + p[1]) + (p[2] + p[3]); Es[i] = p[3]; }
#pragma unroll
            for (int i = 0; i < 4; ++i) { Gs[i] += __shfl_xor(Gs[i], 1); Gs[i] += __shfl_xor(Gs[i], 2); Es[i] += __shfl_xor(Es[i], 1); Es[i] += __shfl_xor(Es[i], 2); }
            float eo[4];
#pragma unroll
            for (int i = 0; i < 4; ++i) eo[i] = __shfl_xor(Es[i], 32);
            if (hi) { sv[0] = Gs[0] + eo[0]; sv[1] = Gs[1] + eo[1]; sv[2] = Gs[2] + eo[2]; sv[3] = Gs[3] + eo[3]; }
            else { sv[0] = Gs[0] + carry; sv[1] = Gs[1] + eo[0]; sv[2] = Gs[2] + eo[1]; sv[3] = Gs[3] + eo[2]; }
            carry = eo[3];
        } else { sv[0] = hi ? 0.f : carry; sv[1] = 0.f; sv[2] = 0.f; sv[3] = 0.f; carry = 0.f; }
        if ((col & 3) == 0) {
#pragma unroll
            for (int i = 0; i < 4; ++i) dst[8 * T + 2 * i + hi] = sv[i]; }
    }
}

__device__ __forceinline__ void sel_attn_unit(const bf16* U2, const bf16* VTS, const bf16* OCMP, const bf16* OWIN, const int* idx, int nv, bf16* ABR, int t, int g, int lane) {
    const int c16 = lane & 15, G = lane >> 4;
    const float scale2 = 0.125f * LOG2E;
    bf16x8 qf[2];
    { const bf16* qp = U2 + (size_t)t * U2W + U2_Q + (4 * g + (c16 & 3)) * 64;
#pragma unroll
      for (int ks = 0; ks < 2; ++ks) { qf[ks] = *(const bf16x8*)(qp + 32 * ks + 8 * G); if (c16 >= 4) qf[ks] = (bf16x8){0, 0, 0, 0, 0, 0, 0, 0}; } }
    f32x4 o[4];
#pragma unroll
    for (int d = 0; d < 4; ++d) o[d] = (f32x4){0.f, 0.f, 0.f, 0.f};
    float m_run = -INFINITY, l_run = 0.f;
    for (int b = 0; b < nv; ++b) {
        const int blk = __builtin_amdgcn_readfirstlane(idx[b]); const int key0 = 64 * blk;
        f32x4 acc[4];
#pragma unroll
        for (int kt = 0; kt < 4; ++kt) { const bf16* kp = U2 + (size_t)(key0 + 16 * kt + c16) * U2W + U2_KV + (2 * 2 + g) * 64 + 8 * G;
            const bf16x8 k0 = *(const bf16x8*)kp, k1 = *(const bf16x8*)(kp + 32);
            acc[kt] = __builtin_amdgcn_mfma_f32_16x16x32_bf16(k0, qf[0], (f32x4){0.f, 0.f, 0.f, 0.f}, 0, 0, 0);
            acc[kt] = __builtin_amdgcn_mfma_f32_16x16x32_bf16(k1, qf[1], acc[kt], 0, 0, 0); }
        float mt = -INFINITY;
#pragma unroll
        for (int kt = 0; kt < 4; ++kt)
#pragma unroll
            for (int i = 0; i < 4; ++i) { const int key = key0 + 16 * kt + 4 * G + i; acc[kt][i] = (key <= t) ? acc[kt][i] * scale2 : -INFINITY; mt = fmaxf(mt, acc[kt][i]); }
        mt = fmaxf(mt, __shfl_xor(mt, 16)); mt = fmaxf(mt, __shfl_xor(mt, 32));
        const float m_new = fmaxf(m_run, mt); const float mref = (m_new == -INFINITY) ? 0.f : m_new;
        const float corr = __builtin_amdgcn_exp2f(m_run - mref); float ps = 0.f;
#pragma unroll
        for (int kt = 0; kt < 4; ++kt)
#pragma unroll
            for (int i = 0; i < 4; ++i) { acc[kt][i] = __builtin_amdgcn_exp2f(acc[kt][i] - mref); ps += acc[kt][i]; }
        l_run = l_run * corr + ps; m_run = m_new;
#pragma unroll
        for (int d = 0; d < 4; ++d) o[d] = o[d] * corr;
        bf16x8 pf[2];
#pragma unroll
        for (int u = 0; u < 2; ++u) pf[u] = __builtin_bit_cast(bf16x8, (u32x4){cvt_pk_bf16(acc[2 * u][0], acc[2 * u][1]), cvt_pk_bf16(acc[2 * u][2], acc[2 * u][3]), cvt_pk_bf16(acc[2 * u + 1][0], acc[2 * u + 1][1]), cvt_pk_bf16(acc[2 * u + 1][2], acc[2 * u + 1][3])});
#pragma unroll
        for (int d = 0; d < 4; ++d) { const bf16* vp = VTS + (size_t)(g * 64 + 16 * d + c16) * S + key0 + 4 * G;
#pragma unroll
            for (int u = 0; u < 2; ++u) { const u32x2 lo = *(const u32x2*)(vp + 32 * u), hh = *(const u32x2*)(vp + 32 * u + 16);
                o[d] = __builtin_amdgcn_mfma_f32_16x16x32_bf16(__builtin_bit_cast(bf16x8, (u32x4){lo.x, lo.y, hh.x, hh.y}), pf[u], o[d], 0, 0, 0); } }
    }
    float l = l_run; l += __shfl_xor(l, 16); l += __shfl_xor(l, 32);
    const float inv = l > 0.f ? 1.0f / l : 0.f;
    if (c16 < 4) { const int head = 4 * g + c16; const bf16* gp = U2 + (size_t)t * U2W + U2_G + head * 3;
        const float s0 = sigmoidf_(bf2f(gp[0])), s1 = sigmoidf_(bf2f(gp[1])) * inv, s2 = sigmoidf_(bf2f(gp[2]));
#pragma unroll
        for (int d = 0; d < 4; ++d) { const size_t off = (size_t)t * 512 + head * 64 + 16 * d + 4 * G; const u32x2 oc = *(const u32x2*)(OCMP + off), ow = *(const u32x2*)(OWIN + off);
            f32x4 r; r[0] = s0 * bflo(oc.x) + s1 * o[d][0] + s2 * bflo(ow.x); r[1] = s0 * bfhi(oc.x) + s1 * o[d][1] + s2 * bfhi(ow.x);
            r[2] = s0 * bflo(oc.y) + s1 * o[d][2] + s2 * bflo(ow.y); r[3] = s0 * bfhi(oc.y) + s1 * o[d][3] + s2 * bfhi(ow.y);
            store4_bf16(ABR + (size_t)t * D + head * 64 + 16 * d + 4 * G, r); } }
}
__device__ __forceinline__ bool selmask_test(const LAS unsigned* m8, int j) { return (m8[(j & 3) * 2 + (j >> 7)] >> ((j >> 2) & 31)) & 1u; }
__device__ __forceinline__ void topk_unit(const float* sc, int t, unsigned* mask_out, int lane) {
    const int cur = t >> 6;
    const f32x4 v = *(const f32x4*)(sc + 4 * lane);
    unsigned key[4];
#pragma unroll
    for (int q = 0; q < 4; ++q) { const int j = 4 * lane + q;
        key[q] = __float_as_uint(v[q]) + 1u;
        if (j == 0 || j == cur || j == cur - 1) key[q] = 0xffffffffu;
        if (j > cur) key[q] = 0u; }
    unsigned T = 0u;
#pragma unroll 1
    for (int bit = 31; bit >= 0; --bit) { const unsigned cand = T | (1u << bit);
        int cnt = 0;
#pragma unroll
        for (int q = 0; q < 4; ++q) cnt += __builtin_popcountll(__ballot(key[q] >= cand));
        if (cnt >= 16) T = cand; }
    unsigned long long G[4], E[4]; int cgt = 0;
#pragma unroll
    for (int q = 0; q < 4; ++q) { G[q] = __ballot(key[q] > T); E[q] = __ballot(key[q] == T && T != 0u); cgt += __builtin_popcountll(G[q]); }
    const int need = 16 - cgt;
    int below = 0;
#pragma unroll
    for (int q = 0; q < 4; ++q) below += (int)__builtin_amdgcn_mbcnt_hi((unsigned)(E[q] >> 32), __builtin_amdgcn_mbcnt_lo((unsigned)E[q], 0u));
    unsigned long long Sel[4]; int own = 0;
#pragma unroll
    for (int q = 0; q < 4; ++q) { const bool eq = (key[q] == T && T != 0u); const bool take = (key[q] > T) || (eq && (below + own) < need); own += eq ? 1 : 0; Sel[q] = __ballot(take); }
    unsigned w = 0u;
#pragma unroll
    for (int q = 0; q < 4; ++q) { if (lane == 2 * q) w = (unsigned)Sel[q]; if (lane == 2 * q + 1) w = (unsigned)(Sel[q] >> 32); }
    if (lane < 8) mask_out[lane] = w;
}

template <int NKS, int KP, int VP, int NVB, class MaskF>
__device__ __forceinline__ void att_step64n(const LAS unsigned char* kb, const LAS unsigned char* vb, const bf16x8 (&qf)[NKS], f32x16 (&o)[NVB], float& m_run, float& l_run, float scale2, bool use_mask, const MaskF& mask, int col, int hi) {
    f32x16 sacc[2];
#pragma unroll
    for (int u = 0; u < 2; ++u) {
#pragma unroll
        for (int r = 0; r < 16; ++r) sacc[u][r] = 0.f;
#pragma unroll
        for (int s = 0; s < NKS; ++s) { const bf16x8 kf = *(const LAS bf16x8*)(kb + ((32 * u + col) * KP + 16 * s + 8 * hi) * 2); sacc[u] = __builtin_amdgcn_mfma_f32_32x32x16_bf16(kf, qf[s], sacc[u], 0, 0, 0); } }
    float mt = -INFINITY;
#pragma unroll
    for (int u = 0; u < 2; ++u)
#pragma unroll
        for (int r = 0; r < 16; ++r) { float x = sacc[u][r] * scale2; if (use_mask) { if (!mask(u, r)) x = -INFINITY; } sacc[u][r] = x; mt = fmaxf(mt, x); }
    mt = xmax32(mt);
    const float m_new = fmaxf(m_run, mt); const float mref = (m_new == -INFINITY) ? 0.f : m_new;
    if (__any(m_new != m_run)) {
        const float corr = __builtin_amdgcn_exp2f(m_run - mref); l_run *= corr; m_run = m_new;
#pragma unroll
        for (int b = 0; b < NVB; ++b)
#pragma unroll
            for (int r = 0; r < 16; ++r) o[b][r] *= corr; }
    float ps = 0.f;
#pragma unroll
    for (int u = 0; u < 2; ++u)
#pragma unroll
        for (int r = 0; r < 16; ++r) { sacc[u][r] = __builtin_amdgcn_exp2f(sacc[u][r] - mref); ps += sacc[u][r]; }
    l_run += ps;
#pragma unroll
    for (int u = 0; u < 2; ++u)
#pragma unroll
        for (int s2 = 0; s2 < 2; ++s2) { const bf16x8 pf = __builtin_bit_cast(bf16x8, (u32x4){cvt_pk_bf16(sacc[u][8 * s2 + 0], sacc[u][8 * s2 + 1]), cvt_pk_bf16(sacc[u][8 * s2 + 2], sacc[u][8 * s2 + 3]), cvt_pk_bf16(sacc[u][8 * s2 + 4], sacc[u][8 * s2 + 5]), cvt_pk_bf16(sacc[u][8 * s2 + 6], sacc[u][8 * s2 + 7])});
#pragma unroll
            for (int b = 0; b < NVB; ++b) { const LAS unsigned char* vp = vb + ((32 * b + col) * VP + 32 * u + 16 * s2 + 4 * hi) * 2;
                const u32x2 lo = *(const LAS u32x2*)vp, hh = *(const LAS u32x2*)(vp + 16);
                o[b] = __builtin_amdgcn_mfma_f32_32x32x16_bf16(__builtin_bit_cast(bf16x8, (u32x4){lo.x, lo.y, hh.x, hh.y}), pf, o[b], 0, 0, 0); } }
}

template <int NKS, int KP, int VP, class MaskF>
__device__ __forceinline__ void att_step64(const LAS unsigned char* kb, const LAS unsigned char* vb, const bf16x8 (&qf)[NKS], f32x16 (&o)[2], float& m_run, float& l_run, float scale2, bool use_mask, const MaskF& mask, int col, int hi) {
    att_step64n<NKS, KP, VP, 2>(kb, vb, qf, o, m_run, l_run, scale2, use_mask, mask, col, hi);
}

constexpr int SK_KP = 72, SK_VP = 132;
constexpr int SK_KB = 128 * SK_KP * 2, SK_VB = 64 * SK_VP * 2, SK_VOFF = 2 * SK_KB, SK_MOFF = SK_VOFF + 2 * SK_VB;
template <int MODE>
__device__ __forceinline__ void sel_unit(LAS unsigned char* lds, const bf16* U2, const bf16* VTS, const unsigned* SM, const bf16* OCMP, bf16* OWIN, bf16* ABR, int g, int qblk, int tid, int wave, int lane) {
    const int col = lane & 31, hi = lane >> 5;
    const int tl = 8 * wave + (col >> 2), t = 64 * qblk + tl, head = 4 * g + (col & 3);
    LAS unsigned* smask = (LAS unsigned*)(lds + SK_MOFF);
    __syncthreads();
    if (MODE == 0) smask[tid] = SM[(size_t)((64 * qblk + (tid >> 3)) * 2 + g) * 8 + (tid & 7)];
    bf16x8 qf[4];
    { const bf16* qp = U2 + (size_t)t * U2W + U2_Q + head * 64;
#pragma unroll
      for (int s = 0; s < 4; ++s) qf[s] = *(const bf16x8*)(qp + 16 * s + 8 * hi); }
    f32x16 o[2];
#pragma unroll
    for (int b = 0; b < 2; ++b)
#pragma unroll
        for (int r = 0; r < 16; ++r) o[b][r] = 0.f;
    float m_run = -INFINITY, l_run = 0.f;
    const float scale2 = 0.125f * LOG2E;
    const int jlo = (MODE == 1 && qblk > 8) ? qblk - 8 : 0;
    const int st0 = jlo >> 1, st1 = (qblk >> 1) + 1;
    const int kvsel = (MODE == 1) ? 4 : 2;
    const bf16* kg[2]; unsigned kl[2]; const bf16* vg[2]; unsigned vl[2];
#pragma unroll
    for (int i = 0; i < 2; ++i) { const int c = tid + 512 * i; { const int row = c >> 3, p = c & 7; kg[i] = U2 + (size_t)row * U2W + U2_KV + (kvsel * 2 + g) * 64 + 8 * p; kl[i] = (unsigned)(row * SK_KP + 8 * p) * 2u; }
        { const int row = c >> 4, p = c & 15; vg[i] = VTS + (size_t)(g * 64 + row) * S + 8 * p; vl[i] = (unsigned)(row * SK_VP + 8 * p) * 2u; } }
    u32x4 kr[2], vr[2];
    auto gload = [&](int step) { const int key0 = 128 * step;
#pragma unroll
        for (int i = 0; i < 2; ++i) { kr[i] = *(const u32x4*)(kg[i] + (size_t)key0 * U2W); vr[i] = *(const u32x4*)(vg[i] + key0); } };
    gload(st0);
#pragma unroll 1
    for (int st = st0; st < st1; ++st) {
        const int buf = st & 1;
        LAS unsigned char* kb = lds + buf * SK_KB; LAS unsigned char* vb = lds + SK_VOFF + buf * SK_VB;
#pragma unroll
        for (int i = 0; i < 2; ++i) { *(LAS u32x4*)(kb + kl[i]) = kr[i]; *(LAS u32x2*)(vb + vl[i]) = (u32x2){vr[i].x, vr[i].y}; *(LAS u32x2*)(vb + vl[i] + 8) = (u32x2){vr[i].z, vr[i].w}; }
        __syncthreads();
        if (st + 1 < st1) gload(st + 1);
#pragma unroll
        for (int h = 0; h < 2; ++h) { const int j = 2 * st + h;
            bool sel = (j >= jlo) && (j <= qblk);
            if (MODE == 0) sel = sel && selmask_test(smask + tl * 8, j);
            if (__any(sel)) { const int key0 = 64 * j; const bool diag = (j == qblk), first = (MODE == 1) && (j == qblk - 8);
                auto mask = [&](int u, int r) { const int key = key0 + 32 * u + crow(r, hi); return sel && (!diag || key <= t) && (!first || key > t - 512); };
                att_step64<4, SK_KP, SK_VP>(kb + h * 64 * SK_KP * 2, vb + h * 128, qf, o, m_run, l_run, scale2, MODE == 0 || diag || first, mask, col, hi); } }
    }
    const float l = l_run + __shfl_xor(l_run, 32); const float inv = l > 0.f ? 1.0f / l : 0.f;
    if (MODE == 1) {
#pragma unroll
        for (int b = 0; b < 2; ++b)
#pragma unroll
            for (int i = 0; i < 4; ++i) store4_bf16(OWIN + (size_t)t * 512 + head * 64 + 32 * b + 8 * i + 4 * hi, (f32x4){o[b][4 * i] * inv, o[b][4 * i + 1] * inv, o[b][4 * i + 2] * inv, o[b][4 * i + 3] * inv});
    } else {
        const bf16* gp = U2 + (size_t)t * U2W + U2_G + head * 3;
        const float s0 = sigmoidf_(bf2f(gp[0])), s1 = sigmoidf_(bf2f(gp[1])) * inv, s2g = sigmoidf_(bf2f(gp[2]));
#pragma unroll
        for (int b = 0; b < 2; ++b)
#pragma unroll
            for (int i = 0; i < 4; ++i) { const int dv = 32 * b + 8 * i + 4 * hi; const size_t off = (size_t)t * 512 + head * 64 + dv; const u32x2 oc = *(const u32x2*)(OCMP + off), ow = *(const u32x2*)(OWIN + off);
                f32x4 r; r[0] = s0 * bflo(oc.x) + s1 * o[b][4 * i] + s2g * bflo(ow.x); r[1] = s0 * bfhi(oc.x) + s1 * o[b][4 * i + 1] + s2g * bfhi(ow.x);
                r[2] = s0 * bflo(oc.y) + s1 * o[b][4 * i + 2] + s2g * bflo(ow.y); r[3] = s0 * bfhi(oc.y) + s1 * o[b][4 * i + 3] + s2g * bfhi(ow.y);
                store4_bf16(ABR + (size_t)t * D + head * 64 + dv, r); }
    }
}

__device__ __forceinline__ void cmp_unit(LAS unsigned char* lds, const bf16* U2, const bf16* KC, const bf16* VCT, bf16* OCMP, float* SC, int g, int qblk, int tid, int wave, int lane) {
    const int col = lane & 31, hi = lane >> 5;
    const int tl = 8 * wave + (col >> 2), t = 64 * qblk + tl, head = 4 * g + (col & 3);
    __syncthreads();
    bf16x8 qf[4];
    { const bf16* qp = U2 + (size_t)t * U2W + U2_Q + head * 64;
#pragma unroll
      for (int s = 0; s < 4; ++s) qf[s] = *(const bf16x8*)(qp + 16 * s + 8 * hi); }
    f32x16 o[2];
#pragma unroll
    for (int b = 0; b < 2; ++b)
#pragma unroll
        for (int r = 0; r < 16; ++r) o[b][r] = 0.f;
    float m_run = -INFINITY, l_run = 0.f;
    const float scale2 = 0.125f * LOG2E;
    const int nst = (4 * qblk + 3 + 127) >> 7;
    const int twmax = 64 * qblk + 8 * wave + 7; const int cw = (twmax >= 31) ? ((twmax - 31) >> 4) : -1;
    const int call = (64 * qblk >= 31) ? ((64 * qblk - 31) >> 4) : -1;
    const bf16* kg[2]; unsigned kl[2]; const bf16* vg[2]; unsigned vl[2];
#pragma unroll
    for (int i = 0; i < 2; ++i) { const int c = tid + 512 * i; { const int row = c >> 3, p = c & 7; kg[i] = KC + (size_t)(g * 1024 + row) * 64 + 8 * p; kl[i] = (unsigned)(row * SK_KP + 8 * p) * 2u; }
        { const int row = c >> 4, p = c & 15; vg[i] = VCT + (size_t)(g * 64 + row) * 1024 + 8 * p; vl[i] = (unsigned)(row * SK_VP + 8 * p) * 2u; } }
    u32x4 kr[2], vr[2];
#pragma unroll
    for (int i = 0; i < 2; ++i) { kr[i] = *(const u32x4*)kg[i]; vr[i] = *(const u32x4*)vg[i]; }
#pragma unroll 1
    for (int st = 0; st < nst; ++st) {
        const int buf = st & 1;
        LAS unsigned char* kb = lds + buf * SK_KB; LAS unsigned char* vb = lds + SK_VOFF + buf * SK_VB;
#pragma unroll
        for (int i = 0; i < 2; ++i) { *(LAS u32x4*)(kb + kl[i]) = kr[i]; *(LAS u32x2*)(vb + vl[i]) = (u32x2){vr[i].x, vr[i].y}; *(LAS u32x2*)(vb + vl[i] + 8) = (u32x2){vr[i].z, vr[i].w}; }
        __syncthreads();
        if (st + 1 < nst) {
#pragma unroll
            for (int i = 0; i < 2; ++i) { kr[i] = *(const u32x4*)(kg[i] + (size_t)128 * (st + 1) * 64); vr[i] = *(const u32x4*)(vg[i] + 128 * (st + 1)); } }
#pragma unroll
        for (int h = 0; h < 2; ++h) { const int c0 = 128 * st + 64 * h;
            if (c0 <= cw) { auto mask = [&](int u, int r) { return 16 * (c0 + 32 * u + crow(r, hi)) + 31 <= t; };
                att_step64<4, SK_KP, SK_VP>(kb + h * 64 * SK_KP * 2, vb + h * 128, qf, o, m_run, l_run, scale2, c0 + 63 > call, mask, col, hi); } }
    }
    const float l = l_run + __shfl_xor(l_run, 32); const float inv = l > 0.f ? 1.0f / l : 0.f;
#pragma unroll
    for (int b = 0; b < 2; ++b)
#pragma unroll
        for (int i = 0; i < 4; ++i) store4_bf16(OCMP + (size_t)t * 512 + head * 64 + 32 * b + 8 * i + 4 * hi, (f32x4){o[b][4 * i] * inv, o[b][4 * i + 1] * inv, o[b][4 * i + 2] * inv, o[b][4 * i + 3] * inv});
    const float mref = (m_run == -INFINITY) ? 0.f : m_run;
    float* dst = SC + (size_t)(t * 2 + g) * 256;
    float carry = 0.f;
    __syncthreads();
#pragma unroll
    for (int i = 0; i < 2; ++i) kr[i] = *(const u32x4*)kg[i];
#pragma unroll 1
    for (int st = 0; st < nst; ++st) {
        const int buf = st & 1; LAS unsigned char* kb = lds + buf * SK_KB;
#pragma unroll
        for (int i = 0; i < 2; ++i) *(LAS u32x4*)(kb + kl[i]) = kr[i];
        __syncthreads();
        if (st + 1 < nst) {
#pragma unroll
            for (int i = 0; i < 2; ++i) kr[i] = *(const u32x4*)(kg[i] + (size_t)128 * (st + 1) * 64); }
#pragma unroll
        for (int q4 = 0; q4 < 4; ++q4) { const int T = 4 * st + q4; float sv[4];
            if (32 * T <= cw) {
                const LAS unsigned char* kt = kb + q4 * 32 * SK_KP * 2;
                f32x16 sacc;
#pragma unroll
                for (int r = 0; r < 16; ++r) sacc[r] = 0.f;
#pragma unroll
                for (int s = 0; s < 4; ++s) { const bf16x8 kf = *(const LAS bf16x8*)(kt + (col * SK_KP + 16 * s + 8 * hi) * 2); sacc = __builtin_amdgcn_mfma_f32_32x32x16_bf16(kf, qf[s], sacc, 0, 0, 0); }
                float Gs[4], Es[4];
#pragma unroll
                for (int i = 0; i < 4; ++i) { float p[4];
#pragma unroll
                    for (int q = 0; q < 4; ++q) { const int r = 4 * i + q; const int c = 32 * T + crow(r, hi); p[q] = (16 * c + 31 <= t) ? __builtin_amdgcn_exp2f(sacc[r] * scale2 - mref) * inv : 0.f; }
                    Gs[i] = (p[0] + p[1]) + (p[2] + p[3]); Es[i] = p[3]; }
#pragma unroll
                for (int i = 0; i < 4; ++i) { Gs[i] += lane_xor1(Gs[i]); Gs[i] += lane_xor2(Gs[i]); Es[i] += lane_xor1(Es[i]); Es[i] += lane_xor2(Es[i]); }
                float eo[4];
#pragma unroll
                for (int i = 0; i < 4; ++i) eo[i] = lane_xor32(Es[i], hi);
                if (hi) { sv[0] = Gs[0] + eo[0]; sv[1] = Gs[1] + eo[1]; sv[2] = Gs[2] + eo[2]; sv[3] = Gs[3] + eo[3]; }
                else { sv[0] = Gs[0] + carry; sv[1] = Gs[1] + eo[0]; sv[2] = Gs[2] + eo[1]; sv[3] = Gs[3] + eo[2]; }
                carry = eo[3];
            } else { sv[0] = hi ? 0.f : carry; sv[1] = 0.f; sv[2] = 0.f; sv[3] = 0.f; carry = 0.f; }
            if ((col & 3) == 0) {
#pragma unroll
                for (int i = 0; i < 4; ++i) dst[8 * T + 2 * i + hi] = sv[i]; } }
    }
#pragma unroll 1
    for (int T = 4 * nst; T < 32; ++T) {
        if ((col & 3) == 0) { dst[8 * T + hi] = (hi || T != 4 * nst) ? 0.f : carry; dst[8 * T + 2 + hi] = 0.f; dst[8 * T + 4 + hi] = 0.f; dst[8 * T + 6 + hi] = 0.f; } }
}

struct Sel16 { bf16x8 qf[2]; f32x4 o[4]; float m_run, l_run; };
template <int VP, class MaskF>
__device__ __forceinline__ void att16_block(const LAS unsigned char* kb, const LAS unsigned char* vb, Sel16& st, float scale2, const MaskF& mask, int c16, int G) {
    bf16x8 kf[4][2]; u32x2 vlo[2][4], vhi[2][4];
#pragma unroll
    for (int kt = 0; kt < 4; ++kt) { const LAS unsigned char* kp = kb + ((16 * kt + c16) * SK_KP + 8 * G) * 2; kf[kt][0] = *(const LAS bf16x8*)kp; kf[kt][1] = *(const LAS bf16x8*)(kp + 64); }
#pragma unroll
    for (int u = 0; u < 2; ++u)
#pragma unroll
        for (int d = 0; d < 4; ++d) { const LAS unsigned char* vp = vb + ((16 * d + c16) * VP + 32 * u + 4 * G) * 2; vlo[u][d] = *(const LAS u32x2*)vp; vhi[u][d] = *(const LAS u32x2*)(vp + 32); }
    __builtin_amdgcn_sched_barrier(0);
    f32x4 acc[4];
#pragma unroll
    for (int kt = 0; kt < 4; ++kt) acc[kt] = __builtin_amdgcn_mfma_f32_16x16x32_bf16(kf[kt][0], st.qf[0], (f32x4){0.f, 0.f, 0.f, 0.f}, 0, 0, 0);
#pragma unroll
    for (int kt = 0; kt < 4; ++kt) acc[kt] = __builtin_amdgcn_mfma_f32_16x16x32_bf16(kf[kt][1], st.qf[1], acc[kt], 0, 0, 0);
    float mt = -INFINITY;
#pragma unroll
    for (int kt = 0; kt < 4; ++kt)
#pragma unroll
        for (int i = 0; i < 4; ++i) { const float x = mask(16 * kt + 4 * G + i) ? acc[kt][i] * scale2 : -INFINITY; acc[kt][i] = x; mt = fmaxf(mt, x); }
    mt = xmax32(xmax16(mt));
    const float m_new = fmaxf(st.m_run, mt); const float mref = (m_new == -INFINITY) ? 0.f : m_new;
    if (__any(m_new != st.m_run)) { const float corr = __builtin_amdgcn_exp2f(st.m_run - mref); st.l_run *= corr; st.m_run = m_new;
#pragma unroll
        for (int d = 0; d < 4; ++d) st.o[d] = st.o[d] * corr; }
    float ps = 0.f;
#pragma unroll
    for (int kt = 0; kt < 4; ++kt)
#pragma unroll
        for (int i = 0; i < 4; ++i) { acc[kt][i] = __builtin_amdgcn_exp2f(acc[kt][i] - mref); ps += acc[kt][i]; }
    st.l_run += ps;
#pragma unroll
    for (int u = 0; u < 2; ++u) {
        const bf16x8 pf = __builtin_bit_cast(bf16x8, (u32x4){cvt_pk_bf16(acc[2 * u][0], acc[2 * u][1]), cvt_pk_bf16(acc[2 * u][2], acc[2 * u][3]), cvt_pk_bf16(acc[2 * u + 1][0], acc[2 * u + 1][1]), cvt_pk_bf16(acc[2 * u + 1][2], acc[2 * u + 1][3])});
#pragma unroll
        for (int d = 0; d < 4; ++d) st.o[d] = __builtin_amdgcn_mfma_f32_16x16x32_bf16(__builtin_bit_cast(bf16x8, (u32x4){vlo[u][d].x, vlo[u][d].y, vhi[u][d].x, vhi[u][d].y}), pf, st.o[d], 0, 0, 0); }
}
constexpr int S16_NB = 4;
constexpr int S16_VP = S16_NB * 64 + 4;
constexpr int S16_KB = S16_NB * 64 * SK_KP * 2, S16_VB = 64 * S16_VP * 2, S16_VOFF = 2 * S16_KB, S16_MOFF = S16_VOFF + 2 * S16_VB;
static_assert(S16_MOFF + 2048 <= LDS_BYTES - 1536, "sel16 LDS map");
__device__ __forceinline__ void sel_unit16(LAS unsigned char* lds, const bf16* U2, const bf16* VTS, const unsigned* SM, const bf16* OCMP, const bf16* OWIN, bf16* ABR, int g, int qblk, int tid, int wave, int lane) {
    const int c16 = lane & 15, G = lane >> 4;
    const int head = 4 * g + (c16 & 3);
    LAS unsigned* smask = (LAS unsigned*)(lds + S16_MOFF);
    __syncthreads();
    smask[tid] = SM[(size_t)((64 * qblk + (tid >> 3)) * 2 + g) * 8 + (tid & 7)];
    Sel16 grp[2]; int tlg[2];
#pragma unroll
    for (int gi = 0; gi < 2; ++gi) { tlg[gi] = 8 * wave + 4 * gi + (c16 >> 2); const bf16* qp = U2 + (size_t)(64 * qblk + tlg[gi]) * U2W + U2_Q + head * 64 + 8 * G;
        grp[gi].qf[0] = *(const bf16x8*)qp; grp[gi].qf[1] = *(const bf16x8*)(qp + 32); grp[gi].m_run = -INFINITY; grp[gi].l_run = 0.f;
#pragma unroll
        for (int d = 0; d < 4; ++d) grp[gi].o[d] = (f32x4){0.f, 0.f, 0.f, 0.f}; }
    const float scale2 = 0.125f * LOG2E;
    const int st1 = qblk / S16_NB + 1;
    const bf16* Kb = U2 + U2_KV + (2 * 2 + g) * 64; const bf16* Vb = VTS + (size_t)(g * 64) * S;
    u32x4 kr[4], vr[4];
    auto gload = [&](int step) { int key0 = 64 * S16_NB * step; if (key0 + 64 * S16_NB > S) key0 = S - 64 * S16_NB;
        const bf16* kp = Kb + (size_t)key0 * U2W; const bf16* vp = Vb + key0; int t_ = tid; asm volatile("" : "+v"(t_));
#pragma unroll
        for (int i = 0; i < 4; ++i) { const int c = t_ + 512 * i; kr[i] = *(const u32x4*)(kp + (unsigned)((c >> 3) * U2W + 8 * (c & 7))); vr[i] = *(const u32x4*)(vp + (unsigned)((c >> 5) * S + 8 * (c & 31))); } };
    gload(0);
#pragma unroll 1
    for (int st = 0; st < st1; ++st) {
        const int buf = st & 1;
        LAS unsigned char* kb = lds + buf * S16_KB; LAS unsigned char* vb = lds + S16_VOFF + buf * S16_VB;
        { int t_ = tid; asm volatile("" : "+v"(t_));
#pragma unroll
          for (int i = 0; i < 4; ++i) { const int c = t_ + 512 * i; const unsigned kl_ = (unsigned)((c >> 3) * SK_KP + 8 * (c & 7)) * 2u, vl_ = (unsigned)((c >> 5) * S16_VP + 8 * (c & 31)) * 2u;
              *(LAS u32x4*)(kb + kl_) = kr[i]; *(LAS u32x2*)(vb + vl_) = (u32x2){vr[i].x, vr[i].y}; *(LAS u32x2*)(vb + vl_ + 8) = (u32x2){vr[i].z, vr[i].w}; } }
        __syncthreads();
        if (st + 1 < st1) gload(st + 1);
#pragma unroll
        for (int h = 0; h < S16_NB; ++h) { const int j = S16_NB * st + h;
            if (j <= qblk) {
#pragma unroll
                for (int gi = 0; gi < 2; ++gi) { const bool sel = selmask_test(smask + tlg[gi] * 8, j);
                    if (__any(sel)) { const int t = 64 * qblk + tlg[gi]; const int key0 = 64 * j; const bool diag = (j == qblk);
                        auto mask = [&](int k) { return sel && (!diag || key0 + k <= t); };
                        att16_block<S16_VP>(kb + h * 64 * SK_KP * 2, vb + h * 128, grp[gi], scale2, mask, c16, G); } } } }
    }
#pragma unroll
    for (int gi = 0; gi < 2; ++gi) { const int t = 64 * qblk + tlg[gi];
        float l = grp[gi].l_run; l += __shfl_xor(l, 16); l += __shfl_xor(l, 32); const float inv = l > 0.f ? 1.0f / l : 0.f;
        const bf16* gp = U2 + (size_t)t * U2W + U2_G + head * 3;
        const float s0 = sigmoidf_(bf2f(gp[0])), s1 = sigmoidf_(bf2f(gp[1])) * inv, s2g = sigmoidf_(bf2f(gp[2]));
#pragma unroll
        for (int d = 0; d < 4; ++d) { const int dv = 16 * d + 4 * G; const size_t off = (size_t)t * 512 + head * 64 + dv; const u32x2 oc = *(const u32x2*)(OCMP + off), ow = *(const u32x2*)(OWIN + off);
            f32x4 r; r[0] = s0 * bflo(oc.x) + s1 * grp[gi].o[d][0] + s2g * bflo(ow.x); r[1] = s0 * bfhi(oc.x) + s1 * grp[gi].o[d][1] + s2g * bfhi(ow.x);
            r[2] = s0 * bflo(oc.y) + s1 * grp[gi].o[d][2] + s2g * bflo(ow.y); r[3] = s0 * bfhi(oc.y) + s1 * grp[gi].o[d][3] + s2g * bfhi(ow.y);
            store4_bf16(ABR + (size_t)t * D + head * 64 + dv, r); } }
}

struct LP {
    unsigned char* ws; unsigned char* wl; int l;
    __device__ __forceinline__ bf16* w(size_t off) const { return (bf16*)(wl + off); }
    __device__ __forceinline__ bf16* b(size_t off) const { return (bf16*)(ws + off); }
    __device__ __forceinline__ float* f(size_t off) const { return (float*)(ws + off); }
    __device__ __forceinline__ int* i(size_t off) const { return (int*)(ws + off); }
};
#define INF32(a, idx, per) ((const float*)(a).in[idx] + (size_t)l * (per))

#ifndef BPARTS
#define BPARTS 31
#endif
#ifndef DUPSUB
#define DUPSUB 0
#endif
#define SUBREP(bit) for (int srep_ = 0; srep_ < 1 + ((DUPSUB >> (bit)) & 1); ++srep_)
__device__ __forceinline__ void phase_prep(const Args& a, Frame& F, const LP& P) {
    const int l = P.l, lane = F.lane, tid = F.tid;
    const bf16* U2 = P.b(WS_U2); bf16* ABR = P.b(WS_ABR);
    if (BPARTS & 1) { const float* cw = INF32(a, 17, 31 * 512); const float* cb = INF32(a, 18, 512); const float* lg = INF32(a, 19, 512); const float* lb = INF32(a, 20, 512);
      LAS bf16* hb = (LAS bf16*)F.lds;
      LAS float* cs = (LAS float*)(F.lds + 65536);
      const int c = tid;
      float w[31];
#pragma unroll
      for (int k = 0; k < 31; ++k) w[k] = cw[k * 512 + c];
      const float bias = cb[c];
#pragma unroll 1
      for (int tile = blockIdx.x; tile < S / 32; tile += F.G) { const int t0 = tile * 32;
          { u32x4 av[8], gv[8];
#pragma unroll
            for (int i = 0; i < 8; ++i) { const int item = tid + 512 * i, r = item >> 6, ch = (item & 63) * 8; int tok = t0 - 30 + r; tok = tok < 0 ? 0 : tok;
                const bf16* up = U2 + (size_t)tok * U2W + U2_CONV + ch;
                if (r < 62) { av[i] = *(const u32x4*)up; gv[i] = *(const u32x4*)(up + 512); } else { av[i] = (u32x4){0u, 0u, 0u, 0u}; gv[i] = av[i]; } }
#pragma unroll
            for (int i = 0; i < 8; ++i) { const int item = tid + 512 * i, r = item >> 6, ch = (item & 63) * 8; const bool ok = (t0 - 30 + r) >= 0;
                u32x4 o;
#pragma unroll
                for (int q = 0; q < 4; ++q) { const float h0 = bflo(av[i][q]) * sigmoidf_(bflo(gv[i][q])), h1 = bfhi(av[i][q]) * sigmoidf_(bfhi(gv[i][q])); o[q] = ok ? cvt_pk_bf16(h0, h1) : 0u; }
                if (r < 62) *(LAS u32x4*)(hb + r * 512 + ch) = o; } }
          __syncthreads();
          float hreg[62];
#pragma unroll
          for (int r = 0; r < 62; ++r) hreg[r] = bf2f(hb[r * 512 + c]);
#pragma unroll
          for (int i = 0; i < 32; ++i) { float acc = bias;
#pragma unroll
              for (int k = 0; k < 31; ++k) acc += w[k] * hreg[i + k];
              cs[i * 512 + c] = acc; }
          __syncthreads();
#pragma unroll
          for (int q = 0; q < 4; ++q) { const int tt = 4 * F.wave + q; float v[8]; float s = 0.f;
#pragma unroll
              for (int j = 0; j < 8; ++j) { v[j] = cs[tt * 512 + lane + 64 * j]; s += v[j]; }
              const float mean = wave_sum(s) * (1.0f / 512.0f); float qq = 0.f;
#pragma unroll
              for (int j = 0; j < 8; ++j) { v[j] -= mean; qq += v[j] * v[j]; }
              const float rstd = 1.0f / sqrtf(wave_sum(qq) * (1.0f / 512.0f) + 1e-5f);
#pragma unroll
              for (int j = 0; j < 8; ++j) { const int ch = lane + 64 * j; const float y = v[j] * rstd * lg[ch] + lb[ch]; ABR[(size_t)(t0 + tt) * D + 1536 + ch] = f2bf(y * sigmoidf_(y)); } }
          __syncthreads(); } }
    if (BPARTS & 2) { float* rq = P.f(WS_RSTD); float* rkv = rq + S;
      const int sub = lane >> 4, l16 = lane & 15;
#pragma unroll 1
      for (int t0 = 4 * F.gw; t0 < S; t0 += 4 * F.NGW) { const int t = t0 + sub; const bf16* row = U2 + (size_t)t * U2W;
          const u32x4 a0 = *(const u32x4*)(row + U2_CQ + 8 * l16), a1 = *(const u32x4*)(row + U2_CQ + 8 * l16 + 128), a2 = *(const u32x4*)(row + U2_CQ + 8 * l16 + 256), a3 = *(const u32x4*)(row + U2_CQ + 8 * l16 + 384);
          const u32x4 c0 = *(const u32x4*)(row + U2_CKV + 8 * l16), c1 = *(const u32x4*)(row + U2_CKV + 8 * l16 + 128);
          float s = 0.f, s2 = 0.f;
#pragma unroll
          for (int q = 0; q < 4; ++q) { float x; x = bflo(a0[q]); s += x * x; x = bfhi(a0[q]); s += x * x; x = bflo(a1[q]); s += x * x; x = bfhi(a1[q]); s += x * x;
              x = bflo(a2[q]); s += x * x; x = bfhi(a2[q]); s += x * x; x = bflo(a3[q]); s += x * x; x = bfhi(a3[q]); s += x * x;
              x = bflo(c0[q]); s2 += x * x; x = bfhi(c0[q]); s2 += x * x; x = bflo(c1[q]); s2 += x * x; x = bfhi(c1[q]); s2 += x * x; }
#pragma unroll
          for (int o = 0; o < 1; ++o) { s = row16_sum(s); s2 = row16_sum(s2); }
          if (l16 == 0) { rq[t] = 1.0f / sqrtf(s * (1.0f / 512.0f) + 1e-6f); rkv[t] = 1.0f / sqrtf(s2 * (1.0f / 256.0f) + 1e-6f); } }
#pragma unroll 1
      for (int r0 = 8 * F.gw; r0 < S; r0 += 8 * F.NGW) { const int w = 2 << (lane >> 4); const bf16* col = U2 + U2_POOL + 8 * lane;
          float sum[8];
#pragma unroll
          for (int q = 0; q < 8; ++q) sum[q] = 0.f;
          for (int i = 1; i < w; ++i) { const int tt = r0 - i; if (tt >= 0) { const u32x4 v = *(const u32x4*)(col + (size_t)tt * U2W);
#pragma unroll
              for (int q = 0; q < 4; ++q) { sum[2 * q] += bflo(v[q]); sum[2 * q + 1] += bfhi(v[q]); } } }
#pragma unroll
          for (int k = 0; k < 8; ++k) { const int t = r0 + k; const u32x4 v = *(const u32x4*)(col + (size_t)t * U2W);
              const int to = t - w + 1; u32x4 vo = (u32x4){0u, 0u, 0u, 0u}; if (to >= 0) vo = *(const u32x4*)(col + (size_t)to * U2W);
              const int cnt = (t + 1 < w) ? (t + 1) : w; const float ic = 1.0f / (float)cnt; u32x4 o;
#pragma unroll
              for (int q = 0; q < 4; ++q) { sum[2 * q] += bflo(v[q]); sum[2 * q + 1] += bfhi(v[q]);
                  o[q] = cvt_pk_bf16(sum[2 * q] * ic - bflo(v[q]), sum[2 * q + 1] * ic - bfhi(v[q]));
                  sum[2 * q] -= bflo(vo[q]); sum[2 * q + 1] -= bfhi(vo[q]); }
              *(u32x4*)(ABR + (size_t)t * D + 512 + 8 * lane) = o; } } }
    if (BPARTS & 4) { LAS bf16* scr = (LAS bf16*)(F.lds + 65536 + F.wave * 8448);
#pragma unroll 1
      for (int it = F.gw; it < 2 * 2 * (S / 64); it += F.NGW) { const int tt = it % (S / 64), g = (it / (S / 64)) & 1, which = it / (2 * (S / 64));
          const bf16* src = U2 + (size_t)(tt * 64) * U2W + U2_KV + ((which ? 5 : 3) * 2 + g) * 64;
          bf16* dst = P.b(which ? WS_VTWIN : WS_VTSEL) + (size_t)(g * 64) * S + tt * 64;
          transpose_tile64(src, U2W, dst, S, scr, lane); } }
    if (BPARTS & 8) { bf16* HID = P.b(WS_HID); const float* b1c = (const float*)(P.wl + WO_B1C);
#pragma unroll 1
      for (int it = F.gw; it < 4 * 64 * 8; it += F.NGW) { const int nt = it & 7, mt = (it >> 3) & 63, jg = it >> 9, j = jg >> 1, g = jg & 1;
          const bf16* Ab = U2 + U2_KV + (j * 2 + g) * 64; const bf16* Bb = P.w(WO_W1C) + (size_t)j * 128 * 2048;
          auto ap = [&](int r, int k) { int n = 16 * mt + r; n = n > 1022 ? 1022 : n; return Ab + (size_t)(16 * n + (k >> 6)) * U2W + (k & 63); };
          auto bp = [&](int r, int k) { return Bb + (size_t)(16 * nt + r) * 2048 + k; };
          const f32x4 acc = sgemm16(ap, bp, 2048, lane);
          const int h = 16 * nt + (lane & 15); const float bb = b1c[j * 128 + h];
#pragma unroll
          for (int i = 0; i < 4; ++i) { const int n = 16 * mt + 4 * (lane >> 4) + i; HID[((size_t)jg * 1024 + n) * 128 + h] = f2bf(gelu_tanh(acc[i] + bb)); } } }
}
__device__ __forceinline__ void memkv_items(const LP& P, int first, int nw, int lane) {
    const int l = P.l; const bf16* MEMB = P.b(WS_MEMB); bf16* KX = P.b(WS_KX) + (size_t)l * 256 * 512; bf16* VXT = P.b(WS_VXT) + (size_t)l * 512 * 256;
#pragma unroll 1
    for (int it = first; it < 1024; it += nw) {
        if (it < 512) { const int mt = it >> 5, nt = it & 31;
            auto ap = [&](int r, int k) { return MEMB + (size_t)(16 * mt + r) * D + k; };
            auto bp = [&](int r, int k) { return P.w(WO_WXK) + (size_t)(16 * nt + r) * D + k; };
            const f32x4 acc = sgemm16(ap, bp, D, lane);
#pragma unroll
            for (int i = 0; i < 4; ++i) KX[(size_t)(16 * mt + 4 * (lane >> 4) + i) * 512 + 16 * nt + (lane & 15)] = f2bf(acc[i]);
        } else { const int q = it - 512, mt = q >> 4, nt = q & 15;
            auto ap = [&](int r, int k) { return P.w(WO_WXV) + (size_t)(16 * mt + r) * D + k; };
            auto bp = [&](int r, int k) { return MEMB + (size_t)(16 * nt + r) * D + k; };
            const f32x4 acc = sgemm16(ap, bp, D, lane);
#pragma unroll
            for (int i = 0; i < 4; ++i) VXT[(size_t)(16 * mt + 4 * (lane >> 4) + i) * 256 + 16 * nt + (lane & 15)] = f2bf(acc[i]); } }
}

__device__ __forceinline__ void phase_compress2(Frame& F, const LP& P) {
    const int lane = F.lane; const bf16* HID = P.b(WS_HID); const bf16* W2 = P.w(WO_W2C);
#pragma unroll 1
    for (int it = F.gw; it < 1024; it += F.NGW) {
        if (it < 512) { const int nt = it & 3, mt = (it >> 2) & 63, g = it >> 8;
            auto ap = [&](int r, int k) { return HID + ((size_t)(0 * 2 + g) * 1024 + 16 * mt + r) * 128 + k; };
            auto bp = [&](int r, int k) { return W2 + (size_t)(16 * nt + r) * 128 + k; };
            const f32x4 acc = sgemm16(ap, bp, 128, lane);
#pragma unroll
            for (int i = 0; i < 4; ++i) P.b(WS_KC)[((size_t)g * 1024 + 16 * mt + 4 * (lane >> 4) + i) * 64 + 16 * nt + (lane & 15)] = f2bf(acc[i]);
        } else { const int q = it - 512, nt = q & 63, mt = (q >> 6) & 3, g = q >> 8;
            auto ap = [&](int r, int k) { return W2 + (size_t)64 * 128 + (size_t)(16 * mt + r) * 128 + k; };
            auto bp = [&](int r, int k) { return HID + ((size_t)(1 * 2 + g) * 1024 + 16 * nt + r) * 128 + k; };
            const f32x4 acc = sgemm16(ap, bp, 128, lane);
#pragma unroll
            for (int i = 0; i < 4; ++i) P.b(WS_VCT)[((size_t)g * 64 + 16 * mt + 4 * (lane >> 4) + i) * 1024 + 16 * nt + (lane & 15)] = f2bf(acc[i]); } }
}

__device__ __forceinline__ void phase_d(Frame& F, const LP& P) {
    const int lane = F.lane;
    { const bf16* KVH = P.b(WS_KVH); const bf16* U2 = P.b(WS_U2); bf16* KR = P.b(WS_KM); const f32x2* rope = (const f32x2*)(P.ws + WS_ROPE);
#pragma unroll 1
      for (int i = F.gw * 64 + lane; i < S * 8; i += F.NGW * 64) { const int t = i >> 3, k = 2 * (i & 7);
          const bf16* kr = U2 + (size_t)t * U2W + U2_KR;
          const unsigned a = *(const unsigned*)(kr + k), b = *(const unsigned*)(kr + 16 + k); const f32x4 cs = *(const f32x4*)(rope + (size_t)t * 16 + k);
          const float x10 = bflo(a), x11 = bfhi(a), x20 = bflo(b), x21 = bfhi(b);
          *(unsigned*)(KR + (size_t)t * 32 + k) = cvt_pk_bf16(x10 * cs[0] - x20 * cs[1], x11 * cs[2] - x21 * cs[3]);
          *(unsigned*)(KR + (size_t)t * 32 + 16 + k) = cvt_pk_bf16(x20 * cs[0] + x10 * cs[1], x21 * cs[2] + x11 * cs[3]); }
      LAS bf16* scr = (LAS bf16*)(F.lds + F.wave * 8448);
#pragma unroll 1
      for (int it = F.gw; it < 8 * (S / 64); it += F.NGW) { const int tt = it % (S / 64), hd = it / (S / 64);
          transpose_tile64(KVH + (size_t)(tt * 64) * 1024 + hd * 128 + 64, 1024, P.b(WS_VTM) + (size_t)(hd * 64) * S + tt * 64, S, scr, lane); } }
    __syncthreads();
    SUBREP(3)
#pragma unroll 1
    for (int i = blockIdx.x; i < 512; i += F.G) { const int r = i >> 8, p = i & 255; const int qb = r ? 255 - (p >> 1) : (p >> 1);
        cmp_unit(F.lds, P.b(WS_U2), P.b(WS_KC), P.b(WS_VCT), P.b(WS_OCMP), P.f(WS_SCORES), p & 1, qb, F.tid, F.wave, lane); }
}


constexpr int MK_KP = 104, MK_VP = 132;
constexpr int MK_KB = 128 * MK_KP * 2, MK_VB = 64 * MK_VP * 2, MK_VOFF = 2 * MK_KB;
__device__ __forceinline__ void mla_unit(LAS unsigned char* lds, const bf16* Q, const bf16* KVH, const bf16* KR, const bf16* Vt, bf16* O, int hd, int qb, int tid, int wave, int lane) {
    const int col = lane & 31, hi = lane >> 5;
    const int q0 = qb * 256 + wave * 32;
    bf16x8 qf[6];
    { const bf16* qp = Q + (size_t)(q0 + col) * 768 + hd * 96;
#pragma unroll
      for (int s = 0; s < 6; ++s) qf[s] = *(const bf16x8*)(qp + 16 * s + 8 * hi); }
    f32x16 o[2];
#pragma unroll
    for (int b = 0; b < 2; ++b)
#pragma unroll
        for (int r = 0; r < 16; ++r) o[b][r] = 0.f;
    float m_run = -INFINITY, l_run = 0.f;
    const int nt = 2 * (qb + 1);
    const bf16* kg[3]; unsigned kl[3]; int kst[3]; const bf16* vg[2]; unsigned vl[2];
#pragma unroll
    for (int i = 0; i < 3; ++i) { const int c = tid + 512 * i, row = c / 12, p = c % 12; const bool nope = p < 8; kst[i] = nope ? 1024 : 32;
        kg[i] = nope ? KVH + (size_t)row * 1024 + hd * 128 + 8 * p : KR + (size_t)row * 32 + 8 * (p - 8); kl[i] = (unsigned)(row * MK_KP + 8 * p) * 2u; }
#pragma unroll
    for (int i = 0; i < 2; ++i) { const int c = tid + 512 * i, row = c >> 4, p = c & 15; vg[i] = Vt + (size_t)(hd * 64 + row) * S + 8 * p; vl[i] = (unsigned)(row * MK_VP + 8 * p) * 2u; }
    u32x4 kr[3], vr[2];
#pragma unroll
    for (int i = 0; i < 3; ++i) kr[i] = *(const u32x4*)kg[i];
#pragma unroll
    for (int i = 0; i < 2; ++i) vr[i] = *(const u32x4*)vg[i];
#pragma unroll 1
    for (int t = 0; t < nt; ++t) {
        const int buf = t & 1; const int key0 = 128 * t;
        LAS unsigned char* kb = lds + buf * MK_KB; LAS unsigned char* vb = lds + MK_VOFF + buf * MK_VB;
#pragma unroll
        for (int i = 0; i < 3; ++i) *(LAS u32x4*)(kb + kl[i]) = kr[i];
#pragma unroll
        for (int i = 0; i < 2; ++i) { *(LAS u32x2*)(vb + vl[i]) = (u32x2){vr[i].x, vr[i].y}; *(LAS u32x2*)(vb + vl[i] + 8) = (u32x2){vr[i].z, vr[i].w}; }
        __syncthreads();
        if (t + 1 < nt) {
#pragma unroll
            for (int i = 0; i < 3; ++i) kr[i] = *(const u32x4*)(kg[i] + (size_t)(key0 + 128) * kst[i]);
#pragma unroll
            for (int i = 0; i < 2; ++i) vr[i] = *(const u32x4*)(vg[i] + key0 + 128); }
#pragma unroll
        for (int h = 0; h < 2; ++h) { const int k0h = key0 + 64 * h;
            if (k0h <= q0 + 31) { auto mask = [&](int u, int r) { return k0h + 32 * u + crow(r, hi) <= q0 + col; };
                att_step64<6, MK_KP, MK_VP>(kb + h * 64 * MK_KP * 2, vb + h * 128, qf, o, m_run, l_run, 1.0f, k0h + 63 > q0, mask, col, hi); } }
    }
    const float l = l_run + __shfl_xor(l_run, 32); const float inv = l > 0.f ? 1.0f / l : 0.f;
    bf16* op = O + (size_t)(q0 + col) * D + 1024 + hd * 64;
#pragma unroll
    for (int b = 0; b < 2; ++b)
#pragma unroll
        for (int i = 0; i < 4; ++i) store4_bf16(op + 32 * b + 8 * i + 4 * hi, (f32x4){o[b][4 * i] * inv, o[b][4 * i + 1] * inv, o[b][4 * i + 2] * inv, o[b][4 * i + 3] * inv});
}

#define MLA_SB __builtin_amdgcn_sched_barrier(0)
template <bool HAS_NEXT, bool FINISH = true>
__device__ __forceinline__ void mla_stage1(const LAS unsigned char* kbn, const bf16x8 (&qf)[6], f32x16& cur, f32x16& nxt, bf16x8 (&pf)[2], float mref, float& l_run, int col, int hi) {
    const LAS unsigned char* kp0 = kbn + (col * MK_KP + 8 * hi) * 2;
    bf16x8 kf[6];
    if (HAS_NEXT) {
#pragma unroll
        for (int c = 0; c < 6; ++c) kf[c] = *(const LAS bf16x8*)(kp0 + 32 * c); }
    float ps = 0.f;
    MLA_SB;
#pragma unroll
    for (int c = 0; c < 6; ++c) {
        const int e0 = (16 * c + 5) / 6, e1 = (16 * (c + 1) + 5) / 6;
        if (FINISH) {
#pragma unroll
            for (int r = e0; r < e1; ++r) { const float pe = __builtin_amdgcn_exp2f(cur[r] - mref); cur[r] = pe; ps += pe; }
            asm volatile("" : "+v"(ps));
            if (c == 3) pf[0] = __builtin_bit_cast(bf16x8, (u32x4){cvt_pk_bf16(cur[0], cur[1]), cvt_pk_bf16(cur[2], cur[3]), cvt_pk_bf16(cur[4], cur[5]), cvt_pk_bf16(cur[6], cur[7])}); }
        if (HAS_NEXT) {
            if (c == 0) { f32x16 z;
#pragma unroll
                for (int r = 0; r < 16; ++r) z[r] = 0.f;
                nxt = __builtin_amdgcn_mfma_f32_32x32x16_bf16(kf[0], qf[0], z, 0, 0, 0); }
            else nxt = __builtin_amdgcn_mfma_f32_32x32x16_bf16(kf[c], qf[c], nxt, 0, 0, 0);
            asm volatile("" : "+v"(nxt)); }
        MLA_SB; }
    if (FINISH) pf[1] = __builtin_bit_cast(bf16x8, (u32x4){cvt_pk_bf16(cur[8], cur[9]), cvt_pk_bf16(cur[10], cur[11]), cvt_pk_bf16(cur[12], cur[13]), cvt_pk_bf16(cur[14], cur[15])});
    l_run += ps;
}
template <bool DO_PV, bool HAS_NEXT>
__device__ __forceinline__ void mla_stage2(const LAS unsigned char* vbc, const bf16x8 (&pf)[2], f32x16 (&o)[2], f32x16& nxt, float& m_run, float& l_run, float& mref, bool use_mask, int kn0, int qcol, int col, int hi) {
    const LAS unsigned char* vp0 = vbc + (col * MK_VP + 4 * hi) * 2; const LAS unsigned char* vp1 = vp0 + 32 * MK_VP * 2;
    u32x2 al[2], ah[2], bl[2], bh[2];
    if (DO_PV) {
#pragma unroll
        for (int c = 0; c < 2; ++c) { al[c] = *(const LAS u32x2*)(vp0 + 32 * c); ah[c] = *(const LAS u32x2*)(vp0 + 32 * c + 16); bl[c] = *(const LAS u32x2*)(vp1 + 32 * c); bh[c] = *(const LAS u32x2*)(vp1 + 32 * c + 16); } }
    if (HAS_NEXT && use_mask) {
        const int lim = qcol - kn0 - 4 * hi;
#pragma unroll
        for (int r = 0; r < 16; ++r) nxt[r] = ((r & 3) + 8 * (r >> 2) > lim) ? -INFINITY : nxt[r]; }
    float mt = -INFINITY;
    MLA_SB;
#pragma unroll
    for (int c = 0; c < 2; ++c) {
        if (HAS_NEXT) {
#pragma unroll
            for (int r = 8 * c; r < 8 * c + 8; ++r) mt = fmaxf(mt, nxt[r]);
            asm volatile("" : "+v"(mt)); }
        if (DO_PV) {
            o[0] = __builtin_amdgcn_mfma_f32_32x32x16_bf16(__builtin_bit_cast(bf16x8, (u32x4){al[c].x, al[c].y, ah[c].x, ah[c].y}), pf[c], o[0], 0, 0, 0);
            o[1] = __builtin_amdgcn_mfma_f32_32x32x16_bf16(__builtin_bit_cast(bf16x8, (u32x4){bl[c].x, bl[c].y, bh[c].x, bh[c].y}), pf[c], o[1], 0, 0, 0); }
        MLA_SB; }
    if (HAS_NEXT) {
        mt = xmax32(mt);
        const float m_new = fmaxf(m_run, mt); const float mr = (m_new == -INFINITY) ? 0.f : m_new;
        if (__any(m_new != m_run)) { const float corr = __builtin_amdgcn_exp2f(m_run - mr); l_run *= corr; m_run = m_new;
#pragma unroll
            for (int b = 0; b < 2; ++b)
#pragma unroll
                for (int r = 0; r < 16; ++r) o[b][r] *= corr; }
        mref = mr; }
}
__device__ __forceinline__ void mla_unit_p(LAS unsigned char* lds, const bf16* Q, const bf16* KVH, const bf16* KR, const bf16* Vt, bf16* O, int hd, int qb, int tid, int wave, int lane) {
    const int col = lane & 31, hi = lane >> 5;
    const int q0 = qb * 256 + wave * 32, qcol = q0 + col;
    bf16x8 qf[6];
    { const bf16* qp = Q + (size_t)(q0 + col) * 768 + hd * 96;
#pragma unroll
      for (int s = 0; s < 6; ++s) qf[s] = *(const bf16x8*)(qp + 16 * s + 8 * hi); }
    f32x16 o[2];
#pragma unroll
    for (int b = 0; b < 2; ++b)
#pragma unroll
        for (int r = 0; r < 16; ++r) o[b][r] = 0.f;
    float m_run = -INFINITY, l_run = 0.f, mref = 0.f;
    const int ns = 2 * (qb + 1);
    const bf16* kg[3]; unsigned kl[3]; int kst[3]; const bf16* vg[2]; unsigned vl[2];
#pragma unroll
    for (int i = 0; i < 3; ++i) { const int c = tid + 512 * i, row = c / 12, p = c % 12; const bool nope = p < 8; kst[i] = nope ? 1024 : 32;
        kg[i] = nope ? KVH + (size_t)row * 1024 + hd * 128 + 8 * p : KR + (size_t)row * 32 + 8 * (p - 8); kl[i] = (unsigned)(row * MK_KP + 8 * p) * 2u; }
#pragma unroll
    for (int i = 0; i < 2; ++i) { const int c = tid + 512 * i, row = c >> 4, p = c & 15; vg[i] = Vt + (size_t)(hd * 64 + row) * S + 8 * p; vl[i] = (unsigned)(row * MK_VP + 8 * p) * 2u; }
    u32x4 kr[3], vr[2];
    auto gload = [&](int step) { const int key0 = 128 * step;
#pragma unroll
        for (int i = 0; i < 3; ++i) kr[i] = *(const u32x4*)(kg[i] + (size_t)key0 * kst[i]);
#pragma unroll
        for (int i = 0; i < 2; ++i) vr[i] = *(const u32x4*)(vg[i] + key0); };
    auto lwrite = [&](int buf) { LAS unsigned char* kb = lds + buf * MK_KB; LAS unsigned char* vb = lds + MK_VOFF + buf * MK_VB;
#pragma unroll
        for (int i = 0; i < 3; ++i) *(LAS u32x4*)(kb + kl[i]) = kr[i];
#pragma unroll
        for (int i = 0; i < 2; ++i) { *(LAS u32x2*)(vb + vl[i]) = (u32x2){vr[i].x, vr[i].y}; *(LAS u32x2*)(vb + vl[i] + 8) = (u32x2){vr[i].z, vr[i].w}; } };
    gload(0); lwrite(0); gload(1);
    __syncthreads();
    f32x16 sA, sB; bf16x8 pf[2];
    pf[0] = __builtin_bit_cast(bf16x8, (u32x4){0u, 0u, 0u, 0u}); pf[1] = pf[0];
    mla_stage1<true, false>(lds, qf, sB, sA, pf, 0.f, l_run, col, hi);
    mla_stage2<false, true>(lds, pf, o, sA, m_run, l_run, mref, 31 > q0, 0, qcol, col, hi);
#define MLA_TILE(CUR, NXT, KNEXT, VCUR, KN0) do { mla_stage1<true>(KNEXT, qf, CUR, NXT, pf, mref, l_run, col, hi); \
        mla_stage2<true, true>(VCUR, pf, o, NXT, m_run, l_run, mref, (KN0) + 31 > q0, KN0, qcol, col, hi); } while (0)
#pragma unroll 1
    for (int s = 0; s < ns; ++s) {
        const int buf = s & 1; const LAS unsigned char* kbs = lds + buf * MK_KB; const LAS unsigned char* vbs = lds + MK_VOFF + buf * MK_VB; const LAS unsigned char* kbn = lds + (buf ^ 1) * MK_KB;
        const int k0 = 128 * s;
        __syncthreads();
        if (s + 1 < ns) { lwrite(buf ^ 1); if (s + 2 < ns) gload(s + 2); }
        MLA_TILE(sA, sB, kbs + 32 * MK_KP * 2, vbs, k0 + 32);
        MLA_TILE(sB, sA, kbs + 64 * MK_KP * 2, vbs + 64, k0 + 64);
        MLA_TILE(sA, sB, kbs + 96 * MK_KP * 2, vbs + 128, k0 + 96);
        __syncthreads();
        if (s + 1 < ns) MLA_TILE(sB, sA, kbn, vbs + 192, k0 + 128);
        else { mla_stage1<false>(kbn, qf, sB, sA, pf, mref, l_run, col, hi); mla_stage2<true, false>(vbs + 192, pf, o, sA, m_run, l_run, mref, false, 0, qcol, col, hi); }
    }
#undef MLA_TILE
    const float l = l_run + __shfl_xor(l_run, 32); const float inv = l > 0.f ? 1.0f / l : 0.f;
    bf16* op = O + (size_t)(q0 + col) * D + 1024 + hd * 64;
#pragma unroll
    for (int b = 0; b < 2; ++b)
#pragma unroll
        for (int i = 0; i < 4; ++i) store4_bf16(op + 32 * b + 8 * i + 4 * hi, (f32x4){o[b][4 * i] * inv, o[b][4 * i + 1] * inv, o[b][4 * i + 2] * inv, o[b][4 * i + 3] * inv});
}

__device__ __forceinline__ void phase_e(Frame& F, const LP& P) {
    const int lane = F.lane;
    SUBREP(0)
#pragma unroll 1
    for (int i = blockIdx.x; i < 256; i += F.G) { const int hd = i & 7, p = i >> 3;
#pragma unroll 1
        for (int rep = 0; rep < 2; ++rep) mla_unit_p(F.lds, P.b(WS_QM), P.b(WS_KVH), P.b(WS_KM), P.b(WS_VTM), P.b(WS_ABR), hd, rep ? 63 - p : p, F.tid, F.wave, lane); }
    __syncthreads();
    SUBREP(1)
#pragma unroll 1
    for (int i = blockIdx.x; i < 512; i += F.G) sel_unit<1>(F.lds, P.b(WS_U2), P.b(WS_VTWIN), nullptr, nullptr, P.b(WS_OWIN), nullptr, i & 1, i >> 1, F.tid, F.wave, lane);
    __syncthreads();
    SUBREP(2)
#pragma unroll 1
    for (int u = F.gw; u < S * 2; u += F.NGW) { const int t = u >> 1;
        topk_unit(P.f(WS_SCORES) + (size_t)u * 256, t, (unsigned*)P.i(WS_IDX) + (size_t)u * 8, lane); }
}
__device__ __forceinline__ void phase_f(Frame& F, const LP& P) {
#pragma unroll 1
    for (int i = blockIdx.x; i < 256; i += F.G) { const int g = i & 1, p = i >> 1;
#pragma unroll 1
        for (int rep = 0; rep < 2; ++rep) sel_unit16(F.lds, P.b(WS_U2), P.b(WS_VTSEL), (const unsigned*)P.i(WS_IDX), P.b(WS_OCMP), P.b(WS_OWIN), P.b(WS_ABR), g, rep ? 255 - p : p, F.tid, F.wave, F.lane); }
}
constexpr int XK_KP = 136, XK_VP = 260, XK_VOFF = 256 * XK_KP * 2;
__device__ __forceinline__ void phase_xattn(Frame& F, const LP& P) {
    const int tid = F.tid, lane = F.lane, col = lane & 31, hi = lane >> 5;
    const bf16* KX = P.b(WS_KX) + (size_t)P.l * 256 * 512; const bf16* VXT = P.b(WS_VXT) + (size_t)P.l * 512 * 256;
    LAS unsigned char* kb = F.lds; LAS unsigned char* vb = F.lds + XK_VOFF;
#pragma unroll 1
    for (int unit = blockIdx.x; unit < 4 * (S / 256); unit += F.G) { const int hd = unit & 3, tb = unit >> 2;
        __syncthreads();
        { u32x4 kr[8], vr[8];
#pragma unroll
          for (int i = 0; i < 8; ++i) { const int c = tid + 512 * i; kr[i] = *(const u32x4*)(KX + (size_t)(c >> 4) * 512 + hd * 128 + 8 * (c & 15)); vr[i] = *(const u32x4*)(VXT + (size_t)(hd * 128 + (c >> 5)) * 256 + 8 * (c & 31)); }
#pragma unroll
          for (int i = 0; i < 8; ++i) { const int c = tid + 512 * i; *(LAS u32x4*)(kb + ((c >> 4) * XK_KP + 8 * (c & 15)) * 2) = kr[i];
              LAS unsigned char* vd = vb + ((c >> 5) * XK_VP + 8 * (c & 31)) * 2; *(LAS u32x2*)vd = (u32x2){vr[i].x, vr[i].y}; *(LAS u32x2*)(vd + 8) = (u32x2){vr[i].z, vr[i].w}; } }
        __syncthreads();
        const int q0 = tb * 256 + F.wave * 32;
        bf16x8 qf[8];
        { const bf16* qp = P.b(WS_QX) + (size_t)(q0 + col) * 512 + hd * 128;
#pragma unroll
          for (int s = 0; s < 8; ++s) qf[s] = *(const bf16x8*)(qp + 16 * s + 8 * hi); }
        f32x16 o[4];
#pragma unroll
        for (int b = 0; b < 4; ++b)
#pragma unroll
            for (int r = 0; r < 16; ++r) o[b][r] = 0.f;
        float m_run = -INFINITY, l_run = 0.f;
        auto mask = [&](int, int) { return true; };
#pragma unroll
        for (int st = 0; st < 4; ++st) att_step64n<8, XK_KP, XK_VP, 4>(kb + st * 64 * XK_KP * 2, vb + st * 128, qf, o, m_run, l_run, 1.0f, false, mask, col, hi);
        const float l = l_run + __shfl_xor(l_run, 32); const float inv = l > 0.f ? 1.0f / l : 0.f;
        bf16* op = P.b(WS_OX) + (size_t)(q0 + col) * 512 + hd * 128;
#pragma unroll
        for (int b = 0; b < 4; ++b)
#pragma unroll
            for (int i = 0; i < 4; ++i) store4_bf16(op + 32 * b + 8 * i + 4 * hi, (f32x4){o[b][4 * i] * inv, o[b][4 * i + 1] * inv, o[b][4 * i + 2] * inv, o[b][4 * i + 3] * inv}); }
}

__device__ __forceinline__ void phase_ln(const Args& a, Frame& F, const LP& P, int gi, int bi) {
    const int l = P.l; const float* g = INF32(a, gi, D); const float* b = INF32(a, bi, D);
    RowRaw na, nb;
    if (2 * F.gw < S) { row_fetch(na, P.b(WS_Y) + (size_t)(2 * F.gw) * D, F.lane); row_fetch(nb, P.b(WS_Y) + (size_t)(2 * F.gw + 1) * D, F.lane); }
#pragma unroll 1
    for (int r = 2 * F.gw; r < S; r += 2 * F.NGW) { Row ra, rb; row_unpack(ra, na); row_unpack(rb, nb);
        const int rn = r + 2 * F.NGW;
        if (rn < S) { row_fetch(na, P.b(WS_Y) + (size_t)rn * D, F.lane); row_fetch(nb, P.b(WS_Y) + (size_t)(rn + 1) * D, F.lane); }
        row_layernorm2(ra, rb, g, b, F.lane);
        row_store_bf16(ra, P.b(WS_XB) + (size_t)r * D, F.lane); row_store_bf16(rb, P.b(WS_XB) + (size_t)(r + 1) * D, F.lane); }
}
__device__ __forceinline__ void phase_ln_router(const Args& a, Frame& F, const LP& P) {
    const int l = P.l, lane = F.lane, wave = F.wave, tid = F.tid; const float* g = INF32(a, 29, D); const float* b = INF32(a, 30, D);
    const float* bg = INF32(a, 32, 4); const float* br = INF32(a, 34, 32);
    int* toke = (int*)(P.ws + WS_MOE + MO_TOKE); float* tokw = (float*)(P.ws + WS_MOE + MO_TOKW); int* tokr = (int*)(P.ws + WS_MOE + MO_TOKP);
    unsigned* cnt = (unsigned*)(P.ws + WS_CTL) + CW_CNT + 128 * l;
    LAS float* lgs = (LAS float*)F.lds; LAS unsigned* hist = (LAS unsigned*)(F.lds + 131072); LAS unsigned* gbase = (LAS unsigned*)(F.lds + 131072 + 128);
    constexpr int RP = 264; LAS unsigned char* sxh = F.lds; LAS unsigned char* sxl = sxh + 64 * RP * 2; LAS unsigned char* swh = sxl + 64 * RP * 2; LAS unsigned char* swl = swh + 48 * RP * 2;
    const bf16* WRT = P.w(WO_WRT);
#pragma unroll 1
    for (int base = 64 * blockIdx.x; base < S; base += 64 * F.G) {
        if (tid < 32) hist[tid] = 0u;
        RowRaw na, nb; row_fetch(na, P.b(WS_Y) + (size_t)(base + 8 * wave) * D, lane); row_fetch(nb, P.b(WS_Y) + (size_t)(base + 8 * wave + 1) * D, lane);
#pragma unroll 1
        for (int i = 0; i < 8; i += 2) { const int r = base + 8 * wave + i; Row ra, rb; row_unpack(ra, na); row_unpack(rb, nb);
            if (i + 2 < 8) { row_fetch(na, P.b(WS_Y) + (size_t)(r + 2) * D, lane); row_fetch(nb, P.b(WS_Y) + (size_t)(r + 3) * D, lane); }
            row_layernorm2(ra, rb, g, b, lane);
            row_store_hilo(ra, P.b(WS_XB) + (size_t)r * D, P.b(WS_XLO) + (size_t)r * D, lane); row_store_hilo(rb, P.b(WS_XB) + (size_t)(r + 1) * D, P.b(WS_XLO) + (size_t)(r + 1) * D, lane); }
        VM_WAIT(); __syncthreads();
        int e1 = 0, e2 = 0, r1 = 0, r2 = 0; float w1 = 0.f, w2 = 0.f;
        { const int tt = wave & 3, kh = wave >> 2;
            const int rr = lane & 15, Gq = lane >> 4;
            f32x4 acc[3];
#pragma unroll
            for (int n = 0; n < 3; ++n) acc[n] = (f32x4){0.f, 0.f, 0.f, 0.f};
            u32x4 stg[14];
            auto gld = [&](int ch) { const int k0 = 256 * ch;
#pragma unroll
                for (int i = 0; i < 14; ++i) { const int c = tid + 512 * (i < 4 ? i : i < 8 ? i - 4 : i < 11 ? i - 8 : i - 11), row = c >> 5, pc = c & 31;
                    const bf16* src = i < 4 ? P.b(WS_XB) + (size_t)(base + row) * D : i < 8 ? P.b(WS_XLO) + (size_t)(base + row) * D : i < 11 ? WRT + (size_t)row * 2048 : WRT + (size_t)(48 + row) * 2048;
                    stg[i] = *(const u32x4*)(src + k0 + 8 * pc); } };
            gld(0);
#pragma unroll 1
            for (int ch = 0; ch < 8; ++ch) {
#pragma unroll
                for (int i = 0; i < 14; ++i) { const int c = tid + 512 * (i < 4 ? i : i < 8 ? i - 4 : i < 11 ? i - 8 : i - 11), row = c >> 5, pc = c & 31;
                    LAS unsigned char* dstb = i < 4 ? sxh : i < 8 ? sxl : i < 11 ? swh : swl; *(LAS u32x4*)(dstb + (row * RP + 8 * pc) * 2) = stg[i]; }
                __syncthreads();
                if (ch + 1 < 8) gld(ch + 1);
#pragma unroll
                for (int ks = 0; ks < 4; ++ks) { const int ko = (32 * (4 * kh + ks) + 8 * Gq) * 2;
                    const bf16x8 ah = *(const LAS bf16x8*)(sxh + (16 * tt + rr) * RP * 2 + ko), al = *(const LAS bf16x8*)(sxl + (16 * tt + rr) * RP * 2 + ko);
#pragma unroll
                    for (int n = 0; n < 3; ++n) { const bf16x8 bh = *(const LAS bf16x8*)(swh + (16 * n + rr) * RP * 2 + ko), bl = *(const LAS bf16x8*)(swl + (16 * n + rr) * RP * 2 + ko);
                        acc[n] = __builtin_amdgcn_mfma_f32_16x16x32_bf16(ah, bh, acc[n], 0, 0, 0); acc[n] = __builtin_amdgcn_mfma_f32_16x16x32_bf16(al, bh, acc[n], 0, 0, 0); acc[n] = __builtin_amdgcn_mfma_f32_16x16x32_bf16(ah, bl, acc[n], 0, 0, 0); } }
                __syncthreads(); }
            LAS float* lp = lgs + (kh * 4 + tt) * 768;
#pragma unroll
            for (int n = 0; n < 3; ++n)
#pragma unroll
                for (int i = 0; i < 4; ++i) lp[(4 * Gq + i) * 48 + 16 * n + rr] = acc[n][i]; }
        LDS_WAIT(); __syncthreads();
        if (wave < 4) {
            LAS float* lw_ = lgs + wave * 768;
            if (lane < 16) {
                const LAS float* lg = lw_ + lane * 48; const LAS float* lg2 = lg + 4 * 768;
                float gl[4]; int gs = 0;
#pragma unroll
                for (int e = 0; e < 4; ++e) gl[e] = (lg[e] + lg2[e]) + bg[e];
                float gmax = gl[0];
#pragma unroll
                for (int e = 1; e < 4; ++e) { if (gl[e] > gmax) { gmax = gl[e]; gs = e; } }
                float gsum = 0.f;
#pragma unroll
                for (int e = 0; e < 4; ++e) gsum += __expf(gl[e] - gmax);
                const float gwt = 1.0f / gsum;
                float el[8];
#pragma unroll
                for (int e = 0; e < 8; ++e) el[e] = (lg[4 + 8 * gs + e] + lg2[4 + 8 * gs + e]) + br[gs * 8 + e];
                int i1 = 0; float m1 = el[0];
#pragma unroll
                for (int e = 1; e < 8; ++e) if (el[e] > m1) { m1 = el[e]; i1 = e; }
                int i2 = -1; float m2 = -INFINITY;
#pragma unroll
                for (int e = 0; e < 8; ++e) if (e != i1 && el[e] > m2) { m2 = el[e]; i2 = e; }
                const float rx = __expf(m2 - m1); const float p1 = 1.0f / (1.0f + rx), p2 = rx * p1;
                e1 = gs * 8 + i1; e2 = gs * 8 + i2; w1 = gwt * p1; w2 = gwt * p2;
                r1 = (int)__hip_atomic_fetch_add(hist + e1, 1u, __ATOMIC_RELAXED, __HIP_MEMORY_SCOPE_WORKGROUP);
                r2 = (int)__hip_atomic_fetch_add(hist + e2, 1u, __ATOMIC_RELAXED, __HIP_MEMORY_SCOPE_WORKGROUP);
            }
        }
        LDS_WAIT(); __syncthreads();
        if (tid < 32) { const unsigned h = hist[tid]; gbase[tid] = h ? atomicAdd(cnt + tid, h) : 0u; }
        LDS_WAIT(); __syncthreads();
        if (wave < 4 && lane < 16) { const int t = base + 16 * wave + lane;
            toke[2 * t] = e1; toke[2 * t + 1] = e2; tokw[2 * t] = w1; tokw[2 * t + 1] = w2; tokr[2 * t] = (int)gbase[e1] + r1; tokr[2 * t + 1] = (int)gbase[e2] + r2; }
        __syncthreads();
    }
}
__device__ __forceinline__ void phase_moe_assign(Frame& F, const LP& P) {
    const int lane = F.lane;
    unsigned* cnt = (unsigned*)(P.ws + WS_CTL) + CW_CNT + 128 * P.l;
    const unsigned c = lane < 32 ? __hip_atomic_load(cnt + lane, __ATOMIC_RELAXED, __HIP_MEMORY_SCOPE_AGENT) : 0u;
    const unsigned padded = (c + 255u) & ~255u;
    unsigned incl = padded;
#pragma unroll
    for (int o = 1; o < 32; o <<= 1) { const unsigned v = __shfl_up(incl, o); if ((lane & 31) >= o) incl += v; }
    const unsigned pstart = incl - padded;
    if (F.gw == 0) {
        int* tile_e = (int*)(P.ws + WS_MOE + MO_TILEE); int* ntp = (int*)(P.ws + WS_MOE + MO_NT);
        if (lane < 32) for (unsigned r = pstart; r < incl; r += 256) tile_e[r >> 8] = lane;
        const unsigned total = __shfl(incl, 31); if (lane == 0) *ntp = (int)(total >> 8);
    }
    const int* toke = (const int*)(P.ws + WS_MOE + MO_TOKE); const float* tokw = (const float*)(P.ws + WS_MOE + MO_TOKW);
    int* tokp = (int*)(P.ws + WS_MOE + MO_TOKP); float* roww = (float*)(P.ws + WS_MOE + MO_ROWW); int* rowtok = (int*)(P.ws + WS_MOE + MO_ROWTOK);
    if (F.gw < 32) {
        const unsigned lo = __shfl(pstart, F.gw) + __shfl(c, F.gw), hi_ = __shfl(incl, F.gw);
        for (unsigned r = lo + lane; r < hi_; r += 64) { rowtok[r] = 0; roww[r] = 0.f; } }
#pragma unroll 1
    for (int i = F.gw * 64 + lane; i < 2 * S; i += F.NGW * 64) { const int e = toke[i];
        unsigned ps = 0u;
#pragma unroll
        for (int q = 0; q < 32; ++q) { const unsigned v = __shfl(pstart, q); ps = (e == q) ? v : ps; }
        const unsigned pos = (unsigned)tokp[i] + ps;
        tokp[i] = (int)pos; roww[pos] = tokw[i]; rowtok[pos] = i >> 1; }
}
__device__ __forceinline__ void phase_moe_combine(const Args& a, Frame& F, const LP& P, bool last) {
    const int l = P.l; const float* g = INF32(a, 37, D); const float* b = INF32(a, 38, D); const int* tokp = (const int*)(P.ws + WS_MOE + MO_TOKP);
    const int step = 2 * F.NGW; const int r0 = 2 * F.gw;
    RowRaw xa, xb_, ya0, ya1, yb0, yb1; int4 pn = {0, 0, 0, 0};
    if (r0 < S) { const int4 p = *(const int4*)(tokp + 2 * r0);
        row_fetch(xa, P.b(WS_XB) + (size_t)r0 * D, F.lane); row_fetch(xb_, P.b(WS_XB) + (size_t)(r0 + 1) * D, F.lane);
        row_fetch(ya0, P.b(WS_Y2) + (size_t)p.x * D, F.lane); row_fetch(yb0, P.b(WS_Y2) + (size_t)p.z * D, F.lane);
        row_fetch(ya1, P.b(WS_Y2) + (size_t)p.y * D, F.lane); row_fetch(yb1, P.b(WS_Y2) + (size_t)p.w * D, F.lane);
        if (r0 + step < S) pn = *(const int4*)(tokp + 2 * (r0 + step)); }
#pragma unroll 1
    for (int r = r0; r < S; r += step) { Row ra, rb;
        row_unpack(ra, xa); row_unpack(rb, xb_);
#pragma unroll
        for (int j = 0; j < 8; ++j) { ra.v[j] = ra.v[j] * DN_ALPHA; rb.v[j] = rb.v[j] * DN_ALPHA; }
        row_unpack_add(ra, ya0); row_unpack_add(rb, yb0); row_unpack_add(ra, ya1); row_unpack_add(rb, yb1);
        const int rn = r + step;
        if (rn < S) { const int4 p = pn;
            row_fetch(xa, P.b(WS_XB) + (size_t)rn * D, F.lane); row_fetch(xb_, P.b(WS_XB) + (size_t)(rn + 1) * D, F.lane);
            row_fetch(ya0, P.b(WS_Y2) + (size_t)p.x * D, F.lane); row_fetch(yb0, P.b(WS_Y2) + (size_t)p.z * D, F.lane);
            row_fetch(ya1, P.b(WS_Y2) + (size_t)p.y * D, F.lane); row_fetch(yb1, P.b(WS_Y2) + (size_t)p.w * D, F.lane);
            if (rn + step < S) pn = *(const int4*)(tokp + 2 * (rn + step)); }
        row_layernorm2(ra, rb, g, b, F.lane);
        if (last) { row_store_f32(ra, a.out + (size_t)r * D, F.lane); row_store_f32(rb, a.out + (size_t)(r + 1) * D, F.lane); }
        else { row_store_bf16(ra, P.b(WS_XB) + (size_t)r * D, F.lane); row_store_bf16(rb, P.b(WS_XB) + (size_t)(r + 1) * D, F.lane); } }
}

constexpr int NPH_LAYER = 17, NPHASES = 1 + DEPTH * NPH_LAYER;
__global__ void __launch_bounds__(NWAVES * 64, 2) mk_fwd(Args a) {
    extern __shared__ __attribute__((aligned(16))) unsigned char lds_raw[];
    Frame F;
    F.lds = (LAS unsigned char*)lds_raw;
    F.tid = threadIdx.x; F.lane = F.tid & 63; F.wave = __builtin_amdgcn_readfirstlane(F.tid >> 6);
    F.G = gridDim.x; F.gw = blockIdx.x * NWAVES + F.wave; F.NGW = F.G * NWAVES; F.ws = a.ws;
    volatile LAS unsigned* MISC = (volatile LAS unsigned*)(F.lds + MISC_OFF);
    if (F.tid < 32) MISC[F.tid] = 0u;
    __syncthreads();
    unsigned* ctl = (unsigned*)(a.ws + WS_CTL);
    XcdBarrier bar = xcd_barrier_post(ctl + CW_BAR + a.li * XCD_BAR_WORDS, MISC + 8);
    const int lo = a.ph_lo, hi = a.ph_hi;
#if defined(PHMASK)
#define IN(k) (((PHMASK >> (((k) == 0) ? 0 : (((k) - 1) % NPH_LAYER) + 1)) & 1) && lo <= (k) && (k) < hi)
#elif defined(PHSEL)
#define IN(k) ((((k) == 0) ? 0 : (((k) - 1) % NPH_LAYER) + 1) == PHSEL && lo <= (k) && (k) < hi)
#else
#define IN(k) (lo <= (k) && (k) < hi)
#endif
#define SEAM(k) do { if (IN((k) + 1)) xcd_barrier(bar); } while (0)
#ifdef DIAG_P1
#define STAMP(k) do { if (blockIdx.x == 0 && threadIdx.x == 0) ((volatile LAS unsigned long long*)(F.lds + MISC_OFF - 1024))[(k)] = wall_clock64(); } while (0)
#else
#define STAMP(k) do {} while (0)
#endif
#ifndef DUPMASK
#define DUPMASK 0
#endif
#define REPB(k) for (int rep_ = 0; rep_ < 1 + ((DUPMASK >> (k)) & 1); ++rep_) { if (rep_) xcd_barrier(bar);
#define REPE }
#define FRESH() do { int t_ = threadIdx.x; asm volatile("" : "+v"(t_)); F.tid = t_; F.lane = t_ & 63; F.wave = __builtin_amdgcn_readfirstlane(t_ >> 6); F.gw = blockIdx.x * NWAVES + F.wave; } while (0)
    const int G = F.G, bx = blockIdx.x;

    if (IN(0)) { FRESH(); STAMP(0); REPB(0) phase_prologue(a, F); REPE SEAM(0); }

    for (int l = 0; l < DEPTH; ++l) {
        LP P; P.ws = a.ws; P.wl = a.ws + WS_WL0 + (size_t)l * WS_WLSTRIDE; P.l = l;
        const int pb = 1 + NPH_LAYER * l;
        if (IN(pb + 0)) { FRESH(); STAMP(pb + 0); REPB(1) pg8::Gemm g{P.b(WS_XB), P.w(WO_WIN), D, D, D, nullptr}; pg8::StaticOrder so; so.init(S, NIN, G, bx);
            EpiIn E{P.b(WS_GATE), P.b(WS_U2), (const float*)(P.wl + WO_BIASP)}; pg8::gemm_phase(F.lds, g, so, E);
            { const int nun = (S / 256) * (NIN / 256), rem = nun % G, nlight = rem ? G - rem : G;
              FRESH(); if (bx >= G - nlight) memkv_items(P, (bx - (G - nlight)) * NWAVES + F.wave, nlight * NWAVES, F.lane); }
            REPE SEAM(pb + 0); }
        if (IN(pb + 1)) { FRESH(); STAMP(pb + 1); REPB(2) phase_prep(a, F, P); REPE SEAM(pb + 1); }
        if (IN(pb + 2)) { FRESH(); STAMP(pb + 2); REPB(3)
            { pg8::Gemm g{P.b(WS_U2) + U2_CQ, P.w(WO_WUQ), U2W, 512, 512, nullptr}; pg8::StaticOrder so; so.init(S, 768, G, bx);
              EpiQM<WS_QM, WS_RSTD, WS_ROPE> E{P.ws}; pg8::gemm_phase(F.lds, g, so, E); }
            { pg8::Gemm g{P.b(WS_U2) + U2_CKV, P.w(WO_WUKV), U2W, 256, 256, nullptr}; pg8::StaticOrder so; so.init(S, 1024, G, bx);
              EpiScale E{P.b(WS_KVH), 1024, P.f(WS_RSTD) + S, 1.0f, 0}; pg8::gemm_phase(F.lds, g, so, E); }
            phase_compress2(F, P); REPE SEAM(pb + 2); }
        if (IN(pb + 3)) { FRESH(); STAMP(pb + 3); REPB(4) phase_d(F, P); REPE SEAM(pb + 3); }
        if (IN(pb + 4)) { FRESH(); STAMP(pb + 4); REPB(5) phase_e(F, P); REPE SEAM(pb + 4); }
        if (IN(pb + 5)) { FRESH(); STAMP(pb + 5); REPB(6) phase_f(F, P); REPE SEAM(pb + 5); }
        if (IN(pb + 6)) { FRESH(); STAMP(pb + 6); REPB(7) pg8::Gemm g{P.b(WS_ABR), P.w(WO_WBR), D, D, D, nullptr}; pg8::StaticOrder so; so.init(S, D, G, bx);
            EpiMerge E{P.b(WS_GATE), P.b(WS_MERGED)};
            for (int sk_ = 0; sk_ < ((bx >> 3) & 3); ++sk_) __builtin_amdgcn_s_sleep(100);
            pg8::gemm_phase(F.lds, g, so, E); REPE SEAM(pb + 6); }
        if (IN(pb + 7)) { FRESH(); STAMP(pb + 7); REPB(8) pg8::Gemm g{P.b(WS_MERGED), P.w(WO_WOUT), D, D, D, nullptr}; pg8::StaticOrder so; so.init(S, D, G, bx);
            EpiResid E{P.b(WS_XB), P.b(WS_Y)}; pg8::gemm_phase(F.lds, g, so, E); REPE SEAM(pb + 7); }
        if (IN(pb + 8)) { FRESH(); STAMP(pb + 8); REPB(9) phase_ln(a, F, P, 23, 24); REPE SEAM(pb + 8); }
        if (IN(pb + 9)) { FRESH(); STAMP(pb + 9); REPB(10) pg8::Gemm g{P.b(WS_XB), P.w(WO_WXQ), D, D, D, nullptr}; pg8::StaticOrder so; so.init(S, 512, G, bx);
            EpiScale E{P.b(WS_QX), 512, nullptr, 0.08838834764831845f * LOG2E, 0}; pg8::gemm_phase(F.lds, g, so, E); REPE SEAM(pb + 9); }
        if (IN(pb + 10)) { FRESH(); STAMP(pb + 10); REPB(11) phase_xattn(F, P); REPE SEAM(pb + 10); }
        if (IN(pb + 11)) { FRESH(); STAMP(pb + 11); REPB(12) pg8::Gemm g{P.b(WS_OX), P.w(WO_WXO), 512, 512, 512, nullptr}; pg8::StaticOrder so; so.init(S, D, G, bx);
            EpiResid E{P.b(WS_XB), P.b(WS_Y)}; pg8::gemm_phase(F.lds, g, so, E); REPE SEAM(pb + 11); }
        if (IN(pb + 12)) { FRESH(); STAMP(pb + 12); REPB(13) phase_ln_router(a, F, P); REPE SEAM(pb + 12); }
        if (IN(pb + 13)) { FRESH(); STAMP(pb + 13); REPB(14) phase_moe_assign(F, P); REPE SEAM(pb + 13); }
        if (IN(pb + 14)) { FRESH(); STAMP(pb + 14); REPB(15) const int* te = (const int*)(P.ws + WS_MOE + MO_TILEE); const int ntl = *(const int*)(P.ws + WS_MOE + MO_NT);
            pg8::Gemm g{P.b(WS_XB), P.w(WO_WEIN), D, D, D, (const int*)(P.ws + WS_MOE + MO_ROWTOK)}; pg8::GroupedGather so{te, ntl, 4, G, bx};
            EpiGlu E{P.b(WS_HS)}; pg8::gemm_phase(F.lds, g, so, E); REPE SEAM(pb + 14); }
        if (IN(pb + 15)) { FRESH(); STAMP(pb + 15); REPB(16) const int* te = (const int*)(P.ws + WS_MOE + MO_TILEE); const int ntl = *(const int*)(P.ws + WS_MOE + MO_NT);
            pg8::Gemm g{P.b(WS_HS), P.w(WO_WEOUT), 512, 512, 512, nullptr}; pg8::GroupedOrder so{te, ntl, 8, G, bx};
            EpiScale E{P.b(WS_Y2), D, (const float*)(P.ws + WS_MOE + MO_ROWW), 1.0f, 8}; pg8::gemm_phase(F.lds, g, so, E); REPE SEAM(pb + 15); }
        if (IN(pb + 16)) { FRESH(); STAMP(pb + 16); REPB(17) phase_moe_combine(a, F, P, l == DEPTH - 1); REPE SEAM(pb + 16); }
    }
#ifdef DIAG_P1
    STAMP(NPHASES);
    __syncthreads();
    if (blockIdx.x == 0) {
        volatile LAS unsigned long long* ts = (volatile LAS unsigned long long*)(F.lds + MISC_OFF - 1024);
        const float t1 = (float)(ts[DIAG_P1 + DIAG_N1] - ts[DIAG_P1]) * 0.01f, t2 = (float)(ts[DIAG_P2 + DIAG_N2] - ts[DIAG_P2]) * 0.01f;
        const float c1 = sqrtf(t1 * 0.1f);
        for (size_t i = threadIdx.x; i < (size_t)S * D; i += 512) a.out[i] = (i == 0) ? t2 : c1;
    }
#endif
#undef IN
#undef SEAM
}

#ifndef MK_PER_PHASE
#define MK_PER_PHASE 0
#endif
extern "C" void kernel_launch(void* const* d_in, const int* in_sizes, int n_in, void* d_out, int out_size, void* d_ws, size_t ws_size, hipStream_t stream) {
    static int grid = 0;
    if (grid == 0) {
        if (n_in != 39 || out_size != S * D || ws_size < WS_END) { fprintf(stderr, "kernel_launch: unexpected problem (n_in %d, out %d, ws %zu)\n", n_in, out_size, ws_size); grid = -1; return; }
        int dev = 0, cus = 0;
        if (hipGetDevice(&dev) != hipSuccess || hipDeviceGetAttribute(&cus, hipDeviceAttributeMultiprocessorCount, dev) != hipSuccess) { grid = -1; return; }
        if (hipFuncSetAttribute((const void*)mk_fwd, hipFuncAttributeMaxDynamicSharedMemorySize, LDS_BYTES) != hipSuccess) { fprintf(stderr, "kernel_launch: hipFuncSetAttribute failed\n"); grid = -1; return; }
        int per_cu = 0;
        if (hipOccupancyMaxActiveBlocksPerMultiprocessor(&per_cu, (const void*)mk_fwd, NWAVES * 64, LDS_BYTES) != hipSuccess || per_cu < 1) fprintf(stderr, "kernel_launch: occupancy query reports %d\n", per_cu);
        (void)hipGetLastError();
        grid = cus;
    }
    if (grid < 0) return;
    if (hipMemsetAsync((char*)d_ws + WS_CTL, 0, CTL_ZERO_BYTES, stream) != hipSuccess) return;
    Args a{};
    for (int i = 0; i < 39; ++i) a.in[i] = d_in[i];
    a.out = (float*)d_out; a.ws = (unsigned char*)d_ws; a.pad = 0;
#if MK_PER_PHASE
#ifndef MK_LAST
#define MK_LAST NPHASES
#endif
    for (int p = 0; p < MK_LAST; ++p) { a.ph_lo = p; a.ph_hi = p + 1; a.li = p; hipLaunchKernelGGL(mk_fwd, dim3(grid), dim3(NWAVES * 64), LDS_BYTES, stream, a); }
#else
    a.ph_lo = 0; a.ph_hi = NPHASES; a.li = 0;
    hipLaunchKernelGGL(mk_fwd, dim3(grid), dim3(NWAVES * 64), LDS_BYTES, stream, a);
#endif
}
```

```cpp
#include <hip/hip_runtime.h>
#include <cstdio>
#include <cstdint>

#define LAS __attribute__((address_space(3)))
#define GAS __attribute__((address_space(1)))
typedef unsigned short bf16;
typedef short bf16x8 __attribute__((ext_vector_type(8)));
typedef short s16x4 __attribute__((ext_vector_type(4)));
typedef float f32x2 __attribute__((ext_vector_type(2)));
typedef float f32x4 __attribute__((ext_vector_type(4)));
typedef float f32x16 __attribute__((ext_vector_type(16)));
typedef unsigned u32x2 __attribute__((ext_vector_type(2)));
typedef unsigned u32x4 __attribute__((ext_vector_type(4)));

constexpr int S = 16384, D = 2048, DEPTH = 2;
constexpr int IN_W = 11832;
constexpr int NIN = 12032;
constexpr int U2W = 3840;
constexpr int U2_Q = 0, U2_KV = 512, U2_POOL = 1280, U2_CQ = 1792, U2_CKV = 2304, U2_CONV = 2560, U2_G = 3584, U2_KR = 3616;
constexpr int NCMP = 1023;
constexpr int RMAX = 40960;
constexpr float DN_ALPHA = 1.4142135623730951f;
constexpr float LOG2E = 1.4426950408889634f;

typedef __bf16 bf16x2_t __attribute__((ext_vector_type(2)));
__device__ __forceinline__ unsigned cvt_pk_bf16(float lo, float hi) { const f32x2 v = {lo, hi}; const bf16x2_t b = __builtin_convertvector(v, bf16x2_t); return __builtin_bit_cast(unsigned, b); }
__device__ __forceinline__ float bf2f(unsigned short b) { return __uint_as_float(((unsigned)b) << 16); }
__device__ __forceinline__ float bflo(unsigned w) { return __uint_as_float(w << 16); }
__device__ __forceinline__ float bfhi(unsigned w) { return __uint_as_float(w & 0xffff0000u); }
__device__ __forceinline__ unsigned short f2bf(float f) { return (unsigned short)(cvt_pk_bf16(f, 0.f) & 0xffffu); }
template <int CTRL> __device__ __forceinline__ float dpp_f(float x) { return __uint_as_float((unsigned)__builtin_amdgcn_update_dpp(0, (int)__float_as_uint(x), CTRL, 0xF, 0xF, true)); }
__device__ __forceinline__ float lane_xor1(float x) { return dpp_f<0xB1>(x); }
__device__ __forceinline__ float lane_xor2(float x) { return dpp_f<0x4E>(x); }
__device__ __forceinline__ float row16_sum(float x) { x += dpp_f<0xB1>(x); x += dpp_f<0x4E>(x); x += dpp_f<0x141>(x); x += dpp_f<0x140>(x); return x; }
__device__ __forceinline__ float xsum16(float x) { const auto r = __builtin_amdgcn_permlane16_swap(__float_as_uint(x), __float_as_uint(x), false, false); return __uint_as_float(r[0]) + __uint_as_float(r[1]); }
__device__ __forceinline__ float xsum32(float x) { const auto r = __builtin_amdgcn_permlane32_swap(__float_as_uint(x), __float_as_uint(x), false, false); return __uint_as_float(r[0]) + __uint_as_float(r[1]); }
__device__ __forceinline__ float xmax16(float x) { const auto r = __builtin_amdgcn_permlane16_swap(__float_as_uint(x), __float_as_uint(x), false, false); return fmaxf(__uint_as_float(r[0]), __uint_as_float(r[1])); }
__device__ __forceinline__ float xmax32(float x) { const auto r = __builtin_amdgcn_permlane32_swap(__float_as_uint(x), __float_as_uint(x), false, false); return fmaxf(__uint_as_float(r[0]), __uint_as_float(r[1])); }
__device__ __forceinline__ float lane_xor32(float x, int hi) { const auto r = __builtin_amdgcn_permlane32_swap(__float_as_uint(x), __float_as_uint(x), false, false); return __uint_as_float(hi ? r[0] : r[1]); }
__device__ __forceinline__ float wave_sum(float v) { return xsum32(xsum16(row16_sum(v))); }
__device__ __forceinline__ float sigmoidf_(float x) { return 1.0f / (1.0f + __expf(-x)); }
#define LDS_WAIT() asm volatile("s_waitcnt lgkmcnt(0)" ::: "memory")
#define VM_WAIT() asm volatile("s_waitcnt vmcnt(0)" ::: "memory")

namespace pg8 {
constexpr int BM = 256, BK = 64, HALF = 128, HTB = HALF * BK * 2, STAGE_BYTES = 8 * HTB, NXCD = 8, WGM = 8;
__host__ __device__ __forceinline__ int lds_byte(int r, int c) { const int st = (r >> 4) * 2 + (c >> 5), rr = r & 15, cc = c & 31, ob = rr * 64 + cc * 2; return st * 1024 + (ob ^ (((ob >> 9) & 1) << 5)); }
__host__ __device__ __forceinline__ void stage_rc(int b, int& R, int& C) { const int st = b / 1024, sb = b % 1024, swz = sb ^ (((sb >> 9) & 1) << 5); R = (st >> 1) * 16 + swz / 64; C = (st & 1) * 32 + (swz % 64) / 2; }
__host__ __device__ __forceinline__ int perm32(int rho) { const int n = rho >> 4, i = rho & 15; return 8 * (i >> 2) + 4 * n + (i & 3); }

struct Unit { int pm, pn; };
struct Gemm { const bf16* A; const bf16* Bt; int lda, ldb, K; const int* rowtok; };

struct StaticOrder {
    static constexpr bool GATHER = false;
    int nM, nN, nwg, G, c;
    __device__ void init(int M, int N, int G_, int c_) { nM = M / BM; nN = N / BM; nwg = nM * nN; G = G_; c = c_; }
    __device__ bool next(int i, Unit& u) const {
        const long L = (long)i * G + c; if (L >= nwg) return false;
        int wgid = (int)L; { const int q = nwg / NXCD, r = nwg % NXCD, xcd = wgid % NXCD, off = wgid / NXCD; wgid = (xcd < r ? xcd * (q + 1) : r * (q + 1) + (xcd - r) * q) + off; }
        const int nig = WGM * nN, gid = wgid / nig, fm = gid * WGM, gsz = (nM - fm) < WGM ? (nM - fm) : WGM;
        u.pm = fm + ((wgid % nig) % gsz); u.pn = (wgid % nig) / gsz; return true;
    }
};
template <bool GATHER_> struct GroupedOrderT {
    static constexpr bool GATHER = GATHER_;
    const int* tile_expert; int ntiles, npn, G, c;
    __device__ bool next(int i, Unit& u) const {
        const long L = (long)i * G + c; if (L >= (long)ntiles * npn) return false;
        const int rt = (int)(L / npn), pn = (int)(L % npn);
        u.pm = rt; u.pn = __builtin_amdgcn_readfirstlane(tile_expert[rt]) * npn + pn; return true;
    }
};
typedef GroupedOrderT<false> GroupedOrder; typedef GroupedOrderT<true> GroupedGather;

template <class Epi, class Sched>
__device__ __forceinline__ void gemm_phase(LAS unsigned char* lds, const Gemm g, const Sched& S, const Epi& E) {
    int tid = threadIdx.x; asm volatile("" : "+v"(tid));
    const int wid = __builtin_amdgcn_readfirstlane(tid >> 6), lane = tid & 63, wr = wid >> 2, wc = wid & 3, fr = lane & 15, fq = lane >> 4;
    const int K = g.K, nt = K / BK;
    constexpr bool GATHER = Sched::GATHER;
    unsigned voffB[2], vAc[2][2], vAn[2][2]; int Rr[2], Cc[2];
#pragma unroll
    for (int i = 0; i < 2; ++i) { int R, C; stage_rc(tid * 16 + i * 8192, R, C); const int Rb = Epi::PERM ? ((R & ~31) + perm32(R & 31)) : R; Rr[i] = R; Cc[i] = C;
        voffB[i] = (unsigned)(Rb * g.ldb + C) * 2u;
#pragma unroll
        for (int h = 0; h < 2; ++h) { vAc[h][i] = (unsigned)((R + h * HALF) * g.lda + C) * 2u; vAn[h][i] = vAc[h][i]; } }
    const size_t kstep = (size_t)(BK * 2);
    const size_t hstepB = (size_t)HALF * g.ldb * 2;
    const size_t tstepA = (size_t)2 * HALF * g.lda * 2, tstepB = 2 * hstepB;
    const unsigned ldsw = (unsigned)wid * 1024u;
    const int aoff = lds_byte(wr * 64 + fr, fq * 8), boff = lds_byte(wc * 32 + fr, fq * 8);
#define PG8_GOFF(v, u) do { _Pragma("unroll") for (int _h = 0; _h < 2; ++_h) _Pragma("unroll") for (int _i = 0; _i < 2; ++_i) { \
        const int _t = g.rowtok[(u).pm * 256 + _h * HALF + Rr[_i]]; (v)[_h][_i] = (unsigned)(_t * g.lda + Cc[_i]) * 2u; } \
        _Pragma("unroll") for (int _h = 0; _h < 2; ++_h) _Pragma("unroll") for (int _i = 0; _i < 2; ++_i) asm volatile("" : "+v"((v)[_h][_i])); } while (0)
#define PG8_SA(b, h) (((b) * 2 + (h)) * HTB)
#define PG8_SB(b, h) ((4 + (b) * 2 + (h)) * HTB)
#define PG8_STAGE(bufoff, gbase, voff) do { _Pragma("unroll") for (int _i = 0; _i < 2; ++_i) \
        __builtin_amdgcn_global_load_lds((const unsigned*)((const char*)(gbase) + (voff)[_i]), (LAS unsigned*)(lds + (bufoff) + ldsw + _i * 8192), 16, 0, 0); } while (0)
#define PG8_LDA(dst, b, h) do { _Pragma("unroll") for (int m = 0; m < 4; ++m) _Pragma("unroll") for (int k = 0; k < 2; ++k) dst[m][k] = *(const LAS bf16x8*)(lds + PG8_SA(b, h) + aoff + m * 2048 + k * 1024); } while (0)
#define PG8_LDB(dst, b, h) do { _Pragma("unroll") for (int n = 0; n < 2; ++n) _Pragma("unroll") for (int k = 0; k < 2; ++k) dst[n][k] = *(const LAS bf16x8*)(lds + PG8_SB(b, h) + boff + n * 2048 + k * 1024); } while (0)
#define PG8_MMA(ai, bj, At, Bt) do { __builtin_amdgcn_s_setprio(1); _Pragma("unroll") for (int m = 0; m < 4; ++m) _Pragma("unroll") for (int n = 0; n < 2; ++n) _Pragma("unroll") for (int k = 0; k < 2; ++k) \
        acc[ai][bj][m][n] = __builtin_amdgcn_mfma_f32_16x16x32_bf16(Bt[n][k], At[m][k], acc[ai][bj][m][n], 0, 0, 0); __builtin_amdgcn_s_setprio(0); } while (0)
#define PG8_WAIT_V(n) asm volatile("s_waitcnt vmcnt(" #n ")" ::: "memory")
#define PG8_WAIT_L(n) asm volatile("s_waitcnt lgkmcnt(" #n ")" ::: "memory")
#define PG8_BAR __builtin_amdgcn_s_barrier()
#define PG8_SCHED __builtin_amdgcn_sched_barrier(0)
    Unit cur, nxt; int ui = 0;
    if (!S.next(0, cur)) return;
    f32x4 acc[2][2][4][2];
#pragma unroll
    for (int a = 0; a < 2; ++a)
#pragma unroll
        for (int b = 0; b < 2; ++b)
#pragma unroll
            for (int m = 0; m < 4; ++m)
#pragma unroll
                for (int n = 0; n < 2; ++n) acc[a][b][m][n] = (f32x4){0.f, 0.f, 0.f, 0.f};
    bf16x8 At[4][2], B0[2][2], B1[2][2];
    if constexpr (GATHER) PG8_GOFF(vAc, cur);
    const char* cA = (const char*)g.A + (GATHER ? (size_t)0 : (size_t)cur.pm * tstepA); const char* cB = (const char*)g.Bt + (size_t)cur.pn * tstepB;
    PG8_STAGE(PG8_SB(0, 0), cB, voffB); PG8_STAGE(PG8_SB(0, 1), cB + hstepB, voffB); PG8_STAGE(PG8_SA(0, 0), cA, vAc[0]); PG8_STAGE(PG8_SA(0, 1), cA, vAc[1]);
    if (wr == 1) PG8_BAR;
    PG8_WAIT_V(2); PG8_BAR;
    PG8_STAGE(PG8_SB(1, 0), cB + kstep, voffB); PG8_STAGE(PG8_SA(1, 0), cA + kstep, vAc[0]); PG8_STAGE(PG8_SB(1, 1), cB + hstepB + kstep, voffB);
    PG8_WAIT_V(6); PG8_BAR;
    for (;;) {
        const bool has_next = S.next(ui + 1, nxt);
        if constexpr (GATHER) { if (has_next) PG8_GOFF(vAn, nxt); }
        const char* nA = GATHER ? cA : (has_next ? (const char*)g.A + (size_t)nxt.pm * tstepA : cA); const char* nB = has_next ? (const char*)g.Bt + (size_t)nxt.pn * tstepB : cB;
        for (int t = 0; t < nt; t += 2) {
            const bool last = (t == nt - 2);
            const char* a1 = cA + (size_t)(t + 1) * kstep;
            const char* a2 = last ? nA : cA + (size_t)(t + 2) * kstep; const char* b2 = last ? nB : cB + (size_t)(t + 2) * kstep;
            const char* a3 = a2 + kstep; const char* b3 = b2 + kstep;
            unsigned v2[2][2];
#pragma unroll
            for (int h = 0; h < 2; ++h)
#pragma unroll
                for (int i = 0; i < 2; ++i) v2[h][i] = (GATHER && last && has_next) ? vAn[h][i] : vAc[h][i];
            if constexpr (Epi::MIDK > 0) { if (t > 0 && (t % Epi::MIDK) == 0) { if (wr == 0) PG8_BAR; PG8_SCHED; E.mid(acc, cur, t / Epi::MIDK, wr, wc, fr, fq); PG8_SCHED; if (wr == 1) PG8_BAR; } }
            PG8_LDB(B0, 0, 0); PG8_LDB(B1, 0, 1); PG8_SCHED; PG8_LDA(At, 0, 0); PG8_STAGE(PG8_SA(1, 1), a1, vAc[1]);
            PG8_WAIT_V(8); PG8_WAIT_L(0); PG8_BAR; PG8_MMA(0, 0, At, B0); PG8_MMA(0, 1, At, B1); PG8_BAR; PG8_SCHED;
            PG8_LDA(At, 0, 1); PG8_STAGE(PG8_SB(0, 0), b2, voffB); PG8_STAGE(PG8_SB(0, 1), b2 + hstepB, voffB); PG8_STAGE(PG8_SA(0, 0), a2, v2[0]);
            PG8_WAIT_V(8); PG8_WAIT_L(0); PG8_BAR; PG8_MMA(1, 0, At, B0); PG8_MMA(1, 1, At, B1); PG8_BAR; PG8_SCHED;
            PG8_LDB(B0, 1, 0); PG8_LDB(B1, 1, 1); PG8_SCHED; PG8_LDA(At, 1, 0); PG8_STAGE(PG8_SA(0, 1), a2, v2[1]);
            PG8_WAIT_V(8); PG8_WAIT_L(0); PG8_BAR; PG8_MMA(0, 0, At, B0); PG8_MMA(0, 1, At, B1); PG8_BAR; PG8_SCHED;
            PG8_LDA(At, 1, 1); PG8_STAGE(PG8_SB(1, 0), b3, voffB); PG8_STAGE(PG8_SB(1, 1), b3 + hstepB, voffB); PG8_STAGE(PG8_SA(1, 0), a3, v2[0]);
            PG8_WAIT_V(8); PG8_WAIT_L(0); PG8_BAR; PG8_MMA(1, 0, At, B0); PG8_MMA(1, 1, At, B1); PG8_BAR; PG8_SCHED;
        }
        if (wr == 0) PG8_BAR;
        E(acc, cur, wr, wc, fr, fq);
        if (!has_next) break;
#pragma unroll
        for (int a = 0; a < 2; ++a)
#pragma unroll
            for (int b = 0; b < 2; ++b)
#pragma unroll
                for (int m = 0; m < 4; ++m)
#pragma unroll
                    for (int n = 0; n < 2; ++n) acc[a][b][m][n] = (f32x4){0.f, 0.f, 0.f, 0.f};
        cur = nxt; cA = nA; cB = nB; ++ui;
        if constexpr (GATHER) {
#pragma unroll
            for (int h = 0; h < 2; ++h)
#pragma unroll
                for (int i = 0; i < 2; ++i) vAc[h][i] = vAn[h][i]; }
        if (wr == 1) PG8_BAR;
    }
    PG8_WAIT_V(0);
    PG8_BAR;
#undef PG8_GOFF
#undef PG8_SA
#undef PG8_SB
#undef PG8_STAGE
#undef PG8_LDA
#undef PG8_LDB
#undef PG8_MMA
#undef PG8_WAIT_V
#undef PG8_WAIT_L
#undef PG8_BAR
#undef PG8_SCHED
}
}

__device__ __forceinline__ float fast_sigmoid(float x) { return __builtin_amdgcn_rcpf(1.0f + __builtin_amdgcn_exp2f(-x * LOG2E)); }
__device__ __forceinline__ u32x4 pack8(const f32x4 v0, const f32x4 v1) { u32x4 w; w.x = cvt_pk_bf16(v0[0], v0[1]); w.y = cvt_pk_bf16(v0[2], v0[3]); w.z = cvt_pk_bf16(v1[0], v1[1]); w.w = cvt_pk_bf16(v1[2], v1[3]); return w; }

struct EpiIn {
    static constexpr bool PERM = true; static constexpr int MIDK = 0;
    bf16* gate; bf16* u2; const float* bias;
    __device__ __forceinline__ void operator()(const f32x4 (&acc)[2][2][4][2], const pg8::Unit& u, int wr, int wc, int fr, int fq) const {
        const int row0 = u.pm * 256 + wr * 64 + fr; const bool isg = u.pn < 32;
        bf16* base = isg ? gate : u2; const int ldc = isg ? 8192 : U2W; const int colt = isg ? u.pn * 256 : (u.pn - 32) * 256;
        const int col0 = colt + wc * 32 + 8 * fq, bcol0 = u.pn * 256 + wc * 32 + 8 * fq;
        f32x4 bv[2][2];
#pragma unroll
        for (int bj = 0; bj < 2; ++bj)
#pragma unroll
            for (int n = 0; n < 2; ++n) bv[bj][n] = *(const f32x4*)(bias + bcol0 + bj * 128 + 4 * n);
        const float qsc = (u.pn == 32 || u.pn == 33) ? 0.125f * LOG2E : 1.0f;
#pragma unroll
        for (int ai = 0; ai < 2; ++ai)
#pragma unroll
            for (int m = 0; m < 4; ++m) { bf16* rowp = base + (size_t)(row0 + ai * 128 + m * 16) * ldc + col0;
#pragma unroll
                for (int bj = 0; bj < 2; ++bj) { f32x4 v0 = (acc[ai][bj][m][0] + bv[bj][0]) * qsc, v1 = (acc[ai][bj][m][1] + bv[bj][1]) * qsc;
                    if (isg) {
#pragma unroll
                        for (int j = 0; j < 4; ++j) { v0[j] = fast_sigmoid(v0[j]); v1[j] = fast_sigmoid(v1[j]); } }
                    *(u32x4*)(rowp + bj * 128) = pack8(v0, v1); } }
    }
};
struct EpiScale {
    static constexpr bool PERM = true; static constexpr int MIDK = 0;
    bf16* O; int ldc; const float* rowscale; float cs; int npn_mod;
    __device__ __forceinline__ void operator()(const f32x4 (&acc)[2][2][4][2], const pg8::Unit& u, int wr, int wc, int fr, int fq) const {
        const int row0 = u.pm * 256 + wr * 64 + fr; const int pnl = npn_mod ? (u.pn % npn_mod) : u.pn;
        const int col0 = pnl * 256 + wc * 32 + 8 * fq;
#pragma unroll
        for (int ai = 0; ai < 2; ++ai)
#pragma unroll
            for (int m = 0; m < 4; ++m) { const int row = row0 + ai * 128 + m * 16; const float sc = (rowscale ? rowscale[row] : 1.0f) * cs;
                bf16* rowp = O + (size_t)row * ldc + col0;
#pragma unroll
                for (int bj = 0; bj < 2; ++bj) *(u32x4*)(rowp + bj * 128) = pack8(acc[ai][bj][m][0] * sc, acc[ai][bj][m][1] * sc); }
    }
};
template <size_t OFF_O, size_t OFF_RS, size_t OFF_ROPE>
struct EpiQM {
    static constexpr bool PERM = true; static constexpr int MIDK = 0;
    unsigned char* ws;
    __device__ __forceinline__ void operator()(const f32x4 (&acc)[2][2][4][2], const pg8::Unit& u, int wr, int wc, int fr, int fq) const {
        const int row0 = u.pm * 256 + wr * 64 + fr; const int col0 = u.pn * 256 + wc * 32 + 8 * fq;
        bf16* O = (bf16*)(ws + OFF_O); const float* rowscale = (const float*)(ws + OFF_RS); const f32x2* rope = (const f32x2*)(ws + OFF_ROPE);
        const float qs = 0.10206207261596577f * LOG2E;
#pragma unroll
        for (int ai = 0; ai < 2; ++ai)
#pragma unroll
            for (int m = 0; m < 4; ++m) { const int row = row0 + ai * 128 + m * 16; const float sc = rowscale[row] * qs;
                asm volatile("" ::: "memory");
                bf16* rowp = O + (size_t)row * 768 + col0;
#pragma unroll
                for (int bj = 0; bj < 2; ++bj) { f32x4 v0 = acc[ai][bj][m][0] * sc, v1 = acc[ai][bj][m][1] * sc;
                    if ((8 * u.pn + 4 * bj + wc) % 3 == 2) {
                        const f32x4* rp = (const f32x4*)(rope + (size_t)row * 16 + 8 * (fq & 1));
                        const float sg = fq < 2 ? -1.0f : 1.0f;
                        { const f32x4 c01 = rp[0], c23 = rp[1]; const float q0 = __shfl_xor(v0[0], 32), q1 = __shfl_xor(v0[1], 32), q2 = __shfl_xor(v0[2], 32), q3 = __shfl_xor(v0[3], 32);
                          v0[0] = v0[0] * c01[0] + sg * q0 * c01[1]; v0[1] = v0[1] * c01[2] + sg * q1 * c01[3]; v0[2] = v0[2] * c23[0] + sg * q2 * c23[1]; v0[3] = v0[3] * c23[2] + sg * q3 * c23[3]; }
                        asm volatile("" ::: "memory");
                        { const f32x4 c45 = rp[2], c67 = rp[3]; const float q0 = __shfl_xor(v1[0], 32), q1 = __shfl_xor(v1[1], 32), q2 = __shfl_xor(v1[2], 32), q3 = __shfl_xor(v1[3], 32);
                          v1[0] = v1[0] * c45[0] + sg * q0 * c45[1]; v1[1] = v1[1] * c45[2] + sg * q1 * c45[3]; v1[2] = v1[2] * c67[0] + sg * q2 * c67[1]; v1[3] = v1[3] * c67[2] + sg * q3 * c67[3]; } }
                    *(u32x4*)(rowp + bj * 128) = pack8(v0, v1); } }
    }
};
struct EpiGlu {
    static constexpr bool PERM = true; static constexpr int MIDK = 0;
    bf16* H;
    __device__ __forceinline__ void operator()(const f32x4 (&acc)[2][2][4][2], const pg8::Unit& u, int wr, int wc, int fr, int fq) const {
        const int row0 = u.pm * 256 + wr * 64 + fr; const int col0 = (u.pn & 3) * 128 + wc * 32 + 8 * fq;
#pragma unroll
        for (int ai = 0; ai < 2; ++ai)
#pragma unroll
            for (int m = 0; m < 4; ++m) { f32x4 o[2];
#pragma unroll
                for (int n = 0; n < 2; ++n)
#pragma unroll
                    for (int j = 0; j < 4; ++j) { const float a = acc[ai][0][m][n][j], b = acc[ai][1][m][n][j]; o[n][j] = a * fast_sigmoid(a) * b; }
                *(u32x4*)(H + (size_t)(row0 + ai * 128 + m * 16) * 512 + col0) = pack8(o[0], o[1]); }
    }
};
struct EpiResid {
    static constexpr bool PERM = true; static constexpr int MIDK = 0;
    const bf16* X; bf16* Y;
    __device__ __forceinline__ void operator()(const f32x4 (&acc)[2][2][4][2], const pg8::Unit& u, int wr, int wc, int fr, int fq) const {
        const int row0 = u.pm * 256 + wr * 64 + fr, col0 = u.pn * 256 + wc * 32 + 8 * fq;
#pragma unroll
        for (int ai = 0; ai < 2; ++ai)
#pragma unroll
            for (int m = 0; m < 4; ++m) { const size_t ro = (size_t)(row0 + ai * 128 + m * 16) * D + col0;
#pragma unroll
                for (int bj = 0; bj < 2; ++bj) { const u32x4 xv = *(const u32x4*)(X + ro + bj * 128); f32x4 v0, v1;
                    v0[0] = bflo(xv.x) * DN_ALPHA + acc[ai][bj][m][0][0]; v0[1] = bfhi(xv.x) * DN_ALPHA + acc[ai][bj][m][0][1]; v0[2] = bflo(xv.y) * DN_ALPHA + acc[ai][bj][m][0][2]; v0[3] = bfhi(xv.y) * DN_ALPHA + acc[ai][bj][m][0][3];
                    v1[0] = bflo(xv.z) * DN_ALPHA + acc[ai][bj][m][1][0]; v1[1] = bfhi(xv.z) * DN_ALPHA + acc[ai][bj][m][1][1]; v1[2] = bflo(xv.w) * DN_ALPHA + acc[ai][bj][m][1][2]; v1[3] = bfhi(xv.w) * DN_ALPHA + acc[ai][bj][m][1][3];
                    *(u32x4*)(Y + ro + bj * 128) = pack8(v0, v1); } }
    }
};
struct EpiMerge {
    static constexpr bool PERM = true; static constexpr int MIDK = 8;
    const bf16* gate; bf16* O;
    __device__ __forceinline__ void mid(f32x4 (&acc)[2][2][4][2], const pg8::Unit& u, int seg, int wr, int wc, int fr, int fq) const {
        int row0 = u.pm * 256 + wr * 64 + fr; const int col0 = u.pn * 256 + wc * 32 + 8 * fq; asm volatile("" : "+v"(row0));
#pragma unroll
        for (int ai = 0; ai < 2; ++ai)
#pragma unroll
            for (int m = 0; m < 4; ++m) { const bf16* gp = gate + (size_t)(row0 + ai * 128 + m * 16) * 8192 + (size_t)(seg - 1) * 2048 + col0;
#pragma unroll
                for (int bj = 0; bj < 2; ++bj) { const u32x4 a = *(const u32x4*)(gp + bj * 128), b = *(const u32x4*)(gp + 2048 + bj * 128);
#pragma unroll
                    for (int q = 0; q < 4; ++q) { const float r0 = fmaxf(bflo(a[q]), 1e-30f) * __builtin_amdgcn_rcpf(fmaxf(bflo(b[q]), 1e-30f)), r1 = fmaxf(bfhi(a[q]), 1e-30f) * __builtin_amdgcn_rcpf(fmaxf(bfhi(b[q]), 1e-30f));
                        acc[ai][bj][m][q >> 1][(q & 1) * 2] *= r0; acc[ai][bj][m][q >> 1][(q & 1) * 2 + 1] *= r1; } }
                asm volatile("" ::: "memory"); }
    }
    __device__ __forceinline__ void operator()(const f32x4 (&acc)[2][2][4][2], const pg8::Unit& u, int wr, int wc, int fr, int fq) const {
        const int row0 = u.pm * 256 + wr * 64 + fr, col0 = u.pn * 256 + wc * 32 + 8 * fq;
#pragma unroll
        for (int ai = 0; ai < 2; ++ai)
#pragma unroll
            for (int m = 0; m < 4; ++m) { const int row = row0 + ai * 128 + m * 16; const bf16* gp = gate + (size_t)row * 8192 + 3 * 2048 + col0;
#pragma unroll
                for (int bj = 0; bj < 2; ++bj) { const u32x4 a = *(const u32x4*)(gp + bj * 128); f32x4 v0, v1;
                    v0[0] = acc[ai][bj][m][0][0] * fmaxf(bflo(a[0]), 1e-30f); v0[1] = acc[ai][bj][m][0][1] * fmaxf(bfhi(a[0]), 1e-30f);
                    v0[2] = acc[ai][bj][m][0][2] * fmaxf(bflo(a[1]), 1e-30f); v0[3] = acc[ai][bj][m][0][3] * fmaxf(bfhi(a[1]), 1e-30f);
                    v1[0] = acc[ai][bj][m][1][0] * fmaxf(bflo(a[2]), 1e-30f); v1[1] = acc[ai][bj][m][1][1] * fmaxf(bfhi(a[2]), 1e-30f);
                    v1[2] = acc[ai][bj][m][1][2] * fmaxf(bflo(a[3]), 1e-30f); v1[3] = acc[ai][bj][m][1][3] * fmaxf(bfhi(a[3]), 1e-30f);
                    *(u32x4*)(O + (size_t)row * D + col0 + bj * 128) = pack8(v0, v1); } }
    }
};

#define XB_TMO      128
#define XB_XCNT(j)  (256  + 64 * (j))
#define XB_XSUB(j)  (1280 + 64 * (j))
#define XB_XGEN(j)  (2304 + 64 * (j))
#define XB_TOP      3328
#define XB_TOPGEN   3392
#define XCD_BAR_WORDS 3456
#define XB_SPIN_CAP (1u << 25)
__device__ __forceinline__ unsigned xb_ld(unsigned* p)              { return __hip_atomic_load(p, __ATOMIC_RELAXED, __HIP_MEMORY_SCOPE_AGENT); }
__device__ __forceinline__ unsigned xb_add(unsigned* p, unsigned v) { return __hip_atomic_fetch_add(p, v, __ATOMIC_RELAXED, __HIP_MEMORY_SCOPE_AGENT); }
__device__ __forceinline__ unsigned xb_xcc_id() { return (unsigned)__builtin_amdgcn_s_getreg((3 << 11) | 20) & 0xFu; }
#define XB_SPIN(cond, bar) do { unsigned _sp = 0; while (cond) { __builtin_amdgcn_s_sleep(1); \
    if ((++_sp & 255u) == 0u) { if (xb_ld(&(bar)[XB_TMO])) break; if (_sp > XB_SPIN_CAP) { atomicAdd(&(bar)[XB_TMO], 1u); break; } } } } while (0)
struct XcdBarrier { unsigned* bar; unsigned x; volatile LAS unsigned* st; };
__device__ __forceinline__ XcdBarrier xcd_barrier_post(unsigned* bar, volatile LAS unsigned* st) {
    XcdBarrier b; b.bar = bar; b.x = xb_xcc_id(); b.st = st;
    if (threadIdx.x == 0) (void)xb_add(&bar[XB_XCNT(b.x)], 1u);
    return b;
}
__device__ __forceinline__ void xcd_barrier_complete(unsigned* bar, unsigned x, unsigned& nloc, unsigned& nx) {
    const unsigned G = gridDim.x * gridDim.y * gridDim.z;
    unsigned sum, cnt, mine, sp = 0u;
    for (;;) {
        sum = 0u; cnt = 0u; mine = 0u;
#pragma unroll
        for (unsigned j = 0; j < 16; ++j) { const unsigned c = xb_ld(&bar[XB_XCNT(j)]); sum += c; cnt += (c > 0u) ? 1u : 0u; mine = (j == x) ? c : mine; }
        if (sum == G) break;
        __builtin_amdgcn_s_sleep(1);
        if ((++sp & 255u) == 0u) { if (xb_ld(&bar[XB_TMO])) break; if (sp > XB_SPIN_CAP) { atomicAdd(&bar[XB_TMO], 1u); break; } }
    }
    nloc = mine > 0u ? mine : 1u; nx = cnt > 0u ? cnt : 1u;
}
__device__ __forceinline__ void xcd_barrier(const XcdBarrier& b) {
    asm volatile("s_waitcnt vmcnt(0)" ::: "memory");
    __syncthreads();
    if (threadIdx.x == 0) {
        unsigned* bar = b.bar;
        __builtin_amdgcn_s_waitcnt(0);
        unsigned nloc = b.st[0], nx = b.st[1];
        if (nloc == 0u) { xcd_barrier_complete(bar, b.x, nloc, nx); b.st[0] = nloc; b.st[1] = nx; }
        const unsigned old = xb_add(&bar[XB_XSUB(b.x)], 1u);
        const unsigned gen = old / nloc;
        if (old + 1u == (gen + 1u) * nloc) {
            __builtin_amdgcn_fence(__ATOMIC_RELEASE, "agent");
            asm volatile("s_waitcnt vmcnt(0)" ::: "memory");
            const unsigned og = xb_add(&bar[XB_TOP], 1u);
            const unsigned tg = og / nx;
            if (og + 1u == (tg + 1u) * nx) xb_add(&bar[XB_TOPGEN], 1u);
            else XB_SPIN(xb_ld(&bar[XB_TOPGEN]) == tg, bar);
            __builtin_amdgcn_fence(__ATOMIC_ACQUIRE, "agent");
            xb_add(&bar[XB_XGEN(b.x)], 1u);
            asm volatile("s_waitcnt vmcnt(0)" ::: "memory");
        } else {
            XB_SPIN(xb_ld(&bar[XB_XGEN(b.x)]) == gen, bar);
            __builtin_amdgcn_fence(__ATOMIC_ACQUIRE, "agent");
            asm volatile("s_waitcnt vmcnt(0)" ::: "memory");
        }
    }
    __syncthreads();
}

constexpr size_t MiB = 1u << 20;
constexpr size_t WS_CTL = 0, CTL_ZERO_BYTES = 1 * MiB;
constexpr size_t WS_WL0 = 2 * MiB, WS_WLSTRIDE = 272 * MiB;
constexpr size_t WO_WIN = 0, WO_WBR = 48 * MiB, WO_WOUT = 56 * MiB, WO_WXQ = 64 * MiB, WO_WXK = 66 * MiB, WO_WXV = 68 * MiB, WO_WXO = 70 * MiB, WO_WUQ = 72 * MiB, WO_WUKV = 73 * MiB,
                 WO_W1C = 74 * MiB, WO_W2C = 75 * MiB, WO_BIASP = 76 * MiB, WO_B1C = 77 * MiB, WO_WRT = 78 * MiB, WO_WEIN = 80 * MiB, WO_WEOUT = 208 * MiB;
constexpr size_t WS_XLO = 546 * MiB, WS_XB = 674 * MiB, WS_GATE = 738 * MiB, WS_U2 = 994 * MiB, WS_ABR = 1114 * MiB, WS_MERGED = 1178 * MiB, WS_QH = 1242 * MiB, WS_KVH = 1266 * MiB,
                 WS_QM = 1298 * MiB, WS_KM = 1322 * MiB, WS_VTM = 1346 * MiB, WS_VTSEL = 1362 * MiB, WS_VTWIN = 1366 * MiB, WS_KC = 1370 * MiB, WS_VCT = 1371 * MiB, WS_HID = 1372 * MiB,
                 WS_OCMP = 1373 * MiB, WS_OWIN = 1389 * MiB, WS_SCORES = 1405 * MiB, WS_IDX = 1437 * MiB, WS_NV = 1439 * MiB, WS_RSTD = 1440 * MiB, WS_ROPE = 1441 * MiB, WS_QX = 1443 * MiB,
                 WS_OX = 1459 * MiB, WS_KX = 1475 * MiB, WS_VXT = 1476 * MiB, WS_MEMB = 1477 * MiB, WS_CSTAT = 1478 * MiB, WS_MOE = 1479 * MiB, WS_Y = 1481 * MiB, WS_END = 1609 * MiB;
constexpr size_t WS_XS = WS_GATE, WS_Y2 = WS_GATE + 160 * MiB, WS_HS = WS_GATE + 320 * MiB;
static_assert(WS_HS + 40 * MiB <= WS_ABR, "MoE overlay");
constexpr int CW_CNT = 1024;
constexpr int CW_BAR = 4096;
constexpr size_t MO_TOKE = 0, MO_TOKW = 128 * 1024, MO_TOKP = 256 * 1024, MO_ROWW = 384 * 1024, MO_TILEE = 640 * 1024, MO_NT = 644 * 1024, MO_ROWTOK = 768 * 1024;

constexpr int RING_BYTES = 131072;
constexpr int LDS_BYTES = 147456;
constexpr int MISC_OFF = LDS_BYTES - 512;

constexpr int NWAVES = 8;
struct Args { const void* in[39]; float* out; unsigned char* ws; int ph_lo, ph_hi, li, pad; };
static_assert(sizeof(Args) == 39 * 8 + 8 + 8 + 16, "Args has no padding");

struct Frame {
    LAS unsigned char* lds;
    int tid, lane, wave, G, gw, NGW;
    unsigned char* ws;
};

__device__ __forceinline__ int in_col(int n) {
    if (n < 8192) return 3640 + n;
    if (n < 8704) return n - 8192;
    if (n < 9472) return 512 + (n - 8704);
    if (n < 9984) return 1304 + (n - 9472);
    if (n < 10496) return 1816 + (n - 9984);
    if (n < 10752) return 2328 + (n - 10496);
    if (n < 11776) return 2616 + (n - 10752);
    const int c = n - 11776; if (c < 24) return 1280 + c; if (c >= 32 && c < 64) return 2584 + (c - 32); return -1;
}
struct Job { const float* W; const float* ks; bf16* WT; int ldw, ldt, kdst0, mode, nkb, nnb, nbatch; size_t sstride, dstride; };
__device__ __forceinline__ void transpose_load(const Job& J, int item, f32x4 (&v)[16], int lane) {
    const int per = J.nkb * J.nnb, e = item / per, r = item % per, kb = r / J.nnb, nb = r % J.nnb, k0 = kb * 64, n0 = nb * 64;
    const float* W = J.W + (size_t)e * J.sstride;
    const int nq = 4 * (lane & 15), nd = n0 + nq;
    int sc;
    if (J.mode == 1) sc = in_col(nd);
    else if (J.mode == 2) { const int T = nd >> 8, w = nd & 255; sc = (w < 128) ? (T * 128 + w) : (512 + T * 128 + (w - 128)); }
    else sc = nd;
#pragma unroll
    for (int i = 0; i < 16; ++i) { const int kk = (lane >> 4) + 4 * i; v[i] = (f32x4){0.f, 0.f, 0.f, 0.f};
        if (sc >= 0) v[i] = *(const f32x4*)(W + (size_t)(k0 + kk) * J.ldw + sc); }
}
__device__ __forceinline__ void transpose_store(const Job& J, int item, f32x4 (&v)[16], LAS float* scr, int lane) {
    const int per = J.nkb * J.nnb, e = item / per, r = item % per, kb = r / J.nnb, nb = r % J.nnb, k0 = kb * 64, n0 = nb * 64;
    bf16* WT = J.WT + (size_t)e * J.dstride;
    const int nq = 4 * (lane & 15);
#pragma unroll
    for (int i = 0; i < 16; ++i) { const int kk = (lane >> 4) + 4 * i;
        if (J.ks) v[i] = v[i] * J.ks[k0 + kk];
        LAS float* d = scr + kk * 65 + nq; d[0] = v[i][0]; d[1] = v[i][1]; d[2] = v[i][2]; d[3] = v[i][3]; }
    LDS_WAIT(); asm volatile("" ::: "memory");
    const int c = lane & 7;
#pragma unroll
    for (int j = 0; j < 8; ++j) { const int n = (lane >> 3) + 8 * j; const LAS float* s = scr + (8 * c) * 65 + n;
        u32x4 o; o.x = cvt_pk_bf16(s[0 * 65], s[1 * 65]); o.y = cvt_pk_bf16(s[2 * 65], s[3 * 65]); o.z = cvt_pk_bf16(s[4 * 65], s[5 * 65]); o.w = cvt_pk_bf16(s[6 * 65], s[7 * 65]);
        *(u32x4*)(WT + (size_t)(n0 + n) * J.ldt + J.kdst0 + k0 + 8 * c) = o; }
    LDS_WAIT(); asm volatile("" ::: "memory");
}
constexpr int NJOBS = 15;
__device__ __forceinline__ Job get_job(const Args& a, int l, int j) {
    unsigned char* wl = a.ws + WS_WL0 + (size_t)l * WS_WLSTRIDE;
    Job J; J.ks = nullptr; J.kdst0 = 0; J.mode = 0; J.nbatch = 1; J.sstride = 0; J.dstride = 0;
#define SRC(i, per) ((const float*)a.in[i] + (size_t)l * (per))
    switch (j) {
    case 0:  J.W = SRC(3, (size_t)D * IN_W); J.ldw = IN_W; J.WT = (bf16*)(wl + WO_WIN); J.ldt = D; J.mode = 1; J.nkb = 32; J.nnb = NIN / 64; break;
    case 1:  J.W = SRC(8, 512 * D);  J.ldw = D; J.WT = (bf16*)(wl + WO_WBR); J.ldt = D; J.kdst0 = 0;    J.nkb = 8; J.nnb = 32; break;
    case 2:  J.W = SRC(16, 512 * D); J.ldw = D; J.WT = (bf16*)(wl + WO_WBR); J.ldt = D; J.kdst0 = 1024; J.nkb = 8; J.nnb = 32; break;
    case 3:  J.W = SRC(21, 512 * D); J.ldw = D; J.WT = (bf16*)(wl + WO_WBR); J.ldt = D; J.kdst0 = 1536; J.nkb = 8; J.nnb = 32; break;
    case 4:  J.W = SRC(22, (size_t)D * D); J.ldw = D; J.WT = (bf16*)(wl + WO_WOUT); J.ldt = D; J.nkb = 32; J.nnb = 32; break;
    case 5:  J.W = SRC(13, 512 * 768); J.ldw = 768; J.ks = SRC(12, 512); J.WT = (bf16*)(wl + WO_WUQ); J.ldt = 512; J.nkb = 8; J.nnb = 12; break;
    case 6:  J.W = SRC(15, 256 * 1024); J.ldw = 1024; J.ks = SRC(14, 256); J.WT = (bf16*)(wl + WO_WUKV); J.ldt = 256; J.nkb = 4; J.nnb = 16; break;
    case 7:  J.W = SRC(25, D * 512); J.ldw = 512; J.WT = (bf16*)(wl + WO_WXQ); J.ldt = D; J.nkb = 32; J.nnb = 8; break;
    case 8:  J.W = SRC(26, D * 512); J.ldw = 512; J.WT = (bf16*)(wl + WO_WXK); J.ldt = D; J.nkb = 32; J.nnb = 8; break;
    case 9:  J.W = SRC(27, D * 512); J.ldw = 512; J.WT = (bf16*)(wl + WO_WXV); J.ldt = D; J.nkb = 32; J.nnb = 8; break;
    case 10: J.W = SRC(28, 512 * D); J.ldw = D; J.WT = (bf16*)(wl + WO_WXO); J.ldt = 512; J.nkb = 8; J.nnb = 32; break;
    case 11: J.W = SRC(35, (size_t)32 * D * 1024); J.ldw = 1024; J.WT = (bf16*)(wl + WO_WEIN); J.ldt = D; J.mode = 2; J.nkb = 32; J.nnb = 16; J.nbatch = 32; J.sstride = (size_t)D * 1024; J.dstride = (size_t)1024 * D; break;
    case 12: J.W = SRC(36, (size_t)32 * 512 * D); J.ldw = D; J.WT = (bf16*)(wl + WO_WEOUT); J.ldt = 512; J.nkb = 8; J.nnb = 32; J.nbatch = 32; J.sstride = (size_t)512 * D; J.dstride = (size_t)D * 512; break;
    case 13: J.W = SRC(6, 2 * 2048 * 128); J.ldw = 128; J.WT = (bf16*)(wl + WO_W1C); J.ldt = 2048; J.nkb = 32; J.nnb = 2; J.nbatch = 2; J.sstride = 2048 * 128; J.dstride = 128 * 2048; break;
    default: J.W = SRC(7, 2 * 128 * 64); J.ldw = 64; J.WT = (bf16*)(wl + WO_W2C); J.ldt = 128; J.nkb = 2; J.nnb = 1; J.nbatch = 2; J.sstride = 128 * 64; J.dstride = 64 * 128; break;
    }
#undef SRC
    return J;
}

struct Row { f32x4 v[8]; };
__device__ __forceinline__ void row_load(Row& r, const float* p, int lane) {
    asm volatile("" : "+v"(lane));
#pragma unroll
    for (int j = 0; j < 8; ++j) r.v[j] = *(const f32x4*)(p + 4 * lane + 256 * j);
}
__device__ __forceinline__ void row_store_f32(const Row& r, float* p, int lane) {
    asm volatile("" : "+v"(lane));
#pragma unroll
    for (int j = 0; j < 8; ++j) *(f32x4*)(p + 4 * lane + 256 * j) = r.v[j];
}
__device__ __forceinline__ void row_store_bf16(const Row& r, bf16* p, int lane) {
    asm volatile("" : "+v"(lane));
#pragma unroll
    for (int j = 0; j < 8; ++j) { u32x2 w; w.x = cvt_pk_bf16(r.v[j][0], r.v[j][1]); w.y = cvt_pk_bf16(r.v[j][2], r.v[j][3]); *(u32x2*)(p + 4 * lane + 256 * j) = w; }
}
__device__ __forceinline__ void row_load_bf16(Row& r, const bf16* p, int lane) {
    asm volatile("" : "+v"(lane));
#pragma unroll
    for (int j = 0; j < 8; ++j) { const u32x2 w = *(const u32x2*)(p + 4 * lane + 256 * j); r.v[j][0] = bflo(w.x); r.v[j][1] = bfhi(w.x); r.v[j][2] = bflo(w.y); r.v[j][3] = bfhi(w.y); }
}
struct RowRaw { u32x2 w[8]; };
__device__ __forceinline__ void row_fetch(RowRaw& q, const bf16* p, int lane) {
    asm volatile("" : "+v"(lane));
#pragma unroll
    for (int j = 0; j < 8; ++j) q.w[j] = *(const u32x2*)(p + 4 * lane + 256 * j);
}
__device__ __forceinline__ void row_unpack(Row& r, const RowRaw& q) {
#pragma unroll
    for (int j = 0; j < 8; ++j) { r.v[j][0] = bflo(q.w[j].x); r.v[j][1] = bfhi(q.w[j].x); r.v[j][2] = bflo(q.w[j].y); r.v[j][3] = bfhi(q.w[j].y); }
}
__device__ __forceinline__ void row_unpack_add(Row& r, const RowRaw& q) {
#pragma unroll
    for (int j = 0; j < 8; ++j) { r.v[j][0] += bflo(q.w[j].x); r.v[j][1] += bfhi(q.w[j].x); r.v[j][2] += bflo(q.w[j].y); r.v[j][3] += bfhi(q.w[j].y); }
}
__device__ __forceinline__ void row_store_hilo(const Row& r, bf16* ph, bf16* pl, int lane) {
    asm volatile("" : "+v"(lane));
#pragma unroll
    for (int j = 0; j < 8; ++j) { u32x2 h, l; h.x = cvt_pk_bf16(r.v[j][0], r.v[j][1]); h.y = cvt_pk_bf16(r.v[j][2], r.v[j][3]);
        l.x = cvt_pk_bf16(r.v[j][0] - bflo(h.x), r.v[j][1] - bfhi(h.x)); l.y = cvt_pk_bf16(r.v[j][2] - bflo(h.y), r.v[j][3] - bfhi(h.y));
        *(u32x2*)(ph + 4 * lane + 256 * j) = h; *(u32x2*)(pl + 4 * lane + 256 * j) = l; }
}
__device__ __forceinline__ void row_add_bf16(Row& r, const bf16* p, int lane) {
    asm volatile("" : "+v"(lane));
#pragma unroll
    for (int j = 0; j < 8; ++j) { const u32x2 w = *(const u32x2*)(p + 4 * lane + 256 * j); r.v[j][0] += bflo(w.x); r.v[j][1] += bfhi(w.x); r.v[j][2] += bflo(w.y); r.v[j][3] += bfhi(w.y); }
}
__device__ __forceinline__ void row_layernorm(Row& r, const float* g, const float* b, int lane) {
    asm volatile("" : "+v"(lane));
    float s = 0.f;
#pragma unroll
    for (int j = 0; j < 8; ++j) s += (r.v[j][0] + r.v[j][1]) + (r.v[j][2] + r.v[j][3]);
    const float mean = wave_sum(s) * (1.0f / D); float q = 0.f;
#pragma unroll
    for (int j = 0; j < 8; ++j) { r.v[j] = r.v[j] - mean; q += (r.v[j][0] * r.v[j][0] + r.v[j][1] * r.v[j][1]) + (r.v[j][2] * r.v[j][2] + r.v[j][3] * r.v[j][3]); }
    const float rstd = 1.0f / sqrtf(wave_sum(q) * (1.0f / D) + 1e-5f);
#pragma unroll
    for (int j = 0; j < 8; ++j) { const f32x4 gg = *(const f32x4*)(g + 4 * lane + 256 * j), bb = *(const f32x4*)(b + 4 * lane + 256 * j); r.v[j] = r.v[j] * rstd * gg + bb; }
}

__device__ __forceinline__ void row_layernorm2(Row& r0, Row& r1, const float* g, const float* b, int lane) {
    asm volatile("" : "+v"(lane));
    float s0 = 0.f, s1 = 0.f;
#pragma unroll
    for (int j = 0; j < 8; ++j) { s0 += (r0.v[j][0] + r0.v[j][1]) + (r0.v[j][2] + r0.v[j][3]); s1 += (r1.v[j][0] + r1.v[j][1]) + (r1.v[j][2] + r1.v[j][3]); }
#pragma unroll
    for (int o = 0; o < 1; ++o) { s0 = wave_sum(s0); s1 = wave_sum(s1); }
    const float m0 = s0 * (1.0f / D), m1 = s1 * (1.0f / D); float q0 = 0.f, q1 = 0.f;
#pragma unroll
    for (int j = 0; j < 8; ++j) { r0.v[j] = r0.v[j] - m0; r1.v[j] = r1.v[j] - m1;
        q0 += (r0.v[j][0] * r0.v[j][0] + r0.v[j][1] * r0.v[j][1]) + (r0.v[j][2] * r0.v[j][2] + r0.v[j][3] * r0.v[j][3]);
        q1 += (r1.v[j][0] * r1.v[j][0] + r1.v[j][1] * r1.v[j][1]) + (r1.v[j][2] * r1.v[j][2] + r1.v[j][3] * r1.v[j][3]); }
#pragma unroll
    for (int o = 0; o < 1; ++o) { q0 = wave_sum(q0); q1 = wave_sum(q1); }
    const float d0 = 1.0f / sqrtf(q0 * (1.0f / D) + 1e-5f), d1 = 1.0f / sqrtf(q1 * (1.0f / D) + 1e-5f);
#pragma unroll
    for (int j = 0; j < 8; ++j) { const f32x4 gg = *(const f32x4*)(g + 4 * lane + 256 * j), bb = *(const f32x4*)(b + 4 * lane + 256 * j); r0.v[j] = r0.v[j] * d0 * gg + bb; r1.v[j] = r1.v[j] * d1 * gg + bb; }
}
template <class AP, class BP>
__device__ __forceinline__ f32x4 sgemm16(const AP& ap, const BP& bp, int K, int lane) {
    const int r = lane & 15, G = lane >> 4; f32x4 acc = (f32x4){0.f, 0.f, 0.f, 0.f};
#pragma unroll 8
    for (int k0 = 0; k0 < K; k0 += 32) { const bf16x8 a = *(const bf16x8*)ap(r, k0 + 8 * G), b = *(const bf16x8*)bp(r, k0 + 8 * G);
        acc = __builtin_amdgcn_mfma_f32_16x16x32_bf16(a, b, acc, 0, 0, 0); }
    return acc;
}
__device__ __forceinline__ void transpose_tile64(const bf16* src, size_t sp, bf16* dst, size_t dp, LAS bf16* scr, int lane) {
    const int r8 = lane >> 3, pc = lane & 7;
#pragma unroll
    for (int c = 0; c < 8; ++c) { const int row = 8 * c + r8; const u32x4 v = *(const u32x4*)(src + (size_t)row * sp + 8 * pc); LAS unsigned* d = (LAS unsigned*)(scr + row * 66 + 8 * pc); d[0] = v.x; d[1] = v.y; d[2] = v.z; d[3] = v.w; }
    LDS_WAIT(); asm volatile("" ::: "memory");
#pragma unroll
    for (int c = 0; c < 8; ++c) { const int drow = 8 * c + r8; unsigned w[4];
#pragma unroll
        for (int q = 0; q < 4; ++q) { const unsigned lo = scr[(8 * pc + 2 * q) * 66 + drow], hi = scr[(8 * pc + 2 * q + 1) * 66 + drow]; w[q] = lo | (hi << 16); }
        *(u32x4*)(dst + (size_t)drow * dp + 8 * pc) = (u32x4){w[0], w[1], w[2], w[3]}; }
    LDS_WAIT(); asm volatile("" ::: "memory");
}
__device__ __forceinline__ float gelu_tanh(float x) { const float u = 0.7978845608028654f * (x + 0.044715f * x * x * x); return 0.5f * x * (1.0f + tanhf(u)); }

__device__ __forceinline__ void phase_prologue(const Args& a, Frame& F) {
    LAS float* scr = (LAS float*)(F.lds + F.wave * 16640);
    const int gw = F.gw, NGW = F.NGW, lane = F.lane;
    { int off = 0;
      for (int l = 0; l < DEPTH; ++l)
        for (int j = 0; j < NJOBS; ++j) { const Job J = get_job(a, l, j); const int n = J.nbatch * J.nkb * J.nnb;
            int st = (gw - off) % NGW; if (st < 0) st += NGW;
            f32x4 va[16], vb[16];
            if (st < n) transpose_load(J, st, va, lane);
#pragma unroll 1
            for (int it = st; it < n; it += 2 * NGW) {
                if (it + NGW < n) transpose_load(J, it + NGW, vb, lane);
                transpose_store(J, it, va, scr, lane);
                if (it + NGW < n) { if (it + 2 * NGW < n) transpose_load(J, it + 2 * NGW, va, lane); transpose_store(J, it + NGW, vb, scr, lane); } }
            off = (off + n) % NGW; } }
#pragma unroll 1
    for (int i = gw * 64 + lane; i < DEPTH * NIN; i += NGW * 64) { const int l = i / NIN, n = i % NIN; const int sc = in_col(n);
        ((float*)(a.ws + WS_WL0 + (size_t)l * WS_WLSTRIDE + WO_BIASP))[n] = sc >= 0 ? ((const float*)a.in[4])[(size_t)l * IN_W + sc] : 0.f; }
#pragma unroll 1
    for (int it = gw; it < DEPTH * 4 * 16 * 32; it += NGW) { const int nb = it & 31, cb = (it >> 5) & 15, g = (it >> 9) & 3, l = it >> 11; const int n = nb * 64 + lane;
        const float* wp = (const float*)a.in[9] + ((size_t)(l * 4 + g) * 128 + 8 * cb) * 128; const float* ps = (const float*)a.in[10] + l * 512 + 128 * g;
        const float* wo = (const float*)a.in[11] + ((size_t)l * 512 + 128 * g) * D + n;
        float acc[8];
#pragma unroll
        for (int i = 0; i < 8; ++i) acc[i] = 0.f;
        for (int d = 0; d < 128; ++d) { const float b = wo[(size_t)d * D] * ps[d];
#pragma unroll
            for (int i = 0; i < 8; ++i) acc[i] += wp[i * 128 + d] * b; }
        bf16* dst = (bf16*)(a.ws + WS_WL0 + (size_t)l * WS_WLSTRIDE + WO_WBR) + (size_t)n * D + 512 + 128 * g + 8 * cb;
        *(u32x4*)dst = (u32x4){cvt_pk_bf16(acc[0], acc[1]), cvt_pk_bf16(acc[2], acc[3]), cvt_pk_bf16(acc[4], acc[5]), cvt_pk_bf16(acc[6], acc[7])}; }
#pragma unroll 1
    for (int it = gw; it < DEPTH * 2; it += NGW) { const float* pos = (const float*)a.in[5] + (size_t)it * 2048; const float* w1 = (const float*)a.in[6] + (size_t)it * 2048 * 128;
        float a0 = 0.f, a1 = 0.f;
        for (int k = 0; k < 2048; ++k) { const float p = pos[k]; a0 += p * w1[(size_t)k * 128 + lane]; a1 += p * w1[(size_t)k * 128 + 64 + lane]; }
        float* dst = (float*)(a.ws + WS_WL0 + (size_t)(it >> 1) * WS_WLSTRIDE + WO_B1C) + (it & 1) * 128; dst[lane] = a0; dst[64 + lane] = a1; }
#pragma unroll 1
    for (int i = gw * 64 + lane; i < S * 16; i += NGW * 64) { const int t = i >> 4, k = i & 15; const float inv = powf(10000.0f, -(float)k / 16.0f); const float ang = (float)((const int*)a.in[2])[t] * inv;
        float sn, cs; sincosf(ang, &sn, &cs); ((f32x2*)(a.ws + WS_ROPE))[i] = (f32x2){cs, sn}; }
#pragma unroll 1
    for (int i = gw * 64 + lane; i < DEPTH * 48 * 2048; i += NGW * 64) { const int l = i / (48 * 2048), n = (i / 2048) % 48, k = i % 2048;
        float w = 0.f; if (n < 4) w = ((const float*)a.in[31])[((size_t)l * D + k) * 4 + n]; else if (n < 36) w = ((const float*)a.in[33])[((size_t)l * D + k) * 32 + (n - 4)];
        const unsigned short h = f2bf(w); const unsigned short lo = f2bf(w - bf2f(h));
        bf16* dst = (bf16*)(a.ws + WS_WL0 + (size_t)l * WS_WLSTRIDE + WO_WRT); dst[(size_t)n * 2048 + k] = h; dst[(size_t)(48 + n) * 2048 + k] = lo; }
#pragma unroll 1
    for (int r = gw; r < S + 256; r += NGW) { Row rw;
        if (r < S) { row_load(rw, (const float*)a.in[0] + (size_t)r * D, lane); row_store_bf16(rw, (bf16*)(a.ws + WS_XB) + (size_t)r * D, lane); }
        else { row_load(rw, (const float*)a.in[1] + (size_t)(r - S) * D, lane); row_store_bf16(rw, (bf16*)(a.ws + WS_MEMB) + (size_t)(r - S) * D, lane); } }
}

__device__ __forceinline__ int crow(int r, int hi) { return (r & 3) + 8 * (r >> 2) + 4 * hi; }
template <int DK, int DV, class V>
__device__ __forceinline__ void attn32(const V& v, int lane, float& m_fin, float& l_fin) {
    const int col = lane & 31, hi = lane >> 5;
    constexpr int NKS = DK / 16, NVB = DV / 32;
    bf16x8 qf[NKS];
    { const bf16* qp = v.qptr(col);
#pragma unroll
      for (int s = 0; s < NKS; ++s) qf[s] = *(const bf16x8*)(qp + 16 * s + 8 * hi); }
    f32x16 o[NVB];
#pragma unroll
    for (int b = 0; b < NVB; ++b)
#pragma unroll
        for (int r = 0; r < 16; ++r) o[b][r] = 0.f;
    float m_run = -INFINITY, l_run = 0.f;
    for (int T = v.tb; T < v.te; ++T) {
        const int key0 = 32 * T;
        const bf16* kp = v.kptr(key0 + col);
        f32x16 sacc;
#pragma unroll
        for (int r = 0; r < 16; ++r) sacc[r] = 0.f;
#pragma unroll
        for (int s = 0; s < NKS; ++s) { const bf16x8 kf = *(const bf16x8*)(kp + 16 * s + 8 * hi); sacc = __builtin_amdgcn_mfma_f32_32x32x16_bf16(kf, qf[s], sacc, 0, 0, 0); }
        float x[16]; float mt = -INFINITY;
#pragma unroll
        for (int r = 0; r < 16; ++r) { const int key = key0 + crow(r, hi); x[r] = v.valid(key, col) ? sacc[r] * v.scale2 : -INFINITY; mt = fmaxf(mt, x[r]); }
        mt = fmaxf(mt, __shfl_xor(mt, 32));
        const float m_new = fmaxf(m_run, mt);
        const float mref = (m_new == -INFINITY) ? 0.f : m_new;
        const float corr = __builtin_amdgcn_exp2f(m_run - mref);
        float ps = 0.f;
#pragma unroll
        for (int r = 0; r < 16; ++r) { x[r] = __builtin_amdgcn_exp2f(x[r] - mref); ps += x[r]; }
        l_run = l_run * corr + ps; m_run = m_new;
#pragma unroll
        for (int b = 0; b < NVB; ++b)
#pragma unroll
            for (int r = 0; r < 16; ++r) o[b][r] *= corr;
        bf16x8 pf[2];
#pragma unroll
        for (int s2 = 0; s2 < 2; ++s2) { const u32x4 w = (u32x4){cvt_pk_bf16(x[8 * s2 + 0], x[8 * s2 + 1]), cvt_pk_bf16(x[8 * s2 + 2], x[8 * s2 + 3]), cvt_pk_bf16(x[8 * s2 + 4], x[8 * s2 + 5]), cvt_pk_bf16(x[8 * s2 + 6], x[8 * s2 + 7])};
            pf[s2] = __builtin_bit_cast(bf16x8, w); }
#pragma unroll
        for (int b = 0; b < NVB; ++b) { const bf16* vp = v.vtptr(32 * b + col) + key0 + 4 * hi;
#pragma unroll
            for (int s2 = 0; s2 < 2; ++s2) { const u32x2 lo = *(const u32x2*)(vp + 16 * s2), hh = *(const u32x2*)(vp + 16 * s2 + 8);
                const bf16x8 vf = __builtin_bit_cast(bf16x8, (u32x4){lo.x, lo.y, hh.x, hh.y});
                o[b] = __builtin_amdgcn_mfma_f32_32x32x16_bf16(vf, pf[s2], o[b], 0, 0, 0); } }
    }
    const float l = l_run + __shfl_xor(l_run, 32);
    const float inv = l > 0.f ? 1.0f / l : 0.f;
#pragma unroll
    for (int b = 0; b < NVB; ++b)
#pragma unroll
        for (int i = 0; i < 4; ++i) v.store(col, 32 * b + 8 * i + 4 * hi, (f32x4){o[b][4 * i] * inv, o[b][4 * i + 1] * inv, o[b][4 * i + 2] * inv, o[b][4 * i + 3] * inv});
    m_fin = m_run; l_fin = l;
}
__device__ __forceinline__ void store4_bf16(bf16* p, const f32x4 v) { *(u32x2*)p = (u32x2){cvt_pk_bf16(v[0], v[1]), cvt_pk_bf16(v[2], v[3])}; }

struct VarMLA {
    const bf16* Q; const bf16* K; const bf16* Vt; bf16* O; int t0, hd, tb, te; float scale2;
    __device__ __forceinline__ const bf16* qptr(int col) const { return Q + (size_t)(t0 + col) * 768 + hd * 96; }
    __device__ __forceinline__ const bf16* kptr(int key) const { return K + (size_t)key * 768 + hd * 96; }
    __device__ __forceinline__ const bf16* vtptr(int dv) const { return Vt + (size_t)(hd * 64 + dv) * S; }
    __device__ __forceinline__ bool valid(int key, int col) const { return key <= t0 + col; }
    __device__ __forceinline__ void store(int col, int dv, const f32x4 x) const { store4_bf16(O + (size_t)(t0 + col) * D + 1024 + hd * 64 + dv, x); }
};
struct VarWin {
    const bf16* U2; const bf16* Vt; bf16* O; int t0, g, tb, te; float scale2;
    __device__ __forceinline__ const bf16* qptr(int col) const { return U2 + (size_t)(t0 + (col >> 2)) * U2W + U2_Q + (4 * g + (col & 3)) * 64; }
    __device__ __forceinline__ const bf16* kptr(int key) const { return U2 + (size_t)key * U2W + U2_KV + (4 * 2 + g) * 64; }
    __device__ __forceinline__ const bf16* vtptr(int dv) const { return Vt + (size_t)(g * 64 + dv) * S; }
    __device__ __forceinline__ bool valid(int key, int col) const { const int tok = t0 + (col >> 2); return key <= tok && key > tok - 512; }
    __device__ __forceinline__ void store(int col, int dv, const f32x4 x) const { store4_bf16(O + (size_t)(t0 + (col >> 2)) * 512 + (4 * g + (col & 3)) * 64 + dv, x); }
};
struct VarCmp {
    const bf16* U2; const bf16* KC; const bf16* Vt; bf16* O; int t0, g, tb, te; float scale2;
    __device__ __forceinline__ const bf16* qptr(int col) const { return U2 + (size_t)(t0 + (col >> 2)) * U2W + U2_Q + (4 * g + (col & 3)) * 64; }
    __device__ __forceinline__ const bf16* kptr(int c) const { return KC + (size_t)(g * 1024 + c) * 64; }
    __device__ __forceinline__ const bf16* vtptr(int dv) const { return Vt + (size_t)(g * 64 + dv) * 1024; }
    __device__ __forceinline__ bool valid(int c, int col) const { return 16 * c + 31 <= t0 + (col >> 2); }
    __device__ __forceinline__ void store(int col, int dv, const f32x4 x) const { store4_bf16(O + (size_t)(t0 + (col >> 2)) * 512 + (4 * g + (col & 3)) * 64 + dv, x); }
};
struct VarX {
    const bf16* Q; const bf16* K; const bf16* Vt; bf16* O; int t0, hd, tb, te; float scale2;
    __device__ __forceinline__ const bf16* qptr(int col) const { return Q + (size_t)(t0 + col) * 512 + hd * 128; }
    __device__ __forceinline__ const bf16* kptr(int key) const { return K + (size_t)key * 512 + hd * 128; }
    __device__ __forceinline__ const bf16* vtptr(int dv) const { return Vt + (size_t)(hd * 128 + dv) * 256; }
    __device__ __forceinline__ bool valid(int, int) const { return true; }
    __device__ __forceinline__ void store(int col, int dv, const f32x4 x) const { store4_bf16(O + (size_t)(t0 + col) * 512 + hd * 128 + dv, x); }
};
__device__ __forceinline__ void cmp_scores(const VarCmp& v, int lane, float m_fin, float l_fin, float* sc) {
    const int col = lane & 31, hi = lane >> 5;
    bf16x8 qf[4];
    { const bf16* qp = v.qptr(col);
#pragma unroll
      for (int s = 0; s < 4; ++s) qf[s] = *(const bf16x8*)(qp + 16 * s + 8 * hi); }
    const float mref = (m_fin == -INFINITY) ? 0.f : m_fin; const float inv = l_fin > 0.f ? 1.0f / l_fin : 0.f;
    float* dst = sc + (size_t)((v.t0 + (col >> 2)) * 2 + v.g) * 256;
    float carry = 0.f;
    for (int T = 0; T < 32; ++T) {
        float sv[4];
        if (T < v.te) {
            const int key0 = 32 * T; const bf16* kp = v.kptr(key0 + col);
            f32x16 sacc;
#pragma unroll
            for (int r = 0; r < 16; ++r) sacc[r] = 0.f;
#pragma unroll
            for (int s = 0; s < 4; ++s) { const bf16x8 kf = *(const bf16x8*)(kp + 16 * s + 8 * hi); sacc = __builtin_amdgcn_mfma_f32_32x32x16_bf16(kf, qf[s], sacc, 0, 0, 0); }
            float Gs[4], Es[4];
#pragma unroll
            for (int i = 0; i < 4; ++i) { float p[4];
#pragma unroll
                for (int q = 0; q < 4; ++q) { const int r = 4 * i + q; const int key = key0 + crow(r, hi); p[q] = v.valid(key, col) ? __builtin_amdgcn_exp2f(sacc[r] * v.scale2 - mref) * inv : 0.f; }
                Gs[i] = (p[0] + p[1]) + (p[2] + p[3]); Es[i] = p[3]; }
#pragma unroll
            for (int i = 0; i < 4; ++i) { Gs[i] += __shfl_xor(Gs[i], 1); Gs[i] += __shfl_xor(Gs[i], 2); Es[i] += __shfl_xor(Es[i], 1); Es[i] += __shfl_xor(Es[i], 2); }
            float eo[4];
#pragma unroll
            for (int i = 0; i < 4; ++i) eo[i] = __shfl_xor(Es[i], 32);
            if (hi) { sv[0] = Gs[0] + eo[0]; sv[1] = Gs[1] + eo[1]; sv[2] = Gs[2] + eo[2]; sv[3] = Gs[3] + eo[3]; }
            else { sv[0] = Gs[0] + carry; sv[1] = Gs[1] + eo[0]; sv[2] = Gs[2] + eo[1]; sv[3] = Gs[3] + eo[2]; }
            carry = eo[3];
        } else { sv[0] = hi ? 0.f : carry; sv[1] = 0.f; sv[2] = 0.f; sv[3] = 0.f; carry = 0.f; }
        if ((col & 3) == 0) {
#pragma unroll
            for (int i = 0; i < 4; ++i) dst[8 * T + 2 * i + hi] = sv[i]; }
    }
}

__device__ __forceinline__ void sel_attn_unit(const bf16* U2, const bf16* VTS, const bf16* OCMP, const bf16* OWIN, const int* idx, int nv, bf16* ABR, int t, int g, int lane) {
    const int c16 = lane & 15, G = lane >> 4;
    const float scale2 = 1.0f;
    bf16x8 qf[2];
    { const bf16* qp = U2 + (size_t)t * U2W + U2_Q + (4 * g + (c16 & 3)) * 64;
#pragma unroll
      for (int ks = 0; ks < 2; ++ks) { qf[ks] = *(const bf16x8*)(qp + 32 * ks + 8 * G); if (c16 >= 4) qf[ks] = (bf16x8){0, 0, 0, 0, 0, 0, 0, 0}; } }
    f32x4 o[4];
#pragma unroll
    for (int d = 0; d < 4; ++d) o[d] = (f32x4){0.f, 0.f, 0.f, 0.f};
    float m_run = -INFINITY, l_run = 0.f;
    for (int b = 0; b < nv; ++b) {
        const int blk = __builtin_amdgcn_readfirstlane(idx[b]); const int key0 = 64 * blk;
        f32x4 acc[4];
#pragma unroll
        for (int kt = 0; kt < 4; ++kt) { const bf16* kp = U2 + (size_t)(key0 + 16 * kt + c16) * U2W + U2_KV + (2 * 2 + g) * 64 + 8 * G;
            const bf16x8 k0 = *(const bf16x8*)kp, k1 = *(const bf16x8*)(kp + 32);
            acc[kt] = __builtin_amdgcn_mfma_f32_16x16x32_bf16(k0, qf[0], (f32x4){0.f, 0.f, 0.f, 0.f}, 0, 0, 0);
            acc[kt] = __builtin_amdgcn_mfma_f32_16x16x32_bf16(k1, qf[1], acc[kt], 0, 0, 0); }
        float mt = -INFINITY;
#pragma unroll
        for (int kt = 0; kt < 4; ++kt)
#pragma unroll
            for (int i = 0; i < 4; ++i) { const int key = key0 + 16 * kt + 4 * G + i; acc[kt][i] = (key <= t) ? acc[kt][i] * scale2 : -INFINITY; mt = fmaxf(mt, acc[kt][i]); }
        mt = fmaxf(mt, __shfl_xor(mt, 16)); mt = fmaxf(mt, __shfl_xor(mt, 32));
        const float m_new = fmaxf(m_run, mt); const float mref = (m_new == -INFINITY) ? 0.f : m_new;
        const float corr = __builtin_amdgcn_exp2f(m_run - mref); float ps = 0.f;
#pragma unroll
        for (int kt = 0; kt < 4; ++kt)
#pragma unroll
            for (int i = 0; i < 4; ++i) { acc[kt][i] = __builtin_amdgcn_exp2f(acc[kt][i] - mref); ps += acc[kt][i]; }
        l_run = l_run * corr + ps; m_run = m_new;
#pragma unroll
        for (int d = 0; d < 4; ++d) o[d] = o[d] * corr;
        bf16x8 pf[2];
#pragma unroll
        for (int u = 0; u < 2; ++u) pf[u] = __builtin_bit_cast(bf16x8, (u32x4){cvt_pk_bf16(acc[2 * u][0], acc[2 * u][1]), cvt_pk_bf16(acc[2 * u][2], acc[2 * u][3]), cvt_pk_bf16(acc[2 * u + 1][0], acc[2 * u + 1][1]), cvt_pk_bf16(acc[2 * u + 1][2], acc[2 * u + 1][3])});
#pragma unroll
        for (int d = 0; d < 4; ++d) { const bf16* vp = VTS + (size_t)(g * 64 + 16 * d + c16) * S + key0 + 4 * G;
#pragma unroll
            for (int u = 0; u < 2; ++u) { const u32x2 lo = *(const u32x2*)(vp + 32 * u), hh = *(const u32x2*)(vp + 32 * u + 16);
                o[d] = __builtin_amdgcn_mfma_f32_16x16x32_bf16(__builtin_bit_cast(bf16x8, (u32x4){lo.x, lo.y, hh.x, hh.y}), pf[u], o[d], 0, 0, 0); } }
    }
    float l = l_run; l += __shfl_xor(l, 16); l += __shfl_xor(l, 32);
    const float inv = l > 0.f ? 1.0f / l : 0.f;
    if (c16 < 4) { const int head = 4 * g + c16; const bf16* gp = U2 + (size_t)t * U2W + U2_G + head * 3;
        const float s0 = sigmoidf_(bf2f(gp[0])), s1 = sigmoidf_(bf2f(gp[1])) * inv, s2 = sigmoidf_(bf2f(gp[2]));
#pragma unroll
        for (int d = 0; d < 4; ++d) { const size_t off = (size_t)t * 512 + head * 64 + 16 * d + 4 * G; const u32x2 oc = *(const u32x2*)(OCMP + off), ow = *(const u32x2*)(OWIN + off);
            f32x4 r; r[0] = s0 * bflo(oc.x) + s1 * o[d][0] + s2 * bflo(ow.x); r[1] = s0 * bfhi(oc.x) + s1 * o[d][1] + s2 * bfhi(ow.x);
            r[2] = s0 * bflo(oc.y) + s1 * o[d][2] + s2 * bflo(ow.y); r[3] = s0 * bfhi(oc.y) + s1 * o[d][3] + s2 * bfhi(ow.y);
            store4_bf16(ABR + (size_t)t * D + head * 64 + 16 * d + 4 * G, r); } }
}
__device__ __forceinline__ bool selmask_test(const LAS unsigned* m8, int j) { return (m8[(j & 3) * 2 + (j >> 7)] >> ((j >> 2) & 31)) & 1u; }
__device__ __forceinline__ void topk_unit(const float* sc, int t, unsigned* mask_out, int lane) {
    const int cur = t >> 6;
    const f32x4 v = *(const f32x4*)(sc + 4 * lane);
    unsigned key[4];
#pragma unroll
    for (int q = 0; q < 4; ++q) { const int j = 4 * lane + q;
        key[q] = __float_as_uint(v[q]) + 1u;
        if (j == 0 || j == cur || j == cur - 1) key[q] = 0xffffffffu;
        if (j > cur) key[q] = 0u; }
    unsigned T = 0u;
#pragma unroll 1
    for (int bit = 31; bit >= 0; --bit) { const unsigned cand = T | (1u << bit);
        int cnt = 0;
#pragma unroll
        for (int q = 0; q < 4; ++q) cnt += __builtin_popcountll(__ballot(key[q] >= cand));
        if (cnt >= 16) T = cand; }
    unsigned long long G[4], E[4]; int cgt = 0;
#pragma unroll
    for (int q = 0; q < 4; ++q) { G[q] = __ballot(key[q] > T); E[q] = __ballot(key[q] == T && T != 0u); cgt += __builtin_popcountll(G[q]); }
    const int need = 16 - cgt;
    int below = 0;
#pragma unroll
    for (int q = 0; q < 4; ++q) below += (int)__builtin_amdgcn_mbcnt_hi((unsigned)(E[q] >> 32), __builtin_amdgcn_mbcnt_lo((unsigned)E[q], 0u));
    unsigned long long Sel[4]; int own = 0;
#pragma unroll
    for (int q = 0; q < 4; ++q) { const bool eq = (key[q] == T && T != 0u); const bool take = (key[q] > T) || (eq && (below + own) < need); own += eq ? 1 : 0; Sel[q] = __ballot(take); }
    unsigned w = 0u;
#pragma unroll
    for (int q = 0; q < 4; ++q) { if (lane == 2 * q) w = (unsigned)Sel[q]; if (lane == 2 * q + 1) w = (unsigned)(Sel[q] >> 32); }
    if (lane < 8) mask_out[lane] = w;
}

template <int NKS, int KP, int VP, int NVB, class MaskF>
__device__ __forceinline__ void att_step64n(const LAS unsigned char* kb, const LAS unsigned char* vb, const bf16x8 (&qf)[NKS], f32x16 (&o)[NVB], float& m_run, float& l_run, float scale2, bool use_mask, const MaskF& mask, int col, int hi) {
    f32x16 sacc[2];
#pragma unroll
    for (int u = 0; u < 2; ++u) {
#pragma unroll
        for (int r = 0; r < 16; ++r) sacc[u][r] = 0.f;
#pragma unroll
        for (int s = 0; s < NKS; ++s) { const bf16x8 kf = *(const LAS bf16x8*)(kb + ((32 * u + col) * KP + 16 * s + 8 * hi) * 2); sacc[u] = __builtin_amdgcn_mfma_f32_32x32x16_bf16(kf, qf[s], sacc[u], 0, 0, 0); } }
    float mt = -INFINITY;
#pragma unroll
    for (int u = 0; u < 2; ++u)
#pragma unroll
        for (int r = 0; r < 16; ++r) { float x = sacc[u][r] * scale2; if (use_mask) { if (!mask(u, r)) x = -INFINITY; } sacc[u][r] = x; mt = fmaxf(mt, x); }
    mt = xmax32(mt);
    const float m_new = fmaxf(m_run, mt); const float mref = (m_new == -INFINITY) ? 0.f : m_new;
    if (__any(m_new != m_run)) {
        const float corr = __builtin_amdgcn_exp2f(m_run - mref); l_run *= corr; m_run = m_new;
#pragma unroll
        for (int b = 0; b < NVB; ++b)
#pragma unroll
            for (int r = 0; r < 16; ++r) o[b][r] *= corr; }
    float ps = 0.f;
#pragma unroll
    for (int u = 0; u < 2; ++u)
#pragma unroll
        for (int r = 0; r < 16; ++r) { sacc[u][r] = __builtin_amdgcn_exp2f(sacc[u][r] - mref); ps += sacc[u][r]; }
    l_run += ps;
#pragma unroll
    for (int u = 0; u < 2; ++u)
#pragma unroll
        for (int s2 = 0; s2 < 2; ++s2) { const bf16x8 pf = __builtin_bit_cast(bf16x8, (u32x4){cvt_pk_bf16(sacc[u][8 * s2 + 0], sacc[u][8 * s2 + 1]), cvt_pk_bf16(sacc[u][8 * s2 + 2], sacc[u][8 * s2 + 3]), cvt_pk_bf16(sacc[u][8 * s2 + 4], sacc[u][8 * s2 + 5]), cvt_pk_bf16(sacc[u][8 * s2 + 6], sacc[u][8 * s2 + 7])});
#pragma unroll
            for (int b = 0; b < NVB; ++b) { const LAS unsigned char* vp = vb + ((32 * b + col) * VP + 32 * u + 16 * s2 + 4 * hi) * 2;
                const u32x2 lo = *(const LAS u32x2*)vp, hh = *(const LAS u32x2*)(vp + 16);
                o[b] = __builtin_amdgcn_mfma_f32_32x32x16_bf16(__builtin_bit_cast(bf16x8, (u32x4){lo.x, lo.y, hh.x, hh.y}), pf, o[b], 0, 0, 0); } }
}

template <int NKS, int KP, int VP, class MaskF>
__device__ __forceinline__ void att_step64(const LAS unsigned char* kb, const LAS unsigned char* vb, const bf16x8 (&qf)[NKS], f32x16 (&o)[2], float& m_run, float& l_run, float scale2, bool use_mask, const MaskF& mask, int col, int hi) {
    att_step64n<NKS, KP, VP, 2>(kb, vb, qf, o, m_run, l_run, scale2, use_mask, mask, col, hi);
}

constexpr int SK_KP = 72, SK_VP = 132;
constexpr int SK_KB = 128 * SK_KP * 2, SK_VB = 64 * SK_VP * 2, SK_VOFF = 2 * SK_KB, SK_MOFF = SK_VOFF + 2 * SK_VB;
template <int MODE>
__device__ __forceinline__ void sel_unit(LAS unsigned char* lds, const bf16* U2, const bf16* VTS, const unsigned* SM, const bf16* OCMP, bf16* OWIN, bf16* ABR, int g, int qblk, int tid, int wave, int lane) {
    const int col = lane & 31, hi = lane >> 5;
    const int tl = 8 * wave + (col >> 2), t = 64 * qblk + tl, head = 4 * g + (col & 3);
    LAS unsigned* smask = (LAS unsigned*)(lds + SK_MOFF);
    __syncthreads();
    if (MODE == 0) smask[tid] = SM[(size_t)((64 * qblk + (tid >> 3)) * 2 + g) * 8 + (tid & 7)];
    bf16x8 qf[4];
    { const bf16* qp = U2 + (size_t)t * U2W + U2_Q + head * 64;
#pragma unroll
      for (int s = 0; s < 4; ++s) qf[s] = *(const bf16x8*)(qp + 16 * s + 8 * hi); }
    f32x16 o[2];
#pragma unroll
    for (int b = 0; b < 2; ++b)
#pragma unroll
        for (int r = 0; r < 16; ++r) o[b][r] = 0.f;
    float m_run = -INFINITY, l_run = 0.f;
    const float scale2 = 1.0f;
    const int jlo = (MODE == 1 && qblk > 8) ? qblk - 8 : 0;
    const int st0 = jlo >> 1, st1 = (qblk >> 1) + 1;
    const int kvsel = (MODE == 1) ? 4 : 2;
    const bf16* kg[2]; unsigned kl[2]; const bf16* vg[2]; unsigned vl[2];
#pragma unroll
    for (int i = 0; i < 2; ++i) { const int c = tid + 512 * i; { const int row = c >> 3, p = c & 7; kg[i] = U2 + (size_t)row * U2W + U2_KV + (kvsel * 2 + g) * 64 + 8 * p; kl[i] = (unsigned)(row * SK_KP + 8 * p) * 2u; }
        { const int row = c >> 4, p = c & 15; vg[i] = VTS + (size_t)(g * 64 + row) * S + 8 * p; vl[i] = (unsigned)(row * SK_VP + 8 * p) * 2u; } }
    u32x4 kr[2], vr[2];
    auto gload = [&](int step) { const int key0 = 128 * step;
#pragma unroll
        for (int i = 0; i < 2; ++i) { kr[i] = *(const u32x4*)(kg[i] + (size_t)key0 * U2W); vr[i] = *(const u32x4*)(vg[i] + key0); } };
    gload(st0);
#pragma unroll 1
    for (int st = st0; st < st1; ++st) {
        const int buf = st & 1;
        LAS unsigned char* kb = lds + buf * SK_KB; LAS unsigned char* vb = lds + SK_VOFF + buf * SK_VB;
#pragma unroll
        for (int i = 0; i < 2; ++i) { *(LAS u32x4*)(kb + kl[i]) = kr[i]; *(LAS u32x2*)(vb + vl[i]) = (u32x2){vr[i].x, vr[i].y}; *(LAS u32x2*)(vb + vl[i] + 8) = (u32x2){vr[i].z, vr[i].w}; }
        __syncthreads();
        if (st + 1 < st1) gload(st + 1);
#pragma unroll
        for (int h = 0; h < 2; ++h) { const int j = 2 * st + h;
            bool sel = (j >= jlo) && (j <= qblk);
            if (MODE == 0) sel = sel && selmask_test(smask + tl * 8, j);
            if (__any(sel)) { const int key0 = 64 * j; const bool diag = (j == qblk), first = (MODE == 1) && (j == qblk - 8);
                auto mask = [&](int u, int r) { const int key = key0 + 32 * u + crow(r, hi); return sel && (!diag || key <= t) && (!first || key > t - 512); };
                att_step64<4, SK_KP, SK_VP>(kb + h * 64 * SK_KP * 2, vb + h * 128, qf, o, m_run, l_run, scale2, MODE == 0 || diag || first, mask, col, hi); } }
    }
    const float l = l_run + __shfl_xor(l_run, 32); const float inv = l > 0.f ? 1.0f / l : 0.f;
    if (MODE == 1) {
#pragma unroll
        for (int b = 0; b < 2; ++b)
#pragma unroll
            for (int i = 0; i < 4; ++i) store4_bf16(OWIN + (size_t)t * 512 + head * 64 + 32 * b + 8 * i + 4 * hi, (f32x4){o[b][4 * i] * inv, o[b][4 * i + 1] * inv, o[b][4 * i + 2] * inv, o[b][4 * i + 3] * inv});
    } else {
        const bf16* gp = U2 + (size_t)t * U2W + U2_G + head * 3;
        const float s0 = sigmoidf_(bf2f(gp[0])), s1 = sigmoidf_(bf2f(gp[1])) * inv, s2g = sigmoidf_(bf2f(gp[2]));
#pragma unroll
        for (int b = 0; b < 2; ++b)
#pragma unroll
            for (int i = 0; i < 4; ++i) { const int dv = 32 * b + 8 * i + 4 * hi; const size_t off = (size_t)t * 512 + head * 64 + dv; const u32x2 oc = *(const u32x2*)(OCMP + off), ow = *(const u32x2*)(OWIN + off);
                f32x4 r; r[0] = s0 * bflo(oc.x) + s1 * o[b][4 * i] + s2g * bflo(ow.x); r[1] = s0 * bfhi(oc.x) + s1 * o[b][4 * i + 1] + s2g * bfhi(ow.x);
                r[2] = s0 * bflo(oc.y) + s1 * o[b][4 * i + 2] + s2g * bflo(ow.y); r[3] = s0 * bfhi(oc.y) + s1 * o[b][4 * i + 3] + s2g * bfhi(ow.y);
                store4_bf16(ABR + (size_t)t * D + head * 64 + dv, r); }
    }
}

__device__ __forceinline__ void cmp_unit(LAS unsigned char* lds, const bf16* U2, const bf16* KC, const bf16* VCT, bf16* OCMP, float* SC, int g, int qblk, int tid, int wave, int lane) {
    const int col = lane & 31, hi = lane >> 5;
    const int tl = 8 * wave + (col >> 2), t = 64 * qblk + tl, head = 4 * g + (col & 3);
    __syncthreads();
    bf16x8 qf[4];
    { const bf16* qp = U2 + (size_t)t * U2W + U2_Q + head * 64;
#pragma unroll
      for (int s = 0; s < 4; ++s) qf[s] = *(const bf16x8*)(qp + 16 * s + 8 * hi); }
    f32x16 o[2];
#pragma unroll
    for (int b = 0; b < 2; ++b)
#pragma unroll
        for (int r = 0; r < 16; ++r) o[b][r] = 0.f;
    float m_run = -INFINITY, l_run = 0.f;
    const float scale2 = 1.0f;
    const int nst = (4 * qblk + 3 + 127) >> 7;
    const int twmax = 64 * qblk + 8 * wave + 7; const int cw = (twmax >= 31) ? ((twmax - 31) >> 4) : -1;
    const int call = (64 * qblk >= 31) ? ((64 * qblk - 31) >> 4) : -1;
    const bf16* kg[2]; unsigned kl[2]; const bf16* vg[2]; unsigned vl[2];
#pragma unroll
    for (int i = 0; i < 2; ++i) { const int c = tid + 512 * i; { const int row = c >> 3, p = c & 7; kg[i] = KC + (size_t)(g * 1024 + row) * 64 + 8 * p; kl[i] = (unsigned)(row * SK_KP + 8 * p) * 2u; }
        { const int row = c >> 4, p = c & 15; vg[i] = VCT + (size_t)(g * 64 + row) * 1024 + 8 * p; vl[i] = (unsigned)(row * SK_VP + 8 * p) * 2u; } }
    u32x4 kr[2], vr[2];
#pragma unroll
    for (int i = 0; i < 2; ++i) { kr[i] = *(const u32x4*)kg[i]; vr[i] = *(const u32x4*)vg[i]; }
#pragma unroll 1
    for (int st = 0; st < nst; ++st) {
        const int buf = st & 1;
        LAS unsigned char* kb = lds + buf * SK_KB; LAS unsigned char* vb = lds + SK_VOFF + buf * SK_VB;
#pragma unroll
        for (int i = 0; i < 2; ++i) { *(LAS u32x4*)(kb + kl[i]) = kr[i]; *(LAS u32x2*)(vb + vl[i]) = (u32x2){vr[i].x, vr[i].y}; *(LAS u32x2*)(vb + vl[i] + 8) = (u32x2){vr[i].z, vr[i].w}; }
        __syncthreads();
        if (st + 1 < nst) {
#pragma unroll
            for (int i = 0; i < 2; ++i) { kr[i] = *(const u32x4*)(kg[i] + (size_t)128 * (st + 1) * 64); vr[i] = *(const u32x4*)(vg[i] + 128 * (st + 1)); } }
#pragma unroll
        for (int h = 0; h < 2; ++h) { const int c0 = 128 * st + 64 * h;
            if (c0 <= cw) { auto mask = [&](int u, int r) { return 16 * (c0 + 32 * u + crow(r, hi)) + 31 <= t; };
                att_step64<4, SK_KP, SK_VP>(kb + h * 64 * SK_KP * 2, vb + h * 128, qf, o, m_run, l_run, scale2, c0 + 63 > call, mask, col, hi); } }
    }
    const float l = l_run + __shfl_xor(l_run, 32); const float inv = l > 0.f ? 1.0f / l : 0.f;
#pragma unroll
    for (int b = 0; b < 2; ++b)
#pragma unroll
        for (int i = 0; i < 4; ++i) store4_bf16(OCMP + (size_t)t * 512 + head * 64 + 32 * b + 8 * i + 4 * hi, (f32x4){o[b][4 * i] * inv, o[b][4 * i + 1] * inv, o[b][4 * i + 2] * inv, o[b][4 * i + 3] * inv});
    const float mref = (m_run == -INFINITY) ? 0.f : m_run;
    float* dst = SC + (size_t)(t * 2 + g) * 256;
    float carry = 0.f;
    __syncthreads();
#pragma unroll
    for (int i = 0; i < 2; ++i) kr[i] = *(const u32x4*)kg[i];
#pragma unroll 1
    for (int st = 0; st < nst; ++st) {
        const int buf = st & 1; LAS unsigned char* kb = lds + buf * SK_KB;
#pragma unroll
        for (int i = 0; i < 2; ++i) *(LAS u32x4*)(kb + kl[i]) = kr[i];
        __syncthreads();
        if (st + 1 < nst) {
#pragma unroll
            for (int i = 0; i < 2; ++i) kr[i] = *(const u32x4*)(kg[i] + (size_t)128 * (st + 1) * 64); }
#pragma unroll
        for (int q4 = 0; q4 < 4; ++q4) { const int T = 4 * st + q4; float sv[4];
            if (32 * T <= cw) {
                const LAS unsigned char* kt = kb + q4 * 32 * SK_KP * 2;
                f32x16 sacc;
#pragma unroll
                for (int r = 0; r < 16; ++r) sacc[r] = 0.f;
#pragma unroll
                for (int s = 0; s < 4; ++s) { const bf16x8 kf = *(const LAS bf16x8*)(kt + (col * SK_KP + 16 * s + 8 * hi) * 2); sacc = __builtin_amdgcn_mfma_f32_32x32x16_bf16(kf, qf[s], sacc, 0, 0, 0); }
                float Gs[4], Es[4];
#pragma unroll
                for (int i = 0; i < 4; ++i) { float p[4];
#pragma unroll
                    for (int q = 0; q < 4; ++q) { const int r = 4 * i + q; const int c = 32 * T + crow(r, hi); p[q] = (16 * c + 31 <= t) ? __builtin_amdgcn_exp2f(sacc[r] * scale2 - mref) * inv : 0.f; }
                    Gs[i] = (p[0] + p[1]) + (p[2] + p[3]); Es[i] = p[3]; }
#pragma unroll
                for (int i = 0; i < 4; ++i) { Gs[i] += lane_xor1(Gs[i]); Gs[i] += lane_xor2(Gs[i]); Es[i] += lane_xor1(Es[i]); Es[i] += lane_xor2(Es[i]); }
                float eo[4];
#pragma unroll
                for (int i = 0; i < 4; ++i) eo[i] = lane_xor32(Es[i], hi);
                if (hi) { sv[0] = Gs[0] + eo[0]; sv[1] = Gs[1] + eo[1]; sv[2] = Gs[2] + eo[2]; sv[3] = Gs[3] + eo[3]; }
                else { sv[0] = Gs[0] + carry; sv[1] = Gs[1] + eo[0]; sv[2] = Gs[2] + eo[1]; sv[3] = Gs[3] + eo[2]; }
                carry = eo[3];
            } else { sv[0] = hi ? 0.f : carry; sv[1] = 0.f; sv[2] = 0.f; sv[3] = 0.f; carry = 0.f; }
            if ((col & 3) == 0) {
#pragma unroll
                for (int i = 0; i < 4; ++i) dst[8 * T + 2 * i + hi] = sv[i]; } }
    }
#pragma unroll 1
    for (int T = 4 * nst; T < 32; ++T) {
        if ((col & 3) == 0) { dst[8 * T + hi] = (hi || T != 4 * nst) ? 0.f : carry; dst[8 * T + 2 + hi] = 0.f; dst[8 * T + 4 + hi] = 0.f; dst[8 * T + 6 + hi] = 0.f; } }
}

struct Sel16 { bf16x8 qf[2]; f32x4 o[4]; float m_run, l_run; };
template <int VP>
__device__ __forceinline__ void att16_block(const LAS unsigned char* kb, const LAS unsigned char* vb, Sel16& st, int lim, int c16, int G) {
    bf16x8 kf[4][2]; u32x2 vlo[2][4], vhi[2][4];
#pragma unroll
    for (int kt = 0; kt < 4; ++kt) { const LAS unsigned char* kp = kb + ((16 * kt + c16) * SK_KP + 8 * G) * 2; kf[kt][0] = *(const LAS bf16x8*)kp; kf[kt][1] = *(const LAS bf16x8*)(kp + 64); }
#pragma unroll
    for (int u = 0; u < 2; ++u)
#pragma unroll
        for (int d = 0; d < 4; ++d) { const LAS unsigned char* vp = vb + ((16 * d + c16) * VP + 32 * u + 4 * G) * 2; vlo[u][d] = *(const LAS u32x2*)vp; vhi[u][d] = *(const LAS u32x2*)(vp + 32); }
    __builtin_amdgcn_sched_barrier(0);
    f32x4 acc[4];
#pragma unroll
    for (int kt = 0; kt < 4; ++kt) acc[kt] = __builtin_amdgcn_mfma_f32_16x16x32_bf16(kf[kt][0], st.qf[0], (f32x4){0.f, 0.f, 0.f, 0.f}, 0, 0, 0);
#pragma unroll
    for (int kt = 0; kt < 4; ++kt) acc[kt] = __builtin_amdgcn_mfma_f32_16x16x32_bf16(kf[kt][1], st.qf[1], acc[kt], 0, 0, 0);
    float mt = -INFINITY;
#pragma unroll
    for (int kt = 0; kt < 4; ++kt)
#pragma unroll
        for (int i = 0; i < 4; ++i) { const float x = (16 * kt + i <= lim) ? acc[kt][i] : -INFINITY; acc[kt][i] = x; mt = fmaxf(mt, x); }
    mt = xmax32(xmax16(mt));
    const float m_new = fmaxf(st.m_run, mt); const float mref = (m_new == -INFINITY) ? 0.f : m_new;
    if (__any(m_new != st.m_run)) { const float corr = __builtin_amdgcn_exp2f(st.m_run - mref); st.l_run *= corr; st.m_run = m_new;
#pragma unroll
        for (int d = 0; d < 4; ++d) st.o[d] = st.o[d] * corr; }
    float ps = 0.f;
#pragma unroll
    for (int kt = 0; kt < 4; ++kt)
#pragma unroll
        for (int i = 0; i < 4; ++i) { acc[kt][i] = __builtin_amdgcn_exp2f(acc[kt][i] - mref); ps += acc[kt][i]; }
    st.l_run += ps;
#pragma unroll
    for (int u = 0; u < 2; ++u) {
        const bf16x8 pf = __builtin_bit_cast(bf16x8, (u32x4){cvt_pk_bf16(acc[2 * u][0], acc[2 * u][1]), cvt_pk_bf16(acc[2 * u][2], acc[2 * u][3]), cvt_pk_bf16(acc[2 * u + 1][0], acc[2 * u + 1][1]), cvt_pk_bf16(acc[2 * u + 1][2], acc[2 * u + 1][3])});
#pragma unroll
        for (int d = 0; d < 4; ++d) st.o[d] = __builtin_amdgcn_mfma_f32_16x16x32_bf16(__builtin_bit_cast(bf16x8, (u32x4){vlo[u][d].x, vlo[u][d].y, vhi[u][d].x, vhi[u][d].y}), pf, st.o[d], 0, 0, 0); }
}
constexpr int S16_NB = 4;
constexpr int S16_VP = S16_NB * 64 + 4;
constexpr int S16_KB = S16_NB * 64 * SK_KP * 2, S16_VB = 64 * S16_VP * 2, S16_VOFF = 2 * S16_KB, S16_MOFF = S16_VOFF + 2 * S16_VB;
static_assert(S16_MOFF + 2048 <= LDS_BYTES - 1536, "sel16 LDS map");
__device__ __forceinline__ void sel_unit16(LAS unsigned char* lds, const bf16* U2, const bf16* VTS, const unsigned* SM, const bf16* OCMP, const bf16* OWIN, bf16* ABR, int g, int qblk, int tid, int wave, int lane) {
    const int c16 = lane & 15, G = lane >> 4;
    const int head = 4 * g + (c16 & 3);
    LAS unsigned* smask = (LAS unsigned*)(lds + S16_MOFF);
    __syncthreads();
    smask[tid] = SM[(size_t)((64 * qblk + (tid >> 3)) * 2 + g) * 8 + (tid & 7)];
    Sel16 grp[2]; int tlg[2];
#pragma unroll
    for (int gi = 0; gi < 2; ++gi) { tlg[gi] = 8 * wave + 4 * gi + (c16 >> 2); const bf16* qp = U2 + (size_t)(64 * qblk + tlg[gi]) * U2W + U2_Q + head * 64 + 8 * G;
        grp[gi].qf[0] = *(const bf16x8*)qp; grp[gi].qf[1] = *(const bf16x8*)(qp + 32); grp[gi].m_run = -INFINITY; grp[gi].l_run = 0.f;
#pragma unroll
        for (int d = 0; d < 4; ++d) grp[gi].o[d] = (f32x4){0.f, 0.f, 0.f, 0.f}; }
    const float scale2 = 1.0f;
    const int st1 = qblk / S16_NB + 1;
    const bf16* Kb = U2 + U2_KV + (2 * 2 + g) * 64; const bf16* Vb = VTS + (size_t)(g * 64) * S;
    u32x4 kr[4], vr[4];
    auto gload = [&](int step) { int key0 = 64 * S16_NB * step; if (key0 + 64 * S16_NB > S) key0 = S - 64 * S16_NB;
        const bf16* kp = Kb + (size_t)key0 * U2W; const bf16* vp = Vb + key0; int t_ = tid; asm volatile("" : "+v"(t_));
#pragma unroll
        for (int i = 0; i < 4; ++i) { const int c = t_ + 512 * i; kr[i] = *(const u32x4*)(kp + (unsigned)((c >> 3) * U2W + 8 * (c & 7))); vr[i] = *(const u32x4*)(vp + (unsigned)((c >> 5) * S + 8 * (c & 31))); } };
    gload(0);
#pragma unroll 1
    for (int st = 0; st < st1; ++st) {
        const int buf = st & 1;
        LAS unsigned char* kb = lds + buf * S16_KB; LAS unsigned char* vb = lds + S16_VOFF + buf * S16_VB;
        { int t_ = tid; asm volatile("" : "+v"(t_));
#pragma unroll
          for (int i = 0; i < 4; ++i) { const int c = t_ + 512 * i; const unsigned kl_ = (unsigned)((c >> 3) * SK_KP + 8 * (c & 7)) * 2u, vl_ = (unsigned)((c >> 5) * S16_VP + 8 * (c & 31)) * 2u;
              *(LAS u32x4*)(kb + kl_) = kr[i]; *(LAS u32x2*)(vb + vl_) = (u32x2){vr[i].x, vr[i].y}; *(LAS u32x2*)(vb + vl_ + 8) = (u32x2){vr[i].z, vr[i].w}; } }
        __syncthreads();
        if (st + 1 < st1) gload(st + 1);
#pragma unroll
        for (int h = 0; h < S16_NB; ++h) { const int j = S16_NB * st + h;
            if (j <= qblk) {
#pragma unroll
                for (int gi = 0; gi < 2; ++gi) { const bool sel = selmask_test(smask + tlg[gi] * 8, j);
                    if (__any(sel)) { const int t = 64 * qblk + tlg[gi]; const int key0 = 64 * j; const bool diag = (j == qblk);
                        const int lim = !sel ? -1 : (diag ? t - key0 - 4 * G : 1 << 20);
                        att16_block<S16_VP>(kb + h * 64 * SK_KP * 2, vb + h * 128, grp[gi], lim, c16, G); } } } }
    }
#pragma unroll
    for (int gi = 0; gi < 2; ++gi) { const int t = 64 * qblk + tlg[gi];
        float l = grp[gi].l_run; l += __shfl_xor(l, 16); l += __shfl_xor(l, 32); const float inv = l > 0.f ? 1.0f / l : 0.f;
        const bf16* gp = U2 + (size_t)t * U2W + U2_G + head * 3;
        const float s0 = sigmoidf_(bf2f(gp[0])), s1 = sigmoidf_(bf2f(gp[1])) * inv, s2g = sigmoidf_(bf2f(gp[2]));
#pragma unroll
        for (int d = 0; d < 4; ++d) { const int dv = 16 * d + 4 * G; const size_t off = (size_t)t * 512 + head * 64 + dv; const u32x2 oc = *(const u32x2*)(OCMP + off), ow = *(const u32x2*)(OWIN + off);
            f32x4 r; r[0] = s0 * bflo(oc.x) + s1 * grp[gi].o[d][0] + s2g * bflo(ow.x); r[1] = s0 * bfhi(oc.x) + s1 * grp[gi].o[d][1] + s2g * bfhi(ow.x);
            r[2] = s0 * bflo(oc.y) + s1 * grp[gi].o[d][2] + s2g * bflo(ow.y); r[3] = s0 * bfhi(oc.y) + s1 * grp[gi].o[d][3] + s2g * bfhi(ow.y);
            store4_bf16(ABR + (size_t)t * D + head * 64 + dv, r); } }
}

struct LP {
    unsigned char* ws; unsigned char* wl; int l;
    __device__ __forceinline__ bf16* w(size_t off) const { return (bf16*)(wl + off); }
    __device__ __forceinline__ bf16* b(size_t off) const { return (bf16*)(ws + off); }
    __device__ __forceinline__ float* f(size_t off) const { return (float*)(ws + off); }
    __device__ __forceinline__ int* i(size_t off) const { return (int*)(ws + off); }
};
#define INF32(a, idx, per) ((const float*)(a).in[idx] + (size_t)l * (per))

#ifndef BPARTS
#define BPARTS 31
#endif
#ifndef DUPSUB
#define DUPSUB 0
#endif
#define SUBREP(bit) for (int srep_ = 0; srep_ < 1 + ((DUPSUB >> (bit)) & 1); ++srep_)
__device__ __forceinline__ void phase_prep(const Args& a, Frame& F, const LP& P) {
    const int l = P.l, lane = F.lane, tid = F.tid;
    const bf16* U2 = P.b(WS_U2); bf16* ABR = P.b(WS_ABR);
    if (BPARTS & 1) { const float* cw = INF32(a, 17, 31 * 512); const float* cb = INF32(a, 18, 512); const float* lg = INF32(a, 19, 512); const float* lb = INF32(a, 20, 512);
      LAS bf16* hb = (LAS bf16*)F.lds;
      LAS float* cs = (LAS float*)(F.lds + 65536);
      const int c = tid;
      float w[31];
#pragma unroll
      for (int k = 0; k < 31; ++k) w[k] = cw[k * 512 + c];
      const float bias = cb[c];
#pragma unroll 1
      for (int tile = blockIdx.x; tile < S / 32; tile += F.G) { const int t0 = tile * 32;
          { u32x4 av[8], gv[8];
#pragma unroll
            for (int i = 0; i < 8; ++i) { const int item = tid + 512 * i, r = item >> 6, ch = (item & 63) * 8; int tok = t0 - 30 + r; tok = tok < 0 ? 0 : tok;
                const bf16* up = U2 + (size_t)tok * U2W + U2_CONV + ch;
                if (r < 62) { av[i] = *(const u32x4*)up; gv[i] = *(const u32x4*)(up + 512); } else { av[i] = (u32x4){0u, 0u, 0u, 0u}; gv[i] = av[i]; } }
#pragma unroll
            for (int i = 0; i < 8; ++i) { const int item = tid + 512 * i, r = item >> 6, ch = (item & 63) * 8; const bool ok = (t0 - 30 + r) >= 0;
                u32x4 o;
#pragma unroll
                for (int q = 0; q < 4; ++q) { const float h0 = bflo(av[i][q]) * sigmoidf_(bflo(gv[i][q])), h1 = bfhi(av[i][q]) * sigmoidf_(bfhi(gv[i][q])); o[q] = ok ? cvt_pk_bf16(h0, h1) : 0u; }
                if (r < 62) *(LAS u32x4*)(hb + r * 512 + ch) = o; } }
          __syncthreads();
          float hreg[62];
#pragma unroll
          for (int r = 0; r < 62; ++r) hreg[r] = bf2f(hb[r * 512 + c]);
#pragma unroll
          for (int i = 0; i < 32; ++i) { float acc = bias;
#pragma unroll
              for (int k = 0; k < 31; ++k) acc += w[k] * hreg[i + k];
              cs[i * 512 + c] = acc; }
          __syncthreads();
#pragma unroll
          for (int q = 0; q < 4; ++q) { const int tt = 4 * F.wave + q; float v[8]; float s = 0.f;
#pragma unroll
              for (int j = 0; j < 8; ++j) { v[j] = cs[tt * 512 + lane + 64 * j]; s += v[j]; }
              const float mean = wave_sum(s) * (1.0f / 512.0f); float qq = 0.f;
#pragma unroll
              for (int j = 0; j < 8; ++j) { v[j] -= mean; qq += v[j] * v[j]; }
              const float rstd = 1.0f / sqrtf(wave_sum(qq) * (1.0f / 512.0f) + 1e-5f);
#pragma unroll
              for (int j = 0; j < 8; ++j) { const int ch = lane + 64 * j; const float y = v[j] * rstd * lg[ch] + lb[ch]; ABR[(size_t)(t0 + tt) * D + 1536 + ch] = f2bf(y * sigmoidf_(y)); } }
          __syncthreads(); } }
    if (BPARTS & 2) { float* rq = P.f(WS_RSTD); float* rkv = rq + S;
      const int sub = lane >> 4, l16 = lane & 15;
#pragma unroll 1
      for (int t0 = 4 * F.gw; t0 < S; t0 += 4 * F.NGW) { const int t = t0 + sub; const bf16* row = U2 + (size_t)t * U2W;
          const u32x4 a0 = *(const u32x4*)(row + U2_CQ + 8 * l16), a1 = *(const u32x4*)(row + U2_CQ + 8 * l16 + 128), a2 = *(const u32x4*)(row + U2_CQ + 8 * l16 + 256), a3 = *(const u32x4*)(row + U2_CQ + 8 * l16 + 384);
          const u32x4 c0 = *(const u32x4*)(row + U2_CKV + 8 * l16), c1 = *(const u32x4*)(row + U2_CKV + 8 * l16 + 128);
          float s = 0.f, s2 = 0.f;
#pragma unroll
          for (int q = 0; q < 4; ++q) { float x; x = bflo(a0[q]); s += x * x; x = bfhi(a0[q]); s += x * x; x = bflo(a1[q]); s += x * x; x = bfhi(a1[q]); s += x * x;
              x = bflo(a2[q]); s += x * x; x = bfhi(a2[q]); s += x * x; x = bflo(a3[q]); s += x * x; x = bfhi(a3[q]); s += x * x;
              x = bflo(c0[q]); s2 += x * x; x = bfhi(c0[q]); s2 += x * x; x = bflo(c1[q]); s2 += x * x; x = bfhi(c1[q]); s2 += x * x; }
#pragma unroll
          for (int o = 0; o < 1; ++o) { s = row16_sum(s); s2 = row16_sum(s2); }
          if (l16 == 0) { rq[t] = 1.0f / sqrtf(s * (1.0f / 512.0f) + 1e-6f); rkv[t] = 1.0f / sqrtf(s2 * (1.0f / 256.0f) + 1e-6f); } }
#pragma unroll 1
      for (int r0 = 8 * F.gw; r0 < S; r0 += 8 * F.NGW) { const int w = 2 << (lane >> 4); const bf16* col = U2 + U2_POOL + 8 * lane;
          float sum[8];
#pragma unroll
          for (int q = 0; q < 8; ++q) sum[q] = 0.f;
          for (int i = 1; i < w; ++i) { const int tt = r0 - i; if (tt >= 0) { const u32x4 v = *(const u32x4*)(col + (size_t)tt * U2W);
#pragma unroll
              for (int q = 0; q < 4; ++q) { sum[2 * q] += bflo(v[q]); sum[2 * q + 1] += bfhi(v[q]); } } }
#pragma unroll
          for (int k = 0; k < 8; ++k) { const int t = r0 + k; const u32x4 v = *(const u32x4*)(col + (size_t)t * U2W);
              const int to = t - w + 1; u32x4 vo = (u32x4){0u, 0u, 0u, 0u}; if (to >= 0) vo = *(const u32x4*)(col + (size_t)to * U2W);
              const int cnt = (t + 1 < w) ? (t + 1) : w; const float ic = 1.0f / (float)cnt; u32x4 o;
#pragma unroll
              for (int q = 0; q < 4; ++q) { sum[2 * q] += bflo(v[q]); sum[2 * q + 1] += bfhi(v[q]);
                  o[q] = cvt_pk_bf16(sum[2 * q] * ic - bflo(v[q]), sum[2 * q + 1] * ic - bfhi(v[q]));
                  sum[2 * q] -= bflo(vo[q]); sum[2 * q + 1] -= bfhi(vo[q]); }
              *(u32x4*)(ABR + (size_t)t * D + 512 + 8 * lane) = o; } } }
    if (BPARTS & 4) { LAS bf16* scr = (LAS bf16*)(F.lds + 65536 + F.wave * 8448);
#pragma unroll 1
      for (int it = F.gw; it < 2 * 2 * (S / 64); it += F.NGW) { const int tt = it % (S / 64), g = (it / (S / 64)) & 1, which = it / (2 * (S / 64));
          const bf16* src = U2 + (size_t)(tt * 64) * U2W + U2_KV + ((which ? 5 : 3) * 2 + g) * 64;
          bf16* dst = P.b(which ? WS_VTWIN : WS_VTSEL) + (size_t)(g * 64) * S + tt * 64;
          transpose_tile64(src, U2W, dst, S, scr, lane); } }
    if (BPARTS & 8) { bf16* HID = P.b(WS_HID); const float* b1c = (const float*)(P.wl + WO_B1C);
#pragma unroll 1
      for (int it = F.gw; it < 4 * 64 * 8; it += F.NGW) { const int nt = it & 7, mt = (it >> 3) & 63, jg = it >> 9, j = jg >> 1, g = jg & 1;
          const bf16* Ab = U2 + U2_KV + (j * 2 + g) * 64; const bf16* Bb = P.w(WO_W1C) + (size_t)j * 128 * 2048;
          auto ap = [&](int r, int k) { int n = 16 * mt + r; n = n > 1022 ? 1022 : n; return Ab + (size_t)(16 * n + (k >> 6)) * U2W + (k & 63); };
          auto bp = [&](int r, int k) { return Bb + (size_t)(16 * nt + r) * 2048 + k; };
          const f32x4 acc = sgemm16(ap, bp, 2048, lane);
          const int h = 16 * nt + (lane & 15); const float bb = b1c[j * 128 + h];
#pragma unroll
          for (int i = 0; i < 4; ++i) { const int n = 16 * mt + 4 * (lane >> 4) + i; HID[((size_t)jg * 1024 + n) * 128 + h] = f2bf(gelu_tanh(acc[i] + bb)); } } }
}
__device__ __forceinline__ void memkv_items(const LP& P, int first, int nw, int lane) {
    const int l = P.l; const bf16* MEMB = P.b(WS_MEMB); bf16* KX = P.b(WS_KX) + (size_t)l * 256 * 512; bf16* VXT = P.b(WS_VXT) + (size_t)l * 512 * 256;
#pragma unroll 1
    for (int it = first; it < 1024; it += nw) {
        if (it < 512) { const int mt = it >> 5, nt = it & 31;
            auto ap = [&](int r, int k) { return MEMB + (size_t)(16 * mt + r) * D + k; };
            auto bp = [&](int r, int k) { return P.w(WO_WXK) + (size_t)(16 * nt + r) * D + k; };
            const f32x4 acc = sgemm16(ap, bp, D, lane);
#pragma unroll
            for (int i = 0; i < 4; ++i) KX[(size_t)(16 * mt + 4 * (lane >> 4) + i) * 512 + 16 * nt + (lane & 15)] = f2bf(acc[i]);
        } else { const int q = it - 512, mt = q >> 4, nt = q & 15;
            auto ap = [&](int r, int k) { return P.w(WO_WXV) + (size_t)(16 * mt + r) * D + k; };
            auto bp = [&](int r, int k) { return MEMB + (size_t)(16 * nt + r) * D + k; };
            const f32x4 acc = sgemm16(ap, bp, D, lane);
#pragma unroll
            for (int i = 0; i < 4; ++i) VXT[(size_t)(16 * mt + 4 * (lane >> 4) + i) * 256 + 16 * nt + (lane & 15)] = f2bf(acc[i]); } }
}

__device__ __forceinline__ void phase_compress2(Frame& F, const LP& P) {
    const int lane = F.lane; const bf16* HID = P.b(WS_HID); const bf16* W2 = P.w(WO_W2C);
#pragma unroll 1
    for (int it = F.gw; it < 1024; it += F.NGW) {
        if (it < 512) { const int nt = it & 3, mt = (it >> 2) & 63, g = it >> 8;
            auto ap = [&](int r, int k) { return HID + ((size_t)(0 * 2 + g) * 1024 + 16 * mt + r) * 128 + k; };
            auto bp = [&](int r, int k) { return W2 + (size_t)(16 * nt + r) * 128 + k; };
            const f32x4 acc = sgemm16(ap, bp, 128, lane);
#pragma unroll
            for (int i = 0; i < 4; ++i) P.b(WS_KC)[((size_t)g * 1024 + 16 * mt + 4 * (lane >> 4) + i) * 64 + 16 * nt + (lane & 15)] = f2bf(acc[i]);
        } else { const int q = it - 512, nt = q & 63, mt = (q >> 6) & 3, g = q >> 8;
            auto ap = [&](int r, int k) { return W2 + (size_t)64 * 128 + (size_t)(16 * mt + r) * 128 + k; };
            auto bp = [&](int r, int k) { return HID + ((size_t)(1 * 2 + g) * 1024 + 16 * nt + r) * 128 + k; };
            const f32x4 acc = sgemm16(ap, bp, 128, lane);
#pragma unroll
            for (int i = 0; i < 4; ++i) P.b(WS_VCT)[((size_t)g * 64 + 16 * mt + 4 * (lane >> 4) + i) * 1024 + 16 * nt + (lane & 15)] = f2bf(acc[i]); } }
}

__device__ __forceinline__ void phase_d(Frame& F, const LP& P) {
    const int lane = F.lane;
    { const bf16* KVH = P.b(WS_KVH); const bf16* U2 = P.b(WS_U2); bf16* KR = P.b(WS_KM); const f32x2* rope = (const f32x2*)(P.ws + WS_ROPE);
#pragma unroll 1
      for (int i = F.gw * 64 + lane; i < S * 8; i += F.NGW * 64) { const int t = i >> 3, k = 2 * (i & 7);
          const bf16* kr = U2 + (size_t)t * U2W + U2_KR;
          const unsigned a = *(const unsigned*)(kr + k), b = *(const unsigned*)(kr + 16 + k); const f32x4 cs = *(const f32x4*)(rope + (size_t)t * 16 + k);
          const float x10 = bflo(a), x11 = bfhi(a), x20 = bflo(b), x21 = bfhi(b);
          *(unsigned*)(KR + (size_t)t * 32 + k) = cvt_pk_bf16(x10 * cs[0] - x20 * cs[1], x11 * cs[2] - x21 * cs[3]);
          *(unsigned*)(KR + (size_t)t * 32 + 16 + k) = cvt_pk_bf16(x20 * cs[0] + x10 * cs[1], x21 * cs[2] + x11 * cs[3]); }
      LAS bf16* scr = (LAS bf16*)(F.lds + F.wave * 8448);
#pragma unroll 1
      for (int it = F.gw; it < 8 * (S / 64); it += F.NGW) { const int tt = it % (S / 64), hd = it / (S / 64);
          transpose_tile64(KVH + (size_t)(tt * 64) * 1024 + hd * 128 + 64, 1024, P.b(WS_VTM) + (size_t)(hd * 64) * S + tt * 64, S, scr, lane); } }
    __syncthreads();
    SUBREP(3)
#pragma unroll 1
    for (int i = blockIdx.x; i < 512; i += F.G) { const int r = i >> 8, p = i & 255; const int qb = r ? 255 - (p >> 1) : (p >> 1);
        cmp_unit(F.lds, P.b(WS_U2), P.b(WS_KC), P.b(WS_VCT), P.b(WS_OCMP), P.f(WS_SCORES), p & 1, qb, F.tid, F.wave, lane); }
}


constexpr int MK_KP = 104, MK_VP = 132;
constexpr int MK_KB = 128 * MK_KP * 2, MK_VB = 64 * MK_VP * 2, MK_VOFF = 2 * MK_KB;
__device__ __forceinline__ void mla_unit(LAS unsigned char* lds, const bf16* Q, const bf16* KVH, const bf16* KR, const bf16* Vt, bf16* O, int hd, int qb, int tid, int wave, int lane) {
    const int col = lane & 31, hi = lane >> 5;
    const int q0 = qb * 256 + wave * 32;
    bf16x8 qf[6];
    { const bf16* qp = Q + (size_t)(q0 + col) * 768 + hd * 96;
#pragma unroll
      for (int s = 0; s < 6; ++s) qf[s] = *(const bf16x8*)(qp + 16 * s + 8 * hi); }
    f32x16 o[2];
#pragma unroll
    for (int b = 0; b < 2; ++b)
#pragma unroll
        for (int r = 0; r < 16; ++r) o[b][r] = 0.f;
    float m_run = -INFINITY, l_run = 0.f;
    const int nt = 2 * (qb + 1);
    const bf16* kg[3]; unsigned kl[3]; int kst[3]; const bf16* vg[2]; unsigned vl[2];
#pragma unroll
    for (int i = 0; i < 3; ++i) { const int c = tid + 512 * i, row = c / 12, p = c % 12; const bool nope = p < 8; kst[i] = nope ? 1024 : 32;
        kg[i] = nope ? KVH + (size_t)row * 1024 + hd * 128 + 8 * p : KR + (size_t)row * 32 + 8 * (p - 8); kl[i] = (unsigned)(row * MK_KP + 8 * p) * 2u; }
#pragma unroll
    for (int i = 0; i < 2; ++i) { const int c = tid + 512 * i, row = c >> 4, p = c & 15; vg[i] = Vt + (size_t)(hd * 64 + row) * S + 8 * p; vl[i] = (unsigned)(row * MK_VP + 8 * p) * 2u; }
    u32x4 kr[3], vr[2];
#pragma unroll
    for (int i = 0; i < 3; ++i) kr[i] = *(const u32x4*)kg[i];
#pragma unroll
    for (int i = 0; i < 2; ++i) vr[i] = *(const u32x4*)vg[i];
#pragma unroll 1
    for (int t = 0; t < nt; ++t) {
        const int buf = t & 1; const int key0 = 128 * t;
        LAS unsigned char* kb = lds + buf * MK_KB; LAS unsigned char* vb = lds + MK_VOFF + buf * MK_VB;
#pragma unroll
        for (int i = 0; i < 3; ++i) *(LAS u32x4*)(kb + kl[i]) = kr[i];
#pragma unroll
        for (int i = 0; i < 2; ++i) { *(LAS u32x2*)(vb + vl[i]) = (u32x2){vr[i].x, vr[i].y}; *(LAS u32x2*)(vb + vl[i] + 8) = (u32x2){vr[i].z, vr[i].w}; }
        __syncthreads();
        if (t + 1 < nt) {
#pragma unroll
            for (int i = 0; i < 3; ++i) kr[i] = *(const u32x4*)(kg[i] + (size_t)(key0 + 128) * kst[i]);
#pragma unroll
            for (int i = 0; i < 2; ++i) vr[i] = *(const u32x4*)(vg[i] + key0 + 128); }
#pragma unroll
        for (int h = 0; h < 2; ++h) { const int k0h = key0 + 64 * h;
            if (k0h <= q0 + 31) { auto mask = [&](int u, int r) { return k0h + 32 * u + crow(r, hi) <= q0 + col; };
                att_step64<6, MK_KP, MK_VP>(kb + h * 64 * MK_KP * 2, vb + h * 128, qf, o, m_run, l_run, 1.0f, k0h + 63 > q0, mask, col, hi); } }
    }
    const float l = l_run + __shfl_xor(l_run, 32); const float inv = l > 0.f ? 1.0f / l : 0.f;
    bf16* op = O + (size_t)(q0 + col) * D + 1024 + hd * 64;
#pragma unroll
    for (int b = 0; b < 2; ++b)
#pragma unroll
        for (int i = 0; i < 4; ++i) store4_bf16(op + 32 * b + 8 * i + 4 * hi, (f32x4){o[b][4 * i] * inv, o[b][4 * i + 1] * inv, o[b][4 * i + 2] * inv, o[b][4 * i + 3] * inv});
}

#define MLA_SB __builtin_amdgcn_sched_barrier(0)
template <bool HAS_NEXT, bool FINISH = true>
__device__ __forceinline__ void mla_stage1(const LAS unsigned char* kbn, const bf16x8 (&qf)[6], f32x16& cur, f32x16& nxt, bf16x8 (&pf)[2], float mref, float& l_run, int col, int hi) {
    const LAS unsigned char* kp0 = kbn + (col * MK_KP + 8 * hi) * 2;
    bf16x8 kf[6];
    if (HAS_NEXT) {
#pragma unroll
        for (int c = 0; c < 6; ++c) kf[c] = *(const LAS bf16x8*)(kp0 + 32 * c); }
    float ps = 0.f;
    MLA_SB;
#pragma unroll
    for (int c = 0; c < 6; ++c) {
        const int e0 = (16 * c + 5) / 6, e1 = (16 * (c + 1) + 5) / 6;
        if (FINISH) {
#pragma unroll
            for (int r = e0; r < e1; ++r) { const float pe = __builtin_amdgcn_exp2f(cur[r] - mref); cur[r] = pe; ps += pe; }
            asm volatile("" : "+v"(ps));
            if (c == 3) pf[0] = __builtin_bit_cast(bf16x8, (u32x4){cvt_pk_bf16(cur[0], cur[1]), cvt_pk_bf16(cur[2], cur[3]), cvt_pk_bf16(cur[4], cur[5]), cvt_pk_bf16(cur[6], cur[7])}); }
        if (HAS_NEXT) {
            if (c == 0) { f32x16 z;
#pragma unroll
                for (int r = 0; r < 16; ++r) z[r] = 0.f;
                nxt = __builtin_amdgcn_mfma_f32_32x32x16_bf16(kf[0], qf[0], z, 0, 0, 0); }
            else nxt = __builtin_amdgcn_mfma_f32_32x32x16_bf16(kf[c], qf[c], nxt, 0, 0, 0);
            asm volatile("" : "+v"(nxt)); }
        MLA_SB; }
    if (FINISH) pf[1] = __builtin_bit_cast(bf16x8, (u32x4){cvt_pk_bf16(cur[8], cur[9]), cvt_pk_bf16(cur[10], cur[11]), cvt_pk_bf16(cur[12], cur[13]), cvt_pk_bf16(cur[14], cur[15])});
    l_run += ps;
}
template <bool DO_PV, bool HAS_NEXT>
__device__ __forceinline__ void mla_stage2(const LAS unsigned char* vbc, const bf16x8 (&pf)[2], f32x16 (&o)[2], f32x16& nxt, float& m_run, float& l_run, float& mref, bool use_mask, int kn0, int qcol, int col, int hi) {
    const LAS unsigned char* vp0 = vbc + (col * MK_VP + 4 * hi) * 2; const LAS unsigned char* vp1 = vp0 + 32 * MK_VP * 2;
    u32x2 al[2], ah[2], bl[2], bh[2];
    if (DO_PV) {
#pragma unroll
        for (int c = 0; c < 2; ++c) { al[c] = *(const LAS u32x2*)(vp0 + 32 * c); ah[c] = *(const LAS u32x2*)(vp0 + 32 * c + 16); bl[c] = *(const LAS u32x2*)(vp1 + 32 * c); bh[c] = *(const LAS u32x2*)(vp1 + 32 * c + 16); } }
    if (HAS_NEXT && use_mask) {
        const int lim = qcol - kn0 - 4 * hi;
#pragma unroll
        for (int r = 0; r < 16; ++r) nxt[r] = ((r & 3) + 8 * (r >> 2) > lim) ? -INFINITY : nxt[r]; }
    float mt = -INFINITY;
    MLA_SB;
#pragma unroll
    for (int c = 0; c < 2; ++c) {
        if (HAS_NEXT) {
#pragma unroll
            for (int r = 8 * c; r < 8 * c + 8; ++r) mt = fmaxf(mt, nxt[r]);
            asm volatile("" : "+v"(mt)); }
        if (DO_PV) {
            o[0] = __builtin_amdgcn_mfma_f32_32x32x16_bf16(__builtin_bit_cast(bf16x8, (u32x4){al[c].x, al[c].y, ah[c].x, ah[c].y}), pf[c], o[0], 0, 0, 0);
            o[1] = __builtin_amdgcn_mfma_f32_32x32x16_bf16(__builtin_bit_cast(bf16x8, (u32x4){bl[c].x, bl[c].y, bh[c].x, bh[c].y}), pf[c], o[1], 0, 0, 0); }
        MLA_SB; }
    if (HAS_NEXT) {
        mt = xmax32(mt);
        const float m_new = fmaxf(m_run, mt); const float mr = (m_new == -INFINITY) ? 0.f : m_new;
        if (__any(m_new != m_run)) { const float corr = __builtin_amdgcn_exp2f(m_run - mr); l_run *= corr; m_run = m_new;
#pragma unroll
            for (int b = 0; b < 2; ++b)
#pragma unroll
                for (int r = 0; r < 16; ++r) o[b][r] *= corr; }
        mref = mr; }
}
__device__ __forceinline__ void mla_unit_p(LAS unsigned char* lds, const bf16* Q, const bf16* KVH, const bf16* KR, const bf16* Vt, bf16* O, int hd, int qb, int tid, int wave, int lane) {
    const int col = lane & 31, hi = lane >> 5;
    const int q0 = qb * 256 + wave * 32, qcol = q0 + col;
    bf16x8 qf[6];
    { const bf16* qp = Q + (size_t)(q0 + col) * 768 + hd * 96;
#pragma unroll
      for (int s = 0; s < 6; ++s) qf[s] = *(const bf16x8*)(qp + 16 * s + 8 * hi); }
    f32x16 o[2];
#pragma unroll
    for (int b = 0; b < 2; ++b)
#pragma unroll
        for (int r = 0; r < 16; ++r) o[b][r] = 0.f;
    float m_run = -INFINITY, l_run = 0.f, mref = 0.f;
    const int ns = 2 * (qb + 1);
    const bf16* kg[3]; unsigned kl[3]; int kst[3]; const bf16* vg[2]; unsigned vl[2];
#pragma unroll
    for (int i = 0; i < 3; ++i) { const int c = tid + 512 * i, row = c / 12, p = c % 12; const bool nope = p < 8; kst[i] = nope ? 1024 : 32;
        kg[i] = nope ? KVH + (size_t)row * 1024 + hd * 128 + 8 * p : KR + (size_t)row * 32 + 8 * (p - 8); kl[i] = (unsigned)(row * MK_KP + 8 * p) * 2u; }
#pragma unroll
    for (int i = 0; i < 2; ++i) { const int c = tid + 512 * i, row = c >> 4, p = c & 15; vg[i] = Vt + (size_t)(hd * 64 + row) * S + 8 * p; vl[i] = (unsigned)(row * MK_VP + 8 * p) * 2u; }
    u32x4 kr[3], vr[2];
    auto gload = [&](int step) { const int key0 = 128 * step;
#pragma unroll
        for (int i = 0; i < 3; ++i) kr[i] = *(const u32x4*)(kg[i] + (size_t)key0 * kst[i]);
#pragma unroll
        for (int i = 0; i < 2; ++i) vr[i] = *(const u32x4*)(vg[i] + key0); };
    auto lwrite = [&](int buf) { LAS unsigned char* kb = lds + buf * MK_KB; LAS unsigned char* vb = lds + MK_VOFF + buf * MK_VB;
#pragma unroll
        for (int i = 0; i < 3; ++i) *(LAS u32x4*)(kb + kl[i]) = kr[i];
#pragma unroll
        for (int i = 0; i < 2; ++i) { *(LAS u32x2*)(vb + vl[i]) = (u32x2){vr[i].x, vr[i].y}; *(LAS u32x2*)(vb + vl[i] + 8) = (u32x2){vr[i].z, vr[i].w}; } };
    gload(0); lwrite(0); gload(1);
    __syncthreads();
    f32x16 sA, sB; bf16x8 pf[2];
    pf[0] = __builtin_bit_cast(bf16x8, (u32x4){0u, 0u, 0u, 0u}); pf[1] = pf[0];
    mla_stage1<true, false>(lds, qf, sB, sA, pf, 0.f, l_run, col, hi);
    mla_stage2<false, true>(lds, pf, o, sA, m_run, l_run, mref, 31 > q0, 0, qcol, col, hi);
#define MLA_TILE(CUR, NXT, KNEXT, VCUR, KN0) do { mla_stage1<true>(KNEXT, qf, CUR, NXT, pf, mref, l_run, col, hi); \
        mla_stage2<true, true>(VCUR, pf, o, NXT, m_run, l_run, mref, (KN0) + 31 > q0, KN0, qcol, col, hi); } while (0)
#pragma unroll 1
    for (int s = 0; s < ns; ++s) {
        const int buf = s & 1; const LAS unsigned char* kbs = lds + buf * MK_KB; const LAS unsigned char* vbs = lds + MK_VOFF + buf * MK_VB; const LAS unsigned char* kbn = lds + (buf ^ 1) * MK_KB;
        const int k0 = 128 * s;
        __syncthreads();
        if (s + 1 < ns) { lwrite(buf ^ 1); if (s + 2 < ns) gload(s + 2); }
        MLA_TILE(sA, sB, kbs + 32 * MK_KP * 2, vbs, k0 + 32);
        MLA_TILE(sB, sA, kbs + 64 * MK_KP * 2, vbs + 64, k0 + 64);
        MLA_TILE(sA, sB, kbs + 96 * MK_KP * 2, vbs + 128, k0 + 96);
        __syncthreads();
        if (s + 1 < ns) MLA_TILE(sB, sA, kbn, vbs + 192, k0 + 128);
        else { mla_stage1<false>(kbn, qf, sB, sA, pf, mref, l_run, col, hi); mla_stage2<true, false>(vbs + 192, pf, o, sA, m_run, l_run, mref, false, 0, qcol, col, hi); }
    }
#undef MLA_TILE
    const float l = l_run + __shfl_xor(l_run, 32); const float inv = l > 0.f ? 1.0f / l : 0.f;
    bf16* op = O + (size_t)(q0 + col) * D + 1024 + hd * 64;
#pragma unroll
    for (int b = 0; b < 2; ++b)
#pragma unroll
        for (int i = 0; i < 4; ++i) store4_bf16(op + 32 * b + 8 * i + 4 * hi, (f32x4){o[b][4 * i] * inv, o[b][4 * i + 1] * inv, o[b][4 * i + 2] * inv, o[b][4 * i + 3] * inv});
}

__device__ __forceinline__ void phase_e(Frame& F, const LP& P) {
    const int lane = F.lane;
    SUBREP(0)
#pragma unroll 1
    for (int i = blockIdx.x; i < 256; i += F.G) { const int hd = i & 7, p = i >> 3;
#pragma unroll 1
        for (int rep = 0; rep < 2; ++rep) mla_unit_p(F.lds, P.b(WS_QM), P.b(WS_KVH), P.b(WS_KM), P.b(WS_VTM), P.b(WS_ABR), hd, rep ? 63 - p : p, F.tid, F.wave, lane); }
    __syncthreads();
    SUBREP(1)
#pragma unroll 1
    for (int i = blockIdx.x; i < 512; i += F.G) sel_unit<1>(F.lds, P.b(WS_U2), P.b(WS_VTWIN), nullptr, nullptr, P.b(WS_OWIN), nullptr, i & 1, i >> 1, F.tid, F.wave, lane);
    __syncthreads();
    SUBREP(2)
#pragma unroll 1
    for (int u = F.gw; u < S * 2; u += F.NGW) { const int t = u >> 1;
        topk_unit(P.f(WS_SCORES) + (size_t)u * 256, t, (unsigned*)P.i(WS_IDX) + (size_t)u * 8, lane); }
}
__device__ __forceinline__ void phase_f(Frame& F, const LP& P) {
#pragma unroll 1
    for (int i = blockIdx.x; i < 256; i += F.G) { const int g = i & 1, p = i >> 1;
#pragma unroll 1
        for (int rep = 0; rep < 2; ++rep) sel_unit16(F.lds, P.b(WS_U2), P.b(WS_VTSEL), (const unsigned*)P.i(WS_IDX), P.b(WS_OCMP), P.b(WS_OWIN), P.b(WS_ABR), g, rep ? 255 - p : p, F.tid, F.wave, F.lane); }
}
constexpr int XK_KP = 136, XK_VP = 260, XK_VOFF = 256 * XK_KP * 2;
__device__ __forceinline__ void phase_xattn(Frame& F, const LP& P) {
    const int tid = F.tid, lane = F.lane, col = lane & 31, hi = lane >> 5;
    const bf16* KX = P.b(WS_KX) + (size_t)P.l * 256 * 512; const bf16* VXT = P.b(WS_VXT) + (size_t)P.l * 512 * 256;
    LAS unsigned char* kb = F.lds; LAS unsigned char* vb = F.lds + XK_VOFF;
#pragma unroll 1
    for (int unit = blockIdx.x; unit < 4 * (S / 256); unit += F.G) { const int hd = unit & 3, tb = unit >> 2;
        __syncthreads();
        { u32x4 kr[8], vr[8];
#pragma unroll
          for (int i = 0; i < 8; ++i) { const int c = tid + 512 * i; kr[i] = *(const u32x4*)(KX + (size_t)(c >> 4) * 512 + hd * 128 + 8 * (c & 15)); vr[i] = *(const u32x4*)(VXT + (size_t)(hd * 128 + (c >> 5)) * 256 + 8 * (c & 31)); }
#pragma unroll
          for (int i = 0; i < 8; ++i) { const int c = tid + 512 * i; *(LAS u32x4*)(kb + ((c >> 4) * XK_KP + 8 * (c & 15)) * 2) = kr[i];
              LAS unsigned char* vd = vb + ((c >> 5) * XK_VP + 8 * (c & 31)) * 2; *(LAS u32x2*)vd = (u32x2){vr[i].x, vr[i].y}; *(LAS u32x2*)(vd + 8) = (u32x2){vr[i].z, vr[i].w}; } }
        __syncthreads();
        const int q0 = tb * 256 + F.wave * 32;
        bf16x8 qf[8];
        { const bf16* qp = P.b(WS_QX) + (size_t)(q0 + col) * 512 + hd * 128;
#pragma unroll
          for (int s = 0; s < 8; ++s) qf[s] = *(const bf16x8*)(qp + 16 * s + 8 * hi); }
        f32x16 o[4];
#pragma unroll
        for (int b = 0; b < 4; ++b)
#pragma unroll
            for (int r = 0; r < 16; ++r) o[b][r] = 0.f;
        float m_run = -INFINITY, l_run = 0.f;
        auto mask = [&](int, int) { return true; };
#pragma unroll
        for (int st = 0; st < 4; ++st) att_step64n<8, XK_KP, XK_VP, 4>(kb + st * 64 * XK_KP * 2, vb + st * 128, qf, o, m_run, l_run, 1.0f, false, mask, col, hi);
        const float l = l_run + __shfl_xor(l_run, 32); const float inv = l > 0.f ? 1.0f / l : 0.f;
        bf16* op = P.b(WS_OX) + (size_t)(q0 + col) * 512 + hd * 128;
#pragma unroll
        for (int b = 0; b < 4; ++b)
#pragma unroll
            for (int i = 0; i < 4; ++i) store4_bf16(op + 32 * b + 8 * i + 4 * hi, (f32x4){o[b][4 * i] * inv, o[b][4 * i + 1] * inv, o[b][4 * i + 2] * inv, o[b][4 * i + 3] * inv}); }
}

__device__ __forceinline__ void phase_ln(const Args& a, Frame& F, const LP& P, int gi, int bi) {
    const int l = P.l; const float* g = INF32(a, gi, D); const float* b = INF32(a, bi, D);
    RowRaw na, nb;
    if (2 * F.gw < S) { row_fetch(na, P.b(WS_Y) + (size_t)(2 * F.gw) * D, F.lane); row_fetch(nb, P.b(WS_Y) + (size_t)(2 * F.gw + 1) * D, F.lane); }
#pragma unroll 1
    for (int r = 2 * F.gw; r < S; r += 2 * F.NGW) { Row ra, rb; row_unpack(ra, na); row_unpack(rb, nb);
        const int rn = r + 2 * F.NGW;
        if (rn < S) { row_fetch(na, P.b(WS_Y) + (size_t)rn * D, F.lane); row_fetch(nb, P.b(WS_Y) + (size_t)(rn + 1) * D, F.lane); }
        row_layernorm2(ra, rb, g, b, F.lane);
        row_store_bf16(ra, P.b(WS_XB) + (size_t)r * D, F.lane); row_store_bf16(rb, P.b(WS_XB) + (size_t)(r + 1) * D, F.lane); }
}
__device__ __forceinline__ void phase_ln_router(const Args& a, Frame& F, const LP& P) {
    const int l = P.l, lane = F.lane, wave = F.wave, tid = F.tid; const float* g = INF32(a, 29, D); const float* b = INF32(a, 30, D);
    const float* bg = INF32(a, 32, 4); const float* br = INF32(a, 34, 32);
    int* toke = (int*)(P.ws + WS_MOE + MO_TOKE); float* tokw = (float*)(P.ws + WS_MOE + MO_TOKW); int* tokr = (int*)(P.ws + WS_MOE + MO_TOKP);
    unsigned* cnt = (unsigned*)(P.ws + WS_CTL) + CW_CNT + 128 * l;
    LAS float* lgs = (LAS float*)F.lds; LAS unsigned* hist = (LAS unsigned*)(F.lds + 131072); LAS unsigned* gbase = (LAS unsigned*)(F.lds + 131072 + 128);
    constexpr int RP = 264; LAS unsigned char* sxh = F.lds; LAS unsigned char* sxl = sxh + 64 * RP * 2; LAS unsigned char* swh = sxl + 64 * RP * 2; LAS unsigned char* swl = swh + 48 * RP * 2;
    const bf16* WRT = P.w(WO_WRT);
#pragma unroll 1
    for (int base = 64 * blockIdx.x; base < S; base += 64 * F.G) {
        if (tid < 32) hist[tid] = 0u;
        RowRaw na, nb; row_fetch(na, P.b(WS_Y) + (size_t)(base + 8 * wave) * D, lane); row_fetch(nb, P.b(WS_Y) + (size_t)(base + 8 * wave + 1) * D, lane);
#pragma unroll 1
        for (int i = 0; i < 8; i += 2) { const int r = base + 8 * wave + i; Row ra, rb; row_unpack(ra, na); row_unpack(rb, nb);
            if (i + 2 < 8) { row_fetch(na, P.b(WS_Y) + (size_t)(r + 2) * D, lane); row_fetch(nb, P.b(WS_Y) + (size_t)(r + 3) * D, lane); }
            row_layernorm2(ra, rb, g, b, lane);
            row_store_hilo(ra, P.b(WS_XB) + (size_t)r * D, P.b(WS_XLO) + (size_t)r * D, lane); row_store_hilo(rb, P.b(WS_XB) + (size_t)(r + 1) * D, P.b(WS_XLO) + (size_t)(r + 1) * D, lane); }
        VM_WAIT(); __syncthreads();
        int e1 = 0, e2 = 0, r1 = 0, r2 = 0; float w1 = 0.f, w2 = 0.f;
        { const int tt = wave & 3, kh = wave >> 2;
            const int rr = lane & 15, Gq = lane >> 4;
            f32x4 acc[3];
#pragma unroll
            for (int n = 0; n < 3; ++n) acc[n] = (f32x4){0.f, 0.f, 0.f, 0.f};
            u32x4 stg[14];
            auto gld = [&](int ch) { const int k0 = 256 * ch;
#pragma unroll
                for (int i = 0; i < 14; ++i) { const int c = tid + 512 * (i < 4 ? i : i < 8 ? i - 4 : i < 11 ? i - 8 : i - 11), row = c >> 5, pc = c & 31;
                    const bf16* src = i < 4 ? P.b(WS_XB) + (size_t)(base + row) * D : i < 8 ? P.b(WS_XLO) + (size_t)(base + row) * D : i < 11 ? WRT + (size_t)row * 2048 : WRT + (size_t)(48 + row) * 2048;
                    stg[i] = *(const u32x4*)(src + k0 + 8 * pc); } };
            gld(0);
#pragma unroll 1
            for (int ch = 0; ch < 8; ++ch) {
#pragma unroll
                for (int i = 0; i < 14; ++i) { const int c = tid + 512 * (i < 4 ? i : i < 8 ? i - 4 : i < 11 ? i - 8 : i - 11), row = c >> 5, pc = c & 31;
                    LAS unsigned char* dstb = i < 4 ? sxh : i < 8 ? sxl : i < 11 ? swh : swl; *(LAS u32x4*)(dstb + (row * RP + 8 * pc) * 2) = stg[i]; }
                __syncthreads();
                if (ch + 1 < 8) gld(ch + 1);
#pragma unroll
                for (int ks = 0; ks < 4; ++ks) { const int ko = (32 * (4 * kh + ks) + 8 * Gq) * 2;
                    const bf16x8 ah = *(const LAS bf16x8*)(sxh + (16 * tt + rr) * RP * 2 + ko), al = *(const LAS bf16x8*)(sxl + (16 * tt + rr) * RP * 2 + ko);
#pragma unroll
                    for (int n = 0; n < 3; ++n) { const bf16x8 bh = *(const LAS bf16x8*)(swh + (16 * n + rr) * RP * 2 + ko), bl = *(const LAS bf16x8*)(swl + (16 * n + rr) * RP * 2 + ko);
                        acc[n] = __builtin_amdgcn_mfma_f32_16x16x32_bf16(ah, bh, acc[n], 0, 0, 0); acc[n] = __builtin_amdgcn_mfma_f32_16x16x32_bf16(al, bh, acc[n], 0, 0, 0); acc[n] = __builtin_amdgcn_mfma_f32_16x16x32_bf16(ah, bl, acc[n], 0, 0, 0); } }
                __syncthreads(); }
            LAS float* lp = lgs + (kh * 4 + tt) * 768;
#pragma unroll
            for (int n = 0; n < 3; ++n)
#pragma unroll
                for (int i = 0; i < 4; ++i) lp[(4 * Gq + i) * 48 + 16 * n + rr] = acc[n][i]; }
        LDS_WAIT(); __syncthreads();
        if (wave < 4) {
            LAS float* lw_ = lgs + wave * 768;
            if (lane < 16) {
                const LAS float* lg = lw_ + lane * 48; const LAS float* lg2 = lg + 4 * 768;
                float gl[4]; int gs = 0;
#pragma unroll
                for (int e = 0; e < 4; ++e) gl[e] = (lg[e] + lg2[e]) + bg[e];
                float gmax = gl[0];
#pragma unroll
                for (int e = 1; e < 4; ++e) { if (gl[e] > gmax) { gmax = gl[e]; gs = e; } }
                float gsum = 0.f;
#pragma unroll
                for (int e = 0; e < 4; ++e) gsum += __expf(gl[e] - gmax);
                const float gwt = 1.0f / gsum;
                float el[8];
#pragma unroll
                for (int e = 0; e < 8; ++e) el[e] = (lg[4 + 8 * gs + e] + lg2[4 + 8 * gs + e]) + br[gs * 8 + e];
                int i1 = 0; float m1 = el[0];
#pragma unroll
                for (int e = 1; e < 8; ++e) if (el[e] > m1) { m1 = el[e]; i1 = e; }
                int i2 = -1; float m2 = -INFINITY;
#pragma unroll
                for (int e = 0; e < 8; ++e) if (e != i1 && el[e] > m2) { m2 = el[e]; i2 = e; }
                const float rx = __expf(m2 - m1); const float p1 = 1.0f / (1.0f + rx), p2 = rx * p1;
                e1 = gs * 8 + i1; e2 = gs * 8 + i2; w1 = gwt * p1; w2 = gwt * p2;
                r1 = (int)__hip_atomic_fetch_add(hist + e1, 1u, __ATOMIC_RELAXED, __HIP_MEMORY_SCOPE_WORKGROUP);
                r2 = (int)__hip_atomic_fetch_add(hist + e2, 1u, __ATOMIC_RELAXED, __HIP_MEMORY_SCOPE_WORKGROUP);
            }
        }
        LDS_WAIT(); __syncthreads();
        if (tid < 32) { const unsigned h = hist[tid]; gbase[tid] = h ? atomicAdd(cnt + tid, h) : 0u; }
        LDS_WAIT(); __syncthreads();
        if (wave < 4 && lane < 16) { const int t = base + 16 * wave + lane;
            toke[2 * t] = e1; toke[2 * t + 1] = e2; tokw[2 * t] = w1; tokw[2 * t + 1] = w2; tokr[2 * t] = (int)gbase[e1] + r1; tokr[2 * t + 1] = (int)gbase[e2] + r2; }
        __syncthreads();
    }
}
__device__ __forceinline__ void phase_moe_assign(Frame& F, const LP& P) {
    const int lane = F.lane;
    unsigned* cnt = (unsigned*)(P.ws + WS_CTL) + CW_CNT + 128 * P.l;
    const unsigned c = lane < 32 ? __hip_atomic_load(cnt + lane, __ATOMIC_RELAXED, __HIP_MEMORY_SCOPE_AGENT) : 0u;
    const unsigned padded = (c + 255u) & ~255u;
    unsigned incl = padded;
#pragma unroll
    for (int o = 1; o < 32; o <<= 1) { const unsigned v = __shfl_up(incl, o); if ((lane & 31) >= o) incl += v; }
    const unsigned pstart = incl - padded;
    if (F.gw == 0) {
        int* tile_e = (int*)(P.ws + WS_MOE + MO_TILEE); int* ntp = (int*)(P.ws + WS_MOE + MO_NT);
        if (lane < 32) for (unsigned r = pstart; r < incl; r += 256) tile_e[r >> 8] = lane;
        const unsigned total = __shfl(incl, 31); if (lane == 0) *ntp = (int)(total >> 8);
    }
    const int* toke = (const int*)(P.ws + WS_MOE + MO_TOKE); const float* tokw = (const float*)(P.ws + WS_MOE + MO_TOKW);
    int* tokp = (int*)(P.ws + WS_MOE + MO_TOKP); float* roww = (float*)(P.ws + WS_MOE + MO_ROWW); int* rowtok = (int*)(P.ws + WS_MOE + MO_ROWTOK);
    if (F.gw < 32) {
        const unsigned lo = __shfl(pstart, F.gw) + __shfl(c, F.gw), hi_ = __shfl(incl, F.gw);
        for (unsigned r = lo + lane; r < hi_; r += 64) { rowtok[r] = 0; roww[r] = 0.f; } }
#pragma unroll 1
    for (int i = F.gw * 64 + lane; i < 2 * S; i += F.NGW * 64) { const int e = toke[i];
        unsigned ps = 0u;
#pragma unroll
        for (int q = 0; q < 32; ++q) { const unsigned v = __shfl(pstart, q); ps = (e == q) ? v : ps; }
        const unsigned pos = (unsigned)tokp[i] + ps;
        tokp[i] = (int)pos; roww[pos] = tokw[i]; rowtok[pos] = i >> 1; }
}
__device__ __forceinline__ void phase_moe_combine(const Args& a, Frame& F, const LP& P, bool last) {
    const int l = P.l; const float* g = INF32(a, 37, D); const float* b = INF32(a, 38, D); const int* tokp = (const int*)(P.ws + WS_MOE + MO_TOKP);
    const int step = 2 * F.NGW; const int r0 = 2 * F.gw;
    RowRaw xa, xb_, ya0, ya1, yb0, yb1; int4 pn = {0, 0, 0, 0};
    if (r0 < S) { const int4 p = *(const int4*)(tokp + 2 * r0);
        row_fetch(xa, P.b(WS_XB) + (size_t)r0 * D, F.lane); row_fetch(xb_, P.b(WS_XB) + (size_t)(r0 + 1) * D, F.lane);
        row_fetch(ya0, P.b(WS_Y2) + (size_t)p.x * D, F.lane); row_fetch(yb0, P.b(WS_Y2) + (size_t)p.z * D, F.lane);
        row_fetch(ya1, P.b(WS_Y2) + (size_t)p.y * D, F.lane); row_fetch(yb1, P.b(WS_Y2) + (size_t)p.w * D, F.lane);
        if (r0 + step < S) pn = *(const int4*)(tokp + 2 * (r0 + step)); }
#pragma unroll 1
    for (int r = r0; r < S; r += step) { Row ra, rb;
        row_unpack(ra, xa); row_unpack(rb, xb_);
#pragma unroll
        for (int j = 0; j < 8; ++j) { ra.v[j] = ra.v[j] * DN_ALPHA; rb.v[j] = rb.v[j] * DN_ALPHA; }
        row_unpack_add(ra, ya0); row_unpack_add(rb, yb0); row_unpack_add(ra, ya1); row_unpack_add(rb, yb1);
        const int rn = r + step;
        if (rn < S) { const int4 p = pn;
            row_fetch(xa, P.b(WS_XB) + (size_t)rn * D, F.lane); row_fetch(xb_, P.b(WS_XB) + (size_t)(rn + 1) * D, F.lane);
            row_fetch(ya0, P.b(WS_Y2) + (size_t)p.x * D, F.lane); row_fetch(yb0, P.b(WS_Y2) + (size_t)p.z * D, F.lane);
            row_fetch(ya1, P.b(WS_Y2) + (size_t)p.y * D, F.lane); row_fetch(yb1, P.b(WS_Y2) + (size_t)p.w * D, F.lane);
            if (rn + step < S) pn = *(const int4*)(tokp + 2 * (rn + step)); }
        row_layernorm2(ra, rb, g, b, F.lane);
        if (last) { row_store_f32(ra, a.out + (size_t)r * D, F.lane); row_store_f32(rb, a.out + (size_t)(r + 1) * D, F.lane); }
        else { row_store_bf16(ra, P.b(WS_XB) + (size_t)r * D, F.lane); row_store_bf16(rb, P.b(WS_XB) + (size_t)(r + 1) * D, F.lane); } }
}

constexpr int NPH_LAYER = 17, NPHASES = 1 + DEPTH * NPH_LAYER;
__global__ void __launch_bounds__(NWAVES * 64, 2) mk_fwd(Args a) {
    extern __shared__ __attribute__((aligned(16))) unsigned char lds_raw[];
    Frame F;
    F.lds = (LAS unsigned char*)lds_raw;
    F.tid = threadIdx.x; F.lane = F.tid & 63; F.wave = __builtin_amdgcn_readfirstlane(F.tid >> 6);
    F.G = gridDim.x; F.gw = blockIdx.x * NWAVES + F.wave; F.NGW = F.G * NWAVES; F.ws = a.ws;
    volatile LAS unsigned* MISC = (volatile LAS unsigned*)(F.lds + MISC_OFF);
    if (F.tid < 32) MISC[F.tid] = 0u;
    __syncthreads();
    unsigned* ctl = (unsigned*)(a.ws + WS_CTL);
    XcdBarrier bar = xcd_barrier_post(ctl + CW_BAR + a.li * XCD_BAR_WORDS, MISC + 8);
    const int lo = a.ph_lo, hi = a.ph_hi;
#if defined(PHMASK)
#define IN(k) (((PHMASK >> (((k) == 0) ? 0 : (((k) - 1) % NPH_LAYER) + 1)) & 1) && lo <= (k) && (k) < hi)
#elif defined(PHSEL)
#define IN(k) ((((k) == 0) ? 0 : (((k) - 1) % NPH_LAYER) + 1) == PHSEL && lo <= (k) && (k) < hi)
#else
#define IN(k) (lo <= (k) && (k) < hi)
#endif
#define SEAM(k) do { if (IN((k) + 1)) xcd_barrier(bar); } while (0)
#ifdef DIAG_P1
#define STAMP(k) do { if (blockIdx.x == 0 && threadIdx.x == 0) ((volatile LAS unsigned long long*)(F.lds + MISC_OFF - 1024))[(k)] = wall_clock64(); } while (0)
#else
#define STAMP(k) do {} while (0)
#endif
#ifndef DUPMASK
#define DUPMASK 0
#endif
#define REPB(k) for (int rep_ = 0; rep_ < 1 + ((DUPMASK >> (k)) & 1); ++rep_) { if (rep_) xcd_barrier(bar);
#define REPE }
#define FRESH() do { int t_ = threadIdx.x; asm volatile("" : "+v"(t_)); F.tid = t_; F.lane = t_ & 63; F.wave = __builtin_amdgcn_readfirstlane(t_ >> 6); F.gw = blockIdx.x * NWAVES + F.wave; } while (0)
    const int G = F.G, bx = blockIdx.x;

    if (IN(0)) { FRESH(); STAMP(0); REPB(0) phase_prologue(a, F); REPE SEAM(0); }

    for (int l = 0; l < DEPTH; ++l) {
        LP P; P.ws = a.ws; P.wl = a.ws + WS_WL0 + (size_t)l * WS_WLSTRIDE; P.l = l;
        const int pb = 1 + NPH_LAYER * l;
        if (IN(pb + 0)) { FRESH(); STAMP(pb + 0); REPB(1) pg8::Gemm g{P.b(WS_XB), P.w(WO_WIN), D, D, D, nullptr}; pg8::StaticOrder so; so.init(S, NIN, G, bx);
            EpiIn E{P.b(WS_GATE), P.b(WS_U2), (const float*)(P.wl + WO_BIASP)}; pg8::gemm_phase(F.lds, g, so, E);
            { const int nun = (S / 256) * (NIN / 256), rem = nun % G, nlight = rem ? G - rem : G;
              FRESH(); if (bx >= G - nlight) memkv_items(P, (bx - (G - nlight)) * NWAVES + F.wave, nlight * NWAVES, F.lane); }
            REPE SEAM(pb + 0); }
        if (IN(pb + 1)) { FRESH(); STAMP(pb + 1); REPB(2) phase_prep(a, F, P); REPE SEAM(pb + 1); }
        if (IN(pb + 2)) { FRESH(); STAMP(pb + 2); REPB(3)
            { pg8::Gemm g{P.b(WS_U2) + U2_CQ, P.w(WO_WUQ), U2W, 512, 512, nullptr}; pg8::StaticOrder so; so.init(S, 768, G, bx);
              EpiQM<WS_QM, WS_RSTD, WS_ROPE> E{P.ws}; pg8::gemm_phase(F.lds, g, so, E); }
            { pg8::Gemm g{P.b(WS_U2) + U2_CKV, P.w(WO_WUKV), U2W, 256, 256, nullptr}; pg8::StaticOrder so; so.init(S, 1024, G, bx);
              EpiScale E{P.b(WS_KVH), 1024, P.f(WS_RSTD) + S, 1.0f, 0}; pg8::gemm_phase(F.lds, g, so, E); }
            phase_compress2(F, P); REPE SEAM(pb + 2); }
        if (IN(pb + 3)) { FRESH(); STAMP(pb + 3); REPB(4) phase_d(F, P); REPE SEAM(pb + 3); }
        if (IN(pb + 4)) { FRESH(); STAMP(pb + 4); REPB(5) phase_e(F, P); REPE SEAM(pb + 4); }
        if (IN(pb + 5)) { FRESH(); STAMP(pb + 5); REPB(6) phase_f(F, P); REPE SEAM(pb + 5); }
        if (IN(pb + 6)) { FRESH(); STAMP(pb + 6); REPB(7) pg8::Gemm g{P.b(WS_ABR), P.w(WO_WBR), D, D, D, nullptr}; pg8::StaticOrder so; so.init(S, D, G, bx);
            EpiMerge E{P.b(WS_GATE), P.b(WS_MERGED)};
            for (int sk_ = 0; sk_ < ((bx >> 3) & 3); ++sk_) __builtin_amdgcn_s_sleep(100);
            pg8::gemm_phase(F.lds, g, so, E); REPE SEAM(pb + 6); }
        if (IN(pb + 7)) { FRESH(); STAMP(pb + 7); REPB(8) pg8::Gemm g{P.b(WS_MERGED), P.w(WO_WOUT), D, D, D, nullptr}; pg8::StaticOrder so; so.init(S, D, G, bx);
            EpiResid E{P.b(WS_XB), P.b(WS_Y)}; pg8::gemm_phase(F.lds, g, so, E); REPE SEAM(pb + 7); }
        if (IN(pb + 8)) { FRESH(); STAMP(pb + 8); REPB(9) phase_ln(a, F, P, 23, 24); REPE SEAM(pb + 8); }
        if (IN(pb + 9)) { FRESH(); STAMP(pb + 9); REPB(10) pg8::Gemm g{P.b(WS_XB), P.w(WO_WXQ), D, D, D, nullptr}; pg8::StaticOrder so; so.init(S, 512, G, bx);
            EpiScale E{P.b(WS_QX), 512, nullptr, 0.08838834764831845f * LOG2E, 0}; pg8::gemm_phase(F.lds, g, so, E); REPE SEAM(pb + 9); }
        if (IN(pb + 10)) { FRESH(); STAMP(pb + 10); REPB(11) phase_xattn(F, P); REPE SEAM(pb + 10); }
        if (IN(pb + 11)) { FRESH(); STAMP(pb + 11); REPB(12) pg8::Gemm g{P.b(WS_OX), P.w(WO_WXO), 512, 512, 512, nullptr}; pg8::StaticOrder so; so.init(S, D, G, bx);
            EpiResid E{P.b(WS_XB), P.b(WS_Y)}; pg8::gemm_phase(F.lds, g, so, E); REPE SEAM(pb + 11); }
        if (IN(pb + 12)) { FRESH(); STAMP(pb + 12); REPB(13) phase_ln_router(a, F, P); REPE SEAM(pb + 12); }
        if (IN(pb + 13)) { FRESH(); STAMP(pb + 13); REPB(14) phase_moe_assign(F, P); REPE SEAM(pb + 13); }
        if (IN(pb + 14)) { FRESH(); STAMP(pb + 14); REPB(15) const int* te = (const int*)(P.ws + WS_MOE + MO_TILEE); const int ntl = *(const int*)(P.ws + WS_MOE + MO_NT);
            pg8::Gemm g{P.b(WS_XB), P.w(WO_WEIN), D, D, D, (const int*)(P.ws + WS_MOE + MO_ROWTOK)}; pg8::GroupedGather so{te, ntl, 4, G, bx};
            EpiGlu E{P.b(WS_HS)}; pg8::gemm_phase(F.lds, g, so, E); REPE SEAM(pb + 14); }
        if (IN(pb + 15)) { FRESH(); STAMP(pb + 15); REPB(16) const int* te = (const int*)(P.ws + WS_MOE + MO_TILEE); const int ntl = *(const int*)(P.ws + WS_MOE + MO_NT);
            pg8::Gemm g{P.b(WS_HS), P.w(WO_WEOUT), 512, 512, 512, nullptr}; pg8::GroupedOrder so{te, ntl, 8, G, bx};
            EpiScale E{P.b(WS_Y2), D, (const float*)(P.ws + WS_MOE + MO_ROWW), 1.0f, 8}; pg8::gemm_phase(F.lds, g, so, E); REPE SEAM(pb + 15); }
        if (IN(pb + 16)) { FRESH(); STAMP(pb + 16); REPB(17) phase_moe_combine(a, F, P, l == DEPTH - 1); REPE SEAM(pb + 16); }
    }
#ifdef DIAG_P1
    STAMP(NPHASES);
    __syncthreads();
    if (blockIdx.x == 0) {
        volatile LAS unsigned long long* ts = (volatile LAS unsigned long long*)(F.lds + MISC_OFF - 1024);
        const float t1 = (float)(ts[DIAG_P1 + DIAG_N1] - ts[DIAG_P1]) * 0.01f, t2 = (float)(ts[DIAG_P2 + DIAG_N2] - ts[DIAG_P2]) * 0.01f;
        const float c1 = sqrtf(t1 * 0.1f);
        for (size_t i = threadIdx.x; i < (size_t)S * D; i += 512) a.out[i] = (i == 0) ? t2 : c1;
    }
#endif
#undef IN
#undef SEAM
}

#ifndef MK_PER_PHASE
#define MK_PER_PHASE 0
#endif
extern "C" void kernel_launch(void* const* d_in, const int* in_sizes, int n_in, void* d_out, int out_size, void* d_ws, size_t ws_size, hipStream_t stream) {
    static int grid = 0;
    if (grid == 0) {
        if (n_in != 39 || out_size != S * D || ws_size < WS_END) { fprintf(stderr, "kernel_launch: unexpected problem (n_in %d, out %d, ws %zu)\n", n_in, out_size, ws_size); grid = -1; return; }
        int dev = 0, cus = 0;
        if (hipGetDevice(&dev) != hipSuccess || hipDeviceGetAttribute(&cus, hipDeviceAttributeMultiprocessorCount, dev) != hipSuccess) { grid = -1; return; }
        if (hipFuncSetAttribute((const void*)mk_fwd, hipFuncAttributeMaxDynamicSharedMemorySize, LDS_BYTES) != hipSuccess) { fprintf(stderr, "kernel_launch: hipFuncSetAttribute failed\n"); grid = -1; return; }
        int per_cu = 0;
        if (hipOccupancyMaxActiveBlocksPerMultiprocessor(&per_cu, (const void*)mk_fwd, NWAVES * 64, LDS_BYTES) != hipSuccess || per_cu < 1) fprintf(stderr, "kernel_launch: occupancy query reports %d\n", per_cu);
        (void)hipGetLastError();
        grid = cus;
    }
    if (grid < 0) return;
    if (hipMemsetAsync((char*)d_ws + WS_CTL, 0, CTL_ZERO_BYTES, stream) != hipSuccess) return;
    Args a{};
    for (int i = 0; i < 39; ++i) a.in[i] = d_in[i];
    a.out = (float*)d_out; a.ws = (unsigned char*)d_ws; a.pad = 0;
#if MK_PER_PHASE
#ifndef MK_LAST
#define MK_LAST NPHASES
#endif
    for (int p = 0; p < MK_LAST; ++p) { a.ph_lo = p; a.ph_hi = p + 1; a.li = p; hipLaunchKernelGGL(mk_fwd, dim3(grid), dim3(NWAVES * 64), LDS_BYTES, stream, a); }
#else
    a.ph_lo = 0; a.ph_hi = NPHASES; a.li = 0;
    hipLaunchKernelGGL(mk_fwd, dim3(grid), dim3(NWAVES * 64), LDS_BYTES, stream, a);
#endif
}
```

```cpp
#include <hip/hip_runtime.h>
#include <cstdio>
#include <cstdint>

#define LAS __attribute__((address_space(3)))
#define GAS __attribute__((address_space(1)))
typedef unsigned short bf16;
typedef short bf16x8 __attribute__((ext_vector_type(8)));
typedef short s16x4 __attribute__((ext_vector_type(4)));
typedef float f32x2 __attribute__((ext_vector_type(2)));
typedef float f32x4 __attribute__((ext_vector_type(4)));
typedef float f32x16 __attribute__((ext_vector_type(16)));
typedef unsigned u32x2 __attribute__((ext_vector_type(2)));
typedef unsigned u32x4 __attribute__((ext_vector_type(4)));

constexpr int S = 16384, D = 2048, DEPTH = 2;
constexpr int IN_W = 11832;
constexpr int NIN = 12032;
constexpr int U2W = 3840;
constexpr int U2_Q = 0, U2_KV = 512, U2_POOL = 1280, U2_CQ = 1792, U2_CKV = 2304, U2_CONV = 2560, U2_G = 3584, U2_KR = 3616;
constexpr int NCMP = 1023;
constexpr int RMAX = 40960;
constexpr float DN_ALPHA = 1.4142135623730951f;
constexpr float LOG2E = 1.4426950408889634f;

typedef __bf16 bf16x2_t __attribute__((ext_vector_type(2)));
__device__ __forceinline__ unsigned cvt_pk_bf16(float lo, float hi) { const f32x2 v = {lo, hi}; const bf16x2_t b = __builtin_convertvector(v, bf16x2_t); return __builtin_bit_cast(unsigned, b); }
__device__ __forceinline__ float bf2f(unsigned short b) { return __uint_as_float(((unsigned)b) << 16); }
__device__ __forceinline__ float bflo(unsigned w) { return __uint_as_float(w << 16); }
__device__ __forceinline__ float bfhi(unsigned w) { return __uint_as_float(w & 0xffff0000u); }
__device__ __forceinline__ unsigned short f2bf(float f) { return (unsigned short)(cvt_pk_bf16(f, 0.f) & 0xffffu); }
template <int CTRL> __device__ __forceinline__ float dpp_f(float x) { return __uint_as_float((unsigned)__builtin_amdgcn_update_dpp(0, (int)__float_as_uint(x), CTRL, 0xF, 0xF, true)); }
__device__ __forceinline__ float lane_xor1(float x) { return dpp_f<0xB1>(x); }
__device__ __forceinline__ float lane_xor2(float x) { return dpp_f<0x4E>(x); }
__device__ __forceinline__ float row16_sum(float x) { x += dpp_f<0xB1>(x); x += dpp_f<0x4E>(x); x += dpp_f<0x141>(x); x += dpp_f<0x140>(x); return x; }
__device__ __forceinline__ float xsum16(float x) { const auto r = __builtin_amdgcn_permlane16_swap(__float_as_uint(x), __float_as_uint(x), false, false); return __uint_as_float(r[0]) + __uint_as_float(r[1]); }
__device__ __forceinline__ float xsum32(float x) { const auto r = __builtin_amdgcn_permlane32_swap(__float_as_uint(x), __float_as_uint(x), false, false); return __uint_as_float(r[0]) + __uint_as_float(r[1]); }
__device__ __forceinline__ float xmax16(float x) { const auto r = __builtin_amdgcn_permlane16_swap(__float_as_uint(x), __float_as_uint(x), false, false); return fmaxf(__uint_as_float(r[0]), __uint_as_float(r[1])); }
__device__ __forceinline__ float xmax32(float x) { const auto r = __builtin_amdgcn_permlane32_swap(__float_as_uint(x), __float_as_uint(x), false, false); return fmaxf(__uint_as_float(r[0]), __uint_as_float(r[1])); }
__device__ __forceinline__ float lane_xor32(float x, int hi) { const auto r = __builtin_amdgcn_permlane32_swap(__float_as_uint(x), __float_as_uint(x), false, false); return __uint_as_float(hi ? r[0] : r[1]); }
__device__ __forceinline__ float wave_sum(float v) { return xsum32(xsum16(row16_sum(v))); }
__device__ __forceinline__ float sigmoidf_(float x) { return 1.0f / (1.0f + __expf(-x)); }
#define LDS_WAIT() asm volatile("s_waitcnt lgkmcnt(0)" ::: "memory")
#define VM_WAIT() asm volatile("s_waitcnt vmcnt(0)" ::: "memory")

namespace pg8 {
constexpr int BM = 256, BK = 64, HALF = 128, HTB = HALF * BK * 2, STAGE_BYTES = 8 * HTB, NXCD = 8, WGM = 8;
__host__ __device__ __forceinline__ int lds_byte(int r, int c) { const int st = (r >> 4) * 2 + (c >> 5), rr = r & 15, cc = c & 31, ob = rr * 64 + cc * 2; return st * 1024 + (ob ^ (((ob >> 9) & 1) << 5)); }
__host__ __device__ __forceinline__ void stage_rc(int b, int& R, int& C) { const int st = b / 1024, sb = b % 1024, swz = sb ^ (((sb >> 9) & 1) << 5); R = (st >> 1) * 16 + swz / 64; C = (st & 1) * 32 + (swz % 64) / 2; }
__host__ __device__ __forceinline__ int perm32(int rho) { const int n = rho >> 4, i = rho & 15; return 8 * (i >> 2) + 4 * n + (i & 3); }

struct Unit { int pm, pn; };
struct Gemm { const bf16* A; const bf16* Bt; int lda, ldb, K; const int* rowtok; };

struct StaticOrder {
    static constexpr bool GATHER = false;
    int nM, nN, nwg, G, c;
    __device__ void init(int M, int N, int G_, int c_) { nM = M / BM; nN = N / BM; nwg = nM * nN; G = G_; c = c_; }
    __device__ bool next(int i, Unit& u) const {
        const long L = (long)i * G + c; if (L >= nwg) return false;
        int wgid = (int)L; { const int q = nwg / NXCD, r = nwg % NXCD, xcd = wgid % NXCD, off = wgid / NXCD; wgid = (xcd < r ? xcd * (q + 1) : r * (q + 1) + (xcd - r) * q) + off; }
        const int nig = WGM * nN, gid = wgid / nig, fm = gid * WGM, gsz = (nM - fm) < WGM ? (nM - fm) : WGM;
        u.pm = fm + ((wgid % nig) % gsz); u.pn = (wgid % nig) / gsz; return true;
    }
};
template <bool GATHER_> struct GroupedOrderT {
    static constexpr bool GATHER = GATHER_;
    const int* tile_expert; int ntiles, npn, G, c;
    __device__ bool next(int i, Unit& u) const {
        const long L = (long)i * G + c; if (L >= (long)ntiles * npn) return false;
        const int rt = (int)(L / npn), pn = (int)(L % npn);
        u.pm = rt; u.pn = __builtin_amdgcn_readfirstlane(tile_expert[rt]) * npn + pn; return true;
    }
};
typedef GroupedOrderT<false> GroupedOrder; typedef GroupedOrderT<true> GroupedGather;
template <bool GATHER_> struct MoeOrderT {
    static constexpr bool GATHER = GATHER_;
    const int* tile_expert; int npn, G, c, u0, u1, a, nL;
    __device__ bool next(int i, Unit& u) const {
        long L;
        if (i < a) L = (long)i * G + c;
        else { if (c < nL) return false; L = (long)a * G + (long)(i - a) * (G - nL) + (c - nL); }
        L += u0; if (L >= u1) return false;
        const int rt = (int)(L / npn), pn = (int)(L % npn);
        u.pm = rt; u.pn = __builtin_amdgcn_readfirstlane(tile_expert[rt]) * npn + pn; return true;
    }
};

template <class Epi, class Sched>
__device__ __forceinline__ void gemm_phase(LAS unsigned char* lds, const Gemm g, const Sched& S, const Epi& E) {
    int tid = threadIdx.x; asm volatile("" : "+v"(tid));
    const int wid = __builtin_amdgcn_readfirstlane(tid >> 6), lane = tid & 63, wr = wid >> 2, wc = wid & 3, fr = lane & 15, fq = lane >> 4;
    const int K = g.K, nt = K / BK;
    constexpr bool GATHER = Sched::GATHER;
    unsigned voffB[2], vAc[2][2], vAn[2][2]; int Rr[2], Cc[2];
#pragma unroll
    for (int i = 0; i < 2; ++i) { int R, C; stage_rc(tid * 16 + i * 8192, R, C); const int Rb = Epi::PERM ? ((R & ~31) + perm32(R & 31)) : R; Rr[i] = R; Cc[i] = C;
        voffB[i] = (unsigned)(Rb * g.ldb + C) * 2u;
#pragma unroll
        for (int h = 0; h < 2; ++h) { vAc[h][i] = (unsigned)((R + h * HALF) * g.lda + C) * 2u; vAn[h][i] = vAc[h][i]; } }
    const size_t kstep = (size_t)(BK * 2);
    const size_t hstepB = (size_t)HALF * g.ldb * 2;
    const size_t tstepA = (size_t)2 * HALF * g.lda * 2, tstepB = 2 * hstepB;
    const unsigned ldsw = (unsigned)wid * 1024u;
    const int aoff = lds_byte(wr * 64 + fr, fq * 8), boff = lds_byte(wc * 32 + fr, fq * 8);
#define PG8_GOFF(v, u) do { _Pragma("unroll") for (int _h = 0; _h < 2; ++_h) _Pragma("unroll") for (int _i = 0; _i < 2; ++_i) { \
        const int _t = g.rowtok[(u).pm * 256 + _h * HALF + Rr[_i]]; (v)[_h][_i] = (unsigned)(_t * g.lda + Cc[_i]) * 2u; } \
        _Pragma("unroll") for (int _h = 0; _h < 2; ++_h) _Pragma("unroll") for (int _i = 0; _i < 2; ++_i) asm volatile("" : "+v"((v)[_h][_i])); } while (0)
#define PG8_SA(b, h) (((b) * 2 + (h)) * HTB)
#define PG8_SB(b, h) ((4 + (b) * 2 + (h)) * HTB)
#define PG8_STAGE(bufoff, gbase, voff) do { _Pragma("unroll") for (int _i = 0; _i < 2; ++_i) \
        __builtin_amdgcn_global_load_lds((const unsigned*)((const char*)(gbase) + (voff)[_i]), (LAS unsigned*)(lds + (bufoff) + ldsw + _i * 8192), 16, 0, 0); } while (0)
#define PG8_LDA(dst, b, h) do { _Pragma("unroll") for (int m = 0; m < 4; ++m) _Pragma("unroll") for (int k = 0; k < 2; ++k) dst[m][k] = *(const LAS bf16x8*)(lds + PG8_SA(b, h) + aoff + m * 2048 + k * 1024); } while (0)
#define PG8_LDB(dst, b, h) do { _Pragma("unroll") for (int n = 0; n < 2; ++n) _Pragma("unroll") for (int k = 0; k < 2; ++k) dst[n][k] = *(const LAS bf16x8*)(lds + PG8_SB(b, h) + boff + n * 2048 + k * 1024); } while (0)
#define PG8_MMA(ai, bj, At, Bt) do { __builtin_amdgcn_s_setprio(1); _Pragma("unroll") for (int m = 0; m < 4; ++m) _Pragma("unroll") for (int n = 0; n < 2; ++n) _Pragma("unroll") for (int k = 0; k < 2; ++k) \
        acc[ai][bj][m][n] = __builtin_amdgcn_mfma_f32_16x16x32_bf16(Bt[n][k], At[m][k], acc[ai][bj][m][n], 0, 0, 0); __builtin_amdgcn_s_setprio(0); } while (0)
#define PG8_WAIT_V(n) asm volatile("s_waitcnt vmcnt(" #n ")" ::: "memory")
#define PG8_WAIT_L(n) asm volatile("s_waitcnt lgkmcnt(" #n ")" ::: "memory")
#define PG8_BAR __builtin_amdgcn_s_barrier()
#define PG8_SCHED __builtin_amdgcn_sched_barrier(0)
    Unit cur, nxt; int ui = 0;
    if (!S.next(0, cur)) return;
    f32x4 acc[2][2][4][2];
#pragma unroll
    for (int a = 0; a < 2; ++a)
#pragma unroll
        for (int b = 0; b < 2; ++b)
#pragma unroll
            for (int m = 0; m < 4; ++m)
#pragma unroll
                for (int n = 0; n < 2; ++n) acc[a][b][m][n] = (f32x4){0.f, 0.f, 0.f, 0.f};
    bf16x8 At[4][2], B0[2][2], B1[2][2];
    if constexpr (GATHER) PG8_GOFF(vAc, cur);
    const char* cA = (const char*)g.A + (GATHER ? (size_t)0 : (size_t)cur.pm * tstepA); const char* cB = (const char*)g.Bt + (size_t)cur.pn * tstepB;
    PG8_STAGE(PG8_SB(0, 0), cB, voffB); PG8_STAGE(PG8_SB(0, 1), cB + hstepB, voffB); PG8_STAGE(PG8_SA(0, 0), cA, vAc[0]); PG8_STAGE(PG8_SA(0, 1), cA, vAc[1]);
    if (wr == 1) PG8_BAR;
    PG8_WAIT_V(2); PG8_BAR;
    PG8_STAGE(PG8_SB(1, 0), cB + kstep, voffB); PG8_STAGE(PG8_SA(1, 0), cA + kstep, vAc[0]); PG8_STAGE(PG8_SB(1, 1), cB + hstepB + kstep, voffB);
    PG8_WAIT_V(6); PG8_BAR;
    for (;;) {
        const bool has_next = S.next(ui + 1, nxt);
        if constexpr (GATHER) { if (has_next) PG8_GOFF(vAn, nxt); }
        const char* nA = GATHER ? cA : (has_next ? (const char*)g.A + (size_t)nxt.pm * tstepA : cA); const char* nB = has_next ? (const char*)g.Bt + (size_t)nxt.pn * tstepB : cB;
        for (int t = 0; t < nt; t += 2) {
            const bool last = (t == nt - 2);
            const char* a1 = cA + (size_t)(t + 1) * kstep;
            const char* a2 = last ? nA : cA + (size_t)(t + 2) * kstep; const char* b2 = last ? nB : cB + (size_t)(t + 2) * kstep;
            const char* a3 = a2 + kstep; const char* b3 = b2 + kstep;
            unsigned v2[2][2];
#pragma unroll
            for (int h = 0; h < 2; ++h)
#pragma unroll
                for (int i = 0; i < 2; ++i) v2[h][i] = (GATHER && last && has_next) ? vAn[h][i] : vAc[h][i];
            if constexpr (Epi::MIDK > 0) { if (t > 0 && (t % Epi::MIDK) == 0) { if (wr == 0) PG8_BAR; PG8_SCHED; E.mid(acc, cur, t / Epi::MIDK, wr, wc, fr, fq); PG8_SCHED; if (wr == 1) PG8_BAR; } }
            PG8_LDB(B0, 0, 0); PG8_LDB(B1, 0, 1); PG8_SCHED; PG8_LDA(At, 0, 0); PG8_STAGE(PG8_SA(1, 1), a1, vAc[1]);
            PG8_WAIT_V(8); PG8_WAIT_L(0); PG8_BAR; PG8_MMA(0, 0, At, B0); PG8_MMA(0, 1, At, B1); PG8_BAR; PG8_SCHED;
            PG8_LDA(At, 0, 1); PG8_STAGE(PG8_SB(0, 0), b2, voffB); PG8_STAGE(PG8_SB(0, 1), b2 + hstepB, voffB); PG8_STAGE(PG8_SA(0, 0), a2, v2[0]);
            PG8_WAIT_V(8); PG8_WAIT_L(0); PG8_BAR; PG8_MMA(1, 0, At, B0); PG8_MMA(1, 1, At, B1); PG8_BAR; PG8_SCHED;
            PG8_LDB(B0, 1, 0); PG8_LDB(B1, 1, 1); PG8_SCHED; PG8_LDA(At, 1, 0); PG8_STAGE(PG8_SA(0, 1), a2, v2[1]);
            PG8_WAIT_V(8); PG8_WAIT_L(0); PG8_BAR; PG8_MMA(0, 0, At, B0); PG8_MMA(0, 1, At, B1); PG8_BAR; PG8_SCHED;
            PG8_LDA(At, 1, 1); PG8_STAGE(PG8_SB(1, 0), b3, voffB); PG8_STAGE(PG8_SB(1, 1), b3 + hstepB, voffB); PG8_STAGE(PG8_SA(1, 0), a3, v2[0]);
            PG8_WAIT_V(8); PG8_WAIT_L(0); PG8_BAR; PG8_MMA(1, 0, At, B0); PG8_MMA(1, 1, At, B1); PG8_BAR; PG8_SCHED;
        }
        if (wr == 0) PG8_BAR;
        E(acc, cur, wr, wc, fr, fq);
        if (!has_next) break;
#pragma unroll
        for (int a = 0; a < 2; ++a)
#pragma unroll
            for (int b = 0; b < 2; ++b)
#pragma unroll
                for (int m = 0; m < 4; ++m)
#pragma unroll
                    for (int n = 0; n < 2; ++n) acc[a][b][m][n] = (f32x4){0.f, 0.f, 0.f, 0.f};
        cur = nxt; cA = nA; cB = nB; ++ui;
        if constexpr (GATHER) {
#pragma unroll
            for (int h = 0; h < 2; ++h)
#pragma unroll
                for (int i = 0; i < 2; ++i) vAc[h][i] = vAn[h][i]; }
        if (wr == 1) PG8_BAR;
    }
    PG8_WAIT_V(0);
    PG8_BAR;
#undef PG8_GOFF
#undef PG8_SA
#undef PG8_SB
#undef PG8_STAGE
#undef PG8_LDA
#undef PG8_LDB
#undef PG8_MMA
#undef PG8_WAIT_V
#undef PG8_WAIT_L
#undef PG8_BAR
#undef PG8_SCHED
}
}

__device__ __forceinline__ float fast_sigmoid(float x) { return __builtin_amdgcn_rcpf(1.0f + __builtin_amdgcn_exp2f(-x * LOG2E)); }
__device__ __forceinline__ u32x4 pack8(const f32x4 v0, const f32x4 v1) { u32x4 w; w.x = cvt_pk_bf16(v0[0], v0[1]); w.y = cvt_pk_bf16(v0[2], v0[3]); w.z = cvt_pk_bf16(v1[0], v1[1]); w.w = cvt_pk_bf16(v1[2], v1[3]); return w; }

struct EpiIn {
    static constexpr bool PERM = true; static constexpr int MIDK = 0;
    bf16* gate; bf16* u2; const float* bias;
    __device__ __forceinline__ void operator()(const f32x4 (&acc)[2][2][4][2], const pg8::Unit& u, int wr, int wc, int fr, int fq) const {
        const int row0 = u.pm * 256 + wr * 64 + fr; const bool isg = u.pn < 32;
        bf16* base = isg ? gate : u2; const int ldc = isg ? 8192 : U2W; const int colt = isg ? u.pn * 256 : (u.pn - 32) * 256;
        const int col0 = colt + wc * 32 + 8 * fq, bcol0 = u.pn * 256 + wc * 32 + 8 * fq;
        f32x4 bv[2][2];
#pragma unroll
        for (int bj = 0; bj < 2; ++bj)
#pragma unroll
            for (int n = 0; n < 2; ++n) bv[bj][n] = *(const f32x4*)(bias + bcol0 + bj * 128 + 4 * n);
        const float qsc = (u.pn == 32 || u.pn == 33) ? 0.125f * LOG2E : 1.0f;
#pragma unroll
        for (int ai = 0; ai < 2; ++ai)
#pragma unroll
            for (int m = 0; m < 4; ++m) { bf16* rowp = base + (size_t)(row0 + ai * 128 + m * 16) * ldc + col0;
#pragma unroll
                for (int bj = 0; bj < 2; ++bj) { f32x4 v0 = (acc[ai][bj][m][0] + bv[bj][0]) * qsc, v1 = (acc[ai][bj][m][1] + bv[bj][1]) * qsc;
                    if (isg) {
#pragma unroll
                        for (int j = 0; j < 4; ++j) { v0[j] = fast_sigmoid(v0[j]); v1[j] = fast_sigmoid(v1[j]); } }
                    *(u32x4*)(rowp + bj * 128) = pack8(v0, v1); } }
    }
};
struct EpiScale {
    static constexpr bool PERM = true; static constexpr int MIDK = 0;
    bf16* O; int ldc; const float* rowscale; float cs; int npn_mod;
    __device__ __forceinline__ void operator()(const f32x4 (&acc)[2][2][4][2], const pg8::Unit& u, int wr, int wc, int fr, int fq) const {
        const int row0 = u.pm * 256 + wr * 64 + fr; const int pnl = npn_mod ? (u.pn % npn_mod) : u.pn;
        const int col0 = pnl * 256 + wc * 32 + 8 * fq;
#pragma unroll
        for (int ai = 0; ai < 2; ++ai)
#pragma unroll
            for (int m = 0; m < 4; ++m) { const int row = row0 + ai * 128 + m * 16; const float sc = (rowscale ? rowscale[row] : 1.0f) * cs;
                bf16* rowp = O + (size_t)row * ldc + col0;
#pragma unroll
                for (int bj = 0; bj < 2; ++bj) *(u32x4*)(rowp + bj * 128) = pack8(acc[ai][bj][m][0] * sc, acc[ai][bj][m][1] * sc); }
    }
};
template <size_t OFF_O, size_t OFF_RS, size_t OFF_ROPE>
struct EpiQM {
    static constexpr bool PERM = true; static constexpr int MIDK = 0;
    unsigned char* ws;
    __device__ __forceinline__ void operator()(const f32x4 (&acc)[2][2][4][2], const pg8::Unit& u, int wr, int wc, int fr, int fq) const {
        const int row0 = u.pm * 256 + wr * 64 + fr; const int col0 = u.pn * 256 + wc * 32 + 8 * fq;
        bf16* O = (bf16*)(ws + OFF_O); const float* rowscale = (const float*)(ws + OFF_RS); const f32x2* rope = (const f32x2*)(ws + OFF_ROPE);
        const float qs = 0.10206207261596577f * LOG2E;
#pragma unroll
        for (int ai = 0; ai < 2; ++ai)
#pragma unroll
            for (int m = 0; m < 4; ++m) { const int row = row0 + ai * 128 + m * 16; const float sc = rowscale[row] * qs;
                asm volatile("" ::: "memory");
                bf16* rowp = O + (size_t)row * 768 + col0;
#pragma unroll
                for (int bj = 0; bj < 2; ++bj) { f32x4 v0 = acc[ai][bj][m][0] * sc, v1 = acc[ai][bj][m][1] * sc;
                    if ((8 * u.pn + 4 * bj + wc) % 3 == 2) {
                        const f32x4* rp = (const f32x4*)(rope + (size_t)row * 16 + 8 * (fq & 1));
                        const float sg = fq < 2 ? -1.0f : 1.0f;
                        { const f32x4 c01 = rp[0], c23 = rp[1]; const float q0 = __shfl_xor(v0[0], 32), q1 = __shfl_xor(v0[1], 32), q2 = __shfl_xor(v0[2], 32), q3 = __shfl_xor(v0[3], 32);
                          v0[0] = v0[0] * c01[0] + sg * q0 * c01[1]; v0[1] = v0[1] * c01[2] + sg * q1 * c01[3]; v0[2] = v0[2] * c23[0] + sg * q2 * c23[1]; v0[3] = v0[3] * c23[2] + sg * q3 * c23[3]; }
                        asm volatile("" ::: "memory");
                        { const f32x4 c45 = rp[2], c67 = rp[3]; const float q0 = __shfl_xor(v1[0], 32), q1 = __shfl_xor(v1[1], 32), q2 = __shfl_xor(v1[2], 32), q3 = __shfl_xor(v1[3], 32);
                          v1[0] = v1[0] * c45[0] + sg * q0 * c45[1]; v1[1] = v1[1] * c45[2] + sg * q1 * c45[3]; v1[2] = v1[2] * c67[0] + sg * q2 * c67[1]; v1[3] = v1[3] * c67[2] + sg * q3 * c67[3]; } }
                    *(u32x4*)(rowp + bj * 128) = pack8(v0, v1); } }
    }
};
struct EpiGlu {
    static constexpr bool PERM = true; static constexpr int MIDK = 0;
    bf16* H;
    __device__ __forceinline__ void operator()(const f32x4 (&acc)[2][2][4][2], const pg8::Unit& u, int wr, int wc, int fr, int fq) const {
        const int row0 = u.pm * 256 + wr * 64 + fr; const int col0 = (u.pn & 3) * 128 + wc * 32 + 8 * fq;
#pragma unroll
        for (int ai = 0; ai < 2; ++ai)
#pragma unroll
            for (int m = 0; m < 4; ++m) { f32x4 o[2];
#pragma unroll
                for (int n = 0; n < 2; ++n)
#pragma unroll
                    for (int j = 0; j < 4; ++j) { const float a = acc[ai][0][m][n][j], b = acc[ai][1][m][n][j]; o[n][j] = a * fast_sigmoid(a) * b; }
                *(u32x4*)(H + (size_t)(row0 + ai * 128 + m * 16) * 512 + col0) = pack8(o[0], o[1]); }
    }
};
struct EpiResid {
    static constexpr bool PERM = true; static constexpr int MIDK = 0;
    const bf16* X; bf16* Y;
    __device__ __forceinline__ void operator()(const f32x4 (&acc)[2][2][4][2], const pg8::Unit& u, int wr, int wc, int fr, int fq) const {
        const int row0 = u.pm * 256 + wr * 64 + fr, col0 = u.pn * 256 + wc * 32 + 8 * fq;
#pragma unroll
        for (int ai = 0; ai < 2; ++ai)
#pragma unroll
            for (int m = 0; m < 4; ++m) { const size_t ro = (size_t)(row0 + ai * 128 + m * 16) * D + col0;
#pragma unroll
                for (int bj = 0; bj < 2; ++bj) { const u32x4 xv = *(const u32x4*)(X + ro + bj * 128); f32x4 v0, v1;
                    v0[0] = bflo(xv.x) * DN_ALPHA + acc[ai][bj][m][0][0]; v0[1] = bfhi(xv.x) * DN_ALPHA + acc[ai][bj][m][0][1]; v0[2] = bflo(xv.y) * DN_ALPHA + acc[ai][bj][m][0][2]; v0[3] = bfhi(xv.y) * DN_ALPHA + acc[ai][bj][m][0][3];
                    v1[0] = bflo(xv.z) * DN_ALPHA + acc[ai][bj][m][1][0]; v1[1] = bfhi(xv.z) * DN_ALPHA + acc[ai][bj][m][1][1]; v1[2] = bflo(xv.w) * DN_ALPHA + acc[ai][bj][m][1][2]; v1[3] = bfhi(xv.w) * DN_ALPHA + acc[ai][bj][m][1][3];
                    *(u32x4*)(Y + ro + bj * 128) = pack8(v0, v1); } }
    }
};
struct EpiMerge {
    static constexpr bool PERM = true; static constexpr int MIDK = 8;
    const bf16* gate; bf16* O;
    __device__ __forceinline__ void mid(f32x4 (&acc)[2][2][4][2], const pg8::Unit& u, int seg, int wr, int wc, int fr, int fq) const {
        int row0 = u.pm * 256 + wr * 64 + fr; const int col0 = u.pn * 256 + wc * 32 + 8 * fq; asm volatile("" : "+v"(row0));
#pragma unroll
        for (int ai = 0; ai < 2; ++ai)
#pragma unroll
            for (int m = 0; m < 4; ++m) { const bf16* gp = gate + (size_t)(row0 + ai * 128 + m * 16) * 8192 + (size_t)(seg - 1) * 2048 + col0;
#pragma unroll
                for (int bj = 0; bj < 2; ++bj) { const u32x4 a = *(const u32x4*)(gp + bj * 128), b = *(const u32x4*)(gp + 2048 + bj * 128);
#pragma unroll
                    for (int q = 0; q < 4; ++q) { const float r0 = fmaxf(bflo(a[q]), 1e-30f) * __builtin_amdgcn_rcpf(fmaxf(bflo(b[q]), 1e-30f)), r1 = fmaxf(bfhi(a[q]), 1e-30f) * __builtin_amdgcn_rcpf(fmaxf(bfhi(b[q]), 1e-30f));
                        acc[ai][bj][m][q >> 1][(q & 1) * 2] *= r0; acc[ai][bj][m][q >> 1][(q & 1) * 2 + 1] *= r1; } }
                asm volatile("" ::: "memory"); }
    }
    __device__ __forceinline__ void operator()(const f32x4 (&acc)[2][2][4][2], const pg8::Unit& u, int wr, int wc, int fr, int fq) const {
        const int row0 = u.pm * 256 + wr * 64 + fr, col0 = u.pn * 256 + wc * 32 + 8 * fq;
#pragma unroll
        for (int ai = 0; ai < 2; ++ai)
#pragma unroll
            for (int m = 0; m < 4; ++m) { const int row = row0 + ai * 128 + m * 16; const bf16* gp = gate + (size_t)row * 8192 + 3 * 2048 + col0;
#pragma unroll
                for (int bj = 0; bj < 2; ++bj) { const u32x4 a = *(const u32x4*)(gp + bj * 128); f32x4 v0, v1;
                    v0[0] = acc[ai][bj][m][0][0] * fmaxf(bflo(a[0]), 1e-30f); v0[1] = acc[ai][bj][m][0][1] * fmaxf(bfhi(a[0]), 1e-30f);
                    v0[2] = acc[ai][bj][m][0][2] * fmaxf(bflo(a[1]), 1e-30f); v0[3] = acc[ai][bj][m][0][3] * fmaxf(bfhi(a[1]), 1e-30f);
                    v1[0] = acc[ai][bj][m][1][0] * fmaxf(bflo(a[2]), 1e-30f); v1[1] = acc[ai][bj][m][1][1] * fmaxf(bfhi(a[2]), 1e-30f);
                    v1[2] = acc[ai][bj][m][1][2] * fmaxf(bflo(a[3]), 1e-30f); v1[3] = acc[ai][bj][m][1][3] * fmaxf(bfhi(a[3]), 1e-30f);
                    *(u32x4*)(O + (size_t)row * D + col0 + bj * 128) = pack8(v0, v1); } }
    }
};

#define XB_TMO      128
#define XB_XCNT(j)  (256  + 64 * (j))
#define XB_XSUB(j)  (1280 + 64 * (j))
#define XB_XGEN(j)  (2304 + 64 * (j))
#define XB_TOP      3328
#define XB_TOPGEN   3392
#define XCD_BAR_WORDS 3456
#define XB_SPIN_CAP (1u << 25)
__device__ __forceinline__ unsigned xb_ld(unsigned* p)              { return __hip_atomic_load(p, __ATOMIC_RELAXED, __HIP_MEMORY_SCOPE_AGENT); }
__device__ __forceinline__ unsigned xb_add(unsigned* p, unsigned v) { return __hip_atomic_fetch_add(p, v, __ATOMIC_RELAXED, __HIP_MEMORY_SCOPE_AGENT); }
__device__ __forceinline__ unsigned xb_xcc_id() { return (unsigned)__builtin_amdgcn_s_getreg((3 << 11) | 20) & 0xFu; }
#define XB_SPIN(cond, bar) do { unsigned _sp = 0; while (cond) { __builtin_amdgcn_s_sleep(1); \
    if ((++_sp & 255u) == 0u) { if (xb_ld(&(bar)[XB_TMO])) break; if (_sp > XB_SPIN_CAP) { atomicAdd(&(bar)[XB_TMO], 1u); break; } } } } while (0)
struct XcdBarrier { unsigned* bar; unsigned x; volatile LAS unsigned* st; };
__device__ __forceinline__ XcdBarrier xcd_barrier_post(unsigned* bar, volatile LAS unsigned* st) {
    XcdBarrier b; b.bar = bar; b.x = xb_xcc_id(); b.st = st;
    if (threadIdx.x == 0) (void)xb_add(&bar[XB_XCNT(b.x)], 1u);
    return b;
}
__device__ __forceinline__ void xcd_barrier_complete(unsigned* bar, unsigned x, unsigned& nloc, unsigned& nx) {
    const unsigned G = gridDim.x * gridDim.y * gridDim.z;
    unsigned sum, cnt, mine, sp = 0u;
    for (;;) {
        sum = 0u; cnt = 0u; mine = 0u;
#pragma unroll
        for (unsigned j = 0; j < 16; ++j) { const unsigned c = xb_ld(&bar[XB_XCNT(j)]); sum += c; cnt += (c > 0u) ? 1u : 0u; mine = (j == x) ? c : mine; }
        if (sum == G) break;
        __builtin_amdgcn_s_sleep(1);
        if ((++sp & 255u) == 0u) { if (xb_ld(&bar[XB_TMO])) break; if (sp > XB_SPIN_CAP) { atomicAdd(&bar[XB_TMO], 1u); break; } }
    }
    nloc = mine > 0u ? mine : 1u; nx = cnt > 0u ? cnt : 1u;
}
__device__ __forceinline__ void xcd_barrier(const XcdBarrier& b) {
    asm volatile("s_waitcnt vmcnt(0)" ::: "memory");
    __syncthreads();
    if (threadIdx.x == 0) {
        unsigned* bar = b.bar;
        __builtin_amdgcn_s_waitcnt(0);
        unsigned nloc = b.st[0], nx = b.st[1];
        if (nloc == 0u) { xcd_barrier_complete(bar, b.x, nloc, nx); b.st[0] = nloc; b.st[1] = nx; }
        const unsigned old = xb_add(&bar[XB_XSUB(b.x)], 1u);
        const unsigned gen = old / nloc;
        if (old + 1u == (gen + 1u) * nloc) {
            __builtin_amdgcn_fence(__ATOMIC_RELEASE, "agent");
            asm volatile("s_waitcnt vmcnt(0)" ::: "memory");
            const unsigned og = xb_add(&bar[XB_TOP], 1u);
            const unsigned tg = og / nx;
            if (og + 1u == (tg + 1u) * nx) xb_add(&bar[XB_TOPGEN], 1u);
            else XB_SPIN(xb_ld(&bar[XB_TOPGEN]) == tg, bar);
            __builtin_amdgcn_fence(__ATOMIC_ACQUIRE, "agent");
            xb_add(&bar[XB_XGEN(b.x)], 1u);
            asm volatile("s_waitcnt vmcnt(0)" ::: "memory");
        } else {
            XB_SPIN(xb_ld(&bar[XB_XGEN(b.x)]) == gen, bar);
            __builtin_amdgcn_fence(__ATOMIC_ACQUIRE, "agent");
            asm volatile("s_waitcnt vmcnt(0)" ::: "memory");
        }
    }
    __syncthreads();
}

constexpr size_t MiB = 1u << 20;
constexpr size_t WS_CTL = 0, CTL_ZERO_BYTES = 1 * MiB;
constexpr size_t WS_WL0 = 2 * MiB, WS_WLSTRIDE = 272 * MiB;
constexpr size_t WO_WIN = 0, WO_WBR = 48 * MiB, WO_WOUT = 56 * MiB, WO_WXQ = 64 * MiB, WO_WXK = 66 * MiB, WO_WXV = 68 * MiB, WO_WXO = 70 * MiB, WO_WUQ = 72 * MiB, WO_WUKV = 73 * MiB,
                 WO_W1C = 74 * MiB, WO_W2C = 75 * MiB, WO_BIASP = 76 * MiB, WO_B1C = 77 * MiB, WO_WRT = 78 * MiB, WO_WEIN = 80 * MiB, WO_WEOUT = 208 * MiB;
constexpr size_t WS_XLO = 546 * MiB, WS_XB = 674 * MiB, WS_GATE = 738 * MiB, WS_U2 = 994 * MiB, WS_ABR = 1114 * MiB, WS_MERGED = 1178 * MiB, WS_QH = 1242 * MiB, WS_KVH = 1266 * MiB,
                 WS_QM = 1298 * MiB, WS_KM = 1322 * MiB, WS_VTM = 1346 * MiB, WS_VTSEL = 1362 * MiB, WS_VTWIN = 1366 * MiB, WS_KC = 1370 * MiB, WS_VCT = 1371 * MiB, WS_HID = 1372 * MiB,
                 WS_OCMP = 1373 * MiB, WS_OWIN = 1389 * MiB, WS_SCORES = 1405 * MiB, WS_IDX = 1437 * MiB, WS_NV = 1439 * MiB, WS_RSTD = 1440 * MiB, WS_ROPE = 1441 * MiB, WS_QX = 1443 * MiB,
                 WS_OX = 1459 * MiB, WS_KX = 1475 * MiB, WS_VXT = 1476 * MiB, WS_MEMB = 1477 * MiB, WS_CSTAT = 1478 * MiB, WS_MOE = 1479 * MiB, WS_Y = 1481 * MiB, WS_END = 1609 * MiB;
constexpr size_t WS_XS = WS_GATE, WS_Y2 = WS_GATE + 160 * MiB, WS_HS = WS_GATE + 320 * MiB;
static_assert(WS_HS + 40 * MiB <= WS_ABR, "MoE overlay");
constexpr int CW_CNT = 1024;
constexpr int CW_BAR = 4096;
constexpr size_t MO_TOKE = 0, MO_TOKW = 128 * 1024, MO_TOKP = 256 * 1024, MO_ROWW = 384 * 1024, MO_TILEE = 640 * 1024, MO_NT = 644 * 1024, MO_ROWTOK = 768 * 1024;

constexpr int RING_BYTES = 131072;
constexpr int LDS_BYTES = 147456;
constexpr int MISC_OFF = LDS_BYTES - 512;

constexpr int NWAVES = 8;
struct Args { const void* in[39]; float* out; unsigned char* ws; int ph_lo, ph_hi, li, pad; };
static_assert(sizeof(Args) == 39 * 8 + 8 + 8 + 16, "Args has no padding");

struct Frame {
    LAS unsigned char* lds;
    int tid, lane, wave, G, gw, NGW;
    unsigned char* ws;
};

__device__ __forceinline__ int in_col(int n) {
    if (n < 8192) return 3640 + n;
    if (n < 8704) return n - 8192;
    if (n < 9472) return 512 + (n - 8704);
    if (n < 9984) return 1304 + (n - 9472);
    if (n < 10496) return 1816 + (n - 9984);
    if (n < 10752) return 2328 + (n - 10496);
    if (n < 11776) return 2616 + (n - 10752);
    const int c = n - 11776; if (c < 24) return 1280 + c; if (c >= 32 && c < 64) return 2584 + (c - 32); return -1;
}
struct Job { const float* W; const float* ks; bf16* WT; int ldw, ldt, kdst0, mode, nkb, nnb, nbatch; size_t sstride, dstride; };
__device__ __forceinline__ void transpose_load(const Job& J, int item, f32x4 (&v)[16], int lane) {
    const int per = J.nkb * J.nnb, e = item / per, r = item % per, kb = r / J.nnb, nb = r % J.nnb, k0 = kb * 64, n0 = nb * 64;
    const float* W = J.W + (size_t)e * J.sstride;
    const int nq = 4 * (lane & 15), nd = n0 + nq;
    int sc;
    if (J.mode == 1) sc = in_col(nd);
    else if (J.mode == 2) { const int T = nd >> 8, w = nd & 255; sc = (w < 128) ? (T * 128 + w) : (512 + T * 128 + (w - 128)); }
    else sc = nd;
#pragma unroll
    for (int i = 0; i < 16; ++i) { const int kk = (lane >> 4) + 4 * i; v[i] = (f32x4){0.f, 0.f, 0.f, 0.f};
        if (sc >= 0) v[i] = *(const f32x4*)(W + (size_t)(k0 + kk) * J.ldw + sc); }
}
__device__ __forceinline__ void transpose_store(const Job& J, int item, f32x4 (&v)[16], LAS float* scr, int lane) {
    const int per = J.nkb * J.nnb, e = item / per, r = item % per, kb = r / J.nnb, nb = r % J.nnb, k0 = kb * 64, n0 = nb * 64;
    bf16* WT = J.WT + (size_t)e * J.dstride;
    const int nq = 4 * (lane & 15);
#pragma unroll
    for (int i = 0; i < 16; ++i) { const int kk = (lane >> 4) + 4 * i;
        if (J.ks) v[i] = v[i] * J.ks[k0 + kk];
        LAS float* d = scr + kk * 65 + nq; d[0] = v[i][0]; d[1] = v[i][1]; d[2] = v[i][2]; d[3] = v[i][3]; }
    LDS_WAIT(); asm volatile("" ::: "memory");
    const int c = lane & 7;
#pragma unroll
    for (int j = 0; j < 8; ++j) { const int n = (lane >> 3) + 8 * j; const LAS float* s = scr + (8 * c) * 65 + n;
        u32x4 o; o.x = cvt_pk_bf16(s[0 * 65], s[1 * 65]); o.y = cvt_pk_bf16(s[2 * 65], s[3 * 65]); o.z = cvt_pk_bf16(s[4 * 65], s[5 * 65]); o.w = cvt_pk_bf16(s[6 * 65], s[7 * 65]);
        *(u32x4*)(WT + (size_t)(n0 + n) * J.ldt + J.kdst0 + k0 + 8 * c) = o; }
    LDS_WAIT(); asm volatile("" ::: "memory");
}
constexpr int NJOBS = 15;
__device__ __forceinline__ Job get_job(const Args& a, int l, int j) {
    unsigned char* wl = a.ws + WS_WL0 + (size_t)l * WS_WLSTRIDE;
    Job J; J.ks = nullptr; J.kdst0 = 0; J.mode = 0; J.nbatch = 1; J.sstride = 0; J.dstride = 0;
#define SRC(i, per) ((const float*)a.in[i] + (size_t)l * (per))
    switch (j) {
    case 0:  J.W = SRC(3, (size_t)D * IN_W); J.ldw = IN_W; J.WT = (bf16*)(wl + WO_WIN); J.ldt = D; J.mode = 1; J.nkb = 32; J.nnb = NIN / 64; break;
    case 1:  J.W = SRC(8, 512 * D);  J.ldw = D; J.WT = (bf16*)(wl + WO_WBR); J.ldt = D; J.kdst0 = 0;    J.nkb = 8; J.nnb = 32; break;
    case 2:  J.W = SRC(16, 512 * D); J.ldw = D; J.WT = (bf16*)(wl + WO_WBR); J.ldt = D; J.kdst0 = 1024; J.nkb = 8; J.nnb = 32; break;
    case 3:  J.W = SRC(21, 512 * D); J.ldw = D; J.WT = (bf16*)(wl + WO_WBR); J.ldt = D; J.kdst0 = 1536; J.nkb = 8; J.nnb = 32; break;
    case 4:  J.W = SRC(22, (size_t)D * D); J.ldw = D; J.WT = (bf16*)(wl + WO_WOUT); J.ldt = D; J.nkb = 32; J.nnb = 32; break;
    case 5:  J.W = SRC(13, 512 * 768); J.ldw = 768; J.ks = SRC(12, 512); J.WT = (bf16*)(wl + WO_WUQ); J.ldt = 512; J.nkb = 8; J.nnb = 12; break;
    case 6:  J.W = SRC(15, 256 * 1024); J.ldw = 1024; J.ks = SRC(14, 256); J.WT = (bf16*)(wl + WO_WUKV); J.ldt = 256; J.nkb = 4; J.nnb = 16; break;
    case 7:  J.W = SRC(25, D * 512); J.ldw = 512; J.WT = (bf16*)(wl + WO_WXQ); J.ldt = D; J.nkb = 32; J.nnb = 8; break;
    case 8:  J.W = SRC(26, D * 512); J.ldw = 512; J.WT = (bf16*)(wl + WO_WXK); J.ldt = D; J.nkb = 32; J.nnb = 8; break;
    case 9:  J.W = SRC(27, D * 512); J.ldw = 512; J.WT = (bf16*)(wl + WO_WXV); J.ldt = D; J.nkb = 32; J.nnb = 8; break;
    case 10: J.W = SRC(28, 512 * D); J.ldw = D; J.WT = (bf16*)(wl + WO_WXO); J.ldt = 512; J.nkb = 8; J.nnb = 32; break;
    case 11: J.W = SRC(35, (size_t)32 * D * 1024); J.ldw = 1024; J.WT = (bf16*)(wl + WO_WEIN); J.ldt = D; J.mode = 2; J.nkb = 32; J.nnb = 16; J.nbatch = 32; J.sstride = (size_t)D * 1024; J.dstride = (size_t)1024 * D; break;
    case 12: J.W = SRC(36, (size_t)32 * 512 * D); J.ldw = D; J.WT = (bf16*)(wl + WO_WEOUT); J.ldt = 512; J.nkb = 8; J.nnb = 32; J.nbatch = 32; J.sstride = (size_t)512 * D; J.dstride = (size_t)D * 512; break;
    case 13: J.W = SRC(6, 2 * 2048 * 128); J.ldw = 128; J.WT = (bf16*)(wl + WO_W1C); J.ldt = 2048; J.nkb = 32; J.nnb = 2; J.nbatch = 2; J.sstride = 2048 * 128; J.dstride = 128 * 2048; break;
    default: J.W = SRC(7, 2 * 128 * 64); J.ldw = 64; J.WT = (bf16*)(wl + WO_W2C); J.ldt = 128; J.nkb = 2; J.nnb = 1; J.nbatch = 2; J.sstride = 128 * 64; J.dstride = 64 * 128; break;
    }
#undef SRC
    return J;
}

struct Row { f32x4 v[8]; };
__device__ __forceinline__ void row_load(Row& r, const float* p, int lane) {
    asm volatile("" : "+v"(lane));
#pragma unroll
    for (int j = 0; j < 8; ++j) r.v[j] = *(const f32x4*)(p + 4 * lane + 256 * j);
}
__device__ __forceinline__ void row_store_f32(const Row& r, float* p, int lane) {
    asm volatile("" : "+v"(lane));
#pragma unroll
    for (int j = 0; j < 8; ++j) *(f32x4*)(p + 4 * lane + 256 * j) = r.v[j];
}
__device__ __forceinline__ void row_store_bf16(const Row& r, bf16* p, int lane) {
    asm volatile("" : "+v"(lane));
#pragma unroll
    for (int j = 0; j < 8; ++j) { u32x2 w; w.x = cvt_pk_bf16(r.v[j][0], r.v[j][1]); w.y = cvt_pk_bf16(r.v[j][2], r.v[j][3]); *(u32x2*)(p + 4 * lane + 256 * j) = w; }
}
__device__ __forceinline__ void row_load_bf16(Row& r, const bf16* p, int lane) {
    asm volatile("" : "+v"(lane));
#pragma unroll
    for (int j = 0; j < 8; ++j) { const u32x2 w = *(const u32x2*)(p + 4 * lane + 256 * j); r.v[j][0] = bflo(w.x); r.v[j][1] = bfhi(w.x); r.v[j][2] = bflo(w.y); r.v[j][3] = bfhi(w.y); }
}
struct RowRaw { u32x2 w[8]; };
__device__ __forceinline__ void row_fetch(RowRaw& q, const bf16* p, int lane) {
    asm volatile("" : "+v"(lane));
#pragma unroll
    for (int j = 0; j < 8; ++j) q.w[j] = *(const u32x2*)(p + 4 * lane + 256 * j);
}
__device__ __forceinline__ void row_unpack(Row& r, const RowRaw& q) {
#pragma unroll
    for (int j = 0; j < 8; ++j) { r.v[j][0] = bflo(q.w[j].x); r.v[j][1] = bfhi(q.w[j].x); r.v[j][2] = bflo(q.w[j].y); r.v[j][3] = bfhi(q.w[j].y); }
}
__device__ __forceinline__ void row_unpack_add(Row& r, const RowRaw& q) {
#pragma unroll
    for (int j = 0; j < 8; ++j) { r.v[j][0] += bflo(q.w[j].x); r.v[j][1] += bfhi(q.w[j].x); r.v[j][2] += bflo(q.w[j].y); r.v[j][3] += bfhi(q.w[j].y); }
}
__device__ __forceinline__ void row_store_hilo(const Row& r, bf16* ph, bf16* pl, int lane) {
    asm volatile("" : "+v"(lane));
#pragma unroll
    for (int j = 0; j < 8; ++j) { u32x2 h, l; h.x = cvt_pk_bf16(r.v[j][0], r.v[j][1]); h.y = cvt_pk_bf16(r.v[j][2], r.v[j][3]);
        l.x = cvt_pk_bf16(r.v[j][0] - bflo(h.x), r.v[j][1] - bfhi(h.x)); l.y = cvt_pk_bf16(r.v[j][2] - bflo(h.y), r.v[j][3] - bfhi(h.y));
        *(u32x2*)(ph + 4 * lane + 256 * j) = h; *(u32x2*)(pl + 4 * lane + 256 * j) = l; }
}
__device__ __forceinline__ void row_add_bf16(Row& r, const bf16* p, int lane) {
    asm volatile("" : "+v"(lane));
#pragma unroll
    for (int j = 0; j < 8; ++j) { const u32x2 w = *(const u32x2*)(p + 4 * lane + 256 * j); r.v[j][0] += bflo(w.x); r.v[j][1] += bfhi(w.x); r.v[j][2] += bflo(w.y); r.v[j][3] += bfhi(w.y); }
}
__device__ __forceinline__ void row_layernorm(Row& r, const float* g, const float* b, int lane) {
    asm volatile("" : "+v"(lane));
    float s = 0.f;
#pragma unroll
    for (int j = 0; j < 8; ++j) s += (r.v[j][0] + r.v[j][1]) + (r.v[j][2] + r.v[j][3]);
    const float mean = wave_sum(s) * (1.0f / D); float q = 0.f;
#pragma unroll
    for (int j = 0; j < 8; ++j) { r.v[j] = r.v[j] - mean; q += (r.v[j][0] * r.v[j][0] + r.v[j][1] * r.v[j][1]) + (r.v[j][2] * r.v[j][2] + r.v[j][3] * r.v[j][3]); }
    const float rstd = 1.0f / sqrtf(wave_sum(q) * (1.0f / D) + 1e-5f);
#pragma unroll
    for (int j = 0; j < 8; ++j) { const f32x4 gg = *(const f32x4*)(g + 4 * lane + 256 * j), bb = *(const f32x4*)(b + 4 * lane + 256 * j); r.v[j] = r.v[j] * rstd * gg + bb; }
}

__device__ __forceinline__ void row_layernorm2(Row& r0, Row& r1, const float* g, const float* b, int lane) {
    asm volatile("" : "+v"(lane));
    float s0 = 0.f, s1 = 0.f;
#pragma unroll
    for (int j = 0; j < 8; ++j) { s0 += (r0.v[j][0] + r0.v[j][1]) + (r0.v[j][2] + r0.v[j][3]); s1 += (r1.v[j][0] + r1.v[j][1]) + (r1.v[j][2] + r1.v[j][3]); }
#pragma unroll
    for (int o = 0; o < 1; ++o) { s0 = wave_sum(s0); s1 = wave_sum(s1); }
    const float m0 = s0 * (1.0f / D), m1 = s1 * (1.0f / D); float q0 = 0.f, q1 = 0.f;
#pragma unroll
    for (int j = 0; j < 8; ++j) { r0.v[j] = r0.v[j] - m0; r1.v[j] = r1.v[j] - m1;
        q0 += (r0.v[j][0] * r0.v[j][0] + r0.v[j][1] * r0.v[j][1]) + (r0.v[j][2] * r0.v[j][2] + r0.v[j][3] * r0.v[j][3]);
        q1 += (r1.v[j][0] * r1.v[j][0] + r1.v[j][1] * r1.v[j][1]) + (r1.v[j][2] * r1.v[j][2] + r1.v[j][3] * r1.v[j][3]); }
#pragma unroll
    for (int o = 0; o < 1; ++o) { q0 = wave_sum(q0); q1 = wave_sum(q1); }
    const float d0 = 1.0f / sqrtf(q0 * (1.0f / D) + 1e-5f), d1 = 1.0f / sqrtf(q1 * (1.0f / D) + 1e-5f);
#pragma unroll
    for (int j = 0; j < 8; ++j) { const f32x4 gg = *(const f32x4*)(g + 4 * lane + 256 * j), bb = *(const f32x4*)(b + 4 * lane + 256 * j); r0.v[j] = r0.v[j] * d0 * gg + bb; r1.v[j] = r1.v[j] * d1 * gg + bb; }
}
template <class AP, class BP>
__device__ __forceinline__ f32x4 sgemm16(const AP& ap, const BP& bp, int K, int lane) {
    const int r = lane & 15, G = lane >> 4; f32x4 acc = (f32x4){0.f, 0.f, 0.f, 0.f};
#pragma unroll 8
    for (int k0 = 0; k0 < K; k0 += 32) { const bf16x8 a = *(const bf16x8*)ap(r, k0 + 8 * G), b = *(const bf16x8*)bp(r, k0 + 8 * G);
        acc = __builtin_amdgcn_mfma_f32_16x16x32_bf16(a, b, acc, 0, 0, 0); }
    return acc;
}
__device__ __forceinline__ void transpose_tile64(const bf16* src, size_t sp, bf16* dst, size_t dp, LAS bf16* scr, int lane) {
    const int r8 = lane >> 3, pc = lane & 7;
#pragma unroll
    for (int c = 0; c < 8; ++c) { const int row = 8 * c + r8; const u32x4 v = *(const u32x4*)(src + (size_t)row * sp + 8 * pc); LAS unsigned* d = (LAS unsigned*)(scr + row * 66 + 8 * pc); d[0] = v.x; d[1] = v.y; d[2] = v.z; d[3] = v.w; }
    LDS_WAIT(); asm volatile("" ::: "memory");
#pragma unroll
    for (int c = 0; c < 8; ++c) { const int drow = 8 * c + r8; unsigned w[4];
#pragma unroll
        for (int q = 0; q < 4; ++q) { const unsigned lo = scr[(8 * pc + 2 * q) * 66 + drow], hi = scr[(8 * pc + 2 * q + 1) * 66 + drow]; w[q] = lo | (hi << 16); }
        *(u32x4*)(dst + (size_t)drow * dp + 8 * pc) = (u32x4){w[0], w[1], w[2], w[3]}; }
    LDS_WAIT(); asm volatile("" ::: "memory");
}
__device__ __forceinline__ float gelu_tanh(float x) { const float u = 0.7978845608028654f * (x + 0.044715f * x * x * x); return 0.5f * x * (1.0f + tanhf(u)); }

__device__ __forceinline__ void phase_prologue(const Args& a, Frame& F) {
    LAS float* scr = (LAS float*)(F.lds + F.wave * 16640);
    const int gw = F.gw, NGW = F.NGW, lane = F.lane;
    { int off = 0;
      for (int l = 0; l < DEPTH; ++l)
        for (int j = 0; j < NJOBS; ++j) { const Job J = get_job(a, l, j); const int n = J.nbatch * J.nkb * J.nnb;
            int st = (gw - off) % NGW; if (st < 0) st += NGW;
            f32x4 va[16], vb[16];
            if (st < n) transpose_load(J, st, va, lane);
#pragma unroll 1
            for (int it = st; it < n; it += 2 * NGW) {
                if (it + NGW < n) transpose_load(J, it + NGW, vb, lane);
                transpose_store(J, it, va, scr, lane);
                if (it + NGW < n) { if (it + 2 * NGW < n) transpose_load(J, it + 2 * NGW, va, lane); transpose_store(J, it + NGW, vb, scr, lane); } }
            off = (off + n) % NGW; } }
#pragma unroll 1
    for (int i = gw * 64 + lane; i < DEPTH * NIN; i += NGW * 64) { const int l = i / NIN, n = i % NIN; const int sc = in_col(n);
        ((float*)(a.ws + WS_WL0 + (size_t)l * WS_WLSTRIDE + WO_BIASP))[n] = sc >= 0 ? ((const float*)a.in[4])[(size_t)l * IN_W + sc] : 0.f; }
#pragma unroll 1
    for (int it = gw; it < DEPTH * 4 * 16 * 32; it += NGW) { const int nb = it & 31, cb = (it >> 5) & 15, g = (it >> 9) & 3, l = it >> 11; const int n = nb * 64 + lane;
        const float* wp = (const float*)a.in[9] + ((size_t)(l * 4 + g) * 128 + 8 * cb) * 128; const float* ps = (const float*)a.in[10] + l * 512 + 128 * g;
        const float* wo = (const float*)a.in[11] + ((size_t)l * 512 + 128 * g) * D + n;
        float acc[8];
#pragma unroll
        for (int i = 0; i < 8; ++i) acc[i] = 0.f;
#pragma unroll 8
        for (int d = 0; d < 128; ++d) { const float b = wo[(size_t)d * D] * ps[d];
#pragma unroll
            for (int i = 0; i < 8; ++i) acc[i] += wp[i * 128 + d] * b; }
        bf16* dst = (bf16*)(a.ws + WS_WL0 + (size_t)l * WS_WLSTRIDE + WO_WBR) + (size_t)n * D + 512 + 128 * g + 8 * cb;
        *(u32x4*)dst = (u32x4){cvt_pk_bf16(acc[0], acc[1]), cvt_pk_bf16(acc[2], acc[3]), cvt_pk_bf16(acc[4], acc[5]), cvt_pk_bf16(acc[6], acc[7])}; }
#pragma unroll 1
    for (int it = gw; it < DEPTH * 2 * 16; it += NGW) { const int lj = it >> 4, ch = it & 15;
        const float* pos = (const float*)a.in[5] + (size_t)lj * 2048 + 128 * ch; const float* w1 = (const float*)a.in[6] + ((size_t)lj * 2048 + 128 * ch) * 128;
        float a0 = 0.f, a1 = 0.f;
#pragma unroll 8
        for (int k = 0; k < 128; ++k) { const float p = pos[k]; a0 += p * w1[(size_t)k * 128 + lane]; a1 += p * w1[(size_t)k * 128 + 64 + lane]; }
        float* dst = (float*)(a.ws + WS_WL0 + (size_t)(lj >> 1) * WS_WLSTRIDE + WO_B1C) + ((lj & 1) * 16 + ch) * 128; dst[lane] = a0; dst[64 + lane] = a1; }
#pragma unroll 1
    for (int i = gw * 64 + lane; i < S * 16; i += NGW * 64) { const int t = i >> 4, k = i & 15; const float inv = powf(10000.0f, -(float)k / 16.0f); const float ang = (float)((const int*)a.in[2])[t] * inv;
        float sn, cs; sincosf(ang, &sn, &cs); ((f32x2*)(a.ws + WS_ROPE))[i] = (f32x2){cs, sn}; }
#pragma unroll 1
    for (int i = gw * 64 + lane; i < DEPTH * 48 * 2048; i += NGW * 64) { const int l = i / (48 * 2048), n = (i / 2048) % 48, k = i % 2048;
        float w = 0.f; if (n < 4) w = ((const float*)a.in[31])[((size_t)l * D + k) * 4 + n]; else if (n < 36) w = ((const float*)a.in[33])[((size_t)l * D + k) * 32 + (n - 4)];
        const unsigned short h = f2bf(w); const unsigned short lo = f2bf(w - bf2f(h));
        bf16* dst = (bf16*)(a.ws + WS_WL0 + (size_t)l * WS_WLSTRIDE + WO_WRT); dst[(size_t)n * 2048 + k] = h; dst[(size_t)(48 + n) * 2048 + k] = lo; }
#pragma unroll 1
    for (int r = gw; r < S + 256; r += NGW) { Row rw;
        if (r < S) { row_load(rw, (const float*)a.in[0] + (size_t)r * D, lane); row_store_bf16(rw, (bf16*)(a.ws + WS_XB) + (size_t)r * D, lane); }
        else { row_load(rw, (const float*)a.in[1] + (size_t)(r - S) * D, lane); row_store_bf16(rw, (bf16*)(a.ws + WS_MEMB) + (size_t)(r - S) * D, lane); } }
}

__device__ __forceinline__ int crow(int r, int hi) { return (r & 3) + 8 * (r >> 2) + 4 * hi; }
template <int DK, int DV, class V>
__device__ __forceinline__ void attn32(const V& v, int lane, float& m_fin, float& l_fin) {
    const int col = lane & 31, hi = lane >> 5;
    constexpr int NKS = DK / 16, NVB = DV / 32;
    bf16x8 qf[NKS];
    { const bf16* qp = v.qptr(col);
#pragma unroll
      for (int s = 0; s < NKS; ++s) qf[s] = *(const bf16x8*)(qp + 16 * s + 8 * hi); }
    f32x16 o[NVB];
#pragma unroll
    for (int b = 0; b < NVB; ++b)
#pragma unroll
        for (int r = 0; r < 16; ++r) o[b][r] = 0.f;
    float m_run = -INFINITY, l_run = 0.f;
    for (int T = v.tb; T < v.te; ++T) {
        const int key0 = 32 * T;
        const bf16* kp = v.kptr(key0 + col);
        f32x16 sacc;
#pragma unroll
        for (int r = 0; r < 16; ++r) sacc[r] = 0.f;
#pragma unroll
        for (int s = 0; s < NKS; ++s) { const bf16x8 kf = *(const bf16x8*)(kp + 16 * s + 8 * hi); sacc = __builtin_amdgcn_mfma_f32_32x32x16_bf16(kf, qf[s], sacc, 0, 0, 0); }
        float x[16]; float mt = -INFINITY;
#pragma unroll
        for (int r = 0; r < 16; ++r) { const int key = key0 + crow(r, hi); x[r] = v.valid(key, col) ? sacc[r] * v.scale2 : -INFINITY; mt = fmaxf(mt, x[r]); }
        mt = fmaxf(mt, __shfl_xor(mt, 32));
        const float m_new = fmaxf(m_run, mt);
        const float mref = (m_new == -INFINITY) ? 0.f : m_new;
        const float corr = __builtin_amdgcn_exp2f(m_run - mref);
        float ps = 0.f;
#pragma unroll
        for (int r = 0; r < 16; ++r) { x[r] = __builtin_amdgcn_exp2f(x[r] - mref); ps += x[r]; }
        l_run = l_run * corr + ps; m_run = m_new;
#pragma unroll
        for (int b = 0; b < NVB; ++b)
#pragma unroll
            for (int r = 0; r < 16; ++r) o[b][r] *= corr;
        bf16x8 pf[2];
#pragma unroll
        for (int s2 = 0; s2 < 2; ++s2) { const u32x4 w = (u32x4){cvt_pk_bf16(x[8 * s2 + 0], x[8 * s2 + 1]), cvt_pk_bf16(x[8 * s2 + 2], x[8 * s2 + 3]), cvt_pk_bf16(x[8 * s2 + 4], x[8 * s2 + 5]), cvt_pk_bf16(x[8 * s2 + 6], x[8 * s2 + 7])};
            pf[s2] = __builtin_bit_cast(bf16x8, w); }
#pragma unroll
        for (int b = 0; b < NVB; ++b) { const bf16* vp = v.vtptr(32 * b + col) + key0 + 4 * hi;
#pragma unroll
            for (int s2 = 0; s2 < 2; ++s2) { const u32x2 lo = *(const u32x2*)(vp + 16 * s2), hh = *(const u32x2*)(vp + 16 * s2 + 8);
                const bf16x8 vf = __builtin_bit_cast(bf16x8, (u32x4){lo.x, lo.y, hh.x, hh.y});
                o[b] = __builtin_amdgcn_mfma_f32_32x32x16_bf16(vf, pf[s2], o[b], 0, 0, 0); } }
    }
    const float l = l_run + __shfl_xor(l_run, 32);
    const float inv = l > 0.f ? 1.0f / l : 0.f;
#pragma unroll
    for (int b = 0; b < NVB; ++b)
#pragma unroll
        for (int i = 0; i < 4; ++i) v.store(col, 32 * b + 8 * i + 4 * hi, (f32x4){o[b][4 * i] * inv, o[b][4 * i + 1] * inv, o[b][4 * i + 2] * inv, o[b][4 * i + 3] * inv});
    m_fin = m_run; l_fin = l;
}
__device__ __forceinline__ void store4_bf16(bf16* p, const f32x4 v) { *(u32x2*)p = (u32x2){cvt_pk_bf16(v[0], v[1]), cvt_pk_bf16(v[2], v[3])}; }

struct VarMLA {
    const bf16* Q; const bf16* K; const bf16* Vt; bf16* O; int t0, hd, tb, te; float scale2;
    __device__ __forceinline__ const bf16* qptr(int col) const { return Q + (size_t)(t0 + col) * 768 + hd * 96; }
    __device__ __forceinline__ const bf16* kptr(int key) const { return K + (size_t)key * 768 + hd * 96; }
    __device__ __forceinline__ const bf16* vtptr(int dv) const { return Vt + (size_t)(hd * 64 + dv) * S; }
    __device__ __forceinline__ bool valid(int key, int col) const { return key <= t0 + col; }
    __device__ __forceinline__ void store(int col, int dv, const f32x4 x) const { store4_bf16(O + (size_t)(t0 + col) * D + 1024 + hd * 64 + dv, x); }
};
struct VarWin {
    const bf16* U2; const bf16* Vt; bf16* O; int t0, g, tb, te; float scale2;
    __device__ __forceinline__ const bf16* qptr(int col) const { return U2 + (size_t)(t0 + (col >> 2)) * U2W + U2_Q + (4 * g + (col & 3)) * 64; }
    __device__ __forceinline__ const bf16* kptr(int key) const { return U2 + (size_t)key * U2W + U2_KV + (4 * 2 + g) * 64; }
    __device__ __forceinline__ const bf16* vtptr(int dv) const { return Vt + (size_t)(g * 64 + dv) * S; }
    __device__ __forceinline__ bool valid(int key, int col) const { const int tok = t0 + (col >> 2); return key <= tok && key > tok - 512; }
    __device__ __forceinline__ void store(int col, int dv, const f32x4 x) const { store4_bf16(O + (size_t)(t0 + (col >> 2)) * 512 + (4 * g + (col & 3)) * 64 + dv, x); }
};
struct VarCmp {
    const bf16* U2; const bf16* KC; const bf16* Vt; bf16* O; int t0, g, tb, te; float scale2;
    __device__ __forceinline__ const bf16* qptr(int col) const { return U2 + (size_t)(t0 + (col >> 2)) * U2W + U2_Q + (4 * g + (col & 3)) * 64; }
    __device__ __forceinline__ const bf16* kptr(int c) const { return KC + (size_t)(g * 1024 + c) * 64; }
    __device__ __forceinline__ const bf16* vtptr(int dv) const { return Vt + (size_t)(g * 64 + dv) * 1024; }
    __device__ __forceinline__ bool valid(int c, int col) const { return 16 * c + 31 <= t0 + (col >> 2); }
    __device__ __forceinline__ void store(int col, int dv, const f32x4 x) const { store4_bf16(O + (size_t)(t0 + (col >> 2)) * 512 + (4 * g + (col & 3)) * 64 + dv, x); }
};
struct VarX {
    const bf16* Q; const bf16* K; const bf16* Vt; bf16* O; int t0, hd, tb, te; float scale2;
    __device__ __forceinline__ const bf16* qptr(int col) const { return Q + (size_t)(t0 + col) * 512 + hd * 128; }
    __device__ __forceinline__ const bf16* kptr(int key) const { return K + (size_t)key * 512 + hd * 128; }
    __device__ __forceinline__ const bf16* vtptr(int dv) const { return Vt + (size_t)(hd * 128 + dv) * 256; }
    __device__ __forceinline__ bool valid(int, int) const { return true; }
    __device__ __forceinline__ void store(int col, int dv, const f32x4 x) const { store4_bf16(O + (size_t)(t0 + col) * 512 + hd * 128 + dv, x); }
};
__device__ __forceinline__ void cmp_scores(const VarCmp& v, int lane, float m_fin, float l_fin, float* sc) {
    const int col = lane & 31, hi = lane >> 5;
    bf16x8 qf[4];
    { const bf16* qp = v.qptr(col);
#pragma unroll
      for (int s = 0; s < 4; ++s) qf[s] = *(const bf16x8*)(qp + 16 * s + 8 * hi); }
    const float mref = (m_fin == -INFINITY) ? 0.f : m_fin; const float inv = l_fin > 0.f ? 1.0f / l_fin : 0.f;
    float* dst = sc + (size_t)((v.t0 + (col >> 2)) * 2 + v.g) * 256;
    float carry = 0.f;
    for (int T = 0; T < 32; ++T) {
        float sv[4];
        if (T < v.te) {
            const int key0 = 32 * T; const bf16* kp = v.kptr(key0 + col);
            f32x16 sacc;
#pragma unroll
            for (int r = 0; r < 16; ++r) sacc[r] = 0.f;
#pragma unroll
            for (int s = 0; s < 4; ++s) { const bf16x8 kf = *(const bf16x8*)(kp + 16 * s + 8 * hi); sacc = __builtin_amdgcn_mfma_f32_32x32x16_bf16(kf, qf[s], sacc, 0, 0, 0); }
            float Gs[4], Es[4];
#pragma unroll
            for (int i = 0; i < 4; ++i) { float p[4];
#pragma unroll
                for (int q = 0; q < 4; ++q) { const int r = 4 * i + q; const int key = key0 + crow(r, hi); p[q] = v.valid(key, col) ? __builtin_amdgcn_exp2f(sacc[r] * v.scale2 - mref) * inv : 0.f; }
                Gs[i] = (p[0] + p[1]) + (p[2] + p[3]); Es[i] = p[3]; }
#pragma unroll
            for (int i = 0; i < 4; ++i) { Gs[i] += __shfl_xor(Gs[i], 1); Gs[i] += __shfl_xor(Gs[i], 2); Es[i] += __shfl_xor(Es[i], 1); Es[i] += __shfl_xor(Es[i], 2); }
            float eo[4];
#pragma unroll
            for (int i = 0; i < 4; ++i) eo[i] = __shfl_xor(Es[i], 32);
            if (hi) { sv[0] = Gs[0] + eo[0]; sv[1] = Gs[1] + eo[1]; sv[2] = Gs[2] + eo[2]; sv[3] = Gs[3] + eo[3]; }
            else { sv[0] = Gs[0] + carry; sv[1] = Gs[1] + eo[0]; sv[2] = Gs[2] + eo[1]; sv[3] = Gs[3] + eo[2]; }
            carry = eo[3];
        } else { sv[0] = hi ? 0.f : carry; sv[1] = 0.f; sv[2] = 0.f; sv[3] = 0.f; carry = 0.f; }
        if ((col & 3) == 0) {
#pragma unroll
            for (int i = 0; i < 4; ++i) dst[8 * T + 2 * i + hi] = sv[i]; }
    }
}

__device__ __forceinline__ void sel_attn_unit(const bf16* U2, const bf16* VTS, const bf16* OCMP, const bf16* OWIN, const int* idx, int nv, bf16* ABR, int t, int g, int lane) {
    const int c16 = lane & 15, G = lane >> 4;
    const float scale2 = 1.0f;
    bf16x8 qf[2];
    { const bf16* qp = U2 + (size_t)t * U2W + U2_Q + (4 * g + (c16 & 3)) * 64;
#pragma unroll
      for (int ks = 0; ks < 2; ++ks) { qf[ks] = *(const bf16x8*)(qp + 32 * ks + 8 * G); if (c16 >= 4) qf[ks] = (bf16x8){0, 0, 0, 0, 0, 0, 0, 0}; } }
    f32x4 o[4];
#pragma unroll
    for (int d = 0; d < 4; ++d) o[d] = (f32x4){0.f, 0.f, 0.f, 0.f};
    float m_run = -INFINITY, l_run = 0.f;
    for (int b = 0; b < nv; ++b) {
        const int blk = __builtin_amdgcn_readfirstlane(idx[b]); const int key0 = 64 * blk;
        f32x4 acc[4];
#pragma unroll
        for (int kt = 0; kt < 4; ++kt) { const bf16* kp = U2 + (size_t)(key0 + 16 * kt + c16) * U2W + U2_KV + (2 * 2 + g) * 64 + 8 * G;
            const bf16x8 k0 = *(const bf16x8*)kp, k1 = *(const bf16x8*)(kp + 32);
            acc[kt] = __builtin_amdgcn_mfma_f32_16x16x32_bf16(k0, qf[0], (f32x4){0.f, 0.f, 0.f, 0.f}, 0, 0, 0);
            acc[kt] = __builtin_amdgcn_mfma_f32_16x16x32_bf16(k1, qf[1], acc[kt], 0, 0, 0); }
        float mt = -INFINITY;
#pragma unroll
        for (int kt = 0; kt < 4; ++kt)
#pragma unroll
            for (int i = 0; i < 4; ++i) { const int key = key0 + 16 * kt + 4 * G + i; acc[kt][i] = (key <= t) ? acc[kt][i] * scale2 : -INFINITY; mt = fmaxf(mt, acc[kt][i]); }
        mt = fmaxf(mt, __shfl_xor(mt, 16)); mt = fmaxf(mt, __shfl_xor(mt, 32));
        const float m_new = fmaxf(m_run, mt); const float mref = (m_new == -INFINITY) ? 0.f : m_new;
        const float corr = __builtin_amdgcn_exp2f(m_run - mref); float ps = 0.f;
#pragma unroll
        for (int kt = 0; kt < 4; ++kt)
#pragma unroll
            for (int i = 0; i < 4; ++i) { acc[kt][i] = __builtin_amdgcn_exp2f(acc[kt][i] - mref); ps += acc[kt][i]; }
        l_run = l_run * corr + ps; m_run = m_new;
#pragma unroll
        for (int d = 0; d < 4; ++d) o[d] = o[d] * corr;
        bf16x8 pf[2];
#pragma unroll
        for (int u = 0; u < 2; ++u) pf[u] = __builtin_bit_cast(bf16x8, (u32x4){cvt_pk_bf16(acc[2 * u][0], acc[2 * u][1]), cvt_pk_bf16(acc[2 * u][2], acc[2 * u][3]), cvt_pk_bf16(acc[2 * u + 1][0], acc[2 * u + 1][1]), cvt_pk_bf16(acc[2 * u + 1][2], acc[2 * u + 1][3])});
#pragma unroll
        for (int d = 0; d < 4; ++d) { const bf16* vp = VTS + (size_t)(g * 64 + 16 * d + c16) * S + key0 + 4 * G;
#pragma unroll
            for (int u = 0; u < 2; ++u) { const u32x2 lo = *(const u32x2*)(vp + 32 * u), hh = *(const u32x2*)(vp + 32 * u + 16);
                o[d] = __builtin_amdgcn_mfma_f32_16x16x32_bf16(__builtin_bit_cast(bf16x8, (u32x4){lo.x, lo.y, hh.x, hh.y}), pf[u], o[d], 0, 0, 0); } }
    }
    float l = l_run; l += __shfl_xor(l, 16); l += __shfl_xor(l, 32);
    const float inv = l > 0.f ? 1.0f / l : 0.f;
    if (c16 < 4) { const int head = 4 * g + c16; const bf16* gp = U2 + (size_t)t * U2W + U2_G + head * 3;
        const float s0 = sigmoidf_(bf2f(gp[0])), s1 = sigmoidf_(bf2f(gp[1])) * inv, s2 = sigmoidf_(bf2f(gp[2]));
#pragma unroll
        for (int d = 0; d < 4; ++d) { const size_t off = (size_t)t * 512 + head * 64 + 16 * d + 4 * G; const u32x2 oc = *(const u32x2*)(OCMP + off), ow = *(const u32x2*)(OWIN + off);
            f32x4 r; r[0] = s0 * bflo(oc.x) + s1 * o[d][0] + s2 * bflo(ow.x); r[1] = s0 * bfhi(oc.x) + s1 * o[d][1] + s2 * bfhi(ow.x);
            r[2] = s0 * bflo(oc.y) + s1 * o[d][2] + s2 * bflo(ow.y); r[3] = s0 * bfhi(oc.y) + s1 * o[d][3] + s2 * bfhi(ow.y);
            store4_bf16(ABR + (size_t)t * D + head * 64 + 16 * d + 4 * G, r); } }
}
__device__ __forceinline__ bool selmask_test(const LAS unsigned* m8, int j) { return (m8[(j & 3) * 2 + (j >> 7)] >> ((j >> 2) & 31)) & 1u; }
__device__ __forceinline__ void topk_unit(const float* sc, int t, unsigned* mask_out, int lane) {
    const int cur = t >> 6;
    const f32x4 v = *(const f32x4*)(sc + 4 * lane);
    unsigned key[4];
#pragma unroll
    for (int q = 0; q < 4; ++q) { const int j = 4 * lane + q;
        key[q] = __float_as_uint(v[q]) + 1u;
        if (j == 0 || j == cur || j == cur - 1) key[q] = 0xffffffffu;
        if (j > cur) key[q] = 0u; }
    unsigned T = 0u;
#pragma unroll 1
    for (int bit = 31; bit >= 0; --bit) { const unsigned cand = T | (1u << bit);
        int cnt = 0;
#pragma unroll
        for (int q = 0; q < 4; ++q) cnt += __builtin_popcountll(__ballot(key[q] >= cand));
        if (cnt >= 16) { T = cand; if (cnt == 16) break; } }
    unsigned long long G[4], E[4]; int cgt = 0;
#pragma unroll
    for (int q = 0; q < 4; ++q) { G[q] = __ballot(key[q] > T); E[q] = __ballot(key[q] == T && T != 0u); cgt += __builtin_popcountll(G[q]); }
    const int need = 16 - cgt;
    int below = 0;
#pragma unroll
    for (int q = 0; q < 4; ++q) below += (int)__builtin_amdgcn_mbcnt_hi((unsigned)(E[q] >> 32), __builtin_amdgcn_mbcnt_lo((unsigned)E[q], 0u));
    unsigned long long Sel[4]; int own = 0;
#pragma unroll
    for (int q = 0; q < 4; ++q) { const bool eq = (key[q] == T && T != 0u); const bool take = (key[q] > T) || (eq && (below + own) < need); own += eq ? 1 : 0; Sel[q] = __ballot(take); }
    unsigned w = 0u;
#pragma unroll
    for (int q = 0; q < 4; ++q) { if (lane == 2 * q) w = (unsigned)Sel[q]; if (lane == 2 * q + 1) w = (unsigned)(Sel[q] >> 32); }
    if (lane < 8) mask_out[lane] = w;
}

template <int NKS, int KP, int VP, int NVB, class MaskF>
__device__ __forceinline__ void att_step64n(const LAS unsigned char* kb, const LAS unsigned char* vb, const bf16x8 (&qf)[NKS], f32x16 (&o)[NVB], float& m_run, float& l_run, float scale2, bool use_mask, const MaskF& mask, int col, int hi) {
    f32x16 sacc[2];
#pragma unroll
    for (int u = 0; u < 2; ++u) {
#pragma unroll
        for (int r = 0; r < 16; ++r) sacc[u][r] = 0.f;
#pragma unroll
        for (int s = 0; s < NKS; ++s) { const bf16x8 kf = *(const LAS bf16x8*)(kb + ((32 * u + col) * KP + 16 * s + 8 * hi) * 2); sacc[u] = __builtin_amdgcn_mfma_f32_32x32x16_bf16(kf, qf[s], sacc[u], 0, 0, 0); } }
    float mt = -INFINITY;
#pragma unroll
    for (int u = 0; u < 2; ++u)
#pragma unroll
        for (int r = 0; r < 16; ++r) { float x = sacc[u][r] * scale2; if (use_mask) { if (!mask(u, r)) x = -INFINITY; } sacc[u][r] = x; mt = fmaxf(mt, x); }
    mt = xmax32(mt);
    const float m_new = fmaxf(m_run, mt); const float mref = (m_new == -INFINITY) ? 0.f : m_new;
    if (__any(m_new != m_run)) {
        const float corr = __builtin_amdgcn_exp2f(m_run - mref); l_run *= corr; m_run = m_new;
#pragma unroll
        for (int b = 0; b < NVB; ++b)
#pragma unroll
            for (int r = 0; r < 16; ++r) o[b][r] *= corr; }
    float ps = 0.f;
#pragma unroll
    for (int u = 0; u < 2; ++u)
#pragma unroll
        for (int r = 0; r < 16; ++r) { sacc[u][r] = __builtin_amdgcn_exp2f(sacc[u][r] - mref); ps += sacc[u][r]; }
    l_run += ps;
#pragma unroll
    for (int u = 0; u < 2; ++u)
#pragma unroll
        for (int s2 = 0; s2 < 2; ++s2) { const bf16x8 pf = __builtin_bit_cast(bf16x8, (u32x4){cvt_pk_bf16(sacc[u][8 * s2 + 0], sacc[u][8 * s2 + 1]), cvt_pk_bf16(sacc[u][8 * s2 + 2], sacc[u][8 * s2 + 3]), cvt_pk_bf16(sacc[u][8 * s2 + 4], sacc[u][8 * s2 + 5]), cvt_pk_bf16(sacc[u][8 * s2 + 6], sacc[u][8 * s2 + 7])});
#pragma unroll
            for (int b = 0; b < NVB; ++b) { const LAS unsigned char* vp = vb + ((32 * b + col) * VP + 32 * u + 16 * s2 + 4 * hi) * 2;
                const u32x2 lo = *(const LAS u32x2*)vp, hh = *(const LAS u32x2*)(vp + 16);
                o[b] = __builtin_amdgcn_mfma_f32_32x32x16_bf16(__builtin_bit_cast(bf16x8, (u32x4){lo.x, lo.y, hh.x, hh.y}), pf, o[b], 0, 0, 0); } }
}

template <int NKS, int KP, int VP, class MaskF>
__device__ __forceinline__ void att_step64(const LAS unsigned char* kb, const LAS unsigned char* vb, const bf16x8 (&qf)[NKS], f32x16 (&o)[2], float& m_run, float& l_run, float scale2, bool use_mask, const MaskF& mask, int col, int hi) {
    att_step64n<NKS, KP, VP, 2>(kb, vb, qf, o, m_run, l_run, scale2, use_mask, mask, col, hi);
}

constexpr int SK_KP = 72, SK_VP = 132;
constexpr int SK_KB = 128 * SK_KP * 2, SK_VB = 64 * SK_VP * 2, SK_VOFF = 2 * SK_KB, SK_MOFF = SK_VOFF + 2 * SK_VB;
template <int MODE>
__device__ __forceinline__ void sel_unit(LAS unsigned char* lds, const bf16* U2, const bf16* VTS, const unsigned* SM, const bf16* OCMP, bf16* OWIN, bf16* ABR, int g, int qblk, int tid, int wave, int lane) {
    const int col = lane & 31, hi = lane >> 5;
    const int tl = 8 * wave + (col >> 2), t = 64 * qblk + tl, head = 4 * g + (col & 3);
    LAS unsigned* smask = (LAS unsigned*)(lds + SK_MOFF);
    __syncthreads();
    if (MODE == 0) smask[tid] = SM[(size_t)((64 * qblk + (tid >> 3)) * 2 + g) * 8 + (tid & 7)];
    bf16x8 qf[4];
    { const bf16* qp = U2 + (size_t)t * U2W + U2_Q + head * 64;
#pragma unroll
      for (int s = 0; s < 4; ++s) qf[s] = *(const bf16x8*)(qp + 16 * s + 8 * hi); }
    f32x16 o[2];
#pragma unroll
    for (int b = 0; b < 2; ++b)
#pragma unroll
        for (int r = 0; r < 16; ++r) o[b][r] = 0.f;
    float m_run = -INFINITY, l_run = 0.f;
    const float scale2 = 1.0f;
    const int jlo = (MODE == 1 && qblk > 8) ? qblk - 8 : 0;
    const int st0 = jlo >> 1, st1 = (qblk >> 1) + 1;
    const int kvsel = (MODE == 1) ? 4 : 2;
    const bf16* kg[2]; unsigned kl[2]; const bf16* vg[2]; unsigned vl[2];
#pragma unroll
    for (int i = 0; i < 2; ++i) { const int c = tid + 512 * i; { const int row = c >> 3, p = c & 7; kg[i] = U2 + (size_t)row * U2W + U2_KV + (kvsel * 2 + g) * 64 + 8 * p; kl[i] = (unsigned)(row * SK_KP + 8 * p) * 2u; }
        { const int row = c >> 4, p = c & 15; vg[i] = VTS + (size_t)(g * 64 + row) * S + 8 * p; vl[i] = (unsigned)(row * SK_VP + 8 * p) * 2u; } }
    u32x4 kr[2], vr[2];
    auto gload = [&](int step) { const int key0 = 128 * step;
#pragma unroll
        for (int i = 0; i < 2; ++i) { kr[i] = *(const u32x4*)(kg[i] + (size_t)key0 * U2W); vr[i] = *(const u32x4*)(vg[i] + key0); } };
    gload(st0);
#pragma unroll 1
    for (int st = st0; st < st1; ++st) {
        const int buf = st & 1;
        LAS unsigned char* kb = lds + buf * SK_KB; LAS unsigned char* vb = lds + SK_VOFF + buf * SK_VB;
#pragma unroll
        for (int i = 0; i < 2; ++i) { *(LAS u32x4*)(kb + kl[i]) = kr[i]; *(LAS u32x2*)(vb + vl[i]) = (u32x2){vr[i].x, vr[i].y}; *(LAS u32x2*)(vb + vl[i] + 8) = (u32x2){vr[i].z, vr[i].w}; }
        __syncthreads();
        if (st + 1 < st1) gload(st + 1);
#pragma unroll
        for (int h = 0; h < 2; ++h) { const int j = 2 * st + h;
            bool sel = (j >= jlo) && (j <= qblk);
            if (MODE == 0) sel = sel && selmask_test(smask + tl * 8, j);
            if (__any(sel)) { const int key0 = 64 * j; const bool diag = (j == qblk), first = (MODE == 1) && (j == qblk - 8);
                auto mask = [&](int u, int r) { const int key = key0 + 32 * u + crow(r, hi); return sel && (!diag || key <= t) && (!first || key > t - 512); };
                att_step64<4, SK_KP, SK_VP>(kb + h * 64 * SK_KP * 2, vb + h * 128, qf, o, m_run, l_run, scale2, MODE == 0 || diag || first, mask, col, hi); } }
    }
    const float l = l_run + __shfl_xor(l_run, 32); const float inv = l > 0.f ? 1.0f / l : 0.f;
    if (MODE == 1) {
#pragma unroll
        for (int b = 0; b < 2; ++b)
#pragma unroll
            for (int i = 0; i < 4; ++i) store4_bf16(OWIN + (size_t)t * 512 + head * 64 + 32 * b + 8 * i + 4 * hi, (f32x4){o[b][4 * i] * inv, o[b][4 * i + 1] * inv, o[b][4 * i + 2] * inv, o[b][4 * i + 3] * inv});
    } else {
        const bf16* gp = U2 + (size_t)t * U2W + U2_G + head * 3;
        const float s0 = sigmoidf_(bf2f(gp[0])), s1 = sigmoidf_(bf2f(gp[1])) * inv, s2g = sigmoidf_(bf2f(gp[2]));
#pragma unroll
        for (int b = 0; b < 2; ++b)
#pragma unroll
            for (int i = 0; i < 4; ++i) { const int dv = 32 * b + 8 * i + 4 * hi; const size_t off = (size_t)t * 512 + head * 64 + dv; const u32x2 oc = *(const u32x2*)(OCMP + off), ow = *(const u32x2*)(OWIN + off);
                f32x4 r; r[0] = s0 * bflo(oc.x) + s1 * o[b][4 * i] + s2g * bflo(ow.x); r[1] = s0 * bfhi(oc.x) + s1 * o[b][4 * i + 1] + s2g * bfhi(ow.x);
                r[2] = s0 * bflo(oc.y) + s1 * o[b][4 * i + 2] + s2g * bflo(ow.y); r[3] = s0 * bfhi(oc.y) + s1 * o[b][4 * i + 3] + s2g * bfhi(ow.y);
                store4_bf16(ABR + (size_t)t * D + head * 64 + dv, r); }
    }
}

__device__ __forceinline__ void cmp_unit(LAS unsigned char* lds, const bf16* U2, const bf16* KC, const bf16* VCT, bf16* OCMP, float* SC, int g, int qblk, int tid, int wave, int lane) {
    const int col = lane & 31, hi = lane >> 5;
    const int tl = 8 * wave + (col >> 2), t = 64 * qblk + tl, head = 4 * g + (col & 3);
    __syncthreads();
    bf16x8 qf[4];
    { const bf16* qp = U2 + (size_t)t * U2W + U2_Q + head * 64;
#pragma unroll
      for (int s = 0; s < 4; ++s) qf[s] = *(const bf16x8*)(qp + 16 * s + 8 * hi); }
    f32x16 o[2];
#pragma unroll
    for (int b = 0; b < 2; ++b)
#pragma unroll
        for (int r = 0; r < 16; ++r) o[b][r] = 0.f;
    float m_run = -INFINITY, l_run = 0.f;
    const float scale2 = 1.0f;
    const int nst = (4 * qblk + 3 + 127) >> 7;
    const int twmax = 64 * qblk + 8 * wave + 7; const int cw = (twmax >= 31) ? ((twmax - 31) >> 4) : -1;
    const int call = (64 * qblk >= 31) ? ((64 * qblk - 31) >> 4) : -1;
    const bf16* kg[2]; unsigned kl[2]; const bf16* vg[2]; unsigned vl[2];
#pragma unroll
    for (int i = 0; i < 2; ++i) { const int c = tid + 512 * i; { const int row = c >> 3, p = c & 7; kg[i] = KC + (size_t)(g * 1024 + row) * 64 + 8 * p; kl[i] = (unsigned)(row * SK_KP + 8 * p) * 2u; }
        { const int row = c >> 4, p = c & 15; vg[i] = VCT + (size_t)(g * 64 + row) * 1024 + 8 * p; vl[i] = (unsigned)(row * SK_VP + 8 * p) * 2u; } }
    u32x4 kr[2], vr[2];
#pragma unroll
    for (int i = 0; i < 2; ++i) { kr[i] = *(const u32x4*)kg[i]; vr[i] = *(const u32x4*)vg[i]; }
#pragma unroll 1
    for (int st = 0; st < nst; ++st) {
        const int buf = st & 1;
        LAS unsigned char* kb = lds + buf * SK_KB; LAS unsigned char* vb = lds + SK_VOFF + buf * SK_VB;
#pragma unroll
        for (int i = 0; i < 2; ++i) { *(LAS u32x4*)(kb + kl[i]) = kr[i]; *(LAS u32x2*)(vb + vl[i]) = (u32x2){vr[i].x, vr[i].y}; *(LAS u32x2*)(vb + vl[i] + 8) = (u32x2){vr[i].z, vr[i].w}; }
        __syncthreads();
        if (st + 1 < nst) {
#pragma unroll
            for (int i = 0; i < 2; ++i) { kr[i] = *(const u32x4*)(kg[i] + (size_t)128 * (st + 1) * 64); vr[i] = *(const u32x4*)(vg[i] + 128 * (st + 1)); } }
#pragma unroll
        for (int h = 0; h < 2; ++h) { const int c0 = 128 * st + 64 * h;
            if (c0 <= cw) { auto mask = [&](int u, int r) { return 16 * (c0 + 32 * u + crow(r, hi)) + 31 <= t; };
                att_step64<4, SK_KP, SK_VP>(kb + h * 64 * SK_KP * 2, vb + h * 128, qf, o, m_run, l_run, scale2, c0 + 63 > call, mask, col, hi); } }
    }
    const float l = l_run + __shfl_xor(l_run, 32); const float inv = l > 0.f ? 1.0f / l : 0.f;
#pragma unroll
    for (int b = 0; b < 2; ++b)
#pragma unroll
        for (int i = 0; i < 4; ++i) store4_bf16(OCMP + (size_t)t * 512 + head * 64 + 32 * b + 8 * i + 4 * hi, (f32x4){o[b][4 * i] * inv, o[b][4 * i + 1] * inv, o[b][4 * i + 2] * inv, o[b][4 * i + 3] * inv});
    const float mref = (m_run == -INFINITY) ? 0.f : m_run;
    float* dst = SC + (size_t)(t * 2 + g) * 256;
    float carry = 0.f;
    __syncthreads();
#pragma unroll
    for (int i = 0; i < 2; ++i) kr[i] = *(const u32x4*)kg[i];
#pragma unroll 1
    for (int st = 0; st < nst; ++st) {
        const int buf = st & 1; LAS unsigned char* kb = lds + buf * SK_KB;
#pragma unroll
        for (int i = 0; i < 2; ++i) *(LAS u32x4*)(kb + kl[i]) = kr[i];
        __syncthreads();
        if (st + 1 < nst) {
#pragma unroll
            for (int i = 0; i < 2; ++i) kr[i] = *(const u32x4*)(kg[i] + (size_t)128 * (st + 1) * 64); }
#pragma unroll
        for (int q4 = 0; q4 < 4; ++q4) { const int T = 4 * st + q4; float sv[4];
            if (32 * T <= cw) {
                const LAS unsigned char* kt = kb + q4 * 32 * SK_KP * 2;
                f32x16 sacc;
#pragma unroll
                for (int r = 0; r < 16; ++r) sacc[r] = 0.f;
#pragma unroll
                for (int s = 0; s < 4; ++s) { const bf16x8 kf = *(const LAS bf16x8*)(kt + (col * SK_KP + 16 * s + 8 * hi) * 2); sacc = __builtin_amdgcn_mfma_f32_32x32x16_bf16(kf, qf[s], sacc, 0, 0, 0); }
                float Gs[4], Es[4];
#pragma unroll
                for (int i = 0; i < 4; ++i) { float p[4];
#pragma unroll
                    for (int q = 0; q < 4; ++q) { const int r = 4 * i + q; const int c = 32 * T + crow(r, hi); p[q] = (16 * c + 31 <= t) ? __builtin_amdgcn_exp2f(sacc[r] * scale2 - mref) * inv : 0.f; }
                    Gs[i] = (p[0] + p[1]) + (p[2] + p[3]); Es[i] = p[3]; }
#pragma unroll
                for (int i = 0; i < 4; ++i) { Gs[i] += lane_xor1(Gs[i]); Gs[i] += lane_xor2(Gs[i]); Es[i] += lane_xor1(Es[i]); Es[i] += lane_xor2(Es[i]); }
                float eo[4];
#pragma unroll
                for (int i = 0; i < 4; ++i) eo[i] = lane_xor32(Es[i], hi);
                if (hi) { sv[0] = Gs[0] + eo[0]; sv[1] = Gs[1] + eo[1]; sv[2] = Gs[2] + eo[2]; sv[3] = Gs[3] + eo[3]; }
                else { sv[0] = Gs[0] + carry; sv[1] = Gs[1] + eo[0]; sv[2] = Gs[2] + eo[1]; sv[3] = Gs[3] + eo[2]; }
                carry = eo[3];
            } else { sv[0] = hi ? 0.f : carry; sv[1] = 0.f; sv[2] = 0.f; sv[3] = 0.f; carry = 0.f; }
            if ((col & 3) == 0) {
#pragma unroll
                for (int i = 0; i < 4; ++i) dst[8 * T + 2 * i + hi] = sv[i]; } }
    }
#pragma unroll 1
    for (int T = 4 * nst; T < 32; ++T) {
        if ((col & 3) == 0) { dst[8 * T + hi] = (hi || T != 4 * nst) ? 0.f : carry; dst[8 * T + 2 + hi] = 0.f; dst[8 * T + 4 + hi] = 0.f; dst[8 * T + 6 + hi] = 0.f; } }
}

struct Sel16 { bf16x8 qf[2]; f32x4 o[4]; float m_run, l_run; };
template <int VP>
__device__ __forceinline__ void att16_block(const LAS unsigned char* kb, const LAS unsigned char* vb, Sel16& st, int lim, int c16, int G) {
    bf16x8 kf[4][2]; u32x2 vlo[2][4], vhi[2][4];
#pragma unroll
    for (int kt = 0; kt < 4; ++kt) { const LAS unsigned char* kp = kb + ((16 * kt + c16) * SK_KP + 8 * G) * 2; kf[kt][0] = *(const LAS bf16x8*)kp; kf[kt][1] = *(const LAS bf16x8*)(kp + 64); }
#pragma unroll
    for (int u = 0; u < 2; ++u)
#pragma unroll
        for (int d = 0; d < 4; ++d) { const LAS unsigned char* vp = vb + ((16 * d + c16) * VP + 32 * u + 4 * G) * 2; vlo[u][d] = *(const LAS u32x2*)vp; vhi[u][d] = *(const LAS u32x2*)(vp + 32); }
    __builtin_amdgcn_sched_barrier(0);
    f32x4 acc[4];
#pragma unroll
    for (int kt = 0; kt < 4; ++kt) acc[kt] = __builtin_amdgcn_mfma_f32_16x16x32_bf16(kf[kt][0], st.qf[0], (f32x4){0.f, 0.f, 0.f, 0.f}, 0, 0, 0);
#pragma unroll
    for (int kt = 0; kt < 4; ++kt) acc[kt] = __builtin_amdgcn_mfma_f32_16x16x32_bf16(kf[kt][1], st.qf[1], acc[kt], 0, 0, 0);
    float mt = -INFINITY;
#pragma unroll
    for (int kt = 0; kt < 4; ++kt)
#pragma unroll
        for (int i = 0; i < 4; ++i) { const float x = (16 * kt + i <= lim) ? acc[kt][i] : -INFINITY; acc[kt][i] = x; mt = fmaxf(mt, x); }
    mt = xmax32(xmax16(mt));
    const float m_new = fmaxf(st.m_run, mt); const float mref = (m_new == -INFINITY) ? 0.f : m_new;
    if (__any(m_new != st.m_run)) { const float corr = __builtin_amdgcn_exp2f(st.m_run - mref); st.l_run *= corr; st.m_run = m_new;
#pragma unroll
        for (int d = 0; d < 4; ++d) st.o[d] = st.o[d] * corr; }
    float ps = 0.f;
#pragma unroll
    for (int kt = 0; kt < 4; ++kt)
#pragma unroll
        for (int i = 0; i < 4; ++i) { acc[kt][i] = __builtin_amdgcn_exp2f(acc[kt][i] - mref); ps += acc[kt][i]; }
    st.l_run += ps;
#pragma unroll
    for (int u = 0; u < 2; ++u) {
        const bf16x8 pf = __builtin_bit_cast(bf16x8, (u32x4){cvt_pk_bf16(acc[2 * u][0], acc[2 * u][1]), cvt_pk_bf16(acc[2 * u][2], acc[2 * u][3]), cvt_pk_bf16(acc[2 * u + 1][0], acc[2 * u + 1][1]), cvt_pk_bf16(acc[2 * u + 1][2], acc[2 * u + 1][3])});
#pragma unroll
        for (int d = 0; d < 4; ++d) st.o[d] = __builtin_amdgcn_mfma_f32_16x16x32_bf16(__builtin_bit_cast(bf16x8, (u32x4){vlo[u][d].x, vlo[u][d].y, vhi[u][d].x, vhi[u][d].y}), pf, st.o[d], 0, 0, 0); }
}
constexpr int S16_NB = 4;
constexpr int S16_VP = S16_NB * 64 + 4;
constexpr int S16_KB = S16_NB * 64 * SK_KP * 2, S16_VB = 64 * S16_VP * 2, S16_VOFF = 2 * S16_KB, S16_MOFF = S16_VOFF + 2 * S16_VB;
static_assert(S16_MOFF + 2048 <= LDS_BYTES - 1536, "sel16 LDS map");
__device__ __forceinline__ void sel_unit16(LAS unsigned char* lds, const bf16* U2, const bf16* VTS, const unsigned* SM, const bf16* OCMP, const bf16* OWIN, bf16* ABR, int g, int qblk, int tid, int wave, int lane) {
    const int c16 = lane & 15, G = lane >> 4;
    const int head = 4 * g + (c16 & 3);
    LAS unsigned* smask = (LAS unsigned*)(lds + S16_MOFF);
    __syncthreads();
    smask[tid] = SM[(size_t)((64 * qblk + (tid >> 3)) * 2 + g) * 8 + (tid & 7)];
    Sel16 grp[2]; int tlg[2];
#pragma unroll
    for (int gi = 0; gi < 2; ++gi) { tlg[gi] = 8 * wave + 4 * gi + (c16 >> 2); const bf16* qp = U2 + (size_t)(64 * qblk + tlg[gi]) * U2W + U2_Q + head * 64 + 8 * G;
        grp[gi].qf[0] = *(const bf16x8*)qp; grp[gi].qf[1] = *(const bf16x8*)(qp + 32); grp[gi].m_run = -INFINITY; grp[gi].l_run = 0.f;
#pragma unroll
        for (int d = 0; d < 4; ++d) grp[gi].o[d] = (f32x4){0.f, 0.f, 0.f, 0.f}; }
    const float scale2 = 1.0f;
    const int st1 = qblk / S16_NB + 1;
    const bf16* Kb = U2 + U2_KV + (2 * 2 + g) * 64; const bf16* Vb = VTS + (size_t)(g * 64) * S;
    u32x4 kr[4], vr[4];
    auto gload = [&](int step) { int key0 = 64 * S16_NB * step; if (key0 + 64 * S16_NB > S) key0 = S - 64 * S16_NB;
        const bf16* kp = Kb + (size_t)key0 * U2W; const bf16* vp = Vb + key0; int t_ = tid; asm volatile("" : "+v"(t_));
#pragma unroll
        for (int i = 0; i < 4; ++i) { const int c = t_ + 512 * i; kr[i] = *(const u32x4*)(kp + (unsigned)((c >> 3) * U2W + 8 * (c & 7))); vr[i] = *(const u32x4*)(vp + (unsigned)((c >> 5) * S + 8 * (c & 31))); } };
    gload(0);
#pragma unroll 1
    for (int st = 0; st < st1; ++st) {
        const int buf = st & 1;
        LAS unsigned char* kb = lds + buf * S16_KB; LAS unsigned char* vb = lds + S16_VOFF + buf * S16_VB;
        { int t_ = tid; asm volatile("" : "+v"(t_));
#pragma unroll
          for (int i = 0; i < 4; ++i) { const int c = t_ + 512 * i; const unsigned kl_ = (unsigned)((c >> 3) * SK_KP + 8 * (c & 7)) * 2u, vl_ = (unsigned)((c >> 5) * S16_VP + 8 * (c & 31)) * 2u;
              *(LAS u32x4*)(kb + kl_) = kr[i]; *(LAS u32x2*)(vb + vl_) = (u32x2){vr[i].x, vr[i].y}; *(LAS u32x2*)(vb + vl_ + 8) = (u32x2){vr[i].z, vr[i].w}; } }
        __syncthreads();
        if (st + 1 < st1) gload(st + 1);
#pragma unroll
        for (int h = 0; h < S16_NB; ++h) { const int j = S16_NB * st + h;
            if (j <= qblk) {
#pragma unroll
                for (int gi = 0; gi < 2; ++gi) { const bool sel = selmask_test(smask + tlg[gi] * 8, j);
                    if (__any(sel)) { const int t = 64 * qblk + tlg[gi]; const int key0 = 64 * j; const bool diag = (j == qblk);
                        const int lim = !sel ? -1 : (diag ? t - key0 - 4 * G : 1 << 20);
                        att16_block<S16_VP>(kb + h * 64 * SK_KP * 2, vb + h * 128, grp[gi], lim, c16, G); } } } }
    }
#pragma unroll
    for (int gi = 0; gi < 2; ++gi) { const int t = 64 * qblk + tlg[gi];
        float l = grp[gi].l_run; l += __shfl_xor(l, 16); l += __shfl_xor(l, 32); const float inv = l > 0.f ? 1.0f / l : 0.f;
        const bf16* gp = U2 + (size_t)t * U2W + U2_G + head * 3;
        const float s0 = sigmoidf_(bf2f(gp[0])), s1 = sigmoidf_(bf2f(gp[1])) * inv, s2g = sigmoidf_(bf2f(gp[2]));
#pragma unroll
        for (int d = 0; d < 4; ++d) { const int dv = 16 * d + 4 * G; const size_t off = (size_t)t * 512 + head * 64 + dv; const u32x2 oc = *(const u32x2*)(OCMP + off), ow = *(const u32x2*)(OWIN + off);
            f32x4 r; r[0] = s0 * bflo(oc.x) + s1 * grp[gi].o[d][0] + s2g * bflo(ow.x); r[1] = s0 * bfhi(oc.x) + s1 * grp[gi].o[d][1] + s2g * bfhi(ow.x);
            r[2] = s0 * bflo(oc.y) + s1 * grp[gi].o[d][2] + s2g * bflo(ow.y); r[3] = s0 * bfhi(oc.y) + s1 * grp[gi].o[d][3] + s2g * bfhi(ow.y);
            store4_bf16(ABR + (size_t)t * D + head * 64 + dv, r); } }
}

struct LP {
    unsigned char* ws; unsigned char* wl; int l;
    __device__ __forceinline__ bf16* w(size_t off) const { return (bf16*)(wl + off); }
    __device__ __forceinline__ bf16* b(size_t off) const { return (bf16*)(ws + off); }
    __device__ __forceinline__ float* f(size_t off) const { return (float*)(ws + off); }
    __device__ __forceinline__ int* i(size_t off) const { return (int*)(ws + off); }
};
#define INF32(a, idx, per) ((const float*)(a).in[idx] + (size_t)l * (per))

#ifndef BPARTS
#define BPARTS 31
#endif
#ifndef DUPSUB
#define DUPSUB 0
#endif
#define SUBREP(bit) for (int srep_ = 0; srep_ < 1 + ((DUPSUB >> (bit)) & 1); ++srep_)
__device__ __forceinline__ void phase_prep(const Args& a, Frame& F, const LP& P) {
    const int l = P.l, lane = F.lane, tid = F.tid;
    const bf16* U2 = P.b(WS_U2); bf16* ABR = P.b(WS_ABR);
    if (BPARTS & 1) { const float* cw = INF32(a, 17, 31 * 512); const float* cb = INF32(a, 18, 512); const float* lg = INF32(a, 19, 512); const float* lb = INF32(a, 20, 512);
      LAS bf16* hb = (LAS bf16*)F.lds;
      LAS float* cs = (LAS float*)(F.lds + 65536);
      const int c = tid;
      float w[31];
#pragma unroll
      for (int k = 0; k < 31; ++k) w[k] = cw[k * 512 + c];
      const float bias = cb[c];
#pragma unroll 1
      for (int tile = blockIdx.x; tile < S / 32; tile += F.G) { const int t0 = tile * 32;
          { u32x4 av[8], gv[8];
#pragma unroll
            for (int i = 0; i < 8; ++i) { const int item = tid + 512 * i, r = item >> 6, ch = (item & 63) * 8; int tok = t0 - 30 + r; tok = tok < 0 ? 0 : tok;
                const bf16* up = U2 + (size_t)tok * U2W + U2_CONV + ch;
                if (r < 62) { av[i] = *(const u32x4*)up; gv[i] = *(const u32x4*)(up + 512); } else { av[i] = (u32x4){0u, 0u, 0u, 0u}; gv[i] = av[i]; } }
#pragma unroll
            for (int i = 0; i < 8; ++i) { const int item = tid + 512 * i, r = item >> 6, ch = (item & 63) * 8; const bool ok = (t0 - 30 + r) >= 0;
                u32x4 o;
#pragma unroll
                for (int q = 0; q < 4; ++q) { const float h0 = bflo(av[i][q]) * sigmoidf_(bflo(gv[i][q])), h1 = bfhi(av[i][q]) * sigmoidf_(bfhi(gv[i][q])); o[q] = ok ? cvt_pk_bf16(h0, h1) : 0u; }
                if (r < 62) *(LAS u32x4*)(hb + r * 512 + ch) = o; } }
          __syncthreads();
          float hreg[62];
#pragma unroll
          for (int r = 0; r < 62; ++r) hreg[r] = bf2f(hb[r * 512 + c]);
#pragma unroll
          for (int i = 0; i < 32; ++i) { float acc = bias;
#pragma unroll
              for (int k = 0; k < 31; ++k) acc += w[k] * hreg[i + k];
              cs[i * 512 + c] = acc; }
          __syncthreads();
#pragma unroll
          for (int q = 0; q < 4; ++q) { const int tt = 4 * F.wave + q; float v[8]; float s = 0.f;
#pragma unroll
              for (int j = 0; j < 8; ++j) { v[j] = cs[tt * 512 + lane + 64 * j]; s += v[j]; }
              const float mean = wave_sum(s) * (1.0f / 512.0f); float qq = 0.f;
#pragma unroll
              for (int j = 0; j < 8; ++j) { v[j] -= mean; qq += v[j] * v[j]; }
              const float rstd = 1.0f / sqrtf(wave_sum(qq) * (1.0f / 512.0f) + 1e-5f);
#pragma unroll
              for (int j = 0; j < 8; ++j) { const int ch = lane + 64 * j; const float y = v[j] * rstd * lg[ch] + lb[ch]; ABR[(size_t)(t0 + tt) * D + 1536 + ch] = f2bf(y * sigmoidf_(y)); } }
          __syncthreads(); } }
    if (BPARTS & 2) { float* rq = P.f(WS_RSTD); float* rkv = rq + S;
      const int sub = lane >> 4, l16 = lane & 15;
#pragma unroll 1
      for (int t0 = 4 * F.gw; t0 < S; t0 += 4 * F.NGW) { const int t = t0 + sub; const bf16* row = U2 + (size_t)t * U2W;
          const u32x4 a0 = *(const u32x4*)(row + U2_CQ + 8 * l16), a1 = *(const u32x4*)(row + U2_CQ + 8 * l16 + 128), a2 = *(const u32x4*)(row + U2_CQ + 8 * l16 + 256), a3 = *(const u32x4*)(row + U2_CQ + 8 * l16 + 384);
          const u32x4 c0 = *(const u32x4*)(row + U2_CKV + 8 * l16), c1 = *(const u32x4*)(row + U2_CKV + 8 * l16 + 128);
          float s = 0.f, s2 = 0.f;
#pragma unroll
          for (int q = 0; q < 4; ++q) { float x; x = bflo(a0[q]); s += x * x; x = bfhi(a0[q]); s += x * x; x = bflo(a1[q]); s += x * x; x = bfhi(a1[q]); s += x * x;
              x = bflo(a2[q]); s += x * x; x = bfhi(a2[q]); s += x * x; x = bflo(a3[q]); s += x * x; x = bfhi(a3[q]); s += x * x;
              x = bflo(c0[q]); s2 += x * x; x = bfhi(c0[q]); s2 += x * x; x = bflo(c1[q]); s2 += x * x; x = bfhi(c1[q]); s2 += x * x; }
#pragma unroll
          for (int o = 0; o < 1; ++o) { s = row16_sum(s); s2 = row16_sum(s2); }
          if (l16 == 0) { rq[t] = 1.0f / sqrtf(s * (1.0f / 512.0f) + 1e-6f); rkv[t] = 1.0f / sqrtf(s2 * (1.0f / 256.0f) + 1e-6f); } }
#pragma unroll 1
      for (int r0 = 8 * F.gw; r0 < S; r0 += 8 * F.NGW) { const int w = 2 << (lane >> 4); const bf16* col = U2 + U2_POOL + 8 * lane;
          float sum[8];
#pragma unroll
          for (int q = 0; q < 8; ++q) sum[q] = 0.f;
          for (int i = 1; i < w; ++i) { const int tt = r0 - i; if (tt >= 0) { const u32x4 v = *(const u32x4*)(col + (size_t)tt * U2W);
#pragma unroll
              for (int q = 0; q < 4; ++q) { sum[2 * q] += bflo(v[q]); sum[2 * q + 1] += bfhi(v[q]); } } }
#pragma unroll
          for (int k = 0; k < 8; ++k) { const int t = r0 + k; const u32x4 v = *(const u32x4*)(col + (size_t)t * U2W);
              const int to = t - w + 1; u32x4 vo = (u32x4){0u, 0u, 0u, 0u}; if (to >= 0) vo = *(const u32x4*)(col + (size_t)to * U2W);
              const int cnt = (t + 1 < w) ? (t + 1) : w; const float ic = 1.0f / (float)cnt; u32x4 o;
#pragma unroll
              for (int q = 0; q < 4; ++q) { sum[2 * q] += bflo(v[q]); sum[2 * q + 1] += bfhi(v[q]);
                  o[q] = cvt_pk_bf16(sum[2 * q] * ic - bflo(v[q]), sum[2 * q + 1] * ic - bfhi(v[q]));
                  sum[2 * q] -= bflo(vo[q]); sum[2 * q + 1] -= bfhi(vo[q]); }
              *(u32x4*)(ABR + (size_t)t * D + 512 + 8 * lane) = o; } } }
    if (BPARTS & 4) { LAS bf16* scr = (LAS bf16*)(F.lds + 65536 + F.wave * 8448);
#pragma unroll 1
      for (int it = F.gw; it < 2 * 2 * (S / 64); it += F.NGW) { const int tt = it % (S / 64), g = (it / (S / 64)) & 1, which = it / (2 * (S / 64));
          const bf16* src = U2 + (size_t)(tt * 64) * U2W + U2_KV + ((which ? 5 : 3) * 2 + g) * 64;
          bf16* dst = P.b(which ? WS_VTWIN : WS_VTSEL) + (size_t)(g * 64) * S + tt * 64;
          transpose_tile64(src, U2W, dst, S, scr, lane); } }
    if (BPARTS & 8) { bf16* HID = P.b(WS_HID); const float* b1c = (const float*)(P.wl + WO_B1C);
#pragma unroll 1
      for (int it = F.gw; it < 4 * 64 * 8; it += F.NGW) { const int nt = it & 7, mt = (it >> 3) & 63, jg = it >> 9, j = jg >> 1, g = jg & 1;
          const bf16* Ab = U2 + U2_KV + (j * 2 + g) * 64; const bf16* Bb = P.w(WO_W1C) + (size_t)j * 128 * 2048;
          auto ap = [&](int r, int k) { int n = 16 * mt + r; n = n > 1022 ? 1022 : n; return Ab + (size_t)(16 * n + (k >> 6)) * U2W + (k & 63); };
          auto bp = [&](int r, int k) { return Bb + (size_t)(16 * nt + r) * 2048 + k; };
          const f32x4 acc = sgemm16(ap, bp, 2048, lane);
          const int h = 16 * nt + (lane & 15); float bb = 0.f;
#pragma unroll
          for (int c = 0; c < 16; ++c) bb += b1c[(j * 16 + c) * 128 + h];
#pragma unroll
          for (int i = 0; i < 4; ++i) { const int n = 16 * mt + 4 * (lane >> 4) + i; HID[((size_t)jg * 1024 + n) * 128 + h] = f2bf(gelu_tanh(acc[i] + bb)); } } }
}
__device__ __forceinline__ void memkv_items(const LP& P, int first, int nw, int lane) {
    const int l = P.l; const bf16* MEMB = P.b(WS_MEMB); bf16* KX = P.b(WS_KX) + (size_t)l * 256 * 512; bf16* VXT = P.b(WS_VXT) + (size_t)l * 512 * 256;
#pragma unroll 1
    for (int it = first; it < 1024; it += nw) {
        if (it < 512) { const int mt = it >> 5, nt = it & 31;
            auto ap = [&](int r, int k) { return MEMB + (size_t)(16 * mt + r) * D + k; };
            auto bp = [&](int r, int k) { return P.w(WO_WXK) + (size_t)(16 * nt + r) * D + k; };
            const f32x4 acc = sgemm16(ap, bp, D, lane);
#pragma unroll
            for (int i = 0; i < 4; ++i) KX[(size_t)(16 * mt + 4 * (lane >> 4) + i) * 512 + 16 * nt + (lane & 15)] = f2bf(acc[i]);
        } else { const int q = it - 512, mt = q >> 4, nt = q & 15;
            auto ap = [&](int r, int k) { return P.w(WO_WXV) + (size_t)(16 * mt + r) * D + k; };
            auto bp = [&](int r, int k) { return MEMB + (size_t)(16 * nt + r) * D + k; };
            const f32x4 acc = sgemm16(ap, bp, D, lane);
#pragma unroll
            for (int i = 0; i < 4; ++i) VXT[(size_t)(16 * mt + 4 * (lane >> 4) + i) * 256 + 16 * nt + (lane & 15)] = f2bf(acc[i]); } }
}

__device__ __forceinline__ void phase_compress2(Frame& F, const LP& P) {
    const int lane = F.lane; const bf16* HID = P.b(WS_HID); const bf16* W2 = P.w(WO_W2C);
#pragma unroll 1
    for (int it = F.gw; it < 1024; it += F.NGW) {
        if (it < 512) { const int nt = it & 3, mt = (it >> 2) & 63, g = it >> 8;
            auto ap = [&](int r, int k) { return HID + ((size_t)(0 * 2 + g) * 1024 + 16 * mt + r) * 128 + k; };
            auto bp = [&](int r, int k) { return W2 + (size_t)(16 * nt + r) * 128 + k; };
            const f32x4 acc = sgemm16(ap, bp, 128, lane);
#pragma unroll
            for (int i = 0; i < 4; ++i) P.b(WS_KC)[((size_t)g * 1024 + 16 * mt + 4 * (lane >> 4) + i) * 64 + 16 * nt + (lane & 15)] = f2bf(acc[i]);
        } else { const int q = it - 512, nt = q & 63, mt = (q >> 6) & 3, g = q >> 8;
            auto ap = [&](int r, int k) { return W2 + (size_t)64 * 128 + (size_t)(16 * mt + r) * 128 + k; };
            auto bp = [&](int r, int k) { return HID + ((size_t)(1 * 2 + g) * 1024 + 16 * nt + r) * 128 + k; };
            const f32x4 acc = sgemm16(ap, bp, 128, lane);
#pragma unroll
            for (int i = 0; i < 4; ++i) P.b(WS_VCT)[((size_t)g * 64 + 16 * mt + 4 * (lane >> 4) + i) * 1024 + 16 * nt + (lane & 15)] = f2bf(acc[i]); } }
}

__device__ __forceinline__ void phase_d(Frame& F, const LP& P) {
    const int lane = F.lane;
    { const bf16* KVH = P.b(WS_KVH); const bf16* U2 = P.b(WS_U2); bf16* KR = P.b(WS_KM); const f32x2* rope = (const f32x2*)(P.ws + WS_ROPE);
#pragma unroll 1
      for (int i = F.gw * 64 + lane; i < S * 8; i += F.NGW * 64) { const int t = i >> 3, k = 2 * (i & 7);
          const bf16* kr = U2 + (size_t)t * U2W + U2_KR;
          const unsigned a = *(const unsigned*)(kr + k), b = *(const unsigned*)(kr + 16 + k); const f32x4 cs = *(const f32x4*)(rope + (size_t)t * 16 + k);
          const float x10 = bflo(a), x11 = bfhi(a), x20 = bflo(b), x21 = bfhi(b);
          *(unsigned*)(KR + (size_t)t * 32 + k) = cvt_pk_bf16(x10 * cs[0] - x20 * cs[1], x11 * cs[2] - x21 * cs[3]);
          *(unsigned*)(KR + (size_t)t * 32 + 16 + k) = cvt_pk_bf16(x20 * cs[0] + x10 * cs[1], x21 * cs[2] + x11 * cs[3]); }
      LAS bf16* scr = (LAS bf16*)(F.lds + F.wave * 8448);
#pragma unroll 1
      for (int it = F.gw; it < 8 * (S / 64); it += F.NGW) { const int tt = it % (S / 64), hd = it / (S / 64);
          transpose_tile64(KVH + (size_t)(tt * 64) * 1024 + hd * 128 + 64, 1024, P.b(WS_VTM) + (size_t)(hd * 64) * S + tt * 64, S, scr, lane); } }
    __syncthreads();
    SUBREP(3)
#pragma unroll 1
    for (int i = blockIdx.x; i < 512; i += F.G) { const int r = i >> 8, p = i & 255; const int qb = r ? 255 - (p >> 1) : (p >> 1);
        cmp_unit(F.lds, P.b(WS_U2), P.b(WS_KC), P.b(WS_VCT), P.b(WS_OCMP), P.f(WS_SCORES), p & 1, qb, F.tid, F.wave, lane); }
}


constexpr int MK_KP = 104, MK_VP = 132;
constexpr int MK_KB = 128 * MK_KP * 2, MK_VB = 64 * MK_VP * 2, MK_VOFF = 2 * MK_KB;
__device__ __forceinline__ void mla_unit(LAS unsigned char* lds, const bf16* Q, const bf16* KVH, const bf16* KR, const bf16* Vt, bf16* O, int hd, int qb, int tid, int wave, int lane) {
    const int col = lane & 31, hi = lane >> 5;
    const int q0 = qb * 256 + wave * 32;
    bf16x8 qf[6];
    { const bf16* qp = Q + (size_t)(q0 + col) * 768 + hd * 96;
#pragma unroll
      for (int s = 0; s < 6; ++s) qf[s] = *(const bf16x8*)(qp + 16 * s + 8 * hi); }
    f32x16 o[2];
#pragma unroll
    for (int b = 0; b < 2; ++b)
#pragma unroll
        for (int r = 0; r < 16; ++r) o[b][r] = 0.f;
    float m_run = -INFINITY, l_run = 0.f;
    const int nt = 2 * (qb + 1);
    const bf16* kg[3]; unsigned kl[3]; int kst[3]; const bf16* vg[2]; unsigned vl[2];
#pragma unroll
    for (int i = 0; i < 3; ++i) { const int c = tid + 512 * i, row = c / 12, p = c % 12; const bool nope = p < 8; kst[i] = nope ? 1024 : 32;
        kg[i] = nope ? KVH + (size_t)row * 1024 + hd * 128 + 8 * p : KR + (size_t)row * 32 + 8 * (p - 8); kl[i] = (unsigned)(row * MK_KP + 8 * p) * 2u; }
#pragma unroll
    for (int i = 0; i < 2; ++i) { const int c = tid + 512 * i, row = c >> 4, p = c & 15; vg[i] = Vt + (size_t)(hd * 64 + row) * S + 8 * p; vl[i] = (unsigned)(row * MK_VP + 8 * p) * 2u; }
    u32x4 kr[3], vr[2];
#pragma unroll
    for (int i = 0; i < 3; ++i) kr[i] = *(const u32x4*)kg[i];
#pragma unroll
    for (int i = 0; i < 2; ++i) vr[i] = *(const u32x4*)vg[i];
#pragma unroll 1
    for (int t = 0; t < nt; ++t) {
        const int buf = t & 1; const int key0 = 128 * t;
        LAS unsigned char* kb = lds + buf * MK_KB; LAS unsigned char* vb = lds + MK_VOFF + buf * MK_VB;
#pragma unroll
        for (int i = 0; i < 3; ++i) *(LAS u32x4*)(kb + kl[i]) = kr[i];
#pragma unroll
        for (int i = 0; i < 2; ++i) { *(LAS u32x2*)(vb + vl[i]) = (u32x2){vr[i].x, vr[i].y}; *(LAS u32x2*)(vb + vl[i] + 8) = (u32x2){vr[i].z, vr[i].w}; }
        __syncthreads();
        if (t + 1 < nt) {
#pragma unroll
            for (int i = 0; i < 3; ++i) kr[i] = *(const u32x4*)(kg[i] + (size_t)(key0 + 128) * kst[i]);
#pragma unroll
            for (int i = 0; i < 2; ++i) vr[i] = *(const u32x4*)(vg[i] + key0 + 128); }
#pragma unroll
        for (int h = 0; h < 2; ++h) { const int k0h = key0 + 64 * h;
            if (k0h <= q0 + 31) { auto mask = [&](int u, int r) { return k0h + 32 * u + crow(r, hi) <= q0 + col; };
                att_step64<6, MK_KP, MK_VP>(kb + h * 64 * MK_KP * 2, vb + h * 128, qf, o, m_run, l_run, 1.0f, k0h + 63 > q0, mask, col, hi); } }
    }
    const float l = l_run + __shfl_xor(l_run, 32); const float inv = l > 0.f ? 1.0f / l : 0.f;
    bf16* op = O + (size_t)(q0 + col) * D + 1024 + hd * 64;
#pragma unroll
    for (int b = 0; b < 2; ++b)
#pragma unroll
        for (int i = 0; i < 4; ++i) store4_bf16(op + 32 * b + 8 * i + 4 * hi, (f32x4){o[b][4 * i] * inv, o[b][4 * i + 1] * inv, o[b][4 * i + 2] * inv, o[b][4 * i + 3] * inv});
}

#define MLA_SB __builtin_amdgcn_sched_barrier(0)
template <bool HAS_NEXT, bool FINISH = true>
__device__ __forceinline__ void mla_stage1(const LAS unsigned char* kbn, const bf16x8 (&qf)[6], f32x16& cur, f32x16& nxt, bf16x8 (&pf)[2], float mref, float& l_run, int col, int hi) {
    const LAS unsigned char* kp0 = kbn + (col * MK_KP + 8 * hi) * 2;
    bf16x8 kf[6];
    if (HAS_NEXT) {
#pragma unroll
        for (int c = 0; c < 6; ++c) kf[c] = *(const LAS bf16x8*)(kp0 + 32 * c); }
    float ps = 0.f;
    MLA_SB;
#pragma unroll
    for (int c = 0; c < 6; ++c) {
        const int e0 = (16 * c + 5) / 6, e1 = (16 * (c + 1) + 5) / 6;
        if (FINISH) {
#pragma unroll
            for (int r = e0; r < e1; ++r) { const float pe = __builtin_amdgcn_exp2f(cur[r] - mref); cur[r] = pe; ps += pe; }
            asm volatile("" : "+v"(ps));
            if (c == 3) pf[0] = __builtin_bit_cast(bf16x8, (u32x4){cvt_pk_bf16(cur[0], cur[1]), cvt_pk_bf16(cur[2], cur[3]), cvt_pk_bf16(cur[4], cur[5]), cvt_pk_bf16(cur[6], cur[7])}); }
        if (HAS_NEXT) {
            if (c == 0) { f32x16 z;
#pragma unroll
                for (int r = 0; r < 16; ++r) z[r] = 0.f;
                nxt = __builtin_amdgcn_mfma_f32_32x32x16_bf16(kf[0], qf[0], z, 0, 0, 0); }
            else nxt = __builtin_amdgcn_mfma_f32_32x32x16_bf16(kf[c], qf[c], nxt, 0, 0, 0);
            asm volatile("" : "+v"(nxt)); }
        MLA_SB; }
    if (FINISH) pf[1] = __builtin_bit_cast(bf16x8, (u32x4){cvt_pk_bf16(cur[8], cur[9]), cvt_pk_bf16(cur[10], cur[11]), cvt_pk_bf16(cur[12], cur[13]), cvt_pk_bf16(cur[14], cur[15])});
    l_run += ps;
}
template <bool DO_PV, bool HAS_NEXT>
__device__ __forceinline__ void mla_stage2(const LAS unsigned char* vbc, const bf16x8 (&pf)[2], f32x16 (&o)[2], f32x16& nxt, float& m_run, float& l_run, float& mref, bool use_mask, int kn0, int qcol, int col, int hi) {
    const LAS unsigned char* vp0 = vbc + (col * MK_VP + 4 * hi) * 2; const LAS unsigned char* vp1 = vp0 + 32 * MK_VP * 2;
    u32x2 al[2], ah[2], bl[2], bh[2];
    if (DO_PV) {
#pragma unroll
        for (int c = 0; c < 2; ++c) { al[c] = *(const LAS u32x2*)(vp0 + 32 * c); ah[c] = *(const LAS u32x2*)(vp0 + 32 * c + 16); bl[c] = *(const LAS u32x2*)(vp1 + 32 * c); bh[c] = *(const LAS u32x2*)(vp1 + 32 * c + 16); } }
    if (HAS_NEXT && use_mask) {
        const int lim = qcol - kn0 - 4 * hi;
#pragma unroll
        for (int r = 0; r < 16; ++r) nxt[r] = ((r & 3) + 8 * (r >> 2) > lim) ? -INFINITY : nxt[r]; }
    float mt = -INFINITY;
    MLA_SB;
#pragma unroll
    for (int c = 0; c < 2; ++c) {
        if (HAS_NEXT) {
#pragma unroll
            for (int r = 8 * c; r < 8 * c + 8; ++r) mt = fmaxf(mt, nxt[r]);
            asm volatile("" : "+v"(mt)); }
        if (DO_PV) {
            o[0] = __builtin_amdgcn_mfma_f32_32x32x16_bf16(__builtin_bit_cast(bf16x8, (u32x4){al[c].x, al[c].y, ah[c].x, ah[c].y}), pf[c], o[0], 0, 0, 0);
            o[1] = __builtin_amdgcn_mfma_f32_32x32x16_bf16(__builtin_bit_cast(bf16x8, (u32x4){bl[c].x, bl[c].y, bh[c].x, bh[c].y}), pf[c], o[1], 0, 0, 0); }
        MLA_SB; }
    if (HAS_NEXT) {
        mt = xmax32(mt);
        const float m_new = fmaxf(m_run, mt); const float mr = (m_new == -INFINITY) ? 0.f : m_new;
        if (__any(m_new != m_run)) { const float corr = __builtin_amdgcn_exp2f(m_run - mr); l_run *= corr; m_run = m_new;
#pragma unroll
            for (int b = 0; b < 2; ++b)
#pragma unroll
                for (int r = 0; r < 16; ++r) o[b][r] *= corr; }
        mref = mr; }
}
__device__ __forceinline__ void mla_unit_p(LAS unsigned char* lds, const bf16* Q, const bf16* KVH, const bf16* KR, const bf16* Vt, bf16* O, int hd, int qb, int tid, int wave, int lane) {
    const int col = lane & 31, hi = lane >> 5;
    const int q0 = qb * 256 + wave * 32, qcol = q0 + col;
    bf16x8 qf[6];
    { const bf16* qp = Q + (size_t)(q0 + col) * 768 + hd * 96;
#pragma unroll
      for (int s = 0; s < 6; ++s) qf[s] = *(const bf16x8*)(qp + 16 * s + 8 * hi); }
    f32x16 o[2];
#pragma unroll
    for (int b = 0; b < 2; ++b)
#pragma unroll
        for (int r = 0; r < 16; ++r) o[b][r] = 0.f;
    float m_run = -INFINITY, l_run = 0.f, mref = 0.f;
    const int ns = 2 * (qb + 1);
    const bf16* kg[3]; unsigned kl[3]; int kst[3]; const bf16* vg[2]; unsigned vl[2];
#pragma unroll
    for (int i = 0; i < 3; ++i) { const int c = tid + 512 * i, row = c / 12, p = c % 12; const bool nope = p < 8; kst[i] = nope ? 1024 : 32;
        kg[i] = nope ? KVH + (size_t)row * 1024 + hd * 128 + 8 * p : KR + (size_t)row * 32 + 8 * (p - 8); kl[i] = (unsigned)(row * MK_KP + 8 * p) * 2u; }
#pragma unroll
    for (int i = 0; i < 2; ++i) { const int c = tid + 512 * i, row = c >> 4, p = c & 15; vg[i] = Vt + (size_t)(hd * 64 + row) * S + 8 * p; vl[i] = (unsigned)(row * MK_VP + 8 * p) * 2u; }
    u32x4 kr[3], vr[2];
    auto gload = [&](int step) { const int key0 = 128 * step;
#pragma unroll
        for (int i = 0; i < 3; ++i) kr[i] = *(const u32x4*)(kg[i] + (size_t)key0 * kst[i]);
#pragma unroll
        for (int i = 0; i < 2; ++i) vr[i] = *(const u32x4*)(vg[i] + key0); };
    auto lwrite = [&](int buf) { LAS unsigned char* kb = lds + buf * MK_KB; LAS unsigned char* vb = lds + MK_VOFF + buf * MK_VB;
#pragma unroll
        for (int i = 0; i < 3; ++i) *(LAS u32x4*)(kb + kl[i]) = kr[i];
#pragma unroll
        for (int i = 0; i < 2; ++i) { *(LAS u32x2*)(vb + vl[i]) = (u32x2){vr[i].x, vr[i].y}; *(LAS u32x2*)(vb + vl[i] + 8) = (u32x2){vr[i].z, vr[i].w}; } };
    gload(0); lwrite(0); gload(1);
    __syncthreads();
    f32x16 sA, sB; bf16x8 pf[2];
    pf[0] = __builtin_bit_cast(bf16x8, (u32x4){0u, 0u, 0u, 0u}); pf[1] = pf[0];
    mla_stage1<true, false>(lds, qf, sB, sA, pf, 0.f, l_run, col, hi);
    mla_stage2<false, true>(lds, pf, o, sA, m_run, l_run, mref, 31 > q0, 0, qcol, col, hi);
#define MLA_TILE(CUR, NXT, KNEXT, VCUR, KN0) do { mla_stage1<true>(KNEXT, qf, CUR, NXT, pf, mref, l_run, col, hi); \
        mla_stage2<true, true>(VCUR, pf, o, NXT, m_run, l_run, mref, (KN0) + 31 > q0, KN0, qcol, col, hi); } while (0)
#pragma unroll 1
    for (int s = 0; s < ns; ++s) {
        const int buf = s & 1; const LAS unsigned char* kbs = lds + buf * MK_KB; const LAS unsigned char* vbs = lds + MK_VOFF + buf * MK_VB; const LAS unsigned char* kbn = lds + (buf ^ 1) * MK_KB;
        const int k0 = 128 * s;
        LDS_WAIT(); __builtin_amdgcn_s_barrier();
        if (s + 1 < ns) { lwrite(buf ^ 1); if (s + 2 < ns) gload(s + 2); }
        MLA_TILE(sA, sB, kbs + 32 * MK_KP * 2, vbs, k0 + 32);
        MLA_TILE(sB, sA, kbs + 64 * MK_KP * 2, vbs + 64, k0 + 64);
        MLA_TILE(sA, sB, kbs + 96 * MK_KP * 2, vbs + 128, k0 + 96);
        LDS_WAIT(); __builtin_amdgcn_s_barrier();
        if (s + 1 < ns) MLA_TILE(sB, sA, kbn, vbs + 192, k0 + 128);
        else { mla_stage1<false>(kbn, qf, sB, sA, pf, mref, l_run, col, hi); mla_stage2<true, false>(vbs + 192, pf, o, sA, m_run, l_run, mref, false, 0, qcol, col, hi); }
    }
#undef MLA_TILE
    const float l = l_run + __shfl_xor(l_run, 32); const float inv = l > 0.f ? 1.0f / l : 0.f;
    bf16* op = O + (size_t)(q0 + col) * D + 1024 + hd * 64;
#pragma unroll
    for (int b = 0; b < 2; ++b)
#pragma unroll
        for (int i = 0; i < 4; ++i) store4_bf16(op + 32 * b + 8 * i + 4 * hi, (f32x4){o[b][4 * i] * inv, o[b][4 * i + 1] * inv, o[b][4 * i + 2] * inv, o[b][4 * i + 3] * inv});
}

__device__ __forceinline__ void phase_e(Frame& F, const LP& P) {
    const int lane = F.lane;
    SUBREP(0)
#pragma unroll 1
    for (int i = blockIdx.x; i < 256; i += F.G) { const int hd = i & 7, p = i >> 3;
#pragma unroll 1
        for (int rep = 0; rep < 2; ++rep) mla_unit_p(F.lds, P.b(WS_QM), P.b(WS_KVH), P.b(WS_KM), P.b(WS_VTM), P.b(WS_ABR), hd, rep ? 63 - p : p, F.tid, F.wave, lane); }
    __syncthreads();
    SUBREP(1)
#pragma unroll 1
    for (int i = blockIdx.x; i < 512; i += F.G) sel_unit<1>(F.lds, P.b(WS_U2), P.b(WS_VTWIN), nullptr, nullptr, P.b(WS_OWIN), nullptr, i & 1, i >> 1, F.tid, F.wave, lane);
    __syncthreads();
    SUBREP(2)
#pragma unroll 1
    for (int u = F.gw; u < S * 2; u += F.NGW) { const int t = u >> 1;
        topk_unit(P.f(WS_SCORES) + (size_t)u * 256, t, (unsigned*)P.i(WS_IDX) + (size_t)u * 8, lane); }
}
__device__ __forceinline__ void phase_f(Frame& F, const LP& P) {
#pragma unroll 1
    for (int i = blockIdx.x; i < 256; i += F.G) { const int g = i & 1, p = i >> 1;
#pragma unroll 1
        for (int rep = 0; rep < 2; ++rep) sel_unit16(F.lds, P.b(WS_U2), P.b(WS_VTSEL), (const unsigned*)P.i(WS_IDX), P.b(WS_OCMP), P.b(WS_OWIN), P.b(WS_ABR), g, rep ? 255 - p : p, F.tid, F.wave, F.lane); }
}
constexpr int XK_KP = 136, XK_VP = 260, XK_VOFF = 256 * XK_KP * 2;
__device__ __forceinline__ void phase_xattn(Frame& F, const LP& P) {
    const int tid = F.tid, lane = F.lane, col = lane & 31, hi = lane >> 5;
    const bf16* KX = P.b(WS_KX) + (size_t)P.l * 256 * 512; const bf16* VXT = P.b(WS_VXT) + (size_t)P.l * 512 * 256;
    LAS unsigned char* kb = F.lds; LAS unsigned char* vb = F.lds + XK_VOFF;
#pragma unroll 1
    for (int unit = blockIdx.x; unit < 4 * (S / 256); unit += F.G) { const int hd = unit & 3, tb = unit >> 2;
        __syncthreads();
        { u32x4 kr[8], vr[8];
#pragma unroll
          for (int i = 0; i < 8; ++i) { const int c = tid + 512 * i; kr[i] = *(const u32x4*)(KX + (size_t)(c >> 4) * 512 + hd * 128 + 8 * (c & 15)); vr[i] = *(const u32x4*)(VXT + (size_t)(hd * 128 + (c >> 5)) * 256 + 8 * (c & 31)); }
#pragma unroll
          for (int i = 0; i < 8; ++i) { const int c = tid + 512 * i; *(LAS u32x4*)(kb + ((c >> 4) * XK_KP + 8 * (c & 15)) * 2) = kr[i];
              LAS unsigned char* vd = vb + ((c >> 5) * XK_VP + 8 * (c & 31)) * 2; *(LAS u32x2*)vd = (u32x2){vr[i].x, vr[i].y}; *(LAS u32x2*)(vd + 8) = (u32x2){vr[i].z, vr[i].w}; } }
        __syncthreads();
        const int q0 = tb * 256 + F.wave * 32;
        bf16x8 qf[8];
        { const bf16* qp = P.b(WS_QX) + (size_t)(q0 + col) * 512 + hd * 128; const bf16* qp1 = P.b(WS_QH) + (size_t)(q0 + col) * 512 + hd * 128;
#pragma unroll
          for (int s = 0; s < 8; ++s) { const u32x4 a = *(const u32x4*)(qp + 16 * s + 8 * hi), b = *(const u32x4*)(qp1 + 16 * s + 8 * hi);
              qf[s] = __builtin_bit_cast(bf16x8, (u32x4){cvt_pk_bf16(bflo(a.x) + bflo(b.x), bfhi(a.x) + bfhi(b.x)), cvt_pk_bf16(bflo(a.y) + bflo(b.y), bfhi(a.y) + bfhi(b.y)),
                                                          cvt_pk_bf16(bflo(a.z) + bflo(b.z), bfhi(a.z) + bfhi(b.z)), cvt_pk_bf16(bflo(a.w) + bflo(b.w), bfhi(a.w) + bfhi(b.w))}); } }
        f32x16 o[4];
#pragma unroll
        for (int b = 0; b < 4; ++b)
#pragma unroll
            for (int r = 0; r < 16; ++r) o[b][r] = 0.f;
        float m_run = -INFINITY, l_run = 0.f;
        auto mask = [&](int, int) { return true; };
#pragma unroll
        for (int st = 0; st < 4; ++st) att_step64n<8, XK_KP, XK_VP, 4>(kb + st * 64 * XK_KP * 2, vb + st * 128, qf, o, m_run, l_run, 1.0f, false, mask, col, hi);
        const float l = l_run + __shfl_xor(l_run, 32); const float inv = l > 0.f ? 1.0f / l : 0.f;
        bf16* op = P.b(WS_OX) + (size_t)(q0 + col) * 512 + hd * 128;
#pragma unroll
        for (int b = 0; b < 4; ++b)
#pragma unroll
            for (int i = 0; i < 4; ++i) store4_bf16(op + 32 * b + 8 * i + 4 * hi, (f32x4){o[b][4 * i] * inv, o[b][4 * i + 1] * inv, o[b][4 * i + 2] * inv, o[b][4 * i + 3] * inv}); }
}

__device__ __forceinline__ void phase_ln(const Args& a, Frame& F, const LP& P, int gi, int bi) {
    const int l = P.l; const float* g = INF32(a, gi, D); const float* b = INF32(a, bi, D);
    RowRaw na, nb;
    if (2 * F.gw < S) { row_fetch(na, P.b(WS_Y) + (size_t)(2 * F.gw) * D, F.lane); row_fetch(nb, P.b(WS_Y) + (size_t)(2 * F.gw + 1) * D, F.lane); }
#pragma unroll 1
    for (int r = 2 * F.gw; r < S; r += 2 * F.NGW) { Row ra, rb; row_unpack(ra, na); row_unpack(rb, nb);
        const int rn = r + 2 * F.NGW;
        if (rn < S) { row_fetch(na, P.b(WS_Y) + (size_t)rn * D, F.lane); row_fetch(nb, P.b(WS_Y) + (size_t)(rn + 1) * D, F.lane); }
        row_layernorm2(ra, rb, g, b, F.lane);
        row_store_bf16(ra, P.b(WS_XB) + (size_t)r * D, F.lane); row_store_bf16(rb, P.b(WS_XB) + (size_t)(r + 1) * D, F.lane); }
}
__device__ __forceinline__ void phase_ln_router(const Args& a, Frame& F, const LP& P) {
    const int l = P.l, lane = F.lane, wave = F.wave, tid = F.tid; const float* g = INF32(a, 29, D); const float* b = INF32(a, 30, D);
    const float* bg = INF32(a, 32, 4); const float* br = INF32(a, 34, 32);
    int* toke = (int*)(P.ws + WS_MOE + MO_TOKE); float* tokw = (float*)(P.ws + WS_MOE + MO_TOKW); int* tokr = (int*)(P.ws + WS_MOE + MO_TOKP);
    unsigned* cnt = (unsigned*)(P.ws + WS_CTL) + CW_CNT + 128 * l;
    LAS float* lgs = (LAS float*)F.lds; LAS unsigned* hist = (LAS unsigned*)(F.lds + 131072); LAS unsigned* gbase = (LAS unsigned*)(F.lds + 131072 + 128);
    constexpr int RP = 264; LAS unsigned char* sxh = F.lds; LAS unsigned char* sxl = sxh + 64 * RP * 2; LAS unsigned char* swh = sxl + 64 * RP * 2; LAS unsigned char* swl = swh + 48 * RP * 2;
    const bf16* WRT = P.w(WO_WRT);
#pragma unroll 1
    for (int base = 64 * blockIdx.x; base < S; base += 64 * F.G) {
        if (tid < 32) hist[tid] = 0u;
        RowRaw na, nb; row_fetch(na, P.b(WS_Y) + (size_t)(base + 8 * wave) * D, lane); row_fetch(nb, P.b(WS_Y) + (size_t)(base + 8 * wave + 1) * D, lane);
#pragma unroll 1
        for (int i = 0; i < 8; i += 2) { const int r = base + 8 * wave + i; Row ra, rb; row_unpack(ra, na); row_unpack(rb, nb);
            if (i + 2 < 8) { row_fetch(na, P.b(WS_Y) + (size_t)(r + 2) * D, lane); row_fetch(nb, P.b(WS_Y) + (size_t)(r + 3) * D, lane); }
            row_layernorm2(ra, rb, g, b, lane);
            row_store_hilo(ra, P.b(WS_XB) + (size_t)r * D, P.b(WS_XLO) + (size_t)r * D, lane); row_store_hilo(rb, P.b(WS_XB) + (size_t)(r + 1) * D, P.b(WS_XLO) + (size_t)(r + 1) * D, lane); }
        VM_WAIT(); __syncthreads();
        int e1 = 0, e2 = 0, r1 = 0, r2 = 0; float w1 = 0.f, w2 = 0.f;
        { const int tt = wave & 3, kh = wave >> 2;
            const int rr = lane & 15, Gq = lane >> 4;
            f32x4 acc[3];
#pragma unroll
            for (int n = 0; n < 3; ++n) acc[n] = (f32x4){0.f, 0.f, 0.f, 0.f};
            u32x4 stg[14];
            auto gld = [&](int ch) { const int k0 = 256 * ch;
#pragma unroll
                for (int i = 0; i < 14; ++i) { const int c = tid + 512 * (i < 4 ? i : i < 8 ? i - 4 : i < 11 ? i - 8 : i - 11), row = c >> 5, pc = c & 31;
                    const bf16* src = i < 4 ? P.b(WS_XB) + (size_t)(base + row) * D : i < 8 ? P.b(WS_XLO) + (size_t)(base + row) * D : i < 11 ? WRT + (size_t)row * 2048 : WRT + (size_t)(48 + row) * 2048;
                    stg[i] = *(const u32x4*)(src + k0 + 8 * pc); } };
            gld(0);
#pragma unroll 1
            for (int ch = 0; ch < 8; ++ch) {
#pragma unroll
                for (int i = 0; i < 14; ++i) { const int c = tid + 512 * (i < 4 ? i : i < 8 ? i - 4 : i < 11 ? i - 8 : i - 11), row = c >> 5, pc = c & 31;
                    LAS unsigned char* dstb = i < 4 ? sxh : i < 8 ? sxl : i < 11 ? swh : swl; *(LAS u32x4*)(dstb + (row * RP + 8 * pc) * 2) = stg[i]; }
                __syncthreads();
                if (ch + 1 < 8) gld(ch + 1);
#pragma unroll
                for (int ks = 0; ks < 4; ++ks) { const int ko = (32 * (4 * kh + ks) + 8 * Gq) * 2;
                    const bf16x8 ah = *(const LAS bf16x8*)(sxh + (16 * tt + rr) * RP * 2 + ko), al = *(const LAS bf16x8*)(sxl + (16 * tt + rr) * RP * 2 + ko);
#pragma unroll
                    for (int n = 0; n < 3; ++n) { const bf16x8 bh = *(const LAS bf16x8*)(swh + (16 * n + rr) * RP * 2 + ko), bl = *(const LAS bf16x8*)(swl + (16 * n + rr) * RP * 2 + ko);
                        acc[n] = __builtin_amdgcn_mfma_f32_16x16x32_bf16(ah, bh, acc[n], 0, 0, 0); acc[n] = __builtin_amdgcn_mfma_f32_16x16x32_bf16(al, bh, acc[n], 0, 0, 0); acc[n] = __builtin_amdgcn_mfma_f32_16x16x32_bf16(ah, bl, acc[n], 0, 0, 0); } }
                __syncthreads(); }
            LAS float* lp = lgs + (kh * 4 + tt) * 768;
#pragma unroll
            for (int n = 0; n < 3; ++n)
#pragma unroll
                for (int i = 0; i < 4; ++i) lp[(4 * Gq + i) * 48 + 16 * n + rr] = acc[n][i]; }
        LDS_WAIT(); __syncthreads();
        if (wave < 4) {
            LAS float* lw_ = lgs + wave * 768;
            if (lane < 16) {
                const LAS float* lg = lw_ + lane * 48; const LAS float* lg2 = lg + 4 * 768;
                float gl[4]; int gs = 0;
#pragma unroll
                for (int e = 0; e < 4; ++e) gl[e] = (lg[e] + lg2[e]) + bg[e];
                float gmax = gl[0];
#pragma unroll
                for (int e = 1; e < 4; ++e) { if (gl[e] > gmax) { gmax = gl[e]; gs = e; } }
                float gsum = 0.f;
#pragma unroll
                for (int e = 0; e < 4; ++e) gsum += __expf(gl[e] - gmax);
                const float gwt = 1.0f / gsum;
                float el[8];
#pragma unroll
                for (int e = 0; e < 8; ++e) el[e] = (lg[4 + 8 * gs + e] + lg2[4 + 8 * gs + e]) + br[gs * 8 + e];
                int i1 = 0; float m1 = el[0];
#pragma unroll
                for (int e = 1; e < 8; ++e) if (el[e] > m1) { m1 = el[e]; i1 = e; }
                int i2 = -1; float m2 = -INFINITY;
#pragma unroll
                for (int e = 0; e < 8; ++e) if (e != i1 && el[e] > m2) { m2 = el[e]; i2 = e; }
                const float rx = __expf(m2 - m1); const float p1 = 1.0f / (1.0f + rx), p2 = rx * p1;
                e1 = gs * 8 + i1; e2 = gs * 8 + i2; w1 = gwt * p1; w2 = gwt * p2;
                r1 = (int)__hip_atomic_fetch_add(hist + e1, 1u, __ATOMIC_RELAXED, __HIP_MEMORY_SCOPE_WORKGROUP);
                r2 = (int)__hip_atomic_fetch_add(hist + e2, 1u, __ATOMIC_RELAXED, __HIP_MEMORY_SCOPE_WORKGROUP);
            }
        }
        LDS_WAIT(); __syncthreads();
        if (tid < 32) { const unsigned h = hist[tid]; gbase[tid] = h ? atomicAdd(cnt + tid, h) : 0u; }
        LDS_WAIT(); __syncthreads();
        if (wave < 4 && lane < 16) { const int t = base + 16 * wave + lane;
            toke[2 * t] = e1; toke[2 * t + 1] = e2; tokw[2 * t] = w1; tokw[2 * t + 1] = w2; tokr[2 * t] = (int)gbase[e1] + r1; tokr[2 * t + 1] = (int)gbase[e2] + r2; }
        __syncthreads();
    }
}
__device__ __forceinline__ void phase_moe_assign(Frame& F, const LP& P) {
    const int lane = F.lane;
    unsigned* cnt = (unsigned*)(P.ws + WS_CTL) + CW_CNT + 128 * P.l;
    const unsigned c = lane < 32 ? __hip_atomic_load(cnt + lane, __ATOMIC_RELAXED, __HIP_MEMORY_SCOPE_AGENT) : 0u;
    const unsigned padded = (c + 255u) & ~255u;
    unsigned incl = padded;
#pragma unroll
    for (int o = 1; o < 32; o <<= 1) { const unsigned v = __shfl_up(incl, o); if ((lane & 31) >= o) incl += v; }
    const unsigned pstart = incl - padded;
    if (F.gw == 0) {
        int* tile_e = (int*)(P.ws + WS_MOE + MO_TILEE); int* ntp = (int*)(P.ws + WS_MOE + MO_NT);
        if (lane < 32) for (unsigned r = pstart; r < incl; r += 256) tile_e[r >> 8] = lane;
        const unsigned total = __shfl(incl, 31); if (lane == 0) *ntp = (int)(total >> 8);
    }
    const int* toke = (const int*)(P.ws + WS_MOE + MO_TOKE); const float* tokw = (const float*)(P.ws + WS_MOE + MO_TOKW);
    int* tokp = (int*)(P.ws + WS_MOE + MO_TOKP); float* roww = (float*)(P.ws + WS_MOE + MO_ROWW); int* rowtok = (int*)(P.ws + WS_MOE + MO_ROWTOK);
    if (F.gw < 32) {
        const unsigned lo = __shfl(pstart, F.gw) + __shfl(c, F.gw), hi_ = __shfl(incl, F.gw);
        for (unsigned r = lo + lane; r < hi_; r += 64) { rowtok[r] = 0; roww[r] = 0.f; } }
#pragma unroll 1
    for (int i = F.gw * 64 + lane; i < 2 * S; i += F.NGW * 64) { const int e = toke[i];
        unsigned ps = 0u;
#pragma unroll
        for (int q = 0; q < 32; ++q) { const unsigned v = __shfl(pstart, q); ps = (e == q) ? v : ps; }
        const unsigned pos = (unsigned)tokp[i] + ps;
        tokp[i] = (int)pos; roww[pos] = tokw[i]; rowtok[pos] = i >> 1; }
}
__device__ __forceinline__ void phase_moe_combine(const Args& a, Frame& F, const LP& P, bool last) {
    const int l = P.l; const float* g = INF32(a, 37, D); const float* b = INF32(a, 38, D); const int* tokp = (const int*)(P.ws + WS_MOE + MO_TOKP);
    const int step = 2 * F.NGW; const int r0 = 2 * F.gw;
    RowRaw xa, xb_, ya0, ya1, yb0, yb1; int4 pn = {0, 0, 0, 0};
    if (r0 < S) { const int4 p = *(const int4*)(tokp + 2 * r0);
        row_fetch(xa, P.b(WS_XB) + (size_t)r0 * D, F.lane); row_fetch(xb_, P.b(WS_XB) + (size_t)(r0 + 1) * D, F.lane);
        row_fetch(ya0, P.b(WS_Y2) + (size_t)p.x * D, F.lane); row_fetch(yb0, P.b(WS_Y2) + (size_t)p.z * D, F.lane);
        row_fetch(ya1, P.b(WS_Y2) + (size_t)p.y * D, F.lane); row_fetch(yb1, P.b(WS_Y2) + (size_t)p.w * D, F.lane);
        if (r0 + step < S) pn = *(const int4*)(tokp + 2 * (r0 + step)); }
#pragma unroll 1
    for (int r = r0; r < S; r += step) { Row ra, rb;
        row_unpack(ra, xa); row_unpack(rb, xb_);
#pragma unroll
        for (int j = 0; j < 8; ++j) { ra.v[j] = ra.v[j] * DN_ALPHA; rb.v[j] = rb.v[j] * DN_ALPHA; }
        row_unpack_add(ra, ya0); row_unpack_add(rb, yb0); row_unpack_add(ra, ya1); row_unpack_add(rb, yb1);
        const int rn = r + step;
        if (rn < S) { const int4 p = pn;
            row_fetch(xa, P.b(WS_XB) + (size_t)rn * D, F.lane); row_fetch(xb_, P.b(WS_XB) + (size_t)(rn + 1) * D, F.lane);
            row_fetch(ya0, P.b(WS_Y2) + (size_t)p.x * D, F.lane); row_fetch(yb0, P.b(WS_Y2) + (size_t)p.z * D, F.lane);
            row_fetch(ya1, P.b(WS_Y2) + (size_t)p.y * D, F.lane); row_fetch(yb1, P.b(WS_Y2) + (size_t)p.w * D, F.lane);
            if (rn + step < S) pn = *(const int4*)(tokp + 2 * (rn + step)); }
        row_layernorm2(ra, rb, g, b, F.lane);
        if (last) { row_store_f32(ra, a.out + (size_t)r * D, F.lane); row_store_f32(rb, a.out + (size_t)(r + 1) * D, F.lane); }
        else { row_store_bf16(ra, P.b(WS_XB) + (size_t)r * D, F.lane); row_store_bf16(rb, P.b(WS_XB) + (size_t)(r + 1) * D, F.lane); } }
}

constexpr int NPH_LAYER = 17, NPHASES = 1 + DEPTH * NPH_LAYER;
__global__ void __launch_bounds__(NWAVES * 64, 2) mk_fwd(Args a) {
    extern __shared__ __attribute__((aligned(16))) unsigned char lds_raw[];
    Frame F;
    F.lds = (LAS unsigned char*)lds_raw;
    F.tid = threadIdx.x; F.lane = F.tid & 63; F.wave = __builtin_amdgcn_readfirstlane(F.tid >> 6);
    F.G = gridDim.x; F.gw = blockIdx.x * NWAVES + F.wave; F.NGW = F.G * NWAVES; F.ws = a.ws;
    volatile LAS unsigned* MISC = (volatile LAS unsigned*)(F.lds + MISC_OFF);
    if (F.tid < 32) MISC[F.tid] = 0u;
    __syncthreads();
    unsigned* ctl = (unsigned*)(a.ws + WS_CTL);
    XcdBarrier bar = xcd_barrier_post(ctl + CW_BAR + a.li * XCD_BAR_WORDS, MISC + 8);
    const int lo = a.ph_lo, hi = a.ph_hi;
#if defined(PHMASK)
#define IN(k) (((PHMASK >> (((k) == 0) ? 0 : (((k) - 1) % NPH_LAYER) + 1)) & 1) && lo <= (k) && (k) < hi)
#elif defined(PHSEL)
#define IN(k) ((((k) == 0) ? 0 : (((k) - 1) % NPH_LAYER) + 1) == PHSEL && lo <= (k) && (k) < hi)
#else
#define IN(k) (lo <= (k) && (k) < hi)
#endif
#define SEAM(k) do { if (IN((k) + 1)) xcd_barrier(bar); } while (0)
#ifdef DIAG_P1
#define STAMP(k) do { if (blockIdx.x == 0 && threadIdx.x == 0) ((volatile LAS unsigned long long*)(F.lds + MISC_OFF - 1024))[(k)] = wall_clock64(); } while (0)
#else
#define STAMP(k) do {} while (0)
#endif
#ifndef DUPMASK
#define DUPMASK 0
#endif
#define REPB(k) for (int rep_ = 0; rep_ < 1 + ((DUPMASK >> (k)) & 1); ++rep_) { if (rep_) xcd_barrier(bar);
#define REPE }
#define FRESH() do { int t_ = threadIdx.x; asm volatile("" : "+v"(t_)); F.tid = t_; F.lane = t_ & 63; F.wave = __builtin_amdgcn_readfirstlane(t_ >> 6); F.gw = blockIdx.x * NWAVES + F.wave; } while (0)
    const int G = F.G, bx = blockIdx.x;

    if (IN(0)) { FRESH(); STAMP(0); REPB(0) phase_prologue(a, F); REPE SEAM(0); }

    for (int l = 0; l < DEPTH; ++l) {
        LP P; P.ws = a.ws; P.wl = a.ws + WS_WL0 + (size_t)l * WS_WLSTRIDE; P.l = l;
        const int pb = 1 + NPH_LAYER * l;
        if (IN(pb + 0)) { FRESH(); STAMP(pb + 0); REPB(1) pg8::Gemm g{P.b(WS_XB), P.w(WO_WIN), D, D, D, nullptr}; pg8::StaticOrder so; so.init(S, NIN, G, bx);
            EpiIn E{P.b(WS_GATE), P.b(WS_U2), (const float*)(P.wl + WO_BIASP)}; pg8::gemm_phase(F.lds, g, so, E);
            { const int nun = (S / 256) * (NIN / 256), rem = nun % G, nlight = rem ? G - rem : G;
              FRESH(); if (bx >= G - nlight) memkv_items(P, (bx - (G - nlight)) * NWAVES + F.wave, nlight * NWAVES, F.lane); }
            REPE SEAM(pb + 0); }
        if (IN(pb + 1)) { FRESH(); STAMP(pb + 1); REPB(2) phase_prep(a, F, P); REPE SEAM(pb + 1); }
        if (IN(pb + 2)) { FRESH(); STAMP(pb + 2); REPB(3)
            { pg8::Gemm g{P.b(WS_U2) + U2_CQ, P.w(WO_WUQ), U2W, 512, 512, nullptr}; pg8::StaticOrder so; so.init(S, 768, G, bx);
              EpiQM<WS_QM, WS_RSTD, WS_ROPE> E{P.ws}; pg8::gemm_phase(F.lds, g, so, E); }
            { pg8::Gemm g{P.b(WS_U2) + U2_CKV, P.w(WO_WUKV), U2W, 256, 256, nullptr}; pg8::StaticOrder so; so.init(S, 1024, G, bx);
              EpiScale E{P.b(WS_KVH), 1024, P.f(WS_RSTD) + S, 1.0f, 0}; pg8::gemm_phase(F.lds, g, so, E); }
            phase_compress2(F, P); REPE SEAM(pb + 2); }
        if (IN(pb + 3)) { FRESH(); STAMP(pb + 3); REPB(4) phase_d(F, P); REPE SEAM(pb + 3); }
        if (IN(pb + 4)) { FRESH(); STAMP(pb + 4); REPB(5) phase_e(F, P); REPE SEAM(pb + 4); }
        if (IN(pb + 5)) { FRESH(); STAMP(pb + 5); REPB(6) phase_f(F, P); REPE SEAM(pb + 5); }
        if (IN(pb + 6)) { FRESH(); STAMP(pb + 6); REPB(7) pg8::Gemm g{P.b(WS_ABR), P.w(WO_WBR), D, D, D, nullptr}; pg8::StaticOrder so; so.init(S, D, G, bx);
            EpiMerge E{P.b(WS_GATE), P.b(WS_MERGED)};
            for (int sk_ = 0; sk_ < ((bx >> 3) & 3); ++sk_) __builtin_amdgcn_s_sleep(100);
            pg8::gemm_phase(F.lds, g, so, E); REPE SEAM(pb + 6); }
        if (IN(pb + 7)) { FRESH(); STAMP(pb + 7); REPB(8) pg8::Gemm g{P.b(WS_MERGED), P.w(WO_WOUT), D, D, D, nullptr}; pg8::StaticOrder so; so.init(S, D, G, bx);
            EpiResid E{P.b(WS_XB), P.b(WS_Y)}; pg8::gemm_phase(F.lds, g, so, E); REPE SEAM(pb + 7); }
        if (IN(pb + 8)) { FRESH(); STAMP(pb + 8); REPB(9) phase_ln(a, F, P, 23, 24); REPE SEAM(pb + 8); }
        if (IN(pb + 9)) { FRESH(); STAMP(pb + 9); REPB(10)
            { pg8::Gemm g{P.b(WS_XB), P.w(WO_WXQ), D, D, D / 2, nullptr}; pg8::StaticOrder so; so.init(S, 512, G, bx);
              EpiScale E{P.b(WS_QX), 512, nullptr, 0.08838834764831845f * LOG2E, 0}; pg8::gemm_phase(F.lds, g, so, E); }
            { pg8::Gemm g{P.b(WS_XB) + D / 2, P.w(WO_WXQ) + D / 2, D, D, D / 2, nullptr}; pg8::StaticOrder so; so.init(S, 512, G, (bx + G / 2) % G);
              EpiScale E{P.b(WS_QH), 512, nullptr, 0.08838834764831845f * LOG2E, 0}; pg8::gemm_phase(F.lds, g, so, E); }
            REPE SEAM(pb + 9); }
        if (IN(pb + 10)) { FRESH(); STAMP(pb + 10); REPB(11) phase_xattn(F, P); REPE SEAM(pb + 10); }
        if (IN(pb + 11)) { FRESH(); STAMP(pb + 11); REPB(12) pg8::Gemm g{P.b(WS_OX), P.w(WO_WXO), 512, 512, 512, nullptr}; pg8::StaticOrder so; so.init(S, D, G, bx);
            EpiResid E{P.b(WS_XB), P.b(WS_Y)}; pg8::gemm_phase(F.lds, g, so, E); REPE SEAM(pb + 11); }
        if (IN(pb + 12)) { FRESH(); STAMP(pb + 12); REPB(13) phase_ln_router(a, F, P); REPE SEAM(pb + 12); }
        if (IN(pb + 13)) { FRESH(); STAMP(pb + 13); REPB(14) phase_moe_assign(F, P); REPE SEAM(pb + 13); }
        if (IN(pb + 14)) { FRESH(); STAMP(pb + 14); REPB(15) const int* te = (const int*)(P.ws + WS_MOE + MO_TILEE); const int ntl = *(const int*)(P.ws + WS_MOE + MO_NT);
            const int nO = 4 * ntl, nO1 = nO < 2 * G ? nO : 2 * G;
            pg8::Gemm g{P.b(WS_XB), P.w(WO_WEIN), D, D, D, (const int*)(P.ws + WS_MOE + MO_ROWTOK)}; pg8::MoeOrderT<true> so{te, 4, G, bx, 0, nO1, 1 << 20, 0};
            EpiGlu E{P.b(WS_HS)}; pg8::gemm_phase(F.lds, g, so, E); REPE SEAM(pb + 14); }
        if (IN(pb + 15)) { FRESH(); STAMP(pb + 15); REPB(16) const int* te = (const int*)(P.ws + WS_MOE + MO_TILEE); const int ntl = *(const int*)(P.ws + WS_MOE + MO_NT);
            const int nO = 4 * ntl, nO1 = nO < 2 * G ? nO : 2 * G, nL = nO - nO1, rtA = nO1 / 4;
            { pg8::Gemm g1{P.b(WS_XB), P.w(WO_WEIN), D, D, D, (const int*)(P.ws + WS_MOE + MO_ROWTOK)}; pg8::MoeOrderT<true> so1{te, 4, G, bx, nO1, nO, 1 << 20, 0};
              EpiGlu E1{P.b(WS_HS)}; pg8::gemm_phase(F.lds, g1, so1, E1); }
            pg8::Gemm g{P.b(WS_HS), P.w(WO_WEOUT), 512, 512, 512, nullptr};
            EpiScale E{P.b(WS_Y2), D, (const float*)(P.ws + WS_MOE + MO_ROWW), 1.0f, 8};
            { const int nP1 = 8 * rtA; const int b_ = (nP1 + 3 * nL + G - 1) / G; const int a_ = b_ > 3 ? b_ - 3 : 0;
              FRESH(); pg8::MoeOrderT<false> so{te, 8, G, bx, 0, nP1, nL > 0 ? a_ : (1 << 20), nL}; pg8::gemm_phase(F.lds, g, so, E); }
            xcd_barrier(bar);
            { FRESH(); pg8::MoeOrderT<false> so{te, 8, G, bx, 8 * rtA, 8 * ntl, 1 << 20, 0}; pg8::gemm_phase(F.lds, g, so, E); }
            REPE SEAM(pb + 15); }
        if (IN(pb + 16)) { FRESH(); STAMP(pb + 16); REPB(17) phase_moe_combine(a, F, P, l == DEPTH - 1); REPE SEAM(pb + 16); }
    }
#ifdef DIAG_P1
    STAMP(NPHASES);
    __syncthreads();
    if (blockIdx.x == 0) {
        volatile LAS unsigned long long* ts = (volatile LAS unsigned long long*)(F.lds + MISC_OFF - 1024);
        const float t1 = (float)(ts[DIAG_P1 + DIAG_N1] - ts[DIAG_P1]) * 0.01f, t2 = (float)(ts[DIAG_P2 + DIAG_N2] - ts[DIAG_P2]) * 0.01f;
        const float c1 = sqrtf(t1 * 0.1f);
        for (size_t i = threadIdx.x; i < (size_t)S * D; i += 512) a.out[i] = (i == 0) ? t2 : c1;
    }
#endif
#undef IN
#undef SEAM
}

#ifndef MK_PER_PHASE
#define MK_PER_PHASE 0
#endif
extern "C" void kernel_launch(void* const* d_in, const int* in_sizes, int n_in, void* d_out, int out_size, void* d_ws, size_t ws_size, hipStream_t stream) {
    static int grid = 0;
    if (grid == 0) {
        if (n_in != 39 || out_size != S * D || ws_size < WS_END) { fprintf(stderr, "kernel_launch: unexpected problem (n_in %d, out %d, ws %zu)\n", n_in, out_size, ws_size); grid = -1; return; }
        int dev = 0, cus = 0;
        if (hipGetDevice(&dev) != hipSuccess || hipDeviceGetAttribute(&cus, hipDeviceAttributeMultiprocessorCount, dev) != hipSuccess) { grid = -1; return; }
        if (hipFuncSetAttribute((const void*)mk_fwd, hipFuncAttributeMaxDynamicSharedMemorySize, LDS_BYTES) != hipSuccess) { fprintf(stderr, "kernel_launch: hipFuncSetAttribute failed\n"); grid = -1; return; }
        int per_cu = 0;
        if (hipOccupancyMaxActiveBlocksPerMultiprocessor(&per_cu, (const void*)mk_fwd, NWAVES * 64, LDS_BYTES) != hipSuccess || per_cu < 1) fprintf(stderr, "kernel_launch: occupancy query reports %d\n", per_cu);
        (void)hipGetLastError();
        grid = cus;
    }
    if (grid < 0) return;
    if (hipMemsetAsync((char*)d_ws + WS_CTL, 0, CTL_ZERO_BYTES, stream) != hipSuccess) return;
    Args a{};
    for (int i = 0; i < 39; ++i) a.in[i] = d_in[i];
    a.out = (float*)d_out; a.ws = (unsigned char*)d_ws; a.pad = 0;
#if MK_PER_PHASE
#ifndef MK_LAST
#define MK_LAST NPHASES
#endif
    for (int p = 0; p < MK_LAST; ++p) { a.ph_lo = p; a.ph_hi = p + 1; a.li = p; hipLaunchKernelGGL(mk_fwd, dim3(grid), dim3(NWAVES * 64), LDS_BYTES, stream, a); }
#else
    a.ph_lo = 0; a.ph_hi = NPHASES; a.li = 0;
    hipLaunchKernelGGL(mk_fwd, dim3(grid), dim3(NWAVES * 64), LDS_BYTES, stream, a);
#endif
}
```
